# Optimizing an MI355X kernel written in HIP

```python
import math
import jax, jax.numpy as jnp
from jax import lax
import numpy as np

D_MODEL = 1024
BATCH = 4
SEQ = 4096
DEPTH = 2

GRID_W = 64
CTX_LEN = 256
Q_BLOCK = 128
EPS = 1e-6
ROPE_THETA = 10000.0

A_HEAD_DIM = 64
A_HEADS = D_MODEL // 128
A_KV_HEADS = A_HEADS // 4
A_GROUP = A_HEADS // A_KV_HEADS
A_Q = A_HEADS * A_HEAD_DIM
A_KV = A_KV_HEADS * A_HEAD_DIM
A_OUT = A_Q

B_CHANNELS = D_MODEL // 2
B_CONV_W = 31
B_IN = 2 * B_CHANNELS

C_HEADS = D_MODEL // 256
C_HEAD_DIM = 64
C_V_DIM = 2 * C_HEAD_DIM
C_QK = C_HEADS * 2 * C_HEAD_DIM
C_V = C_HEADS * C_V_DIM

N_BRANCH = 3
IN_SPLITS = [A_Q, A_KV, A_KV, B_IN, C_QK, C_QK, C_V, N_BRANCH * D_MODEL]
IN_WIDTH = sum(IN_SPLITS)
IN_OFFSETS = [int(v) for v in np.cumsum(IN_SPLITS)[:-1]]

D_FF = 256 * math.ceil(8 * D_MODEL / 3 / 256)
N_EXPERTS = 8
TOP_K = 2
D_FF_EXPERT = 7 * D_MODEL // 2
N_DENSE = (DEPTH + 1) // 2
N_MOE = DEPTH // 2

kernel_name = "hybrid_gqa_conformer_diffattn_moe_dit"


def rms_norm(x, g):
    xf = x.astype(jnp.float32)
    y = xf * lax.rsqrt(jnp.mean(xf * xf, axis=-1, keepdims=True) + EPS)
    return (y * g.astype(jnp.float32)).astype(x.dtype)


def layer_norm(x, g, b):
    xf = x.astype(jnp.float32)
    mu = jnp.mean(xf, axis=-1, keepdims=True)
    var = jnp.mean(jnp.square(xf - mu), axis=-1, keepdims=True)
    y = (xf - mu) * lax.rsqrt(var + EPS)
    return (y * g.astype(jnp.float32) + b.astype(jnp.float32)).astype(x.dtype)


def axial_rope_tables(seq, head_dim):
    rows = seq // GRID_W
    row = jnp.repeat(jnp.arange(rows), GRID_W)
    col = jnp.tile(jnp.arange(GRID_W), rows)
    n_freq = head_dim // 4
    inv = ROPE_THETA ** (-jnp.arange(n_freq, dtype=jnp.float32) / n_freq)
    pos = jnp.stack([row, col], axis=-1).astype(jnp.float32)
    ang = pos[:, :, None] * inv
    return jnp.cos(ang), jnp.sin(ang)


def apply_axial_rope(x, cos, sin):
    shp = x.shape
    xr = x.astype(jnp.float32).reshape(shp[:-1] + (2, 2, shp[-1] // 4))
    extra = x.ndim - 3
    cos = cos.reshape((cos.shape[0],) + (1,) * extra + cos.shape[1:])
    sin = sin.reshape((sin.shape[0],) + (1,) * extra + sin.shape[1:])
    x1, x2 = xr[..., 0, :], xr[..., 1, :]
    out = jnp.stack([x1 * cos - x2 * sin, x2 * cos + x1 * sin], axis=-2)
    return out.reshape(shp).astype(x.dtype)


def map_query_blocks(fn, q):
    b, s = q.shape[0], q.shape[1]
    qb = jnp.moveaxis(q.reshape((b, s // Q_BLOCK, Q_BLOCK) + q.shape[2:]), 1, 0)
    out = lax.map(fn, qb)
    out = jnp.moveaxis(out, 0, 1)
    return out.reshape((b, s) + out.shape[3:])


def gqa_attend(q, k, v):
    s = jnp.einsum('bqkgd,bskd->bkgqs', q, k).astype(jnp.float32) * (A_HEAD_DIM ** -0.5)
    p = jax.nn.softmax(s, axis=-1).astype(v.dtype)
    return jnp.einsum('bkgqs,bskd->bqkgd', p, v)


def diff_attend(q, k, v, lam):
    s = jnp.einsum('bqhmd,bshmd->bhmqs', q, k).astype(jnp.float32) * (C_HEAD_DIM ** -0.5)
    p = jax.nn.softmax(s, axis=-1)
    a = (p[:, :, 0] - lam * p[:, :, 1]).astype(v.dtype)
    return jnp.einsum('bhqs,bshd->bqhd', a, v)


def project_in(u, qn_g, kn_g):
    aq, ak, av, bz, cq, ck, cv, gt = jnp.split(u, IN_OFFSETS, axis=-1)
    b, t = u.shape[0], u.shape[1]
    aq = rms_norm(aq.reshape(b, t, A_KV_HEADS, A_GROUP, A_HEAD_DIM), qn_g)
    ak = rms_norm(ak.reshape(b, t, A_KV_HEADS, A_HEAD_DIM), kn_g)
    av = av.reshape(b, t, A_KV_HEADS, A_HEAD_DIM)
    cq = cq.reshape(b, t, C_HEADS, 2, C_HEAD_DIM)
    ck = ck.reshape(b, t, C_HEADS, 2, C_HEAD_DIM)
    cv = cv.reshape(b, t, C_HEADS, C_V_DIM)
    return aq, ak, av, bz, cq, ck, cv, gt


def conformer_conv(z, dw_w, dw_b, ln_g, ln_b):
    a, g = jnp.split(z, 2, axis=-1)
    y = a * jax.nn.sigmoid(g)
    pad = B_CONV_W // 2
    y = lax.conv_general_dilated(y, dw_w[:, None, :], window_strides=(1,), padding=[(pad, pad)],
                                 dimension_numbers=('NWC', 'WIO', 'NWC'),
                                 feature_group_count=B_CHANNELS) + dw_b
    return jax.nn.silu(layer_norm(y, ln_g, ln_b))


def mixer_merge(o_a, o_c, bz, gt, lam_init, subln_g, dw_w, dw_b, ln_g, ln_b, b_gate, w_pa, w_pb, w_pc, w_out):
    b, t = o_a.shape[0], o_a.shape[1]
    o_a = o_a.reshape(b, t, A_OUT)
    o_c = (rms_norm(o_c, subln_g) * (1.0 - lam_init)).reshape(b, t, C_V)
    o_b = conformer_conv(bz, dw_w, dw_b, ln_g, ln_b)
    g_a, g_b, g_c = jnp.split(jax.nn.sigmoid(gt + b_gate), N_BRANCH, axis=-1)
    m = g_a * (o_a @ w_pa) + g_b * (o_b @ w_pb) + g_c * (o_c @ w_pc)
    return m @ w_out


def swiglu(h, w1, w3, w2):
    return (jax.nn.silu(h @ w1) * (h @ w3)) @ w2


def moe_swiglu(h, w_r, b_r, w1, w3, w2):
    logits = (h @ w_r).astype(jnp.float32) + b_r.astype(jnp.float32)
    top_v, top_i = lax.top_k(logits, TOP_K)
    top_w = jax.nn.softmax(top_v, axis=-1)
    gates = jnp.sum(jax.nn.one_hot(top_i, N_EXPERTS, dtype=jnp.float32) * top_w[..., None], axis=-2).astype(h.dtype)
    out = jnp.zeros_like(h)
    for e in range(N_EXPERTS):
        out = out + gates[..., e:e + 1] * swiglu(h, w1[e], w3[e], w2[e])
    return out


def setup_inputs(seed: int = 0) -> dict:
    key = jax.random.key(seed)
    ks = iter(jax.random.split(key, 48))

    def nrm(shape, scale):
        return jax.random.normal(next(ks), shape, jnp.float32) * scale

    d = D_MODEL
    return {
        "x": nrm((BATCH, SEQ, d), 1.0),
        "c": nrm((BATCH, d), 1.0),
        "ctx": nrm((BATCH, CTX_LEN, d), 1.0),
        "c_ctx": nrm((d,), 1.0),
        "w_mod": nrm((DEPTH, d, 6 * d), 0.5 * d ** -0.5),
        "b_mod": nrm((DEPTH, 6 * d), 0.02),
        "norm1_g": 1.0 + nrm((DEPTH, d), 0.02),
        "norm2_g": 1.0 + nrm((DEPTH, d), 0.02),
        "w_in": nrm((DEPTH, d, IN_WIDTH), d ** -0.5),
        "b_gate": nrm((DEPTH, N_BRANCH * d), 0.02),
        "a_qn_g": 1.0 + nrm((DEPTH, A_HEAD_DIM), 0.02),
        "a_kn_g": 1.0 + nrm((DEPTH, A_HEAD_DIM), 0.02),
        "b_dw_w": nrm((DEPTH, B_CONV_W, B_CHANNELS), B_CONV_W ** -0.5),
        "b_dw_b": nrm((DEPTH, B_CHANNELS), 0.02),
        "b_ln_g": 1.0 + nrm((DEPTH, B_CHANNELS), 0.02),
        "b_ln_b": nrm((DEPTH, B_CHANNELS), 0.02),
        "c_lq1": nrm((DEPTH, C_HEAD_DIM), 0.1),
        "c_lk1": nrm((DEPTH, C_HEAD_DIM), 0.1),
        "c_lq2": nrm((DEPTH, C_HEAD_DIM), 0.1),
        "c_lk2": nrm((DEPTH, C_HEAD_DIM), 0.1),
        "c_subln_g": 1.0 + nrm((DEPTH, C_V_DIM), 0.02),
        "w_pa": nrm((DEPTH, A_OUT, d), A_OUT ** -0.5),
        "w_pb": nrm((DEPTH, B_CHANNELS, d), B_CHANNELS ** -0.5),
        "w_pc": nrm((DEPTH, C_V, d), C_V ** -0.5),
        "w_out": nrm((DEPTH, d, d), d ** -0.5),
        "ffn_w1": nrm((N_DENSE, d, D_FF), d ** -0.5),
        "ffn_w3": nrm((N_DENSE, d, D_FF), d ** -0.5),
        "ffn_w2": nrm((N_DENSE, D_FF, d), D_FF ** -0.5),
        "moe_router": nrm((N_MOE, d, N_EXPERTS), d ** -0.5),
        "moe_router_b": nrm((N_MOE, N_EXPERTS), 0.01),
        "moe_w1": nrm((N_MOE, N_EXPERTS, d, D_FF_EXPERT), d ** -0.5),
        "moe_w3": nrm((N_MOE, N_EXPERTS, d, D_FF_EXPERT), d ** -0.5),
        "moe_w2": nrm((N_MOE, N_EXPERTS, D_FF_EXPERT, d), D_FF_EXPERT ** -0.5),
        "final_g": 1.0 + nrm((d,), 0.02),
    }


def reference(x, c, ctx, c_ctx, w_mod, b_mod, norm1_g, norm2_g, w_in, b_gate,
              a_qn_g, a_kn_g, b_dw_w, b_dw_b, b_ln_g, b_ln_b,
              c_lq1, c_lk1, c_lq2, c_lk2, c_subln_g,
              w_pa, w_pb, w_pc, w_out,
              ffn_w1, ffn_w3, ffn_w2,
              moe_router, moe_router_b, moe_w1, moe_w3, moe_w2, final_g):
    seq = x.shape[1]
    cos, sin = axial_rope_tables(seq, A_HEAD_DIM)
    xc = ctx
    for i in range(DEPTH):
        last = i == DEPTH - 1
        mod = jnp.split((jax.nn.silu(c) @ w_mod[i] + b_mod[i])[:, None, :], 6, axis=-1)
        modc = jnp.split((jax.nn.silu(c_ctx) @ w_mod[i] + b_mod[i])[None, None, :], 6, axis=-1)

        h = rms_norm(x, norm1_g[i]) * (1.0 + mod[1]) + mod[0]
        hc = rms_norm(xc, norm1_g[i]) * (1.0 + modc[1]) + modc[0]
        aq, ak, av, bz, cq, ck, cv, gt = project_in(h @ w_in[i], a_qn_g[i], a_kn_g[i])
        aqc, akc, avc, bzc, cqc, ckc, cvc, gtc = project_in(hc @ w_in[i], a_qn_g[i], a_kn_g[i])
        aq = apply_axial_rope(aq, cos, sin)
        ak = apply_axial_rope(ak, cos, sin)
        cq = apply_axial_rope(cq, cos, sin)
        ck = apply_axial_rope(ck, cos, sin)

        lam_init = 0.8 - 0.6 * math.exp(-0.3 * i)
        lam = (jnp.exp(jnp.sum(c_lq1[i].astype(jnp.float32) * c_lk1[i].astype(jnp.float32)))
               - jnp.exp(jnp.sum(c_lq2[i].astype(jnp.float32) * c_lk2[i].astype(jnp.float32)))
               + lam_init)

        k_a = jnp.concatenate([ak, akc], axis=1)
        v_a = jnp.concatenate([av, avc], axis=1)
        o_a = map_query_blocks(lambda qb: gqa_attend(qb, k_a, v_a), aq)
        k_c = jnp.concatenate([ck, ckc], axis=1)
        v_c = jnp.concatenate([cv, cvc], axis=1)
        o_c = map_query_blocks(lambda qb: diff_attend(qb, k_c, v_c, lam), cq)
        y = mixer_merge(o_a, o_c, bz, gt, lam_init, c_subln_g[i], b_dw_w[i], b_dw_b[i], b_ln_g[i], b_ln_b[i],
                        b_gate[i], w_pa[i], w_pb[i], w_pc[i], w_out[i])
        x = x + mod[2] * y

        if not last:
            o_ac = gqa_attend(aqc, akc, avc)
            o_cc = diff_attend(cqc, ckc, cvc, lam)
            yc = mixer_merge(o_ac, o_cc, bzc, gtc, lam_init, c_subln_g[i], b_dw_w[i], b_dw_b[i], b_ln_g[i],
                             b_ln_b[i], b_gate[i], w_pa[i], w_pb[i], w_pc[i], w_out[i])
            xc = xc + modc[2] * yc

        j = i // 2
        h2 = rms_norm(x, norm2_g[i]) * (1.0 + mod[4]) + mod[3]
        if i % 2 == 0:
            x = x + mod[5] * swiglu(h2, ffn_w1[j], ffn_w3[j], ffn_w2[j])
        else:
            x = x + mod[5] * moe_swiglu(h2, moe_router[j], moe_router_b[j], moe_w1[j], moe_w3[j], moe_w2[j])
        if not last:
            h2c = rms_norm(xc, norm2_g[i]) * (1.0 + modc[4]) + modc[3]
            if i % 2 == 0:
                xc = xc + modc[5] * swiglu(h2c, ffn_w1[j], ffn_w3[j], ffn_w2[j])
            else:
                xc = xc + modc[5] * moe_swiglu(h2c, moe_router[j], moe_router_b[j], moe_w1[j], moe_w3[j],
                                               moe_w2[j])
    return rms_norm(x, final_g)
```

```cpp
#include <hip/hip_runtime.h>
#include <cstdint>
#include <cstdio>


#ifndef MEGA_MASK
#define MEGA_MASK 0x1FFFFF
#endif
#define ALL_MEGA ((MEGA_MASK) == 0x1FFFFF)
typedef unsigned short bf16;
typedef float f32x4 __attribute__((ext_vector_type(4)));
typedef unsigned u32x4 __attribute__((ext_vector_type(4)));
typedef unsigned u32x2 __attribute__((ext_vector_type(2)));

constexpr int D = 1024, NB = 4, SEQ = 4096, CTXL = 256;
constexpr int M_LAT = NB * SEQ, M_CTX = NB * CTXL, MT = M_LAT + M_CTX;
constexpr int NKEY = SEQ + CTXL;
constexpr int IN_W = 6400;
constexpr int DFF = 2816, DFFX = 3584, NEXP = 8;
constexpr int RMAX = 34816;
constexpr float EPS = 1e-6f;
constexpr float C2 = 0.125f * 1.4426950408889634f;

constexpr size_t MiB = 1u << 20;
constexpr size_t WS_CTL = 0, CTL_ZERO_BYTES = 1 * MiB;
constexpr size_t WS_MODV = 1 * MiB;
constexpr size_t WS_ROPE = WS_MODV + 256 * 1024;
constexpr size_t WS_LAM = WS_ROPE + 16 * 1024;
constexpr size_t WS_TOKE = 2 * MiB;
constexpr size_t WS_TOKS = WS_TOKE + 128 * 1024;
constexpr size_t WS_TOKP = WS_TOKS + 128 * 1024;
constexpr size_t WS_EXPP = 3 * MiB;
constexpr size_t WS_XSC = 4 * MiB;
constexpr size_t WS_MOE13 = 8 * MiB;
constexpr size_t WS_XB = 64 * MiB;
constexpr size_t WS_CPF = 96 * MiB;
constexpr size_t WS_CPO = 148 * MiB;
constexpr size_t WS_MOE2 = 120 * MiB;
constexpr size_t WS_A2 = 176 * MiB;
constexpr size_t WS_WIN = WS_A2;
constexpr size_t WS_WP = WS_WIN + 2 * (size_t)IN_W * D * 2;
constexpr size_t WS_WOUT = WS_WP + 2 * (size_t)D * 1536 * 2;
constexpr size_t WS_FFN13 = WS_WOUT + 2 * (size_t)D * D * 2;
constexpr size_t WS_FFN2 = WS_FFN13 + (size_t)2 * DFF * D * 2;
constexpr size_t WS_U = 228 * MiB;
static_assert(WS_FFN2 + (size_t)D * DFF * 2 <= WS_U, "A2");
static_assert(WS_MOE13 + (size_t)8 * 7168 * 1024 <= WS_XB && WS_XB + (size_t)M_LAT * D * 2 <= WS_CPF && WS_CPF + (size_t)11 * 1024 * 1024 * 2 <= WS_MOE2 && WS_MOE2 + (size_t)8 * 1024 * 3584 <= WS_CPO && WS_CPO + (size_t)4 * 1024 * 1024 * 2 <= WS_A2, "XB / ctx partials");
constexpr size_t WS_QA = WS_U;
constexpr size_t WS_KA = WS_QA + (size_t)MT * 512 * 2;
constexpr size_t WS_VA = WS_KA + (size_t)MT * 128 * 2;
constexpr size_t WS_Y = WS_VA + (size_t)MT * 128 * 2;
constexpr size_t WS_QC = WS_Y + (size_t)MT * 512 * 2;
constexpr size_t WS_KC = WS_QC + (size_t)MT * 512 * 2;
constexpr size_t WS_VC = WS_KC + (size_t)MT * 512 * 2;
constexpr size_t WS_G = WS_VC + (size_t)MT * 512 * 2;
constexpr size_t WS_OABC = WS_G + (size_t)MT * 3072 * 2;
constexpr size_t WS_H = WS_OABC;
constexpr size_t WS_H8 = WS_H + (size_t)MT * D * 2;
constexpr size_t WS_OCR = WS_OABC + (size_t)MT * 1536 * 2;
constexpr size_t WS_MB = WS_OCR;
constexpr size_t WS_END = WS_OCR + (size_t)MT * 1024 * 2;
constexpr size_t WS_HMID = WS_U;
static_assert(WS_HMID + (size_t)MT * DFF * 2 <= WS_G, "HMID overlay");
constexpr size_t WS_H2P = WS_A2;
constexpr size_t WS_HMX = WS_H2P + (size_t)RMAX * D * 2;
constexpr size_t WS_H2PX = WS_HMX + (size_t)RMAX * DFFX;
constexpr size_t WS_YPT = WS_H2PX + (size_t)8 * 16384 * D;
constexpr size_t WS_END2 = WS_YPT + (size_t)7 * 2048 * 1024 * 2;
static_assert(WS_HMX + (size_t)RMAX * DFFX * 2 <= WS_END2 && WS_END2 <= 582000000, "HMX overlay");
static_assert(WS_H2P + (size_t)RMAX * D * 2 <= WS_H, "H2P must not overlap H");

constexpr int CW_CNT = 64;

__device__ __forceinline__ float bf2f(bf16 v) { return __uint_as_float(((unsigned)v) << 16); }
__device__ __forceinline__ unsigned f2bf(float f) { unsigned u = __float_as_uint(f); return (u + 0x7fffu + ((u >> 16) & 1u)) >> 16; }
typedef float f32x2_pk __attribute__((ext_vector_type(2))); typedef __bf16 bf16x2_pk __attribute__((ext_vector_type(2)));
__device__ __forceinline__ unsigned pk2(float lo, float hi) { f32x2_pk v = {lo, hi}; bf16x2_pk b = __builtin_convertvector(v, bf16x2_pk); return __builtin_bit_cast(unsigned, b); }
__device__ __forceinline__ float sigmoidf_(float x) { return 1.f / (1.f + __expf(-x)); }
__device__ __forceinline__ float siluf_(float x) { return x * __builtin_amdgcn_rcpf(1.f + __expf(-x)); }
__device__ __forceinline__ float rsq_(float x) { return __builtin_amdgcn_rsqf(x); }
template <int CTRL> __device__ __forceinline__ float dpp_mov(float v) { return __builtin_bit_cast(float, __builtin_amdgcn_update_dpp(0, __builtin_bit_cast(int, v), CTRL, 0xf, 0xf, true)); }
__device__ __forceinline__ float xsum_row16(float v) {
    v += dpp_mov<0xB1>(v); v += dpp_mov<0x4E>(v); v += dpp_mov<0x141>(v); v += dpp_mov<0x140>(v); return v; }
__device__ __forceinline__ float xsum_x16(float v) { const auto rr = __builtin_amdgcn_permlane16_swap(__float_as_uint(v), __float_as_uint(v), false, false); return __uint_as_float(rr[0]) + __uint_as_float(rr[1]); }
__device__ __forceinline__ float xsum_x32(float v) { const auto rr = __builtin_amdgcn_permlane32_swap(__float_as_uint(v), __float_as_uint(v), false, false); return __uint_as_float(rr[0]) + __uint_as_float(rr[1]); }
__device__ __forceinline__ float wave_sum(float v) { return xsum_x32(xsum_x16(xsum_row16(v))); }
__host__ __device__ __forceinline__ int pcol5(int j) { return 8 * ((j >> 2) & 3) + 4 * ((j >> 4) & 1) + (j & 3); }
__host__ __device__ __forceinline__ int pcol(int c) { return (c & ~31) | pcol5(c & 31); }
__device__ __forceinline__ int keyrow(int r) { return r < M_LAT ? (r / SEQ) * NKEY + (r % SEQ) : ((r - M_LAT) / CTXL) * NKEY + SEQ + ((r - M_LAT) % CTXL); }
__device__ __forceinline__ int bidx(int r) { return r < M_LAT ? r / SEQ : 4; }

struct P {
    const float* in[34];
    float* out;
    unsigned char* ws;
};
__device__ __forceinline__ const float* modv(const P& p, int l, int bi, int j) { return (const float*)(p.ws + WS_MODV) + ((size_t)(l * 5 + bi) * 6 + j) * D; }
__device__ __forceinline__ float* xs_row(const P& p, int r) { return r < M_LAT ? p.out + (size_t)r * D : (float*)(p.ws + WS_XSC) + (size_t)(r - M_LAT) * D; }
__device__ __forceinline__ f32x4 ld_bf4(const bf16* q) { const u32x2 a = *(const u32x2*)q; return (f32x4){__uint_as_float(a.x << 16), __uint_as_float(a.x & 0xffff0000u), __uint_as_float(a.y << 16), __uint_as_float(a.y & 0xffff0000u)}; }
__device__ __forceinline__ const float* x0_row(const P& p, int r) { return r < M_LAT ? p.in[0] + (size_t)r * D : p.in[2] + (size_t)(r - M_LAT) * D; }

__host__ __device__ __forceinline__ int win_src_col(int np) {
    const int pn = np >> 8, c = np & 255, bj = c >> 7, hh = (c >> 5) & 3, j32 = c & 31, d = 32 * bj + j32;
    if (pn < 2) return (4 * pn + hh) * 64 + d;
    if (pn == 2) return hh < 2 ? 512 + hh * 64 + d : 640 + (hh - 2) * 64 + d;
    if (pn < 7) { const int ch = (pn - 3) * 128 + pcol(c & 127); return 768 + (bj ? 512 : 0) + ch; }
    if (pn < 9) return 1792 + (4 * (pn - 7) + hh) * 64 + d;
    if (pn < 11) return 2304 + (4 * (pn - 9) + hh) * 64 + d;
    if (pn < 13) return 2816 + (pn - 11) * 256 + pcol(c);
    return 3328 + (pn - 13) * 256 + pcol(c);
}
__device__ __forceinline__ void xpose_block(const float* src, int ldn, int k0, int scol, bf16* dst, int ldk, float* scr, int lane) {
    float ld_[32];
#pragma unroll
    for (int i = 0; i < 32; ++i) ld_[i] = src[(size_t)(k0 + 2 * i + (lane >> 5)) * ldn + scol];
#pragma unroll
    for (int i = 0; i < 32; ++i) scr[(2 * i + (lane >> 5)) * 33 + (lane & 31)] = ld_[i];
    asm volatile("s_waitcnt lgkmcnt(0)" ::: "memory");
    const int c = lane & 7;
#pragma unroll
    for (int j = 0; j < 4; ++j) { const int n = (lane >> 3) + 8 * j; const float* s = scr + (8 * c) * 33 + n;
        u32x4 o; o.x = pk2(s[0 * 33], s[1 * 33]); o.y = pk2(s[2 * 33], s[3 * 33]); o.z = pk2(s[4 * 33], s[5 * 33]); o.w = pk2(s[6 * 33], s[7 * 33]);
        *(u32x4*)(dst + (size_t)n * ldk + 8 * c) = o; }
    asm volatile("s_waitcnt lgkmcnt(0)" ::: "memory");
}
__device__ __forceinline__ unsigned pk4_fp8(float a, float b, float c, float d) { unsigned w = __builtin_amdgcn_cvt_pk_fp8_f32(a, b, 0u, false); return __builtin_amdgcn_cvt_pk_fp8_f32(c, d, w, true); }
__device__ __forceinline__ void xpose_block_f8(const float* src, int ldn, int k0, int scol, unsigned char* dst, int ldk, float* scr, int lane, float sc) {
    float ld_[32];
#pragma unroll
    for (int i = 0; i < 32; ++i) ld_[i] = src[(size_t)(k0 + 2 * i + (lane >> 5)) * ldn + scol];
#pragma unroll
    for (int i = 0; i < 32; ++i) scr[(2 * i + (lane >> 5)) * 33 + (lane & 31)] = ld_[i];
    asm volatile("s_waitcnt lgkmcnt(0)" ::: "memory");
    const int c = lane & 7;
#pragma unroll
    for (int j = 0; j < 4; ++j) { const int n = (lane >> 3) + 8 * j; const float* s = scr + (8 * c) * 33 + n;
        u32x2 o; o.x = pk4_fp8(s[0 * 33] * sc, s[1 * 33] * sc, s[2 * 33] * sc, s[3 * 33] * sc); o.y = pk4_fp8(s[4 * 33] * sc, s[5 * 33] * sc, s[6 * 33] * sc, s[7 * 33] * sc);
        *(u32x2*)(dst + (size_t)n * ldk + 8 * c) = o; }
    asm volatile("s_waitcnt lgkmcnt(0)" ::: "memory");
}
constexpr float F8_W13 = 32.f, F8_W2 = 64.f, F8_HM = 4.f;
constexpr int SC_W13 = 0x7a7a7a7a, SC_W2 = 0x79797979, SC_HM = 0x7d7d7d7d, SC_ONE = 0x7f7f7f7f;
constexpr int IT_WIN = 16 * 200, IT_WP = 8 * 32, IT_WOUT = 16 * 32, IT_F13 = 16 * 176, IT_F2 = 44 * 32, IT_M13 = 16 * 224, IT_M2 = 56 * 32;
constexpr int IT_EARLY = 2 * IT_WIN + 6 * IT_WP + 2 * IT_WOUT + IT_F13 + IT_F2;
constexpr int IT_TOTAL = IT_EARLY + 8 * IT_M13 + 8 * IT_M2;
constexpr int IT_PRO = IT_EARLY;
constexpr int L1A0 = IT_WIN, L1A1 = 2 * IT_WIN, L1B0 = 2 * IT_WIN + 3 * IT_WP, L1B1 = 2 * IT_WIN + 6 * IT_WP, L1C0 = L1B1 + IT_WOUT, L1C1 = L1B1 + 2 * IT_WOUT;
constexpr int N_L1 = (L1A1 - L1A0) + (L1B1 - L1B0) + (L1C1 - L1C0), N_PRO = IT_EARLY - N_L1;
__host__ __device__ __forceinline__ int pro_item(int j) {
    if (j < L1A0) return j; j += L1A1 - L1A0;
    if (j < L1B0) return j; j += L1B1 - L1B0;
    if (j < L1C0) return j; return j + (L1C1 - L1C0); }
__host__ __device__ __forceinline__ int l1_item(int j) {
    if (j < L1A1 - L1A0) return L1A0 + j; j -= L1A1 - L1A0;
    if (j < L1B1 - L1B0) return L1B0 + j; j -= L1B1 - L1B0;
    return L1C0 + j; }
constexpr int IT_DEF1 = IT_EARLY + 30000, IT_DEF2 = IT_DEF1 + 4000;
__device__ __forceinline__ void prep_item(const P& p, int it, float* scr, int lane) {
    const int nl = lane & 31;
    if (it < 2 * IT_WIN) { const int l = it / IT_WIN, r = it % IT_WIN, kb = r / 200, nb = r % 200;
        xpose_block(p.in[8] + (size_t)l * D * IN_W, IN_W, 64 * kb, win_src_col(32 * nb + nl), (bf16*)(p.ws + WS_WIN) + (size_t)l * IN_W * D + (size_t)(32 * nb) * D + 64 * kb, D, scr, lane); return; }
    it -= 2 * IT_WIN;
    if (it < 6 * IT_WP) { const int l = it / (3 * IT_WP), r3 = it % (3 * IT_WP), br = r3 / IT_WP, r = r3 % IT_WP, kb = r / 32, nb = r % 32;
        xpose_block((br == 0 ? p.in[21] : br == 1 ? p.in[22] : p.in[23]) + (size_t)l * 512 * D, D, 64 * kb, pcol(32 * nb + nl), (bf16*)(p.ws + WS_WP) + (size_t)l * D * 1536 + (size_t)(32 * nb) * 1536 + br * 512 + 64 * kb, 1536, scr, lane); return; }
    it -= 6 * IT_WP;
    if (it < 2 * IT_WOUT) { const int l = it / IT_WOUT, r = it % IT_WOUT, kb = r / 32, nb = r % 32;
        xpose_block(p.in[24] + (size_t)l * D * D, D, 64 * kb, 32 * nb + nl, (bf16*)(p.ws + WS_WOUT) + (size_t)l * D * D + (size_t)(32 * nb) * D + 64 * kb, D, scr, lane); return; }
    it -= 2 * IT_WOUT;
    if (it < IT_F13) { const int kb = it / 176, nb = it % 176, np = 32 * nb + nl, c = np & 255, j = np >> 8;
        xpose_block(((c >> 7) ? p.in[26] : p.in[25]), DFF, 64 * kb, j * 128 + pcol(c & 127), (bf16*)(p.ws + WS_FFN13) + (size_t)(32 * nb) * D + 64 * kb, D, scr, lane); return; }
    it -= IT_F13;
    if (it < IT_F2) { const int kb = it / 32, nb = it % 32;
        xpose_block(p.in[27], D, 64 * kb, 32 * nb + nl, (bf16*)(p.ws + WS_FFN2) + (size_t)(32 * nb) * DFF + 64 * kb, DFF, scr, lane); return; }
    it -= IT_F2;
    if (it < 8 * IT_M13) { const int e = it / IT_M13, r = it % IT_M13, kb = r / 224, nb = r % 224, np = 32 * nb + nl, c = np & 255, j = np >> 8;
        xpose_block_f8(((c >> 7) ? p.in[31] : p.in[30]) + (size_t)e * D * DFFX, DFFX, 64 * kb, j * 128 + pcol(c & 127), (unsigned char*)(p.ws + WS_MOE13) + (size_t)e * 7168 * D + (size_t)(32 * nb) * D + 64 * kb, D, scr, lane, F8_W13); return; }
    it -= 8 * IT_M13;
    { const int e = it / IT_M2, r = it % IT_M2, kb = r / 32, nb = r % 32;
        xpose_block_f8(p.in[32] + (size_t)e * DFFX * D, D, 64 * kb, pcol(32 * nb + nl), (unsigned char*)(p.ws + WS_MOE2) + (size_t)e * D * DFFX + (size_t)(32 * nb) * DFFX + 64 * kb, DFFX, scr, lane, F8_W2); }
}

__device__ __forceinline__ void ph_mod_item(const P& p, int item, float* lds, int tid) {
    const int l = item / 96, n0 = (item % 96) * 64, w = tid >> 6, lane = tid & 63;
    const float* wm = p.in[4] + (size_t)l * D * 6144 + (size_t)(128 * w) * 6144 + n0 + lane;
    float* sl = lds + 8 * 5 * 64;
    for (int i = tid; i < 5 * D; i += 512) { const float v = i < 4 * D ? p.in[1][i] : p.in[3][i - 4 * D]; sl[i] = siluf_(v); }
    __syncthreads();
    float a0 = 0.f, a1 = 0.f, a2 = 0.f, a3 = 0.f, a4 = 0.f;
#pragma unroll 32
    for (int k = 0; k < 128; ++k) { const float wv = wm[(size_t)k * 6144]; const int kk = 128 * w + k;
        a0 += sl[kk] * wv; a1 += sl[D + kk] * wv; a2 += sl[2 * D + kk] * wv; a3 += sl[3 * D + kk] * wv; a4 += sl[4 * D + kk] * wv; }
    lds[(w * 5 + 0) * 64 + lane] = a0; lds[(w * 5 + 1) * 64 + lane] = a1; lds[(w * 5 + 2) * 64 + lane] = a2; lds[(w * 5 + 3) * 64 + lane] = a3; lds[(w * 5 + 4) * 64 + lane] = a4;
    __syncthreads();
    if (tid < 320) { const int bi = tid >> 6; float s = 0.f;
#pragma unroll
        for (int ww = 0; ww < 8; ++ww) s += lds[(ww * 5 + bi) * 64 + lane];
        ((float*)(p.ws + WS_MODV))[(size_t)(l * 5 + bi) * 6144 + n0 + lane] = s + p.in[5][l * 6144 + n0 + lane]; }
    __syncthreads();
}
__device__ __forceinline__ void ph_misc(const P& p, int tid, int nthreads) {
    if (tid < 16) { const int f = tid;
        const double CS[16][2] = {{0.5403023058681397174, 0.84147098480789650665}, {0.84600911028170792533, 0.5331684399140228157}, {0.95041528025518286254, 0.31098359290718572638},
            {0.98423023447009458711, 0.17689218624615003844}, {0.9950041652780257661, 0.099833416646828152307}, {0.99841927779266443401, 0.056204499214692484859},
            {0.99950004166527780258, 0.031617506402433710095}, {0.99984189028361432743, 0.017781856879666127606}, {0.99995000041666527778, 0.0099998333341666646825},
            {0.99998418865336578085, 0.0056233836139601852304}, {0.99999500000416666528, 0.0031622723897082476155}, {0.99999841886158658243, 0.0017782784728035290072},
            {0.99999950000004166667, 0.00099999983333334166667}, {0.99999984188612115825, 0.0005623412955523593817}, {0.99999995000000041667, 0.0003162277607463751926},
            {0.99999998418861174082, 0.00017782794006665673962}};
        double C = 1.0, S = 0.0, c1 = 0.0, s1 = 0.0;
#pragma unroll
        for (int q = 0; q < 16; ++q) if (q == f) { c1 = CS[q][0]; s1 = CS[q][1]; }
        float* t = (float*)(p.ws + WS_ROPE);
        for (int pos = 0; pos < 64; ++pos) { t[pos * 16 + f] = (float)C; t[1024 + pos * 16 + f] = (float)S; const double nc = C * c1 - S * s1, ns = S * c1 + C * s1; C = nc; S = ns; } }
    if (tid < 2) { const int l = tid; float s1 = 0.f, s2 = 0.f;
        for (int k = 0; k < 64; ++k) { s1 += p.in[16][l * 64 + k] * p.in[17][l * 64 + k]; s2 += p.in[18][l * 64 + k] * p.in[19][l * 64 + k]; }
        const float li = 0.8f - 0.6f * expf(-0.3f * (float)l);
        float* t = (float*)(p.ws + WS_LAM); t[l] = expf(s1) - expf(s2) + li; t[2 + l] = li; }
}

__device__ __forceinline__ void norm_row(const float* xrow, const float* g, const float* sc, const float* sh, bf16* orow, int lane, f32x4 (&hv)[4]) {
    f32x4 v[4]; float s = 0.f;
#pragma unroll
    for (int j = 0; j < 4; ++j) { v[j] = *(const f32x4*)(xrow + 4 * lane + 256 * j); s += (v[j].x * v[j].x + v[j].y * v[j].y) + (v[j].z * v[j].z + v[j].w * v[j].w); }
    const float rinv = rsq_(wave_sum(s) * (1.f / D) + EPS);
#pragma unroll
    for (int j = 0; j < 4; ++j) { const int c = 4 * lane + 256 * j; const f32x4 gv = *(const f32x4*)(g + c), scv = *(const f32x4*)(sc + c), shv = *(const f32x4*)(sh + c);
        hv[j] = (v[j] * rinv * gv) * (1.f + scv) + shv;
        u32x2 o; o.x = pk2(hv[j].x, hv[j].y); o.y = pk2(hv[j].z, hv[j].w); *(u32x2*)(orow + c) = o; }
}
__device__ __forceinline__ void ph_norm(const P& p, int l, int which  , int nrows, int gw, int NGW, int lane) {
    const bool first = which == 0 && l == 0; const int lim = first ? nrows : M_LAT;
    const float* g = (which ? p.in[7] : p.in[6]) + l * D;
    f32x4 vc[4], vn[4];
#define NLOAD(R, V) do { if (first) { const float* xr_ = x0_row(p, (R)); _Pragma("unroll") for (int j = 0; j < 4; ++j) V[j] = *(const f32x4*)(xr_ + 4 * lane + 256 * j); } \
        else { const bf16* xb_ = (const bf16*)(p.ws + WS_XB) + (size_t)(R) * D; _Pragma("unroll") for (int j = 0; j < 4; ++j) V[j] = ld_bf4(xb_ + 4 * lane + 256 * j); } } while (0)
    int r = gw; if (r < lim) NLOAD(r, vc);
    for (; r < lim; r += NGW) {
        const int rn = r + NGW; if (rn < lim) NLOAD(rn, vn);
        const int bi = bidx(r); const float* sc = modv(p, l, bi, which ? 4 : 1); const float* sh = modv(p, l, bi, which ? 3 : 0);
        float s = 0.f;
#pragma unroll
        for (int j = 0; j < 4; ++j) s += (vc[j].x * vc[j].x + vc[j].y * vc[j].y) + (vc[j].z * vc[j].z + vc[j].w * vc[j].w);
        const float rinv = rsq_(wave_sum(s) * (1.f / D) + EPS);
#pragma unroll
        for (int j = 0; j < 4; ++j) { const int c = 4 * lane + 256 * j; const f32x4 gv = *(const f32x4*)(g + c), scv = *(const f32x4*)(sc + c), shv = *(const f32x4*)(sh + c);
            const f32x4 h = (vc[j] * rinv * gv) * (1.f + scv) + shv;
            { u32x2 o; o.x = pk2(h.x, h.y); o.y = pk2(h.z, h.w); *(u32x2*)((bf16*)(p.ws + WS_H) + (size_t)r * D + c) = o; } }
#pragma unroll
        for (int j = 0; j < 4; ++j) vc[j] = vn[j];
    }
#undef NLOAD
    if (first) return;
    for (; r < nrows; r += NGW) {
        const float* xr = xs_row(p, r); const int bi = bidx(r);
        {
            const int rc = r - M_LAT, nks = which == 1 ? 4 : 11; const bf16* P = (const bf16*)(p.ws + (which == 1 ? WS_CPO : WS_CPF)) + (size_t)rc * D;
            const float* base = which == 1 ? p.in[2] + (size_t)rc * D : xr; const float* gt = modv(p, 0, 4, which == 1 ? 2 : 5);
            const float* g = (which ? p.in[7] : p.in[6]) + l * D; const float* sc = modv(p, l, bi, which ? 4 : 1); const float* sh = modv(p, l, bi, which ? 3 : 0);
            f32x4 v[4]; float s = 0.f;
#pragma unroll
            for (int j = 0; j < 4; ++j) { const int c = 4 * lane + 256 * j; f32x4 y = (f32x4){0.f, 0.f, 0.f, 0.f};
                for (int ks = 0; ks < nks; ++ks) { const u32x2 a = *(const u32x2*)(P + (size_t)ks * 1024 * 1024 + c);
                    y.x += __uint_as_float(a.x << 16); y.y += __uint_as_float(a.x & 0xffff0000u); y.z += __uint_as_float(a.y << 16); y.w += __uint_as_float(a.y & 0xffff0000u); }
                v[j] = *(const f32x4*)(base + c) + *(const f32x4*)(gt + c) * y; s += (v[j].x * v[j].x + v[j].y * v[j].y) + (v[j].z * v[j].z + v[j].w * v[j].w);
                if (which == 1) *(f32x4*)((float*)(p.ws + WS_XSC) + (size_t)rc * D + c) = v[j]; }
            const float rinv = rsq_(wave_sum(s) * (1.f / D) + EPS); bf16* orow = (bf16*)(p.ws + WS_H) + (size_t)r * D;
#pragma unroll
            for (int j = 0; j < 4; ++j) { const int c = 4 * lane + 256 * j; const f32x4 gv = *(const f32x4*)(g + c), scv = *(const f32x4*)(sc + c), shv = *(const f32x4*)(sh + c);
                const f32x4 h = (v[j] * rinv * gv) * (1.f + scv) + shv;
                { u32x2 o; o.x = pk2(h.x, h.y); o.y = pk2(h.z, h.w); *(u32x2*)(orow + c) = o; } }
        }
    }
}
__device__ __forceinline__ void router_row(const P& p, int r, int lane, unsigned* rowbuf  , const f32x4 (&v)[4], const f32x4 (&wr)[32], int& e1, int& e2, float& p1, float& p2) {
    const int bi = bidx(r); f32x4 hv[4];
    {
        const float* g = p.in[7] + 1 * D; const float* sc = modv(p, 1, bi, 4); const float* sh = modv(p, 1, bi, 3);
        float s = 0.f;
#pragma unroll
        for (int j = 0; j < 4; ++j) s += (v[j].x * v[j].x + v[j].y * v[j].y) + (v[j].z * v[j].z + v[j].w * v[j].w);
        const float rinv = rsq_(wave_sum(s) * (1.f / D) + EPS);
#pragma unroll
        for (int j = 0; j < 4; ++j) { const int c = 4 * lane + 256 * j; const f32x4 gv = *(const f32x4*)(g + c), scv = *(const f32x4*)(sc + c), shv = *(const f32x4*)(sh + c);
            hv[j] = (v[j] * rinv * gv) * (1.f + scv) + shv; rowbuf[lane + 64 * j] = pk4_fp8(hv[j].x, hv[j].y, hv[j].z, hv[j].w); } }
    float lg[8];
#pragma unroll
    for (int e = 0; e < 8; ++e) lg[e] = 0.f;
#pragma unroll
    for (int j = 0; j < 4; ++j)
#pragma unroll
        for (int i = 0; i < 4; ++i) { const f32x4 w0 = wr[(4 * j + i) * 2], w1 = wr[(4 * j + i) * 2 + 1]; const float h = hv[j][i];
            lg[0] += h * w0.x; lg[1] += h * w0.y; lg[2] += h * w0.z; lg[3] += h * w0.w; lg[4] += h * w1.x; lg[5] += h * w1.y; lg[6] += h * w1.z; lg[7] += h * w1.w; }
#pragma unroll
    for (int e = 0; e < 8; ++e) lg[e] = wave_sum(lg[e]) + p.in[29][e];
    e1 = 0; float v1 = lg[0];
#pragma unroll
    for (int e = 1; e < 8; ++e) if (lg[e] > v1) { v1 = lg[e]; e1 = e; }
    e2 = -1; float v2 = -INFINITY;
#pragma unroll
    for (int e = 0; e < 8; ++e) if (e != e1 && lg[e] > v2) { v2 = lg[e]; e2 = e; }
    p1 = 1.f / (1.f + expf(v2 - v1)); p2 = 1.f - p1;
}
__device__ __forceinline__ void ph_router(const P& p, int wg, int nwg, int nw, unsigned char* lds, int tid) {
    unsigned* cnt = (unsigned*)(p.ws + WS_CTL) + CW_CNT;
    const int wave = tid >> 6, lane = tid & 63;
    int* sE = (int*)lds; float* sP = (float*)(lds + 1024); unsigned* sC = (unsigned*)(lds + 2048); int* sS = (int*)(lds + 3072);
    unsigned* rows = (unsigned*)(lds + 4096);
    const int per = 64 / nw;
    f32x4 wr[32];
#pragma unroll
    for (int j = 0; j < 4; ++j)
#pragma unroll
        for (int i = 0; i < 4; ++i) { const int k = 4 * lane + 256 * j + i; wr[(4 * j + i) * 2] = *(const f32x4*)(p.in[28] + (size_t)k * 8); wr[(4 * j + i) * 2 + 1] = *(const f32x4*)(p.in[28] + (size_t)k * 8 + 4); }
    for (int j0 = 0; (j0 * nwg + wg) * nw < M_LAT; j0 += per) {
        if (tid < 16) sC[tid] = 0u;
        if (tid < 128) sE[tid] = -1;
        __syncthreads();
        f32x4 xv[4], xn[4];
#define RLOAD(R, V) do { const bf16* xb_ = (const bf16*)(p.ws + WS_XB) + (size_t)(R) * D; _Pragma("unroll") for (int j = 0; j < 4; ++j) V[j] = ld_bf4(xb_ + 4 * lane + 256 * j); } while (0)
        { const int r0 = (j0 * nwg + wg) * nw + wave; if (r0 < M_LAT) RLOAD(r0, xv); }
        for (int jj = 0; jj < per; ++jj) { const int r = ((j0 + jj) * nwg + wg) * nw + wave, li = jj * nw + wave;
            { const int rnx = ((j0 + jj + 1) * nwg + wg) * nw + wave; if (jj + 1 < per && rnx < M_LAT) RLOAD(rnx, xn); }
            if (r < M_LAT) { int e1, e2; float p1, p2; router_row(p, r, lane, rows + li * 256, xv, wr, e1, e2, p1, p2);
                if (lane == 0) { sE[2 * li] = e1; sE[2 * li + 1] = e2; sP[2 * li] = p1; sP[2 * li + 1] = p2; atomicAdd(&sC[e1], 1u); atomicAdd(&sC[e2], 1u); } }
#pragma unroll
            for (int j = 0; j < 4; ++j) xv[j] = xn[j]; }
#undef RLOAD
        __syncthreads();
        if (tid < 8) sC[8 + tid] = sC[tid] ? atomicAdd(cnt + tid, sC[tid]) : 0u;
        __syncthreads();
        if (tid < 128) { const int e = sE[tid]; if (e >= 0) { int pre = 0; for (int q = 0; q < tid; ++q) pre += (sE[q] == e) ? 1 : 0;
                const int li = tid >> 1, jj = li / nw, w = li % nw, r = ((j0 + jj) * nwg + wg) * nw + w;
                const int slot = (int)sC[8 + e] + pre; sS[tid] = slot;
                ((int*)(p.ws + WS_TOKE))[2 * r + (tid & 1)] = e; ((int*)(p.ws + WS_TOKS))[2 * r + (tid & 1)] = slot; ((float*)(p.ws + WS_EXPP))[e * 16384 + slot] = sP[tid]; } }
        __syncthreads();
        for (int i = tid; i < 128 * 64; i += nw * 64) { const int pr = i >> 6, ck = i & 63, e = sE[pr]; if (e >= 0) { const u32x4 v = *(const u32x4*)(rows + (pr >> 1) * 256 + ck * 4);
                *(u32x4*)((unsigned char*)(p.ws + WS_H2PX) + ((size_t)e * 16384 + sS[pr]) * D + ck * 16) = v; } }
        __syncthreads();
    }
}
__device__ __forceinline__ void moe_bases(const P& p, int (&base)[9]) {
    const unsigned* cnt = (const unsigned*)(p.ws + WS_CTL) + CW_CNT; int b = 0;
#pragma unroll
    for (int e = 0; e < 8; ++e) { base[e] = b; b += (int)((cnt[e] + 255u) & ~255u); }
    base[8] = b;
}
__device__ __forceinline__ void ph_final(const P& p, int gw, int NGW, int lane) {
    int base[9]; moe_bases(p, base);
    const int* te = (const int*)(p.ws + WS_TOKE); const int* ts = (const int*)(p.ws + WS_TOKS);
#define FROWS(R, ROWS) do { _Pragma("unroll") for (int k = 0; k < 2; ++k) { const int e = te[2 * (R) + k]; int bs = 0; _Pragma("unroll") for (int q = 0; q < 8; ++q) bs = (q == e) ? base[q] : bs; ROWS[k] = bs + ts[2 * (R) + k]; } } while (0)
#define FLOAD(R, ROWS, XV, YA) do { const bf16* xb_ = (const bf16*)(p.ws + WS_XB) + (size_t)(R) * D; _Pragma("unroll") for (int j = 0; j < 4; ++j) { const int c = 4 * lane + 256 * j; XV[j] = *(const u32x2*)(xb_ + c); \
        _Pragma("unroll") for (int k = 0; k < 2; ++k) YA[k][j] = ROWS[k] < 32768 ? *(const u32x2*)((const bf16*)(p.ws + WS_H2P) + (size_t)ROWS[k] * D + c) : (u32x2){0u, 0u}; } } while (0)
    int r = gw; int rc[2] = {0, 0}, rn[2] = {0, 0}; u32x2 xc[4], ya[2][4], xn[4], yn[2][4];
    if (r < M_LAT) { FROWS(r, rc); FLOAD(r, rc, xc, ya); }
    for (; r < M_LAT; r += NGW) {
        const int rnx = r + NGW; if (rnx < M_LAT) { FROWS(rnx, rn); FLOAD(rnx, rn, xn, yn); }
        float* xr = p.out + (size_t)r * D; const float* g5 = modv(p, 1, bidx(r), 5);
        f32x4 v[4]; float s = 0.f;
#pragma unroll
        for (int j = 0; j < 4; ++j) { const int c = 4 * lane + 256 * j; const f32x4 g = *(const f32x4*)(g5 + c);
            const f32x4 x = (f32x4){__uint_as_float(xc[j].x << 16), __uint_as_float(xc[j].x & 0xffff0000u), __uint_as_float(xc[j].y << 16), __uint_as_float(xc[j].y & 0xffff0000u)};
            f32x4 y = (f32x4){0.f, 0.f, 0.f, 0.f};
#pragma unroll
            for (int k = 0; k < 2; ++k) { const u32x2 a = ya[k][j];
                y.x += __uint_as_float(a.x << 16); y.y += __uint_as_float(a.x & 0xffff0000u); y.z += __uint_as_float(a.y << 16); y.w += __uint_as_float(a.y & 0xffff0000u);
                if (rc[k] >= 32768) { for (int ks = 0; ks < 7; ++ks) { const u32x2 q = *(const u32x2*)((const bf16*)(p.ws + WS_YPT) + ((size_t)ks * 2048 + (rc[k] - 32768)) * D + c);
                    y.x += __uint_as_float(q.x << 16); y.y += __uint_as_float(q.x & 0xffff0000u); y.z += __uint_as_float(q.y << 16); y.w += __uint_as_float(q.y & 0xffff0000u); } } }
            v[j] = x + g * y; s += (v[j].x * v[j].x + v[j].y * v[j].y) + (v[j].z * v[j].z + v[j].w * v[j].w); }
        const float rinv = rsq_(wave_sum(s) * (1.f / D) + EPS);
#pragma unroll
        for (int j = 0; j < 4; ++j) { const int c = 4 * lane + 256 * j; *(f32x4*)(xr + c) = v[j] * rinv * *(const f32x4*)(p.in[33] + c); }
        rc[0] = rn[0]; rc[1] = rn[1];
#pragma unroll
        for (int j = 0; j < 4; ++j) { xc[j] = xn[j]; ya[0][j] = yn[0][j]; ya[1][j] = yn[1][j]; }
    }
#undef FROWS
#undef FLOAD
}
__device__ __forceinline__ void ph_occomb(const P& p, int l, int nrows, int gw, int NGW, int lane) {
    const float lam = ((const float*)(p.ws + WS_LAM))[l], li = ((const float*)(p.ws + WS_LAM))[2 + l];
    const int h = lane >> 4, dv = (lane & 15) * 8, half = dv >> 6, d = dv & 63;
    for (int r = gw; r < nrows; r += NGW) {
        const u32x4 a = *(const u32x4*)((const bf16*)(p.ws + WS_OCR) + (size_t)r * 1024 + ((h * 2 + 0) * 2 + half) * 64 + d);
        const u32x4 b = *(const u32x4*)((const bf16*)(p.ws + WS_OCR) + (size_t)r * 1024 + ((h * 2 + 1) * 2 + half) * 64 + d);
        float df[8]; float s = 0.f;
#pragma unroll
        for (int i = 0; i < 4; ++i) { df[2 * i] = __uint_as_float(a[i] << 16) - lam * __uint_as_float(b[i] << 16); df[2 * i + 1] = __uint_as_float(a[i] & 0xffff0000u) - lam * __uint_as_float(b[i] & 0xffff0000u); }
#pragma unroll
        for (int i = 0; i < 8; ++i) s += df[i] * df[i];
        s += __shfl_xor(s, 1); s += __shfl_xor(s, 2); s += __shfl_xor(s, 4); s += __shfl_xor(s, 8);
        const float rinv = (1.f - li) / sqrtf(s * (1.f / 128.f) + EPS);
        const float* sg = p.in[20] + l * 128 + dv;
        u32x4 o; o.x = pk2(df[0] * rinv * sg[0], df[1] * rinv * sg[1]); o.y = pk2(df[2] * rinv * sg[2], df[3] * rinv * sg[3]);
        o.z = pk2(df[4] * rinv * sg[4], df[5] * rinv * sg[5]); o.w = pk2(df[6] * rinv * sg[6], df[7] * rinv * sg[7]);
        *(u32x4*)((bf16*)(p.ws + WS_OABC) + (size_t)r * 1536 + 1024 + h * 128 + dv) = o;
    }
}
__device__ __forceinline__ void occomb_rows32(const P& p, int l, int row0, int h, int lane) {
    const float lam = ((const float*)(p.ws + WS_LAM))[l], li = ((const float*)(p.ws + WS_LAM))[2 + l];
    const int rsel = lane >> 4, dv = (lane & 15) * 8, half = dv >> 6, d = dv & 63;
    const float* sg = p.in[20] + l * 128 + dv;
    const f32x4 g0 = *(const f32x4*)sg, g1 = *(const f32x4*)(sg + 4);
#pragma unroll 2
    for (int it = 0; it < 8; ++it) { const int r = row0 + it * 4 + rsel;
        const u32x4 a = *(const u32x4*)((const bf16*)(p.ws + WS_OCR) + (size_t)r * 1024 + ((h * 2 + 0) * 2 + half) * 64 + d);
        const u32x4 b = *(const u32x4*)((const bf16*)(p.ws + WS_OCR) + (size_t)r * 1024 + ((h * 2 + 1) * 2 + half) * 64 + d);
        float df[8]; float s = 0.f;
#pragma unroll
        for (int i = 0; i < 4; ++i) { df[2 * i] = __uint_as_float(a[i] << 16) - lam * __uint_as_float(b[i] << 16); df[2 * i + 1] = __uint_as_float(a[i] & 0xffff0000u) - lam * __uint_as_float(b[i] & 0xffff0000u); }
#pragma unroll
        for (int i = 0; i < 8; ++i) s += df[i] * df[i];
        s += __shfl_xor(s, 1); s += __shfl_xor(s, 2); s += __shfl_xor(s, 4); s += __shfl_xor(s, 8);
        const float rinv = (1.f - li) / sqrtf(s * (1.f / 128.f) + EPS);
        u32x4 o; o.x = pk2(df[0] * rinv * g0.x, df[1] * rinv * g0.y); o.y = pk2(df[2] * rinv * g0.z, df[3] * rinv * g0.w);
        o.z = pk2(df[4] * rinv * g1.x, df[5] * rinv * g1.y); o.w = pk2(df[6] * rinv * g1.z, df[7] * rinv * g1.w);
        *(u32x4*)((bf16*)(p.ws + WS_OABC) + (size_t)r * 1536 + 1024 + h * 128 + dv) = o; }
}
constexpr int CONV_TILES_LAT = M_LAT / 64, CONV_TILES_ALL = CONV_TILES_LAT + M_CTX / 16;
constexpr int CONV_LDS_BYTES = 94 * 1024 + 16 * 512 * 4;
__device__ __forceinline__ void conv_tile(const P& p, int l, int tile, unsigned char* lds, int tid) {
    int s0, len, t0, nsub;
    if (tile < CONV_TILES_LAT) { s0 = (tile >> 6) * SEQ; len = SEQ; t0 = (tile & 63) * 64; nsub = 4; } else { const int q = tile - CONV_TILES_LAT; s0 = M_LAT + (q >> 4) * CTXL; len = CTXL; t0 = (q & 15) * 16; nsub = 1; }
    bf16* yin = (bf16*)lds;
    float* outs = (float*)(lds + 94 * 1024);
    const bf16* Y = (const bf16*)(p.ws + WS_Y);
    const int nin = 16 * nsub + 30;
    {
        u32x4 v[12];
#pragma unroll
        for (int q = 0; q < 12; ++q) { const int i = tid + q * 512, rr = i >> 6, ck = i & 63, tt = t0 - 15 + rr;
            v[q] = (u32x4){0u, 0u, 0u, 0u}; if (i < nin * 64 && tt >= 0 && tt < len) v[q] = *(const u32x4*)(Y + (size_t)(s0 + tt) * 512 + ck * 8); }
#pragma unroll
        for (int q = 0; q < 12; ++q) { const int i = tid + q * 512, rr = i >> 6, ck = i & 63; if (i < nin * 64) *(u32x4*)(yin + rr * 512 + ck * 8) = v[q]; } }
    const int ch = tid, wave = tid >> 6, lane = tid & 63;
    float w[31];
    const float* wp = p.in[12] + (size_t)l * 31 * 512 + ch;
#pragma unroll
    for (int j = 0; j < 31; ++j) w[j] = wp[j * 512];
    const float bias = p.in[13][l * 512 + ch];
    const f32x4 lg0 = *(const f32x4*)(p.in[14] + l * 512 + lane * 8), lg1 = *(const f32x4*)(p.in[14] + l * 512 + lane * 8 + 4);
    const f32x4 lb0 = *(const f32x4*)(p.in[15] + l * 512 + lane * 8), lb1 = *(const f32x4*)(p.in[15] + l * 512 + lane * 8 + 4);
    __syncthreads();
#pragma unroll 1
    for (int sb = 0; sb < nsub; ++sb) {
        float a[16];
#pragma unroll
        for (int o = 0; o < 16; ++o) a[o] = bias;
#pragma unroll
        for (int i = 0; i < 46; ++i) { const float x = bf2f(yin[(sb * 16 + i) * 512 + ch]);
#pragma unroll
            for (int o = 0; o < 16; ++o) { const int j = i - o; if (j >= 0 && j < 31) a[o] += x * w[j]; } }
#pragma unroll
        for (int o = 0; o < 16; ++o) outs[o * 512 + ch] = a[o];
        __syncthreads();
#pragma unroll
        for (int rr = 0; rr < 2; ++rr) { const int o = 2 * wave + rr;
            f32x4 v0 = *(const f32x4*)(outs + o * 512 + lane * 8), v1 = *(const f32x4*)(outs + o * 512 + lane * 8 + 4);
            const float mean = wave_sum((v0.x + v0.y) + (v0.z + v0.w) + (v1.x + v1.y) + (v1.z + v1.w)) * (1.f / 512.f);
            v0 = v0 - mean; v1 = v1 - mean;
            const float var = wave_sum((v0.x * v0.x + v0.y * v0.y) + (v0.z * v0.z + v0.w * v0.w) + (v1.x * v1.x + v1.y * v1.y) + (v1.z * v1.z + v1.w * v1.w)) * (1.f / 512.f);
            const float rstd = rsq_(var + EPS);
            v0 = v0 * rstd * lg0 + lb0; v1 = v1 * rstd * lg1 + lb1;
            u32x4 ov; ov.x = pk2(siluf_(v0.x), siluf_(v0.y)); ov.y = pk2(siluf_(v0.z), siluf_(v0.w)); ov.z = pk2(siluf_(v1.x), siluf_(v1.y)); ov.w = pk2(siluf_(v1.z), siluf_(v1.w));
            *(u32x4*)((bf16*)(p.ws + WS_OABC) + (size_t)(s0 + t0 + sb * 16 + o) * 1536 + 512 + lane * 8) = ov; }
        __syncthreads();
    }
}


namespace pg8 {
#define PG8_LAS __attribute__((address_space(3)))
typedef unsigned short bf16_t;
typedef short bf16x8 __attribute__((ext_vector_type(8)));
typedef float f32x4 __attribute__((ext_vector_type(4)));
typedef unsigned u32x4 __attribute__((ext_vector_type(4)));
constexpr int BM = 256, BK = 64, HALF = 128, HTB = HALF * BK * 2  , STAGE_BYTES = 8 * HTB, NXCD = 8, WGM = 8;

__host__ __device__ __forceinline__ int lds_byte(int r, int c) { const int st = (r >> 4) * 2 + (c >> 5), rr = r & 15, cc = c & 31, ob = rr * 64 + cc * 2; return st * 1024 + (ob ^ (((ob >> 9) & 1) << 5)); }
__host__ __device__ __forceinline__ void stage_rc(int b, int& R, int& C) { const int st = b / 1024, sb = b % 1024, swz = sb ^ (((sb >> 9) & 1) << 5); R = (st >> 1) * 16 + swz / 64; C = (st & 1) * 32 + (swz % 64) / 2; }
__host__ __device__ __forceinline__ int perm32(int rho) { const int n = rho >> 4, i = rho & 15; return 8 * (i >> 2) + 4 * n + (i & 3); }

typedef int v4i_t __attribute__((ext_vector_type(4))); typedef int v8i_t __attribute__((ext_vector_type(8)));
__device__ __forceinline__ v8i_t pg8_cat(bf16x8 a, bf16x8 b) { const v4i_t x = __builtin_bit_cast(v4i_t, a), y = __builtin_bit_cast(v4i_t, b); return __builtin_shufflevector(x, y, 0, 1, 2, 3, 4, 5, 6, 7); }
struct Unit { int pm, pn, ko, pa; };
struct Gemm { const bf16_t* A; const bf16_t* Bt; int M, N, K, ld; int sc_w, sc_a; int a_pa; };

struct StaticOrder {
    int nM, nN, nwg, G, c;
    __host__ __device__ void init(int M, int N, int G_, int c_) { nM = M / BM; nN = N / BM; nwg = nM * nN; G = G_; c = c_; }
    __host__ __device__ bool next(int i, Unit& u) const {
        const long L = (long)i * G + c; if (L >= nwg) return false;
        int wgid = (int)L; { const int q = nwg / NXCD, r = nwg % NXCD, xcd = wgid % NXCD, off = wgid / NXCD; wgid = (xcd < r ? xcd * (q + 1) : r * (q + 1) + (xcd - r) * q) + off; }
        const int nig = WGM * nN, gid = wgid / nig, fm = gid * WGM, gsz = (nM - fm) < WGM ? (nM - fm) : WGM;
        u.pm = fm + ((wgid % nig) % gsz); u.pn = (wgid % nig) / gsz; u.ko = 0; u.pa = u.pm; return true;
    }
    __device__ __forceinline__ void a_ready(const Unit&) const {}
    __device__ __forceinline__ void done(const Unit&) const {}
};


typedef float f32x2_cv __attribute__((ext_vector_type(2))); typedef __bf16 bf16x2_cv __attribute__((ext_vector_type(2)));
__device__ __forceinline__ unsigned cvt_pk_bf16(float lo, float hi) { f32x2_cv v = {lo, hi}; bf16x2_cv b = __builtin_convertvector(v, bf16x2_cv); return __builtin_bit_cast(unsigned, b); }
typedef float f32x2 __attribute__((ext_vector_type(2)));

struct InprojL1Order {
    StaticOrder so; int G, c;
    __device__ void init(int G_, int c_) { so.init(16384, 6400, G_, c_); G = G_; c = c_; }
    __device__ bool next(int i, Unit& u) const {
        const int L = i * G + c;
        if (L < 1600) return so.next(i, u);
        const int q = L - 1600; if (q >= 20) return false;
        const int k = q % 5; u.pm = 64 + q / 5; u.pn = k == 0 ? 2 : 8 + k; u.ko = 0; u.pa = u.pm; return true;
    }
    __device__ __forceinline__ void a_ready(const Unit&) const {}
    __device__ __forceinline__ void done(const Unit&) const {}
};
struct MoeOrder {
    StaticOrder so; int nper; int t1, t2, t3, t4, t5, t6, t7;
    __device__ void init(const int (&base)[9], int nper_, int G_, int c_, int max_tiles = 1 << 20) { const int nt_ = (base[8] >> 8) < max_tiles ? (base[8] >> 8) : max_tiles; so.init(nt_ * BM, nper_ * BM, G_, c_); nper = nper_;
        t1 = base[1] >> 8; t2 = base[2] >> 8; t3 = base[3] >> 8; t4 = base[4] >> 8; t5 = base[5] >> 8; t6 = base[6] >> 8; t7 = base[7] >> 8; }
    __device__ bool next(int i, Unit& u) const {
        if (!so.next(i, u)) return false;
        const int e = (u.pm >= t1) + (u.pm >= t2) + (u.pm >= t3) + (u.pm >= t4) + (u.pm >= t5) + (u.pm >= t6) + (u.pm >= t7);
        const int te = e == 0 ? 0 : e == 1 ? t1 : e == 2 ? t2 : e == 3 ? t3 : e == 4 ? t4 : e == 5 ? t5 : e == 6 ? t6 : t7;
        u.pn += e * nper; u.pa = e * 64 + (u.pm - te); return true;
    }
    __device__ __forceinline__ void a_ready(const Unit&) const {}
    __device__ __forceinline__ void done(const Unit&) const {}
};

struct CtxSliceOrder {
    int nks, G, c;
    __device__ void init(int nks_, int G_, int c_) { nks = nks_; G = G_; c = c_; }
    __device__ bool next(int i, Unit& u) const {
        const int s = i * G + c; if (s >= 16 * nks) return false;
        const int q = s / nks, r = s % nks; u.pm = 64 + (q >> 2); u.pn = q & 3; u.ko = r * 256; u.pa = u.pm; return true;
    }
    __device__ __forceinline__ void a_ready(const Unit&) const {}
    __device__ __forceinline__ void done(const Unit&) const {}
};
struct MoeTailOrder {
    int ntail, G, c; int t1, t2, t3, t4, t5, t6, t7;
    __device__ void init(const int (&base)[9], int G_, int c_) { ntail = (base[8] >> 8) - 128; G = G_; c = c_;
        t1 = base[1] >> 8; t2 = base[2] >> 8; t3 = base[3] >> 8; t4 = base[4] >> 8; t5 = base[5] >> 8; t6 = base[6] >> 8; t7 = base[7] >> 8; }
    __device__ bool next(int i, Unit& u) const {
        const int s = i * G + c; if (s >= ntail * 28) return false;
        const int tile = s / 28, r = s % 28; u.pm = 128 + tile;
        const int e = (u.pm >= t1) + (u.pm >= t2) + (u.pm >= t3) + (u.pm >= t4) + (u.pm >= t5) + (u.pm >= t6) + (u.pm >= t7);
        const int te = e == 0 ? 0 : e == 1 ? t1 : e == 2 ? t2 : e == 3 ? t3 : e == 4 ? t4 : e == 5 ? t5 : e == 6 ? t6 : t7;
        u.pn = e * 4 + r / 7; u.ko = (r % 7) * 256; u.pa = e * 64 + (u.pm - te); return true;
    }
    __device__ __forceinline__ void a_ready(const Unit&) const {}
    __device__ __forceinline__ void done(const Unit&) const {}
};

__device__ __forceinline__ u32x4 pack8(f32x4 a, f32x4 b) { u32x4 w; w.x = cvt_pk_bf16(a[0], a[1]); w.y = cvt_pk_bf16(a[2], a[3]); w.z = cvt_pk_bf16(b[0], b[1]); w.w = cvt_pk_bf16(b[2], b[3]); return w; }
__device__ __forceinline__ float sigm(float x) { return __builtin_amdgcn_rcpf(1.f + __expf(-x)); }
__device__ __forceinline__ f32x4 sigm4(f32x4 v) { f32x4 r; r[0] = sigm(v[0]); r[1] = sigm(v[1]); r[2] = sigm(v[2]); r[3] = sigm(v[3]); return r; }
__device__ __forceinline__ f32x4 lo4(u32x4 g) { f32x4 r; r[0] = __uint_as_float(g.x << 16); r[1] = __uint_as_float(g.x & 0xffff0000u); r[2] = __uint_as_float(g.y << 16); r[3] = __uint_as_float(g.y & 0xffff0000u); return r; }
__device__ __forceinline__ f32x4 hi4(u32x4 g) { f32x4 r; r[0] = __uint_as_float(g.z << 16); r[1] = __uint_as_float(g.z & 0xffff0000u); r[2] = __uint_as_float(g.w << 16); r[3] = __uint_as_float(g.w & 0xffff0000u); return r; }
typedef unsigned u32x2 __attribute__((ext_vector_type(2)));

struct EpiInproj {
    static constexpr bool PERM = false, AFTER_DRAIN = false, MIDK = false, DUPABLE = true;
    unsigned char* ws; const float* qn_g; const float* kn_g; const float* b_gate;
    __device__ __forceinline__ void operator()(const f32x4 (&acc)[2][2][4][2], const Unit& u, int wr, int wc, int fr, int fq) const {
        const int pn = u.pn, pm = u.pm, row0 = pm * BM + wr * 64 + fr;
        const int kroff = pm < 64 ? (pm >> 4) * 256 : (pm - 64) * 4096 - 12288;
#ifndef DBG_INPROJ
#define DBG_INPROJ 15
#endif
        if (pn >= 13) { if (!(DBG_INPROJ & 1)) return;
            const int gc0 = (pn - 13) * 256 + wc * 32 + 8 * fq; f32x4 bv[2][2];
#pragma unroll
            for (int bj = 0; bj < 2; ++bj)
#pragma unroll
                for (int n = 0; n < 2; ++n) bv[bj][n] = *(const f32x4*)(b_gate + gc0 + 128 * bj + 4 * n);
            unsigned char* gb = ws + WS_G + (size_t)row0 * 3072 + (pn - 13) * 256 + (4 * wc + fq) * 16;
#pragma unroll
            for (int ai = 0; ai < 2; ++ai)
#pragma unroll
                for (int m = 0; m < 4; ++m) { u32x4 w;
#pragma unroll
                    for (int bj = 0; bj < 2; ++bj)
#pragma unroll
                        for (int n = 0; n < 2; ++n) { const f32x4 x = acc[ai][bj][m][n] + bv[bj][n]; unsigned d = 0u;
#pragma unroll
                            for (int e = 0; e < 4; ++e) { const float g255 = __builtin_amdgcn_rcpf(__builtin_fmaf(__expf(-x[e]), 1.f / 255.f, 1.f / 255.f));
                                d = __builtin_amdgcn_cvt_pk_u8_f32(__builtin_fmaxf(g255, 1.f), e, d); }
                            w[2 * bj + n] = d; }
                    *(u32x4*)(gb + (size_t)(ai * HALF + m * 16) * 3072) = w; }
        } else if (pn >= 11) { if (!(DBG_INPROJ & 2)) return;
            const int c0 = (pn - 11) * 256 + wc * 32 + 8 * fq;
#pragma unroll
            for (int ai = 0; ai < 2; ++ai)
#pragma unroll
                for (int m = 0; m < 4; ++m) { bf16_t* dst = (bf16_t*)(ws + WS_VC) + (size_t)(row0 + ai * HALF + m * 16 + kroff) * 512 + c0;
#pragma unroll
                    for (int bj = 0; bj < 2; ++bj) *(u32x4*)(dst + 128 * bj) = pack8(acc[ai][bj][m][0], acc[ai][bj][m][1]); }
        } else if (pn >= 3 && pn < 7) { if (!(DBG_INPROJ & 4)) return;
            const int c0 = (pn - 3) * 128 + wc * 32 + 8 * fq;
#pragma unroll
            for (int ai = 0; ai < 2; ++ai)
#pragma unroll
                for (int m = 0; m < 4; ++m) { bf16_t* dst = (bf16_t*)(ws + WS_Y) + (size_t)(row0 + ai * HALF + m * 16) * 512 + c0;
                    *(u32x4*)dst = pack8(acc[ai][0][m][0] * sigm4(acc[ai][1][m][0]), acc[ai][0][m][1] * sigm4(acc[ai][1][m][1])); }
        } else { if (!(DBG_INPROJ & 8)) return;
            const bool isv = (pn == 2 && wc >= 2), isq = pn < 2 || pn == 7 || pn == 8, normed = pn < 3 && !isv, roped = !isv && pm < 64;
            bf16_t* dst; int pitch, roff;
            if (pn < 2) { dst = (bf16_t*)(ws + WS_QA) + (4 * pn + wc) * 64; pitch = 512; roff = 0; }
            else if (pn == 2) { dst = (bf16_t*)(ws + (wc < 2 ? WS_KA : WS_VA)) + (wc & 1) * 64; pitch = 128; roff = kroff; }
            else if (pn < 9) { dst = (bf16_t*)(ws + WS_QC) + (4 * (pn - 7) + wc) * 64; pitch = 512; roff = 0; }
            else { dst = (bf16_t*)(ws + WS_KC) + (4 * (pn - 9) + wc) * 64; pitch = 512; roff = kroff; }
            dst += isv ? 4 * fq : 8 * fq;
            f32x4 gv[2][2];
            const float* g = isq ? qn_g : kn_g;
#pragma unroll
            for (int bj = 0; bj < 2; ++bj)
#pragma unroll
                for (int n = 0; n < 2; ++n) gv[bj][n] = normed ? *(const f32x4*)(g + 32 * bj + 16 * n + 4 * fq) : (f32x4){1.f, 1.f, 1.f, 1.f};
            const float qs = isq ? C2 : 1.f;
            const float* cosT = (const float*)(ws + WS_ROPE) + 4 * fq; const float* sinT = cosT + 1024;
#pragma unroll
            for (int ai = 0; ai < 2; ++ai)
#pragma unroll
                for (int m = 0; m < 4; ++m) { const int row = row0 + ai * HALF + m * 16;
                    f32x4 v[2][2];
#pragma unroll
                    for (int bj = 0; bj < 2; ++bj)
#pragma unroll
                        for (int n = 0; n < 2; ++n) v[bj][n] = acc[ai][bj][m][n];
                    if (normed) { float ss = 0.f;
#pragma unroll
                        for (int bj = 0; bj < 2; ++bj)
#pragma unroll
                            for (int n = 0; n < 2; ++n) ss += (v[bj][n][0] * v[bj][n][0] + v[bj][n][1] * v[bj][n][1]) + (v[bj][n][2] * v[bj][n][2] + v[bj][n][3] * v[bj][n][3]);
                        ss = ::xsum_x32(::xsum_x16(ss));
                        const float rinv = ::rsq_(ss * (1.f / 64.f) + EPS);
#pragma unroll
                        for (int bj = 0; bj < 2; ++bj)
#pragma unroll
                            for (int n = 0; n < 2; ++n) v[bj][n] = v[bj][n] * rinv * gv[bj][n]; }
                    if (roped) { const int t = row & 4095;
#pragma unroll
                        for (int bj = 0; bj < 2; ++bj) { const int pos = bj ? (t & 63) : (t >> 6); const f32x4 cs = *(const f32x4*)(cosT + pos * 16), sn = *(const f32x4*)(sinT + pos * 16);
                            const f32x4 x1 = v[bj][0], x2 = v[bj][1]; v[bj][0] = x1 * cs - x2 * sn; v[bj][1] = x2 * cs + x1 * sn; } }
                    bf16_t* rp = dst + (size_t)(row + roff) * pitch;
                    if (isv) {
#pragma unroll
                        for (int bj = 0; bj < 2; ++bj)
#pragma unroll
                            for (int n = 0; n < 2; ++n) { const f32x4 o = v[bj][n]; u32x2 w; w.x = cvt_pk_bf16(o[0], o[1]); w.y = cvt_pk_bf16(o[2], o[3]); *(u32x2*)(rp + 32 * bj + 16 * n) = w; } }
                    else {
#pragma unroll
                        for (int bj = 0; bj < 2; ++bj) *(u32x4*)(rp + 32 * bj) = pack8(v[bj][0] * qs, v[bj][1] * qs); }
                }
        }
    }
};
struct EpiMerge {
    static constexpr bool PERM = false, AFTER_DRAIN = false, MIDK = true, DUPABLE = false;
    const unsigned char* G; bf16_t* MB;
    static __device__ __forceinline__ float ub(unsigned w, int k) { return (float)((w >> (8 * k)) & 0xffu); }
    __device__ __forceinline__ void mid(f32x4 (&acc)[2][2][4][2], const Unit& u, int wr, int wc, int fr, int fq, int seg) const {
        const unsigned rowb = (unsigned)(u.pm * BM + wr * 64 + fr) * 3072u + (unsigned)((seg - 1) * 1024 + u.pn * 256 + (4 * wc + fq) * 16);
        const unsigned char* Gb = G;
#pragma unroll
        for (int ai = 0; ai < 2; ++ai) { u32x4 ga[4], gb[4];
#pragma unroll
            for (int m = 0; m < 4; ++m) { const unsigned o = rowb + (unsigned)(ai * HALF + m * 16) * 3072u; ga[m] = *(const u32x4*)(Gb + o); gb[m] = *(const u32x4*)(Gb + (o + 1024u)); }
#pragma unroll
            for (int m = 0; m < 4; ++m)
#pragma unroll
                for (int bj = 0; bj < 2; ++bj)
#pragma unroll
                    for (int n = 0; n < 2; ++n) { const unsigned a = ga[m][2 * bj + n], b = gb[m][2 * bj + n]; f32x4 r;
#pragma unroll
                        for (int e = 0; e < 4; ++e) r[e] = ub(a, e) * __builtin_amdgcn_rcpf(ub(b, e));
                        acc[ai][bj][m][n] *= r; }
            asm volatile("" ::: "memory"); }
    }
    __device__ __forceinline__ void operator()(const f32x4 (&acc)[2][2][4][2], const Unit& u, int wr, int wc, int fr, int fq) const {
        const int row0 = u.pm * BM + wr * 64 + fr, c0 = u.pn * 256 + wc * 32 + 8 * fq;
#pragma unroll
        for (int ai = 0; ai < 2; ++ai)
#pragma unroll
            for (int m = 0; m < 4; ++m) { const int row = row0 + ai * HALF + m * 16; const u32x4 g = *(const u32x4*)(G + (size_t)row * 3072 + 2048 + u.pn * 256 + (4 * wc + fq) * 16);
#pragma unroll
                for (int bj = 0; bj < 2; ++bj) { f32x4 g0, g1;
#pragma unroll
                    for (int e = 0; e < 4; ++e) { g0[e] = ub(g[2 * bj], e) * (1.f / 255.f); g1[e] = ub(g[2 * bj + 1], e) * (1.f / 255.f); }
                    *(u32x4*)(MB + (size_t)row * 1024 + c0 + 128 * bj) = pack8(acc[ai][bj][m][0] * g0, acc[ai][bj][m][1] * g1); } }
    }
};
struct EpiResid {
    static constexpr bool PERM = false, AFTER_DRAIN = false, MIDK = false, DUPABLE = false;
    __device__ __forceinline__ int nst(const Unit&) const { return 0; }
    const float* base_f32; bf16_t* xb; const float* gate;
    __device__ __forceinline__ void operator()(const f32x4 (&acc)[2][2][4][2], const Unit& u, int wr, int wc, int fr, int fq) const {
        const int pm = u.pm, c0 = u.pn * 256 + wc * 32 + 4 * fq, bi = pm >> 4, row0 = pm * BM + wr * 64 + fr;
        f32x4 gv[2][2];
#pragma unroll
        for (int bj = 0; bj < 2; ++bj)
#pragma unroll
            for (int n = 0; n < 2; ++n) gv[bj][n] = *(const f32x4*)(gate + (size_t)bi * 6 * 1024 + c0 + 128 * bj + 16 * n);
#pragma unroll
        for (int ai = 0; ai < 2; ++ai)
#pragma unroll
            for (int m = 0; m < 4; ++m) { const size_t off = (size_t)(row0 + ai * HALF + m * 16) * 1024 + c0;
#pragma unroll
                for (int bj = 0; bj < 2; ++bj)
#pragma unroll
                    for (int n = 0; n < 2; ++n) { const size_t o = off + 128 * bj + 16 * n; f32x4 b;
                        if (base_f32) b = *(const f32x4*)(base_f32 + o);
                        else { const u32x2 q = *(const u32x2*)(xb + o); b[0] = __uint_as_float(q.x << 16); b[1] = __uint_as_float(q.x & 0xffff0000u); b[2] = __uint_as_float(q.y << 16); b[3] = __uint_as_float(q.y & 0xffff0000u); }
                        const f32x4 r = b + gv[bj][n] * acc[ai][bj][m][n]; u32x2 w; w.x = cvt_pk_bf16(r[0], r[1]); w.y = cvt_pk_bf16(r[2], r[3]); *(u32x2*)(xb + o) = w; } }
    }
};
struct EpiSwiglu {
    static constexpr bool PERM = false, AFTER_DRAIN = false, MIDK = false, DUPABLE = false;
    bf16_t* O; int ld, nper;
    __device__ __forceinline__ void operator()(const f32x4 (&acc)[2][2][4][2], const Unit& u, int wr, int wc, int fr, int fq) const {
        const int row0 = u.pm * BM + wr * 64 + fr, c0 = (u.pn % nper) * 128 + wc * 32 + 8 * fq;
#pragma unroll
        for (int ai = 0; ai < 2; ++ai)
#pragma unroll
            for (int m = 0; m < 4; ++m) { const f32x4 a0 = acc[ai][0][m][0], a1 = acc[ai][0][m][1];
                *(u32x4*)(O + (size_t)(row0 + ai * HALF + m * 16) * ld + c0) = pack8(a0 * sigm4(a0) * acc[ai][1][m][0], a1 * sigm4(a1) * acc[ai][1][m][1]); }
    }
};
struct EpiSwigluF8 {
    static constexpr bool PERM = false, AFTER_DRAIN = false, MIDK = false, DUPABLE = false;
    unsigned char* O; int ld, nper;
    __device__ __forceinline__ void operator()(const f32x4 (&acc)[2][2][4][2], const Unit& u, int wr, int wc, int fr, int fq) const {
        const int row0 = u.pm * BM + wr * 64 + fr, c0 = (u.pn % nper) * 128 + wc * 32 + 8 * fq;
#pragma unroll
        for (int ai = 0; ai < 2; ++ai)
#pragma unroll
            for (int m = 0; m < 4; ++m) { const f32x4 a0 = acc[ai][0][m][0], a1 = acc[ai][0][m][1];
                const f32x4 y0 = a0 * sigm4(a0) * acc[ai][1][m][0] * 4.f, y1 = a1 * sigm4(a1) * acc[ai][1][m][1] * 4.f;
                u32x2 w; w.x = __builtin_amdgcn_cvt_pk_fp8_f32(y0[2], y0[3], __builtin_amdgcn_cvt_pk_fp8_f32(y0[0], y0[1], 0u, false), true);
                w.y = __builtin_amdgcn_cvt_pk_fp8_f32(y1[2], y1[3], __builtin_amdgcn_cvt_pk_fp8_f32(y1[0], y1[1], 0u, false), true);
                *(u32x2*)(O + (size_t)(row0 + ai * HALF + m * 16) * ld + c0) = w; }
    }
};
struct EpiCtxPartial {
    static constexpr bool PERM = false, AFTER_DRAIN = false, MIDK = false, DUPABLE = false;
    bf16_t* P;
    __device__ __forceinline__ void operator()(const f32x4 (&acc)[2][2][4][2], const Unit& u, int wr, int wc, int fr, int fq) const {
        const int row0 = (u.pm - 64) * BM + wr * 64 + fr, c0 = u.pn * 256 + wc * 32 + 4 * fq; bf16_t* Y = P + (size_t)(u.ko >> 8) * 1024 * 1024;
#pragma unroll
        for (int ai = 0; ai < 2; ++ai)
#pragma unroll
            for (int m = 0; m < 4; ++m) { const int row = row0 + ai * HALF + m * 16;
#pragma unroll
                for (int bj = 0; bj < 2; ++bj)
#pragma unroll
                    for (int n = 0; n < 2; ++n) { const f32x4 a = acc[ai][bj][m][n]; u32x2 w; w.x = cvt_pk_bf16(a[0], a[1]); w.y = cvt_pk_bf16(a[2], a[3]); *(u32x2*)(Y + (size_t)row * 1024 + c0 + 128 * bj + 16 * n) = w; } }
    }
};
struct EpiMoeDownTail {
    static constexpr bool PERM = false, AFTER_DRAIN = false, MIDK = false, DUPABLE = false;
    bf16_t* YPT; const float* rowp;
    __device__ __forceinline__ void operator()(const f32x4 (&acc)[2][2][4][2], const Unit& u, int wr, int wc, int fr, int fq) const {
        const int row0 = u.pm * BM + wr * 64 + fr, c0 = (u.pn & 3) * 256 + wc * 32 + 8 * fq; bf16_t* Y = YPT + (size_t)(u.ko >> 8) * 2048 * 1024 - (size_t)32768 * 1024;
#pragma unroll
        for (int ai = 0; ai < 2; ++ai)
#pragma unroll
            for (int m = 0; m < 4; ++m) { const int row = row0 + ai * HALF + m * 16; const float rp = rowp[u.pa * BM + wr * 64 + fr + ai * HALF + m * 16];
#pragma unroll
                for (int bj = 0; bj < 2; ++bj) *(u32x4*)(Y + (size_t)row * 1024 + c0 + 128 * bj) = pack8(acc[ai][bj][m][0] * rp, acc[ai][bj][m][1] * rp); }
    }
};
struct EpiMoeDown {
    static constexpr bool PERM = false, AFTER_DRAIN = false, MIDK = false, DUPABLE = false;
    bf16_t* YP; const float* rowp;
    __device__ __forceinline__ void operator()(const f32x4 (&acc)[2][2][4][2], const Unit& u, int wr, int wc, int fr, int fq) const {
        const int row0 = u.pm * BM + wr * 64 + fr, c0 = (u.pn & 3) * 256 + wc * 32 + 8 * fq;
#pragma unroll
        for (int ai = 0; ai < 2; ++ai)
#pragma unroll
            for (int m = 0; m < 4; ++m) { const int row = row0 + ai * HALF + m * 16; const float rp = rowp[u.pa * BM + wr * 64 + fr + ai * HALF + m * 16];
#pragma unroll
                for (int bj = 0; bj < 2; ++bj) *(u32x4*)(YP + (size_t)row * 1024 + c0 + 128 * bj) = pack8(acc[ai][bj][m][0] * rp, acc[ai][bj][m][1] * rp); }
    }
};

template <class Epi, class Sched, bool ALIGN_EPI = false, bool SP2 = false, bool F8 = false>
__device__ __forceinline__ void gemm_phase(PG8_LAS unsigned char* lds, const Gemm g, const Sched& S, const Epi& E) {
    int tid_o = threadIdx.x; asm volatile("" : "+v"(tid_o));
    const int tid = tid_o, wid = __builtin_amdgcn_readfirstlane(tid >> 6), lane = tid & 63, wr = wid >> 2, wc = wid & 3, fr = lane & 15, fq = lane >> 4;
    const int K = g.K, nt = K / BK;
    unsigned voffA[2], voffB[2];
#pragma unroll
    for (int i = 0; i < 2; ++i) { int R, C; stage_rc(tid * 16 + i * 8192, R, C); const int Rb = Epi::PERM ? ((R & ~31) + perm32(R & 31)) : R;
        voffA[i] = (unsigned)(R * g.ld + C) * 2u; voffB[i] = (unsigned)(Rb * g.ld + C) * 2u; }
    const size_t kstep = (size_t)(BK * 2);
    const size_t hstep = (size_t)HALF * g.ld * 2;
    const size_t tstep = 2 * hstep;
    const unsigned ldsw = (unsigned)wid * 1024u;
    const int aoff = lds_byte(wr * 64 + fr, fq * 8), boff = lds_byte(wc * 32 + fr, fq * 8);
#define PG8_SA(b, h) (((b) * 2 + (h)) * HTB)
#define PG8_SB(b, h) ((4 + (b) * 2 + (h)) * HTB)
#define PG8_STAGE(bufoff, gbase, voff) do { _Pragma("unroll") for (int _i = 0; _i < 2; ++_i) \
        __builtin_amdgcn_global_load_lds((const unsigned*)((const char*)(gbase) + (voff)[_i]), (PG8_LAS unsigned*)(lds + (bufoff) + ldsw + _i * 8192), 16, 0, 0); } while (0)
#define PG8_LDA(dst, b, h) do { if constexpr (F8) { _Pragma("unroll") for (int m = 0; m < 4; ++m) { const v4i_t x_ = *(const PG8_LAS v4i_t*)(lds + PG8_SA(b, h) + aoff + m * 2048), y_ = *(const PG8_LAS v4i_t*)(lds + PG8_SA(b, h) + aoff + m * 2048 + 1024); dst##8[m] = __builtin_shufflevector(x_, y_, 0, 1, 2, 3, 4, 5, 6, 7); } } \
        else { _Pragma("unroll") for (int m = 0; m < 4; ++m) _Pragma("unroll") for (int k = 0; k < 2; ++k) dst[m][k] = *(const PG8_LAS bf16x8*)(lds + PG8_SA(b, h) + aoff + m * 2048 + k * 1024); } } while (0)
#define PG8_LDB(dst, b, h) do { if constexpr (F8) { _Pragma("unroll") for (int n = 0; n < 2; ++n) { const v4i_t x_ = *(const PG8_LAS v4i_t*)(lds + PG8_SB(b, h) + boff + n * 2048), y_ = *(const PG8_LAS v4i_t*)(lds + PG8_SB(b, h) + boff + n * 2048 + 1024); dst##8[n] = __builtin_shufflevector(x_, y_, 0, 1, 2, 3, 4, 5, 6, 7); } } \
        else { _Pragma("unroll") for (int n = 0; n < 2; ++n) _Pragma("unroll") for (int k = 0; k < 2; ++k) dst[n][k] = *(const PG8_LAS bf16x8*)(lds + PG8_SB(b, h) + boff + n * 2048 + k * 1024); } } while (0)
#define PG8_MMA(ai, bj, At, Bt) do { if constexpr (F8) { __builtin_amdgcn_s_setprio(1); _Pragma("unroll") for (int m = 0; m < 4; ++m) _Pragma("unroll") for (int n = 0; n < 2; ++n) \
        asm volatile("v_mfma_scale_f32_16x16x128_f8f6f4 %0, %1, %2, %0, %3, %4 op_sel_hi:[0,0,0]" : "+v"(acc[ai][bj][m][n]) : "v"(Bt##8[n]), "v"(At##8[m]), "v"(scw_), "v"(sca_));     __builtin_amdgcn_s_setprio(0); } else { __builtin_amdgcn_s_setprio(1); _Pragma("unroll") for (int m = 0; m < 4; ++m) _Pragma("unroll") for (int n = 0; n < 2; ++n) _Pragma("unroll") for (int k = 0; k < 2; ++k) \
        acc[ai][bj][m][n] = __builtin_amdgcn_mfma_f32_16x16x32_bf16(Bt[n][k], At[m][k], acc[ai][bj][m][n], 0, 0, 0); __builtin_amdgcn_s_setprio(0); } } while (0)
#define PG8_WAIT_V(n) asm volatile("s_waitcnt vmcnt(" #n ")" ::: "memory")
#define PG8_WAIT_L(n) asm volatile("s_waitcnt lgkmcnt(" #n ")" ::: "memory")
#define PG8_BAR __builtin_amdgcn_s_barrier()
#define PG8_SCHED __builtin_amdgcn_sched_barrier(0)
    Unit cur, nxt; int ui = 0;
    if (!S.next(0, cur)) return;
    f32x4 acc[2][2][4][2];
#pragma unroll
    for (int a = 0; a < 2; ++a)
#pragma unroll
        for (int b = 0; b < 2; ++b)
#pragma unroll
            for (int m = 0; m < 4; ++m)
#pragma unroll
                for (int n = 0; n < 2; ++n) acc[a][b][m][n] = (f32x4){0.f, 0.f, 0.f, 0.f};
    int scw_ = g.sc_w, sca_ = g.sc_a; asm volatile("" : "+v"(scw_), "+v"(sca_));
    bf16x8 At[4][2], B0[2][2], B1[2][2]; v8i_t At8[4], B08[2], B18[2];
    const char* cA = (const char*)g.A + (size_t)(g.a_pa ? cur.pa : cur.pm) * tstep + (size_t)cur.ko * 2; const char* cB = (const char*)g.Bt + (size_t)cur.pn * tstep + (size_t)cur.ko * 2;
    S.a_ready(cur);
    if constexpr (SP2) {
        PG8_STAGE(PG8_SB(0, 0), cB, voffB); PG8_STAGE(PG8_SB(0, 1), cB + hstep, voffB); PG8_STAGE(PG8_SA(0, 0), cA, voffA); PG8_STAGE(PG8_SA(0, 1), cA + hstep, voffA);
        if (wr == 1) PG8_BAR;
        PG8_WAIT_V(2); PG8_BAR;
        PG8_STAGE(PG8_SB(1, 0), cB + kstep, voffB); PG8_STAGE(PG8_SA(1, 0), cA + kstep, voffA); PG8_STAGE(PG8_SB(1, 1), cB + hstep + kstep, voffB);
        PG8_WAIT_V(6); PG8_BAR;
    } else {
        PG8_STAGE(PG8_SB(0, 0), cB, voffB); PG8_STAGE(PG8_SA(0, 0), cA, voffA); PG8_STAGE(PG8_SB(0, 1), cB + hstep, voffB); PG8_STAGE(PG8_SA(0, 1), cA + hstep, voffA);
        if (wr == 1) PG8_BAR;
        PG8_WAIT_V(4); PG8_BAR;
        PG8_STAGE(PG8_SB(1, 0), cB + kstep, voffB); PG8_STAGE(PG8_SA(1, 0), cA + kstep, voffA); PG8_STAGE(PG8_SB(1, 1), cB + hstep + kstep, voffB);
        PG8_WAIT_V(6); PG8_BAR;
    }
    for (;;) {
        const bool has_next = S.next(ui + 1, nxt);
        const char* nA = has_next ? (const char*)g.A + (size_t)(g.a_pa ? nxt.pa : nxt.pm) * tstep + (size_t)nxt.ko * 2 : cA; const char* nB = has_next ? (const char*)g.Bt + (size_t)nxt.pn * tstep + (size_t)nxt.ko * 2 : cB;
#pragma unroll 1
        for (int t = 0; t < nt; t += 2) {
            const bool last = (t == nt - 2);
            const char* a1 = cA + (size_t)(t + 1) * kstep;
            const char* a2 = last ? nA : cA + (size_t)(t + 2) * kstep; const char* b2 = last ? nB : cB + (size_t)(t + 2) * kstep;
            const char* a3 = a2 + kstep; const char* b3 = b2 + kstep;
            if (last && has_next) S.a_ready(nxt);
            if constexpr (Epi::MIDK) { if (t == 8 || t == 16) E.mid(acc, cur, wr, wc, fr, fq, t >> 3); }
            if constexpr (SP2) {
            PG8_LDB(B0, 0, 0); PG8_LDB(B1, 0, 1); PG8_SCHED; PG8_LDA(At, 0, 0); PG8_STAGE(PG8_SA(1, 1), a1 + hstep, voffA);
            PG8_WAIT_V(8); PG8_WAIT_L(0); PG8_BAR; PG8_MMA(0, 0, At, B0); PG8_MMA(0, 1, At, B1); PG8_BAR; PG8_SCHED;
            PG8_LDA(At, 0, 1); PG8_STAGE(PG8_SB(0, 0), b2, voffB); PG8_STAGE(PG8_SB(0, 1), b2 + hstep, voffB); PG8_STAGE(PG8_SA(0, 0), a2, voffA);
            PG8_WAIT_V(8); PG8_WAIT_L(0); PG8_BAR; PG8_MMA(1, 0, At, B0); PG8_MMA(1, 1, At, B1); PG8_BAR; PG8_SCHED;
            PG8_LDB(B0, 1, 0); PG8_LDB(B1, 1, 1); PG8_SCHED; PG8_LDA(At, 1, 0); PG8_STAGE(PG8_SA(0, 1), a2 + hstep, voffA);
            PG8_WAIT_V(8); PG8_WAIT_L(0); PG8_BAR; PG8_MMA(0, 0, At, B0); PG8_MMA(0, 1, At, B1); PG8_BAR; PG8_SCHED;
            PG8_LDA(At, 1, 1); PG8_STAGE(PG8_SB(1, 0), b3, voffB); PG8_STAGE(PG8_SB(1, 1), b3 + hstep, voffB); PG8_STAGE(PG8_SA(1, 0), a3, voffA);
            PG8_WAIT_V(8); PG8_WAIT_L(0); PG8_BAR; PG8_MMA(1, 0, At, B0); PG8_MMA(1, 1, At, B1); PG8_BAR; PG8_SCHED;
            } else {
            PG8_LDB(B0, 0, 0); PG8_SCHED; PG8_LDA(At, 0, 0); PG8_STAGE(PG8_SA(1, 1), a1 + hstep, voffA);
            PG8_WAIT_L(8); PG8_BAR; PG8_WAIT_L(0); PG8_MMA(0, 0, At, B0); PG8_BAR; PG8_SCHED;
            PG8_LDB(B1, 0, 1); PG8_STAGE(PG8_SB(0, 0), b2, voffB);
            PG8_BAR; PG8_WAIT_L(0); PG8_MMA(0, 1, At, B1); PG8_BAR;
            PG8_LDA(At, 0, 1); PG8_STAGE(PG8_SA(0, 0), a2, voffA);
            PG8_BAR; PG8_WAIT_L(0); PG8_MMA(1, 0, At, B0); PG8_BAR; PG8_SCHED;
            PG8_STAGE(PG8_SB(0, 1), b2 + hstep, voffB);
            PG8_WAIT_V(6); PG8_BAR; PG8_MMA(1, 1, At, B1); PG8_BAR;
            PG8_LDB(B0, 1, 0); PG8_SCHED; PG8_LDA(At, 1, 0); PG8_STAGE(PG8_SA(0, 1), a2 + hstep, voffA);
            PG8_WAIT_L(8); PG8_BAR; PG8_WAIT_L(0); PG8_MMA(0, 0, At, B0); PG8_BAR; PG8_SCHED;
            PG8_LDB(B1, 1, 1); PG8_STAGE(PG8_SB(1, 0), b3, voffB);
            PG8_BAR; PG8_WAIT_L(0); PG8_MMA(0, 1, At, B1); PG8_BAR;
            PG8_LDA(At, 1, 1); PG8_STAGE(PG8_SA(1, 0), a3, voffA);
            PG8_BAR; PG8_WAIT_L(0); PG8_MMA(1, 0, At, B0); PG8_BAR; PG8_SCHED;
            PG8_STAGE(PG8_SB(1, 1), b3 + hstep, voffB);
            PG8_WAIT_V(6); PG8_BAR; PG8_MMA(1, 1, At, B1); PG8_BAR;
            }
        }
        if constexpr (F8) asm volatile("s_nop 15\n\ts_nop 7" ::: "memory");
        if constexpr (ALIGN_EPI) { if (wr == 0) PG8_BAR; }
        if constexpr (!Epi::AFTER_DRAIN) { E(acc, cur, wr, wc, fr, fq);
#ifdef DUP_EPI
            if constexpr (Epi::DUPABLE) { asm volatile("" ::: "memory"); E(acc, cur, wr, wc, fr, fq); }
#endif
            S.done(cur); }
        if (!has_next) break;
#pragma unroll
        for (int a = 0; a < 2; ++a)
#pragma unroll
            for (int b = 0; b < 2; ++b)
#pragma unroll
                for (int m = 0; m < 4; ++m)
#pragma unroll
                    for (int n = 0; n < 2; ++n) acc[a][b][m][n] = (f32x4){0.f, 0.f, 0.f, 0.f};
        cur = nxt; cA = nA; cB = nB; ++ui;
        if constexpr (ALIGN_EPI) { if (wr == 1) PG8_BAR; }
    }
    PG8_WAIT_V(0);
    if constexpr (!ALIGN_EPI) { if (wr == 0) PG8_BAR; }
    PG8_BAR;
    if constexpr (Epi::AFTER_DRAIN) { E.fused(acc, cur, wr, wc, fr, fq, lds, wid, lane); S.done(cur); }
#undef PG8_SA
#undef PG8_SB
#undef PG8_STAGE
#undef PG8_LDA
#undef PG8_LDB
#undef PG8_MMA
#undef PG8_WAIT_V
#undef PG8_WAIT_L
#undef PG8_BAR
#undef PG8_SCHED
}
}


#include <hip/hip_bf16.h>
#include <cmath>

namespace attn_body {
using bf16=__hip_bfloat16;
using bf16x8=__attribute__((ext_vector_type(8)))short;
using s16x4=__attribute__((ext_vector_type(4)))short;
using f32x16=__attribute__((ext_vector_type(16)))float;
using u32x4=__attribute__((ext_vector_type(4)))unsigned;
constexpr int D=64;
constexpr int NW=8,QBLK=32,QB=QBLK*NW,KVBLK=64;
constexpr int ATTN_UNIT_ROWS=QB;
__device__ __forceinline__ int crow(int r,int hi){return (r&3)+8*(r>>2)+4*hi;}
#define SBAR() __builtin_amdgcn_sched_barrier(0)
__device__ __forceinline__ void cmask(f32x16&p0,f32x16&p1,int jb,int qrel,int hi){
  const float NEG=-INFINITY; int kb=64*jb+4*hi;
  #pragma unroll
  for(int r=0;r<16;++r){int kv=kb+(r&3)+8*(r>>2); if(kv>qrel)p0[r]=NEG; if(kv+32>qrel)p1[r]=NEG;}
}

constexpr int NSLOT=3, SLOTB=8192;
constexpr int LDS_K=0, LDS_V=NSLOT*SLOTB, LDS_WS=2*NSLOT*SLOTB, LDS_OST=LDS_WS+NW*64*4, LDS_BYTES=LDS_OST+NW*4096;
constexpr float C2=0.125f*1.4426950408889634f;
__device__ __forceinline__ void glds16(const void*gsrc,unsigned lds_dst){unsigned keep;
  asm volatile("s_mov_b32 %0, m0\n\ts_mov_b32 m0, %2\n\ts_nop 0\n\tglobal_load_lds_dwordx4 %1, off\n\ts_mov_b32 m0, %0":"=&s"(keep):"v"(gsrc),"s"(lds_dst):"memory");}
__device__ __forceinline__ float max3f(float a,float b,float c){float r;asm("v_max3_f32 %0, %1, %2, %3":"=v"(r):"v"(a),"v"(b),"v"(c));return r;}
__device__ __forceinline__ float max2f(float a,float b){float r;asm("v_max_f32_e32 %0, %1, %2":"=v"(r):"v"(a),"v"(b));return r;}
__device__ __forceinline__ float fadd_s(float a,float b){float r;asm("v_add_f32_e32 %0, %1, %2":"=v"(r):"v"(a),"v"(b));return r;}
__device__ __forceinline__ float fsub_s(float a,float b){float r;asm("v_sub_f32_e32 %0, %1, %2":"=v"(r):"v"(a),"v"(b));return r;}
typedef float f32x2_t __attribute__((ext_vector_type(2))); typedef __bf16 bf16x2_t __attribute__((ext_vector_type(2)));
__device__ __forceinline__ unsigned cvtpk_s(float lo,float hi){f32x2_t v={lo,hi};bf16x2_t b=__builtin_convertvector(v,bf16x2_t);return __builtin_bit_cast(unsigned,b);}
#define WAIT_BAR(N) asm volatile("s_waitcnt vmcnt(" #N ") lgkmcnt(0)\n\ts_barrier":::"memory")

__device__ __forceinline__ void qkt(f32x16&p0,f32x16&p1,const char*Kslot,const bf16x8*qr,const f32x16&negm,int r32,int hi){
  const char*kb=Kslot+hi*1024+r32*16;
  #pragma unroll
  for(int d0=0;d0<4;++d0){
    const bf16x8 b0=*reinterpret_cast<const bf16x8*>(kb+d0*2048);
    const bf16x8 b1=*reinterpret_cast<const bf16x8*>(kb+d0*2048+512);
    if(d0==0){p0=__builtin_amdgcn_mfma_f32_32x32x16_bf16(b0,qr[0],negm,0,0,0);p1=__builtin_amdgcn_mfma_f32_32x32x16_bf16(b1,qr[0],negm,0,0,0);}
    else{p0=__builtin_amdgcn_mfma_f32_32x32x16_bf16(b0,qr[d0],p0,0,0,0);p1=__builtin_amdgcn_mfma_f32_32x32x16_bf16(b1,qr[d0],p1,0,0,0);}}
}
typedef __attribute__((address_space(3))) const char* lds_cptr;
typedef short v4i16_t __attribute__((ext_vector_type(4)));
__device__ __forceinline__ void kload8(bf16x8*kf,lds_cptr kp){
  kf[0]=*(const __attribute__((address_space(3))) bf16x8*)(kp);      kf[1]=*(const __attribute__((address_space(3))) bf16x8*)(kp+512);
  kf[2]=*(const __attribute__((address_space(3))) bf16x8*)(kp+2048); kf[3]=*(const __attribute__((address_space(3))) bf16x8*)(kp+2560);
  kf[4]=*(const __attribute__((address_space(3))) bf16x8*)(kp+4096); kf[5]=*(const __attribute__((address_space(3))) bf16x8*)(kp+4608);
  kf[6]=*(const __attribute__((address_space(3))) bf16x8*)(kp+6144); kf[7]=*(const __attribute__((address_space(3))) bf16x8*)(kp+6656);
}
__device__ __forceinline__ void kload2(bf16x8*kf,lds_cptr kp,int j){ kf[2*j]=*(const __attribute__((address_space(3))) bf16x8*)(kp+j*2048); kf[2*j+1]=*(const __attribute__((address_space(3))) bf16x8*)(kp+j*2048+512); }
__device__ __forceinline__ s16x4 vtr(lds_cptr p){ return __builtin_bit_cast(s16x4,__builtin_amdgcn_ds_read_tr16_b64_v4i16((__attribute__((address_space(3))) v4i16_t*)p)); }
__device__ __forceinline__ float rowmax(const f32x16&p0,const f32x16&p1){
  float a=max3f(p0[0],p0[1],p1[0]),b=max3f(p0[2],p0[3],p1[1]);a=max3f(a,p1[2],p1[3]);
  #pragma unroll
  for(int r=4;r<16;r+=4){a=max3f(a,p0[r],p0[r+1]);b=max3f(b,p0[r+2],p0[r+3]);a=max3f(a,p1[r],p1[r+1]);b=max3f(b,p1[r+2],p1[r+3]);}
  const float m=max2f(a,b);
  auto rr=__builtin_amdgcn_permlane32_swap(__float_as_uint(m),__float_as_uint(m),false,false);
  return max2f(__uint_as_float(rr[0]),__uint_as_float(rr[1]));
}
__device__ __forceinline__ void pv(f32x16*o,int vb,bf16x8 pa0,bf16x8 pa1,bf16x8 pa2,bf16x8 pa3){
  #pragma unroll
  for(int d0=0;d0<2;++d0){s16x4 lo[4],hi[4];
    #pragma unroll
    for(int ks=0;ks<4;++ks){
      asm volatile("ds_read_b64_tr_b16 %0,%1 offset:%c2":"=&v"(lo[ks]):"v"(vb),"i"(d0*4096+ks*1024):"memory");
      asm volatile("ds_read_b64_tr_b16 %0,%1 offset:%c2":"=&v"(hi[ks]):"v"(vb),"i"(d0*4096+ks*1024+512):"memory");}
    asm volatile("s_waitcnt lgkmcnt(0)":::"memory");SBAR();
    #define PK(k) (bf16x8){lo[k][0],lo[k][1],lo[k][2],lo[k][3],hi[k][0],hi[k][1],hi[k][2],hi[k][3]}
    o[d0]=__builtin_amdgcn_mfma_f32_32x32x16_bf16(pa0,PK(0),o[d0],0,0,0);
    o[d0]=__builtin_amdgcn_mfma_f32_32x32x16_bf16(pa1,PK(1),o[d0],0,0,0);
    o[d0]=__builtin_amdgcn_mfma_f32_32x32x16_bf16(pa2,PK(2),o[d0],0,0,0);
    o[d0]=__builtin_amdgcn_mfma_f32_32x32x16_bf16(pa3,PK(3),o[d0],0,0,0);
    #undef PK
  }
}

#ifndef ATTN_STORE16
#define ATTN_STORE16(p,v) (*(u32x4*)(p)=(v))
#endif
template<int THRL> __device__ __forceinline__ void attn_unit(const bf16*Qu,int qp,const bf16*__restrict__ Kh,const bf16*__restrict__ Vh,int kvp,bf16*Ou,int op,int NT,char*shm){
  int tid_o=threadIdx.x; asm volatile("":"+v"(tid_o)); const int tid=tid_o,lane=tid&63,r32=lane&31,hi=lane>>5; const int wid=__builtin_amdgcn_readfirstlane(tid>>6);
  const bf16*Qw=Qu+(long)(wid*QBLK)*qp;
  const unsigned lds0=(unsigned)(uintptr_t)shm;
  float*wsf=(float*)(shm+LDS_WS)+wid*64;
  const bf16*ksrc=Kh+(long)lane*kvp+wid*8;
  const bf16*vsrc=Vh+(long)(16*(wid&3)+(lane>>2))*kvp+(wid>>2)*32+(lane&3)*8;
  const unsigned kdst=lds0+LDS_K+wid*1024, vdst=lds0+LDS_V+wid*1024;
  #define DMA_K(t,slot) glds16(ksrc+(long)(t)*KVBLK*kvp,(unsigned)__builtin_amdgcn_readfirstlane(kdst+(slot)))
  #define DMA_V(t,slot) glds16(vsrc+(long)(t)*KVBLK*kvp,(unsigned)__builtin_amdgcn_readfirstlane(vdst+(slot)))
  const int vb0=(int)(lds0+LDS_V)+((lane>>4)&1)*32+(lane&3)*8+(4*hi+((lane&15)>>2))*64;
  const char*Kbase=shm+LDS_K; bf16x8 kf[8];
  const lds_cptr shm3=(lds_cptr)shm; const lds_cptr kp0=shm3+LDS_K+hi*1024+r32*16; const lds_cptr vp0=shm3+LDS_V+((lane>>4)&1)*32+(lane&3)*8+(4*hi+((lane&15)>>2))*64;
  DMA_K(0,0);DMA_V(0,0);DMA_K(1,SLOTB);
  bf16x8 qr[4];
  #pragma unroll
  for(int d0=0;d0<4;++d0)qr[d0]=*reinterpret_cast<const bf16x8*>(&Qw[(long)r32*qp+d0*16+hi*8]);
  float mhat=0.f,l_reg=0.f;f32x16 o[2];o[0]=f32x16{};o[1]=f32x16{};f32x16 negm=f32x16{};asm volatile("":"+v"(negm));
  #define CMASK(P0,P1,t) do{}while(0)
  bool resc=false;
  #define START(P0,P1) do{ const float rm=rowmax(P0,P1); resc=false; \
    { const float dl=rm; mhat=fadd_s(mhat,dl); \
      _Pragma("unroll") for(int r=0;r<16;++r){P0[r]=fsub_s(P0[r],dl);P1[r]=fsub_s(P1[r],dl);} \
      _Pragma("unroll") for(int r=0;r<16;++r)negm[r]=-mhat; asm volatile("":"+v"(negm)); } \
    _Pragma("unroll") for(int r=0;r<16;++r)P0[r]=__builtin_amdgcn_exp2f(P0[r]); }while(0)
  #define RESC() do{ if(resc){ asm volatile("s_waitcnt lgkmcnt(0)":::"memory"); \
      _Pragma("unroll") for(int d_=0;d_<2;++d_) _Pragma("unroll") for(int r=0;r<16;++r)o[d_][r]*=wsf[crow(r,hi)]; } }while(0)
  f32x16 pA0,pA1,pB0,pB1;
  int sl_prev=0,sl_cur=0,sl_next=SLOTB;
  #define ROT() do{sl_prev=sl_cur;sl_cur=sl_next;sl_next=(sl_next==(NSLOT-1)*SLOTB)?0:sl_next+SLOTB;}while(0)
  DMA_K(2,2*SLOTB);
  WAIT_BAR(3);
  qkt(pA0,pA1,Kbase,qr,negm,r32,hi);asm volatile("s_nop 15\n\ts_nop 7":"+v"(pA0),"+v"(pA1));CMASK(pA0,pA1,0);
  START(pA0,pA1);
  _Pragma("unroll") for(int r=0;r<16;++r)pA1[r]=__builtin_amdgcn_exp2f(pA1[r]);
  WAIT_BAR(0);
  DMA_K(3,0);DMA_V(1,SLOTB);
  ROT();
  kload8(kf,kp0+sl_cur);
  WAIT_BAR(2);
  s16x4 vlo[8],vhi[8]; u32x4 pw0,pw1,pw2,pw3;
  #define PKW(P,B) cvtpk_s(P[B],P[B+1])
  #define PAF(k) __builtin_bit_cast(bf16x8,pw##k)
  #define VFR(i) (bf16x8){vlo[i][0],vlo[i][1],vlo[i][2],vlo[i][3],vhi[i][0],vhi[i][1],vhi[i][2],vhi[i][3]}
  #define PIN(x) asm volatile("":"+v"(x))
  #define MX3(a,b,c) __builtin_fmaxf(__builtin_fmaxf((a),(b)),(c))
  #define GAPA(MF,A0,A1,A2,A3,W0,W1,PW) do{ MF; sacc+=A0; sacc+=A1; sacc+=A2; sacc+=A3; PIN(sacc); W0; W1; PIN(PW); SBAR(); }while(0)
  #define EX(v) __builtin_amdgcn_exp2f(v)
  #define GAPB(MF,X,B) do{ MF; X[B]=EX(X[B]); X[B+1]=EX(X[B+1]); X[B+2]=EX(X[B+2]); X[B+3]=EX(X[B+3]); PIN(X); SBAR(); }while(0)
  #define VRD(i) do{ vlo[i]=vtr(vp_+(((i)>>2)*4096+((i)&3)*1024)); vhi[i]=vtr(vp_+(((i)>>2)*4096+((i)&3)*1024+512)); }while(0)
  #define KRD(G,j) do{ if(G){ kload2(kf,kp0+sl_next,j); SBAR(); } }while(0)
  #define STEP(C0,C1,P0,P1,t,GK,GV,GL) do{ SBAR(); \
    const lds_cptr vp_=vp0+sl_prev; \
    VRD(0); SBAR(); float sacc=(P0[0]+P0[1]); \
    GAPA(C0=__builtin_amdgcn_mfma_f32_32x32x16_bf16(kf[0],qr[0],negm,0,0,0), P0[2],P0[3],P0[4],P0[5],     pw0[0]=PKW(P0,0), pw0[1]=PKW(P0,2), pw0); \
    VRD(4); SBAR(); GAPA(C1=__builtin_amdgcn_mfma_f32_32x32x16_bf16(kf[1],qr[0],negm,0,0,0), P0[6],P0[7],P0[8],P0[9],     pw0[2]=PKW(P0,4), pw0[3]=PKW(P0,6), pw0); \
    VRD(1); SBAR(); GAPA(C0=__builtin_amdgcn_mfma_f32_32x32x16_bf16(kf[2],qr[1],C0,0,0,0),   P0[10],P0[11],P0[12],P0[13], pw1[0]=PKW(P0,8), pw1[1]=PKW(P0,10), pw1); \
    VRD(5); SBAR(); GAPA(C1=__builtin_amdgcn_mfma_f32_32x32x16_bf16(kf[3],qr[1],C1,0,0,0),   P0[14],P0[15],P1[0],P1[1],   pw1[2]=PKW(P0,12),pw1[3]=PKW(P0,14), pw1); \
    VRD(2); SBAR(); GAPA(C0=__builtin_amdgcn_mfma_f32_32x32x16_bf16(kf[4],qr[2],C0,0,0,0),   P1[2],P1[3],P1[4],P1[5],     pw2[0]=PKW(P1,0), pw2[1]=PKW(P1,2), pw2); \
    VRD(6); SBAR(); GAPA(C1=__builtin_amdgcn_mfma_f32_32x32x16_bf16(kf[5],qr[2],C1,0,0,0),   P1[6],P1[7],P1[8],P1[9],     pw2[2]=PKW(P1,4), pw2[3]=PKW(P1,6), pw2); \
    VRD(3); SBAR(); GAPA(C0=__builtin_amdgcn_mfma_f32_32x32x16_bf16(kf[6],qr[3],C0,0,0,0),   P1[10],P1[11],P1[12],P1[13], pw3[0]=PKW(P1,8), pw3[1]=PKW(P1,10), pw3); \
    VRD(7); SBAR(); GAPA(C1=__builtin_amdgcn_mfma_f32_32x32x16_bf16(kf[7],qr[3],C1,0,0,0),   P1[14],P1[15],0.f,0.f,       pw3[2]=PKW(P1,12),pw3[3]=PKW(P1,14), pw3); \
    l_reg+=sacc; \
    if(GK){DMA_K((t)+3,sl_cur);} if(GV){DMA_V((t)+1,sl_next);} \
    CMASK(C0,C1,t); \
    { float a=MX3(C0[0],C0[1],C1[0]),b=MX3(C0[2],C0[3],C1[1]); a=MX3(a,C1[2],C1[3]); \
      _Pragma("unroll") for(int r=4;r<16;r+=4){a=MX3(a,C0[r],C0[r+1]);b=MX3(b,C0[r+2],C0[r+3]);a=MX3(a,C1[r],C1[r+1]);b=MX3(b,C1[r+2],C1[r+3]);} \
      float rm=__builtin_fmaxf(a,b); { auto rr=__builtin_amdgcn_permlane32_swap(__float_as_uint(rm),__float_as_uint(rm),false,false); rm=__builtin_fmaxf(__uint_as_float(rr[0]),__uint_as_float(rr[1])); } \
      resc=false; \
      if(__builtin_expect(__any(rm>(float)THRL),0)){ const float dl=__builtin_fmaxf(rm,0.f); mhat+=dl; \
        _Pragma("unroll") for(int r=0;r<16;++r){C0[r]-=dl;C1[r]-=dl;} \
        _Pragma("unroll") for(int r=0;r<16;++r)negm[r]=-mhat; asm volatile("":"+v"(negm)); \
        const float f=__builtin_amdgcn_exp2f(-dl); l_reg*=f; if(hi==0)wsf[r32]=f; resc=true; } } \
    SBAR(); \
    GAPB(o[0]=__builtin_amdgcn_mfma_f32_32x32x16_bf16(PAF(0),VFR(0),o[0],0,0,0), C0,0); \
    GAPB(o[1]=__builtin_amdgcn_mfma_f32_32x32x16_bf16(PAF(0),VFR(4),o[1],0,0,0), C0,4); \
    KRD(GL,0); GAPB(o[0]=__builtin_amdgcn_mfma_f32_32x32x16_bf16(PAF(1),VFR(1),o[0],0,0,0), C0,8); \
    KRD(GL,1); GAPB(o[1]=__builtin_amdgcn_mfma_f32_32x32x16_bf16(PAF(1),VFR(5),o[1],0,0,0), C0,12); \
    KRD(GL,2); GAPB(o[0]=__builtin_amdgcn_mfma_f32_32x32x16_bf16(PAF(2),VFR(2),o[0],0,0,0), C1,0); \
    KRD(GL,3); GAPB(o[1]=__builtin_amdgcn_mfma_f32_32x32x16_bf16(PAF(2),VFR(6),o[1],0,0,0), C1,4); \
    GAPB(o[0]=__builtin_amdgcn_mfma_f32_32x32x16_bf16(PAF(3),VFR(3),o[0],0,0,0), C1,8); \
    GAPB(o[1]=__builtin_amdgcn_mfma_f32_32x32x16_bf16(PAF(3),VFR(7),o[1],0,0,0), C1,12); \
    }while(0)
  int t=1;
  #undef CMASK
  #define CMASK(P0,P1,t) do{}while(0)
  for(;t+5<NT;t+=2){
    STEP(pB0,pB1,pA0,pA1,t,true,true,true);     WAIT_BAR(2); RESC(); ROT();
    STEP(pA0,pA1,pB0,pB1,t+1,true,true,true);   WAIT_BAR(2); RESC(); ROT();
  }
  #undef CMASK
  #define CMASK(P0,P1,t) do{}while(0)
  #define ENDW(tt) do{ if((tt)+3<NT){WAIT_BAR(2);} else if((tt)+2<NT){WAIT_BAR(1);} else {WAIT_BAR(0);} }while(0)
  for(;t+1<NT;t+=2){
    STEP(pB0,pB1,pA0,pA1,t,(t+3<NT),(t+1<NT),(t+1<NT));       ENDW(t);   RESC(); ROT();
    STEP(pA0,pA1,pB0,pB1,t+1,(t+4<NT),(t+2<NT),(t+2<NT));     ENDW(t+1); RESC(); ROT();
  }
  STEP(pB0,pB1,pA0,pA1,NT-1,false,false,false); RESC();
  { float sacc=pB0[0]+pB0[1]; _Pragma("unroll") for(int r=2;r<16;++r)sacc+=pB0[r]; _Pragma("unroll") for(int r=0;r<16;++r)sacc+=pB1[r]; l_reg+=sacc;
    pw0=(u32x4){PKW(pB0,0),PKW(pB0,2),PKW(pB0,4),PKW(pB0,6)};pw1=(u32x4){PKW(pB0,8),PKW(pB0,10),PKW(pB0,12),PKW(pB0,14)};pw2=(u32x4){PKW(pB1,0),PKW(pB1,2),PKW(pB1,4),PKW(pB1,6)};pw3=(u32x4){PKW(pB1,8),PKW(pB1,10),PKW(pB1,12),PKW(pB1,14)};
    SBAR(); pv(o,vb0+sl_cur,PAF(0),PAF(1),PAF(2),PAF(3)); }
  #undef PKW
  #undef PAF
  #undef VFR
  #undef PIN
  #undef MX3
  #undef GAPA
  #undef GAPB
  #undef EX
  #undef VRD
  #undef KRD
  #undef STEP
  #undef ENDW
  {auto rr=__builtin_amdgcn_permlane32_swap(__float_as_uint(l_reg),__float_as_uint(l_reg),false,false);l_reg=__uint_as_float(rr[0])+__uint_as_float(rr[1]);}
  if(hi==0)wsf[32+r32]=l_reg;asm volatile("s_waitcnt lgkmcnt(0)":::"memory");
  float rli[16];
  #pragma unroll
  for(int r=0;r<16;++r)rli[r]=__builtin_amdgcn_rcpf(wsf[32+crow(r,hi)]);
  bf16*Ow=Ou+(long)(wid*QBLK)*op;
  { bf16*stg=(bf16*)(shm+LDS_OST)+wid*2048;
    #pragma unroll
    for(int r=0;r<16;++r){const int orow=crow(r,hi);
      #pragma unroll
      for(int d0=0;d0<2;++d0)stg[orow*64+d0*32+r32]=__float2bfloat16(o[d0][r]*rli[r]);}
    asm volatile("s_waitcnt lgkmcnt(0)":::"memory");
    #pragma unroll
    for(int i=0;i<4;++i){const int row=i*8+(lane>>3),ch=lane&7; const u32x4 v=*(const u32x4*)(stg+row*64+ch*8); ATTN_STORE16(Ow+(long)row*op+ch*8,v);} }
  asm volatile("s_waitcnt lgkmcnt(0)\n\ts_barrier":::"memory");
  #undef DMA_K
  #undef DMA_V
  #undef CMASK
  #undef START
  #undef RESC
  #undef ROT
}
constexpr int ATTN_LDS_BYTES=LDS_BYTES;
constexpr int C2_KSL=8192, C2_VSL=16384, C2_LK=0, C2_LV=3*C2_KSL, C2_LWS=C2_LV+2*C2_VSL, C2_END=C2_LWS+NW*64*4, C2_STASH=65536;
static_assert(C2_END<=C2_STASH,"c2 lds");
template<int MODE,int THRL> __device__ __forceinline__ void attn_unit_v128(const bf16*Qu,int qp,const bf16*__restrict__ Kh,const bf16*__restrict__ Vh,int kvp,bf16*Ou,int op,int NT,char*shm,float lam,float oscale,const float*__restrict__ sg){
  int tid_o=threadIdx.x; asm volatile("":"+v"(tid_o)); const int tid=tid_o,lane=tid&63,r32=lane&31,hi=lane>>5; const int wid=__builtin_amdgcn_readfirstlane(tid>>6);
  const bf16*Qw=Qu+(long)(wid*QBLK)*qp;
  const unsigned lds0=(unsigned)(uintptr_t)shm;
  float*wsf=(float*)(shm+C2_LWS)+wid*64;
  const bf16*ksrc=Kh+(long)lane*kvp+wid*8;
  const bf16*vsrc=Vh+(long)(16*(wid&3)+(lane>>2))*kvp+(wid>>2)*32+(lane&3)*8;
  const unsigned kdst=lds0+C2_LK+wid*1024, vdst=lds0+C2_LV+wid*1024;
  #define XK(t,slot) glds16(ksrc+(long)(t)*KVBLK*kvp,(unsigned)__builtin_amdgcn_readfirstlane(kdst+(slot)))
  #define XV(t,slot) do{ glds16(vsrc+(long)(t)*KVBLK*kvp,(unsigned)__builtin_amdgcn_readfirstlane(vdst+(slot))); glds16(vsrc+64+(long)(t)*KVBLK*kvp,(unsigned)__builtin_amdgcn_readfirstlane(vdst+8192+(slot))); }while(0)
  const char*Kbase=shm+C2_LK; bf16x8 kf[8];
  const lds_cptr shm3=(lds_cptr)shm; const lds_cptr kp0=shm3+C2_LK+hi*1024+r32*16; const lds_cptr vp0=shm3+C2_LV+((lane>>4)&1)*32+(lane&3)*8+(4*hi+((lane&15)>>2))*64;
  const int vb0=(int)(lds0+C2_LV)+((lane>>4)&1)*32+(lane&3)*8+(4*hi+((lane&15)>>2))*64;
  XK(0,0);XV(0,0);XK(1,C2_KSL);
  bf16x8 qr[4];
  #pragma unroll
  for(int d0=0;d0<4;++d0)qr[d0]=*reinterpret_cast<const bf16x8*>(&Qw[(long)r32*qp+d0*16+hi*8]);
  float mhat=0.f,l_reg=0.f;f32x16 o[4];o[0]=f32x16{};o[1]=f32x16{};o[2]=f32x16{};o[3]=f32x16{};f32x16 negm=f32x16{};asm volatile("":"+v"(negm));
  bool resc=false;
  #define XRESC() do{ if(resc){ asm volatile("s_waitcnt lgkmcnt(0)":::"memory"); \
      _Pragma("unroll") for(int d_=0;d_<4;++d_) _Pragma("unroll") for(int r=0;r<16;++r)o[d_][r]*=wsf[crow(r,hi)]; } }while(0)
  f32x16 C0,C1; s16x4 vlo[8],vhi[8]; u32x4 pw0,pw1,pw2,pw3;
  int k_t=C2_KSL,k_t1=2*C2_KSL;
  int v_tm1=0,v_t=C2_VSL;
  #define XROT() do{ k_t=k_t1; k_t1=(k_t1==2*C2_KSL)?0:k_t1+C2_KSL; const int s_=v_tm1; v_tm1=v_t; v_t=s_; }while(0)
  XK(2,2*C2_KSL);
  WAIT_BAR(3);
  qkt(C0,C1,Kbase,qr,negm,r32,hi);asm volatile("s_nop 15\n\ts_nop 7":"+v"(C0),"+v"(C1));
  { const float rm=rowmax(C0,C1); mhat=fadd_s(mhat,rm);
    _Pragma("unroll") for(int r=0;r<16;++r){C0[r]=fsub_s(C0[r],rm);C1[r]=fsub_s(C1[r],rm);}
    _Pragma("unroll") for(int r=0;r<16;++r)negm[r]=-mhat; asm volatile("":"+v"(negm));
    _Pragma("unroll") for(int r=0;r<16;++r){C0[r]=__builtin_amdgcn_exp2f(C0[r]);C1[r]=__builtin_amdgcn_exp2f(C1[r]);}
    float sacc=0.f; _Pragma("unroll") for(int r=0;r<16;++r)sacc+=C0[r]; _Pragma("unroll") for(int r=0;r<16;++r)sacc+=C1[r]; l_reg=sacc;
    pw0=(u32x4){cvtpk_s(C0[0],C0[1]),cvtpk_s(C0[2],C0[3]),cvtpk_s(C0[4],C0[5]),cvtpk_s(C0[6],C0[7])}; pw1=(u32x4){cvtpk_s(C0[8],C0[9]),cvtpk_s(C0[10],C0[11]),cvtpk_s(C0[12],C0[13]),cvtpk_s(C0[14],C0[15])};
    pw2=(u32x4){cvtpk_s(C1[0],C1[1]),cvtpk_s(C1[2],C1[3]),cvtpk_s(C1[4],C1[5]),cvtpk_s(C1[6],C1[7])}; pw3=(u32x4){cvtpk_s(C1[8],C1[9]),cvtpk_s(C1[10],C1[11]),cvtpk_s(C1[12],C1[13]),cvtpk_s(C1[14],C1[15])};
    asm volatile("":"+v"(pw0),"+v"(pw1),"+v"(pw2),"+v"(pw3)); }
  WAIT_BAR(0);
  if(3<NT){XK(3,0);} XV(1,C2_VSL);
  kload8(kf,kp0+k_t);
  if(3<NT){WAIT_BAR(3);}else{WAIT_BAR(2);}
  #define PAF(k) __builtin_bit_cast(bf16x8,pw##k)
  #define VFR(i) (bf16x8){vlo[i][0],vlo[i][1],vlo[i][2],vlo[i][3],vhi[i][0],vhi[i][1],vhi[i][2],vhi[i][3]}
  #define PIN(x) asm volatile("":"+v"(x))
  #define MX3(a,b,c) __builtin_fmaxf(__builtin_fmaxf((a),(b)),(c))
  #define EX(v) __builtin_amdgcn_exp2f(v)
  #define VRD(s,f) do{ vlo[s]=vtr(vp_+((((f)&3))*4096+((f)>>2)*1024)); vhi[s]=vtr(vp_+((((f)&3))*4096+((f)>>2)*1024+512)); }while(0)
  #define KRD(G,j) do{ if(G){ kload2(kf,kp0+k_t1,j); SBAR(); } }while(0)
  #define QKG(MF,i) do{ VRD(i,i); SBAR(); MF; SBAR(); }while(0)
  #define PVG(f,RD,X0,X1,A0,A1,PK) do{ o[(f)&3]=__builtin_amdgcn_mfma_f32_32x32x16_bf16(PAFK(f),VFR((f)&7),o[(f)&3],0,0,0); RD; X0=EX(X0); X1=EX(X1); sacc+=A0; sacc+=A1; PIN(sacc); PK; PIN(C0); PIN(C1); SBAR(); }while(0)
  #define PAFK(f) (((f)>>2)==0?PAF(0):((f)>>2)==1?PAF(1):((f)>>2)==2?PAF(2):PAF(3))
  #define PKW(P,B) cvtpk_s(P[B],P[B+1])
  #define XSTEP(t,GK,GV,GL) do{ SBAR(); \
    if(GV){XV((t),v_t);} \
    const lds_cptr vp_=vp0+v_tm1; \
    QKG(C0=__builtin_amdgcn_mfma_f32_32x32x16_bf16(kf[0],qr[0],negm,0,0,0),0); \
    QKG(C1=__builtin_amdgcn_mfma_f32_32x32x16_bf16(kf[1],qr[0],negm,0,0,0),1); \
    QKG(C0=__builtin_amdgcn_mfma_f32_32x32x16_bf16(kf[2],qr[1],C0,0,0,0),2); \
    QKG(C1=__builtin_amdgcn_mfma_f32_32x32x16_bf16(kf[3],qr[1],C1,0,0,0),3); \
    QKG(C0=__builtin_amdgcn_mfma_f32_32x32x16_bf16(kf[4],qr[2],C0,0,0,0),4); \
    QKG(C1=__builtin_amdgcn_mfma_f32_32x32x16_bf16(kf[5],qr[2],C1,0,0,0),5); \
    QKG(C0=__builtin_amdgcn_mfma_f32_32x32x16_bf16(kf[6],qr[3],C0,0,0,0),6); \
    QKG(C1=__builtin_amdgcn_mfma_f32_32x32x16_bf16(kf[7],qr[3],C1,0,0,0),7); \
    if(GK){XK((t)+3,k_t);} \
    { float a=MX3(C0[0],C0[1],C1[0]),b=MX3(C0[2],C0[3],C1[1]); a=MX3(a,C1[2],C1[3]); \
      _Pragma("unroll") for(int r=4;r<16;r+=4){a=MX3(a,C0[r],C0[r+1]);b=MX3(b,C0[r+2],C0[r+3]);a=MX3(a,C1[r],C1[r+1]);b=MX3(b,C1[r+2],C1[r+3]);} \
      float rm=__builtin_fmaxf(a,b); { auto rr=__builtin_amdgcn_permlane32_swap(__float_as_uint(rm),__float_as_uint(rm),false,false); rm=__builtin_fmaxf(__uint_as_float(rr[0]),__uint_as_float(rr[1])); } \
      resc=false; \
      if(__builtin_expect(__any(rm>(float)THRL),0)){ const float dl=__builtin_fmaxf(rm,0.f); mhat+=dl; \
        _Pragma("unroll") for(int r=0;r<16;++r){C0[r]-=dl;C1[r]-=dl;} \
        _Pragma("unroll") for(int r=0;r<16;++r)negm[r]=-mhat; asm volatile("":"+v"(negm)); \
        const float f=__builtin_amdgcn_exp2f(-dl); l_reg*=f; if(hi==0)wsf[r32]=f; resc=true; } } \
    SBAR(); \
    float sacc=0.f; \
    PVG(0, VRD(0,8),  C0[0],C0[1],  0.f,0.f,      ;); \
    PVG(1, VRD(1,9),  C0[2],C0[3],  C0[0],C0[1],  ;); \
    PVG(2, VRD(2,10), C0[4],C0[5],  C0[2],C0[3],  ;); \
    KRD(GL,0); PVG(3, VRD(3,11), C0[6],C0[7],  C0[4],C0[5],  ;); \
    KRD(GL,1); PVG(4, VRD(4,12), C0[8],C0[9],  C0[6],C0[7],  pw0[0]=PKW(C0,0);pw0[1]=PKW(C0,2);PIN(pw0)); \
    KRD(GL,2); PVG(5, VRD(5,13), C0[10],C0[11],C0[8],C0[9],  pw0[2]=PKW(C0,4);pw0[3]=PKW(C0,6);PIN(pw0)); \
    KRD(GL,3); PVG(6, VRD(6,14), C0[12],C0[13],C0[10],C0[11],;); \
    PVG(7, VRD(7,15), C0[14],C0[15],C0[12],C0[13],;); \
    PVG(8, ;,         C1[0],C1[1],  C0[14],C0[15],pw1[0]=PKW(C0,8);pw1[1]=PKW(C0,10);PIN(pw1)); \
    PVG(9, ;,         C1[2],C1[3],  C1[0],C1[1],  pw1[2]=PKW(C0,12);pw1[3]=PKW(C0,14);PIN(pw1)); \
    PVG(10,;,         C1[4],C1[5],  C1[2],C1[3],  ;); \
    PVG(11,;,         C1[6],C1[7],  C1[4],C1[5],  ;); \
    PVG(12,;,         C1[8],C1[9],  C1[6],C1[7],  pw2[0]=PKW(C1,0);pw2[1]=PKW(C1,2);PIN(pw2)); \
    PVG(13,;,         C1[10],C1[11],C1[8],C1[9],  pw2[2]=PKW(C1,4);pw2[3]=PKW(C1,6);PIN(pw2)); \
    PVG(14,;,         C1[12],C1[13],C1[10],C1[11],;); \
    PVG(15,;,         C1[14],C1[15],C1[12],C1[13],;); \
    sacc+=C1[14]; sacc+=C1[15]; l_reg+=sacc; \
    pw3[0]=PKW(C1,8);pw3[1]=PKW(C1,10);pw3[2]=PKW(C1,12);pw3[3]=PKW(C1,14);PIN(pw3); SBAR(); \
    }while(0)
  int t=1;
  XSTEP(1,(4<NT),false,(2<NT)); if(4<NT){WAIT_BAR(1);}else{WAIT_BAR(0);} XRESC(); XROT(); t=2;
  for(;t+3<NT;++t){ XSTEP(t,true,true,true); WAIT_BAR(1); XRESC(); XROT(); }
  for(;t+1<NT;++t){ XSTEP(t,false,true,true); WAIT_BAR(0); XRESC(); XROT(); }
  XSTEP(NT-1,false,true,false); WAIT_BAR(0); XRESC();
  { const int vb=vb0+v_t;
    #pragma unroll
    for(int d0=0;d0<4;++d0){s16x4 lo[4],hh[4];
      #pragma unroll
      for(int ks=0;ks<4;++ks){
        asm volatile("ds_read_b64_tr_b16 %0,%1 offset:%c2":"=&v"(lo[ks]):"v"(vb),"i"(d0*4096+ks*1024):"memory");
        asm volatile("ds_read_b64_tr_b16 %0,%1 offset:%c2":"=&v"(hh[ks]):"v"(vb),"i"(d0*4096+ks*1024+512):"memory");}
      asm volatile("s_waitcnt lgkmcnt(0)":::"memory");SBAR();
      #define PKD(k) (bf16x8){lo[k][0],lo[k][1],lo[k][2],lo[k][3],hh[k][0],hh[k][1],hh[k][2],hh[k][3]}
      o[d0]=__builtin_amdgcn_mfma_f32_32x32x16_bf16(PAF(0),PKD(0),o[d0],0,0,0);
      o[d0]=__builtin_amdgcn_mfma_f32_32x32x16_bf16(PAF(1),PKD(1),o[d0],0,0,0);
      o[d0]=__builtin_amdgcn_mfma_f32_32x32x16_bf16(PAF(2),PKD(2),o[d0],0,0,0);
      o[d0]=__builtin_amdgcn_mfma_f32_32x32x16_bf16(PAF(3),PKD(3),o[d0],0,0,0);
      #undef PKD
    } }
  #undef PKW
  #undef PAFK
  #undef PVG
  #undef QKG
  #undef KRD
  #undef VRD
  #undef EX
  #undef MX3
  #undef PIN
  #undef VFR
  #undef PAF
  #undef XSTEP
  {auto rr=__builtin_amdgcn_permlane32_swap(__float_as_uint(l_reg),__float_as_uint(l_reg),false,false);l_reg=__uint_as_float(rr[0])+__uint_as_float(rr[1]);}
  if(hi==0)wsf[32+r32]=l_reg;asm volatile("s_waitcnt lgkmcnt(0)":::"memory");
  float rli[16];
  #pragma unroll
  for(int r=0;r<16;++r)rli[r]=__builtin_amdgcn_rcpf(wsf[32+crow(r,hi)]);
  unsigned*stash=(unsigned*)(shm+C2_STASH)+wid*2048;
  if constexpr(MODE==0){
    #pragma unroll
    for(int d0=0;d0<4;++d0)
      #pragma unroll
      for(int r=0;r<16;r+=2)stash[(d0*8+(r>>1))*64+lane]=cvtpk_s(o[d0][r]*rli[r],o[d0][r+1]*rli[r+1]);
  }else{
    float ss[16];
    #pragma unroll
    for(int r=0;r<16;++r)ss[r]=0.f;
    #pragma unroll
    for(int d0=0;d0<4;++d0)
      #pragma unroll
      for(int r=0;r<16;r+=2){const unsigned w=stash[(d0*8+(r>>1))*64+lane];
        const float da=__uint_as_float(w<<16)-lam*(o[d0][r]*rli[r]),db=__uint_as_float(w&0xffff0000u)-lam*(o[d0][r+1]*rli[r+1]);
        o[d0][r]=da;o[d0][r+1]=db;ss[r]+=da*da;ss[r+1]+=db*db;}
    #pragma unroll
    for(int r=0;r<16;++r){float v=::xsum_x16(::xsum_row16(ss[r]));
      ss[r]=oscale*::rsq_(v*(1.f/128.f)+1e-6f);}
    bf16*stg=(bf16*)stash;
    #pragma unroll
    for(int d0=0;d0<4;++d0){const float g=sg[d0*32+r32];
      #pragma unroll
      for(int r=0;r<16;++r)stg[crow(r,hi)*128+d0*32+r32]=__float2bfloat16(o[d0][r]*ss[r]*g);}
    asm volatile("s_waitcnt lgkmcnt(0)":::"memory");
    bf16*Ow=Ou+(long)(wid*QBLK)*op;
    #pragma unroll
    for(int i=0;i<8;++i){const int row=i*4+(lane>>4),ch=lane&15;const u32x4 v=*(const u32x4*)(stg+row*128+ch*8);*(u32x4*)(Ow+(long)row*op+ch*8)=v;}
  }
  asm volatile("s_waitcnt lgkmcnt(0)\n\ts_barrier":::"memory");
  #undef XK
  #undef XV
  #undef XRESC
  #undef XROT
}
#undef SBAR
#undef WAIT_BAR
}

namespace attn_c {
using bf16 = __hip_bfloat16;
constexpr int D = 128, DQK = 64, NW = 8, QBLK = 32, KVBLK = 64, SDEPTH = 2;
constexpr size_t SHM_V = KVBLK * D * 2, SHM_K = KVBLK * DQK * 2, SHM_ATTN = 2 * SHM_V + 2 * SHM_K + NW * 64 * 4;
constexpr float THR_L2 = 8.f * 1.4426950408889634f;
using bf16x8 = __attribute__((ext_vector_type(8))) short;
using s16x4  = __attribute__((ext_vector_type(4))) short;
using f32x16 = __attribute__((ext_vector_type(16))) float;
using f32x8  = __attribute__((ext_vector_type(8))) float;
using u32x4  = __attribute__((ext_vector_type(4))) unsigned;
#define KSWZ(row, colB) ((row) * 128 + ((colB) ^ ((((row) >> 1) & 7) << 4)))
#define SBAR_C() __builtin_amdgcn_sched_barrier(0)
__device__ __forceinline__ int crow(int r, int hi) { return (r & 3) + 8 * (r >> 2) + 4 * hi; }
__device__ __forceinline__ unsigned cvtpk(float lo, float hi) {
  typedef float f2_ __attribute__((ext_vector_type(2))); typedef __bf16 b2_ __attribute__((ext_vector_type(2))); f2_ v = {lo, hi}; b2_ b = __builtin_convertvector(v, b2_); return __builtin_bit_cast(unsigned, b);
}
template <typename TIn> struct Stage;
template <> struct Stage<bf16>  { using T = bf16x8;
  __device__ static __forceinline__ T ld8(const bf16* p) { return *reinterpret_cast<const bf16x8*>(p); }
  __device__ static __forceinline__ bf16x8 tobf(T x) { return x; } };
template <> struct Stage<float> { using T = f32x8;
  __device__ static __forceinline__ T ld8(const float* p) { return *reinterpret_cast<const f32x8*>(p); }
  __device__ static __forceinline__ bf16x8 tobf(T x) {
    u32x4 w = {cvtpk(x[0], x[1]), cvtpk(x[2], x[3]), cvtpk(x[4], x[5]), cvtpk(x[6], x[7])}; return *reinterpret_cast<bf16x8*>(&w); } };

__device__ __forceinline__ void partialSM(f32x16& p0, f32x16& p1, float& m_reg, float& mn, float& alpha) {
  constexpr float C = 1.f;
  float pmax = p0[0]; for (int r = 1; r < 16; ++r) pmax = fmaxf(pmax, p0[r]); for (int r = 0; r < 16; ++r) pmax = fmaxf(pmax, p1[r]);
  { auto rr = __builtin_amdgcn_permlane32_swap(__float_as_uint(pmax), __float_as_uint(pmax), false, false);
    pmax = fmaxf(__uint_as_float(rr[0]), __uint_as_float(rr[1])); }
  if (__builtin_expect(__all(pmax - m_reg <= THR_L2), 1)) { mn = m_reg; alpha = 1.f; }
  else { mn = fmaxf(m_reg, pmax); alpha = __builtin_amdgcn_exp2f((m_reg - mn) * C); m_reg = mn; }
  float mnC = -mn * C;
  for (int r = 0; r < 16; ++r) p0[r] = fmaf(p0[r], C, mnC); for (int r = 0; r < 16; ++r) p1[r] = fmaf(p1[r], C, mnC);
  for (int r = 0; r < 16; ++r) p0[r] = __builtin_amdgcn_exp2f(p0[r]);
}
__device__ __forceinline__ void finishSM(f32x16& p0, f32x16& p1, float alpha, float& l_reg, bf16x8& pa0, bf16x8& pa1, bf16x8& pa2, bf16x8& pa3) {
  for (int r = 0; r < 16; ++r) p1[r] = __builtin_amdgcn_exp2f(p1[r]);
  float ps = 0; for (int r = 0; r < 16; ++r) ps += p0[r]; for (int r = 0; r < 16; ++r) ps += p1[r];
  { auto rr = __builtin_amdgcn_permlane32_swap(__float_as_uint(ps), __float_as_uint(ps), false, false);
    ps = __uint_as_float(rr[0]) + __uint_as_float(rr[1]); }
  l_reg = l_reg * alpha + ps;
#define PK4(P, BASE, OUT) do { unsigned a0 = cvtpk(P[BASE + 0], P[BASE + 1]), a1 = cvtpk(P[BASE + 2], P[BASE + 3]);   \
    unsigned b0 = cvtpk(P[BASE + 4], P[BASE + 5]), b1 = cvtpk(P[BASE + 6], P[BASE + 7]);                              \
    auto r0 = __builtin_amdgcn_permlane32_swap(a0, b0, false, false); auto r1 = __builtin_amdgcn_permlane32_swap(a1, b1, false, false); \
    u32x4 w = {r0[0], r1[0], r0[1], r1[1]}; OUT = *reinterpret_cast<bf16x8*>(&w); } while (0)
  PK4(p0, 0, pa0); PK4(p0, 8, pa1); PK4(p1, 0, pa2); PK4(p1, 8, pa3);
#undef PK4
}
__device__ __forceinline__ void qkt(f32x16& p0, f32x16& p1, const bf16* Ks, const bf16x8* qr, int r32, int hi) {
  p0 = f32x16{}; p1 = f32x16{};
  for (int d0 = 0; d0 < 4; ++d0) { int cb = (d0 * 16 + hi * 8) * 2;
    bf16x8 b0 = *reinterpret_cast<const bf16x8*>((const char*)Ks + KSWZ(r32, cb));
    bf16x8 b1 = *reinterpret_cast<const bf16x8*>((const char*)Ks + KSWZ(32 + r32, cb));
    p0 = __builtin_amdgcn_mfma_f32_32x32x16_bf16(b0, qr[d0], p0, 0, 0, 0);
    p1 = __builtin_amdgcn_mfma_f32_32x32x16_bf16(b1, qr[d0], p1, 0, 0, 0); }
}
__device__ __forceinline__ int v_st(int k, int c) { const int kk = (k & ~0xC) | ((k & 4) << 1) | ((k & 8) >> 1); return ((kk >> 3) * 4 + (c >> 5)) * 512 + ((kk & 7) * 32 + (c & 31)) * 2; }
__device__ __forceinline__ int v_rd_base(int lane) { return ((lane & 3) << 3) | (((lane >> 2) & 3) << 6) | (((lane >> 4) & 1) << 5) | (((lane >> 5) & 1) << 8); }
constexpr int v_rd_off(int d0, int ks, int half) { return d0 * 512 + ks * 4096 + half * 2048; }
template <int OFF> __device__ __forceinline__ s16x4 tr_read(int vb) {
  s16x4 r; asm volatile("ds_read_b64_tr_b16 %0, %1 offset:%2" : "=&v"(r) : "v"(vb), "i"(OFF) : "memory"); return r;
}
template <int D0> __device__ __forceinline__ void pv_one(f32x16& od, int vb, bf16x8 pa0, bf16x8 pa1, bf16x8 pa2, bf16x8 pa3) {
  const s16x4 l0 = tr_read<v_rd_off(D0, 0, 0)>(vb), h0 = tr_read<v_rd_off(D0, 0, 1)>(vb), l1 = tr_read<v_rd_off(D0, 1, 0)>(vb), h1 = tr_read<v_rd_off(D0, 1, 1)>(vb);
  const s16x4 l2 = tr_read<v_rd_off(D0, 2, 0)>(vb), h2 = tr_read<v_rd_off(D0, 2, 1)>(vb), l3 = tr_read<v_rd_off(D0, 3, 0)>(vb), h3 = tr_read<v_rd_off(D0, 3, 1)>(vb);
  asm volatile("s_waitcnt lgkmcnt(0)" ::: "memory"); SBAR_C();
#define PK(L, H) (bf16x8){L[0], L[1], L[2], L[3], H[0], H[1], H[2], H[3]}
  od = __builtin_amdgcn_mfma_f32_32x32x16_bf16(pa0, PK(l0, h0), od, 0, 0, 0);
  od = __builtin_amdgcn_mfma_f32_32x32x16_bf16(pa1, PK(l1, h1), od, 0, 0, 0);
  od = __builtin_amdgcn_mfma_f32_32x32x16_bf16(pa2, PK(l2, h2), od, 0, 0, 0);
  od = __builtin_amdgcn_mfma_f32_32x32x16_bf16(pa3, PK(l3, h3), od, 0, 0, 0);
#undef PK
}
__device__ __forceinline__ void pv_d0(f32x16* o, int vb, bf16x8 pa0, bf16x8 pa1, bf16x8 pa2, bf16x8 pa3) {
  pv_one<0>(o[0], vb, pa0, pa1, pa2, pa3); pv_one<1>(o[1], vb, pa0, pa1, pa2, pa3); pv_one<2>(o[2], vb, pa0, pa1, pa2, pa3); pv_one<3>(o[3], vb, pa0, pa1, pa2, pa3);
}

template <int MODE> __device__ __forceinline__ void attn_c_unit(const bf16* __restrict__ Qb, int ldq, const bf16* __restrict__ Kh, const bf16* __restrict__ Vh, int ldk,
                                            bf16* __restrict__ Ob, int ldo, int seq, char* lds, float lam, float oscale, const float* __restrict__ sg) {
  typedef bf16 TQ; const int LDQ = ldq, LDK = ldk, LDO = ldo;
  using St = Stage<bf16>; using SQ = Stage<bf16>;
  int tid_o = threadIdx.x; asm volatile("" : "+v"(tid_o)); const int tid = tid_o, wid = tid >> 6, lane = tid & 63, r32 = lane & 31, hi = lane >> 5;
  bf16* V_lds = (bf16*)lds; bf16* K_lds = (bf16*)(lds + 2 * SHM_V);
  float* ws = (float*)(lds + 2 * SHM_V + 2 * SHM_K) + wid * 64; float* li_l = ws; float* al_l = ws + 32;
  float m_reg = -1e30f, l_reg = 0; f32x16 o[4] = {}; bf16x8 qr[4];
  const TQ* Qw = Qb + (long)(wid * QBLK + r32) * LDQ + hi * 8;
#pragma unroll
  for (int d0 = 0; d0 < 4; ++d0) qr[d0] = SQ::tobf(SQ::ld8(Qw + d0 * 16));
  const int sr = tid >> 4, sc = (tid & 15) * 8, vst0 = v_st(sr, sc), vst1 = v_st(32 + sr, sc), kr = tid >> 3, kcb = (tid & 7) * 16;
  const int vb0 = (int)(uintptr_t)V_lds + v_rd_base(lane);
  struct { typename St::T vs0, vs1, ks0; } sr_[SDEPTH];
#define SLOAD(i, k0) do { sr_[i].vs0 = St::ld8(&Vh[(long)((k0) + sr) * LDK + sc]); sr_[i].vs1 = St::ld8(&Vh[(long)((k0) + 32 + sr) * LDK + sc]); \
    sr_[i].ks0 = St::ld8(&Kh[(long)((k0) + kr) * LDK + (kcb >> 1)]); } while (0)
#define SWRITE(b, i) do { *(bf16x8*)((char*)V_lds + (b) * SHM_V + vst0) = St::tobf(sr_[i].vs0);          \
    *(bf16x8*)((char*)V_lds + (b) * SHM_V + vst1) = St::tobf(sr_[i].vs1);                               \
    *(bf16x8*)((char*)K_lds + (b) * SHM_K + KSWZ(kr, kcb)) = St::tobf(sr_[i].ks0); } while (0)
#define SWAIT() do { if constexpr (SDEPTH == 2) asm volatile("s_waitcnt vmcnt(3)" ::: "memory"); else asm volatile("s_waitcnt vmcnt(0)" ::: "memory"); } while (0)
#define RESC(a) do { if (__any((a) < 1.f)) { if (hi == 0) al_l[r32] = (a); asm volatile("s_waitcnt lgkmcnt(0)" ::: "memory"); \
    for (int d = 0; d < 4; ++d) for (int r = 0; r < 16; ++r) o[d][r] *= al_l[crow(r, hi)]; } } while (0)
  f32x16 pA0, pA1, pB0, pB1; float mnA, mnB, alA, alB; bf16x8 pa0, pa1, pa2, pa3; const int NT = seq / KVBLK;
  constexpr int SE = 0, SO = SDEPTH - 1;
  SLOAD(SE, 0); asm volatile("s_waitcnt vmcnt(0)" ::: "memory"); SWRITE(0, SE); __syncthreads();
  qkt(pA0, pA1, K_lds, qr, r32, hi); partialSM(pA0, pA1, m_reg, mnA, alA);
  SLOAD(SO, KVBLK); if constexpr (SDEPTH == 2) { if (2 < NT) SLOAD(SE, 2 * KVBLK); }
  SWAIT(); SWRITE(1, SO); __syncthreads();
  for (int j = 1; j + 1 < NT; j += 2) {
    SBAR_C(); qkt(pB0, pB1, (bf16*)((char*)K_lds + SHM_K), qr, r32, hi);
    finishSM(pA0, pA1, alA, l_reg, pa0, pa1, pa2, pa3); SBAR_C();
    SLOAD(SO, (j + SDEPTH) * KVBLK); SBAR_C();
    pv_d0(o, vb0, pa0, pa1, pa2, pa3); partialSM(pB0, pB1, m_reg, mnB, alB);
    __syncthreads(); SWAIT(); SWRITE(0, SE);
    RESC(alB); __syncthreads();
    SBAR_C(); qkt(pA0, pA1, K_lds, qr, r32, hi);
    finishSM(pB0, pB1, alB, l_reg, pa0, pa1, pa2, pa3); SBAR_C();
    if (SDEPTH == 1 || j + 3 < NT) SLOAD(SE, (j + 1 + SDEPTH) * KVBLK); SBAR_C();
    pv_d0(o, vb0 + (int)SHM_V, pa0, pa1, pa2, pa3); partialSM(pA0, pA1, m_reg, mnA, alA);
    __syncthreads(); SWAIT(); SWRITE(1, SO);
    RESC(alA); __syncthreads();
  }
  SBAR_C(); qkt(pB0, pB1, (bf16*)((char*)K_lds + SHM_K), qr, r32, hi);
  finishSM(pA0, pA1, alA, l_reg, pa0, pa1, pa2, pa3); SBAR_C();
  pv_d0(o, vb0, pa0, pa1, pa2, pa3); partialSM(pB0, pB1, m_reg, mnB, alB);
  __syncthreads(); RESC(alB);
  finishSM(pB0, pB1, alB, l_reg, pa0, pa1, pa2, pa3); SBAR_C();
  pv_d0(o, vb0 + (int)SHM_V, pa0, pa1, pa2, pa3);
  if (hi == 0) li_l[r32] = l_reg; asm volatile("s_waitcnt lgkmcnt(0)" ::: "memory");
  float rli[16];
#pragma unroll
  for (int r = 0; r < 16; ++r) rli[r] = __builtin_amdgcn_rcpf(li_l[crow(r, hi)]);
  unsigned* stash = (unsigned*)(lds + 65536) + wid * 2048;
  if constexpr (MODE == 0) {
#pragma unroll
    for (int d0 = 0; d0 < 4; ++d0)
#pragma unroll
      for (int r = 0; r < 16; r += 2) stash[(d0 * 8 + (r >> 1)) * 64 + lane] = cvtpk(o[d0][r] * rli[r], o[d0][r + 1] * rli[r + 1]);
  } else {
    float ss[16];
#pragma unroll
    for (int r = 0; r < 16; ++r) ss[r] = 0.f;
#pragma unroll
    for (int d0 = 0; d0 < 4; ++d0)
#pragma unroll
      for (int r = 0; r < 16; r += 2) { const unsigned w = stash[(d0 * 8 + (r >> 1)) * 64 + lane];
        const float da = __uint_as_float(w << 16) - lam * (o[d0][r] * rli[r]), db = __uint_as_float(w & 0xffff0000u) - lam * (o[d0][r + 1] * rli[r + 1]);
        o[d0][r] = da; o[d0][r + 1] = db; ss[r] += da * da; ss[r + 1] += db * db; }
#pragma unroll
    for (int r = 0; r < 16; ++r) { float v = ss[r]; v += __shfl_xor(v, 1); v += __shfl_xor(v, 2); v += __shfl_xor(v, 4); v += __shfl_xor(v, 8); v += __shfl_xor(v, 16);
      ss[r] = oscale / sqrtf(v * (1.f / 128.f) + 1e-6f); }
    bf16* stg = (bf16*)stash;
#pragma unroll
    for (int d0 = 0; d0 < 4; ++d0) { const float g = sg[d0 * 32 + r32];
#pragma unroll
      for (int r = 0; r < 16; ++r) stg[crow(r, hi) * 128 + d0 * 32 + r32] = __float2bfloat16(o[d0][r] * ss[r] * g); }
    asm volatile("s_waitcnt lgkmcnt(0)" ::: "memory");
    bf16* Ow = Ob + (long)(wid * QBLK) * LDO;
#pragma unroll
    for (int i = 0; i < 8; ++i) { const int row = i * 4 + (lane >> 4), ch = lane & 15; const u32x4 v = *(const u32x4*)(stg + row * 128 + ch * 8); *(u32x4*)(Ow + (long)row * LDO + ch * 8) = v; }
  }
  __syncthreads();
#undef SLOAD
#undef SWRITE
#undef SWAIT
#undef RESC
}


#undef KSWZ
}


#define LAS __attribute__((address_space(3)))

#define XB_TMO      128
#define XB_XCNT(j)  (256  + 64 * (j))
#define XB_XSUB(j)  (1280 + 64 * (j))
#define XB_XGEN(j)  (2304 + 64 * (j))
#define XB_TOP      3328
#define XB_TOPGEN   3392
#define XCD_BAR_WORDS 3456
#define XB_SPIN_CAP (1u << 18)

__device__ __forceinline__ unsigned xb_ld(unsigned* p)              { return __hip_atomic_load(p, __ATOMIC_RELAXED, __HIP_MEMORY_SCOPE_AGENT); }
__device__ __forceinline__ unsigned xb_add(unsigned* p, unsigned v) { return __hip_atomic_fetch_add(p, v, __ATOMIC_RELAXED, __HIP_MEMORY_SCOPE_AGENT); }
__device__ __forceinline__ unsigned xb_xcc_id() { return (unsigned)__builtin_amdgcn_s_getreg((3 << 11) | 20) & 0xFu; }
#define XB_SPIN(cond, bar) do { unsigned _sp = 0; while (cond) { __builtin_amdgcn_s_sleep(1); \
    if ((++_sp & 255u) == 0u) { if (xb_ld(&(bar)[XB_TMO])) break; if (_sp > XB_SPIN_CAP) { atomicAdd(&(bar)[XB_TMO], 1u); break; } } } } while (0)

struct XcdBarrier {
    unsigned* bar; unsigned x;
    volatile LAS unsigned* st;
};

__device__ __forceinline__ XcdBarrier xcd_barrier_post(unsigned* bar, volatile LAS unsigned* st) {
    XcdBarrier b; b.bar = bar; b.x = xb_xcc_id(); b.st = st;
    if (threadIdx.x == 0) (void)xb_add(&bar[XB_XCNT(b.x)], 1u);
    return b;
}
__device__ __forceinline__ void xcd_barrier_complete(unsigned* bar, unsigned x, unsigned& nloc, unsigned& nx) {
    const unsigned G = gridDim.x * gridDim.y * gridDim.z;
    unsigned sum, cnt, mine, sp = 0u;
    for (;;) {
        sum = 0u; cnt = 0u; mine = 0u;
#pragma unroll
        for (unsigned j = 0; j < 16; ++j) { const unsigned c = xb_ld(&bar[XB_XCNT(j)]); sum += c; cnt += (c > 0u) ? 1u : 0u; mine = (j == x) ? c : mine; }
        if (sum == G) break;
        __builtin_amdgcn_s_sleep(1);
        if ((++sp & 255u) == 0u) { if (xb_ld(&bar[XB_TMO])) break; if (sp > XB_SPIN_CAP) { atomicAdd(&bar[XB_TMO], 1u); break; } }
    }
    nloc = mine > 0u ? mine : 1u; nx = cnt > 0u ? cnt : 1u;
}

__device__ __forceinline__ void xcd_barrier(const XcdBarrier& b) {
    asm volatile("s_waitcnt vmcnt(0)" ::: "memory");
    __syncthreads();
    if (threadIdx.x == 0) {
        unsigned* bar = b.bar;
        __builtin_amdgcn_s_waitcnt(0);
        unsigned nloc = b.st[0], nx = b.st[1];
        if (nloc == 0u) { xcd_barrier_complete(bar, b.x, nloc, nx); b.st[0] = nloc; b.st[1] = nx; }
        const unsigned old = xb_add(&bar[XB_XSUB(b.x)], 1u);
        const unsigned gen = old / nloc;
        if (old + 1u == (gen + 1u) * nloc) {
            __builtin_amdgcn_fence(__ATOMIC_RELEASE, "agent");
            asm volatile("s_waitcnt vmcnt(0)" ::: "memory");
            const unsigned og = xb_add(&bar[XB_TOP], 1u);
            const unsigned tg = og / nx;
            if (og + 1u == (tg + 1u) * nx) xb_add(&bar[XB_TOPGEN], 1u);
            else XB_SPIN(xb_ld(&bar[XB_TOPGEN]) == tg, bar);
            __builtin_amdgcn_fence(__ATOMIC_ACQUIRE, "agent");
            xb_add(&bar[XB_XGEN(b.x)], 1u);
            asm volatile("s_waitcnt vmcnt(0)" ::: "memory");
        } else {
            XB_SPIN(xb_ld(&bar[XB_XGEN(b.x)]) == gen, bar);
            __builtin_amdgcn_fence(__ATOMIC_ACQUIRE, "agent");
            asm volatile("s_waitcnt vmcnt(0)" ::: "memory");
        }
    }
    __syncthreads();
}

constexpr int NWAVES = 8, RING_BYTES = 131072, LDSCTL_OFF = RING_BYTES, MISC_OFF = LDSCTL_OFF + 320, LDS_BYTES = 147456;
constexpr int CW_BAR = 4096;
#ifndef KMASK
#define KMASK 0xFFFF
#endif
#define KEN(k) (((KMASK) >> (k)) & 1)
#ifndef DUPMASK
#define DUPMASK 0
#endif
#define NREP(k) ((((DUPMASK) >> (k)) & 1) ? 2 : 1)
struct Args { P p; int ph_lo, ph_hi, li, pad; };

struct InprojOrder {
    pg8::StaticOrder so; int G, c, nmain, nextra;
    __device__ void init(int l, int G_, int c_) { so.init(l == 0 ? MT : M_LAT, IN_W, G_, c_); G = G_; c = c_; nmain = so.nwg; nextra = l == 0 ? 0 : 20; }
    __device__ bool next(int i, pg8::Unit& u) const {
        const int L = i * G + c;
        if (L < nmain) return so.next(i, u);
        const int q = L - nmain; if (q >= nextra) return false;
        const int k = q % 5; u.pm = 64 + q / 5; u.pn = k == 0 ? 2 : 8 + k; u.ko = 0; u.pa = u.pm; return true;
    }
    __device__ __forceinline__ void a_ready(const pg8::Unit&) const {}
    __device__ __forceinline__ void done(const pg8::Unit&) const {}
};

__device__ __forceinline__ P load_p() {
    const __attribute__((address_space(4))) P* k = (const __attribute__((address_space(4))) P*)__builtin_amdgcn_kernarg_segment_ptr();
    asm volatile("" : "+s"(k));
    P r;
#pragma unroll
    for (int i = 0; i < 34; ++i) r.in[i] = k->in[i];
    r.out = k->out; r.ws = k->ws; return r;
}
__global__ void __launch_bounds__(NWAVES * 64, 2) mega(Args args) {
    extern __shared__ __attribute__((aligned(16))) unsigned char lds[];
    LAS unsigned char* ldsl = (LAS unsigned char*)lds;
    const int tid = threadIdx.x, lane = tid & 63, wave = __builtin_amdgcn_readfirstlane(tid >> 6);
    const int G = gridDim.x, bx = blockIdx.x, vcu = (G % 8 == 0) ? (bx % 8) * (G / 8) + bx / 8 : bx;
    const int gw = vcu * NWAVES + wave, NGW = G * NWAVES;
    for (int u = tid; u < (LDS_BYTES - LDSCTL_OFF) / 4; u += NWAVES * 64) ((LAS unsigned*)(ldsl + LDSCTL_OFF))[u] = 0u;
    __syncthreads();
    XcdBarrier bar = xcd_barrier_post((unsigned*)(args.p.ws + WS_CTL) + CW_BAR + args.li * XCD_BAR_WORDS, (volatile LAS unsigned*)(ldsl + MISC_OFF) + 8);
    const int lo = args.ph_lo, hi = args.ph_hi;
#define IN(k) (lo <= (k) && (k) < hi)
#define OPQ(x) ({ int t_ = (x); asm volatile("" : "+v"(t_)); t_; })
#define SEAM(k) do { if (IN(k) && IN((k) + 1)) { xcd_barrier(bar); if (NREP(16) == 2) xcd_barrier(bar); } } while (0)

    if (KEN(0) && IN(0)) { const P& p = args.p;
        for (int rep_ = 0; rep_ < NREP(0); ++rep_) {
        for (int it = vcu; it < 192; it += G) ph_mod_item(p, it, (float*)lds, OPQ(tid));
        if (vcu == G - 1) ph_misc(p, tid, NWAVES * 64);
        float* scr = (float*)(lds + wave * 16384);
        if (ALL_MEGA) { for (int j = gw; j < N_PRO; j += NGW) prep_item(p, pro_item(j), scr, OPQ(lane)); }
        else for (int it = gw; it < IT_TOTAL; it += NGW) prep_item(p, it, scr, OPQ(lane));
        __syncthreads(); }
    }
    SEAM(0);

    for (int l = 0; l < 2; ++l) {
        const int pb = l == 0 ? 1 : 10;
        const int nrows = l == 0 ? MT : M_LAT;
        if (KEN(1) && IN(pb)) { const P p = load_p(); for (int rep_ = 0; rep_ < NREP(1); ++rep_) ph_norm(p, l, 0, MT, OPQ(gw), NGW, OPQ(lane)); }
        SEAM(pb);
        if (KEN(2) && IN(pb + 1)) { const P p = load_p(); unsigned char* ws = p.ws;
            pg8::Gemm g{(const bf16*)(ws + WS_H), (const bf16*)(ws + WS_WIN) + (size_t)l * IN_W * D, MT, IN_W, D, D};
            InprojOrder S; S.init(l, G, bx);
            pg8::EpiInproj E{ws, p.in[10] + l * 64, p.in[11] + l * 64, p.in[9] + l * 3072};
            for (int rep_ = 0; rep_ < NREP(2); ++rep_) pg8::gemm_phase<pg8::EpiInproj, InprojOrder, true, true>(ldsl, g, S, E);
            if (ALL_MEGA && l == 0) {
                const int nfull = (MT / 256 * 25) % G; const P& pa = args.p; float* scr = (float*)(lds + wave * 16384);
                const int rank = nfull != 0 ? (int)bx - nfull : (int)bx, nid = nfull != 0 ? G - nfull : G;
                if (rank >= 0) for (int j = rank * NWAVES + wave; j < N_L1; j += nid * NWAVES) prep_item(pa, l1_item(j), scr, OPQ(lane)); }
            if (ALL_MEGA && l == 1) {
                const int nfull = (M_LAT / 256 * 25 + 20) % G;
                if (nfull != 0 && (int)bx >= nfull) { const P& pa = args.p; const int rank = (int)bx - nfull, nid = G - nfull; float* scr = (float*)(lds + wave * 16384);
                    for (int it = IT_DEF1 + rank * NWAVES + wave; it < IT_TOTAL; it += nid * NWAVES) prep_item(pa, it, scr, OPQ(lane)); }
                else if (nfull == 0) { const P& pa = args.p; float* scr = (float*)(lds + wave * 16384);
                    for (int it = IT_DEF1 + (int)bx * NWAVES + wave; it < IT_TOTAL; it += G * NWAVES) prep_item(pa, it, scr, OPQ(lane)); } }
        }
        SEAM(pb + 1);
        if (IN(pb + 2)) { const P p = load_p(); unsigned char* ws = p.ws;
            if (KEN(3)) for (int rep_ = 0; rep_ < NREP(3); ++rep_) for (int t = vcu; t < (l == 0 ? CONV_TILES_ALL : CONV_TILES_LAT); t += G) conv_tile(p, l, t, lds, OPQ(tid));
            __syncthreads();
            if (KEN(4)) for (int rep_ = 0; rep_ < NREP(4); ++rep_) for (int k = 0;; ++k) {
                const int nl = vcu < 512 ? (512 - vcu + G - 1) / G : 0; int u;
                if (k < nl) u = vcu + k * G; else { const int q = (vcu + G - 32 % G) % G + (k - nl) * G; if (l != 0 || q >= 32) break; u = 512 + q; }
                int b, vh, qrow0, krow0, NT;
                if (u < 512) { b = u >> 7; vh = (u >> 4) & 7; qrow0 = b * SEQ + (u & 15) * 256; krow0 = b * NKEY; NT = NKEY / 64; }
                else { const int q = u - 512; b = q >> 3; vh = q & 7; qrow0 = M_LAT + b * CTXL; krow0 = b * NKEY + SEQ; NT = CTXL / 64; }
                attn_body::attn_unit<8>((const attn_body::bf16*)(ws + WS_QA) + (size_t)qrow0 * 512 + vh * 64, 512, (const attn_body::bf16*)(ws + WS_KA) + (size_t)krow0 * 128 + (vh >> 2) * 64,
                                        (const attn_body::bf16*)(ws + WS_VA) + (size_t)krow0 * 128 + (vh >> 2) * 64, 128, (attn_body::bf16*)(ws + WS_OABC) + (size_t)qrow0 * 1536 + vh * 64, 1536, NT, (char*)lds);
            }
            if (KEN(4)) for (int rep_ = 0; rep_ < NREP(4); ++rep_) for (int k = 0;; ++k) {
                const int nl = vcu < 256 ? (256 - vcu + G - 1) / G : 0; int su;
                if (k < nl) su = vcu + k * G; else { const int q = (vcu + G - 64 % G) % G + (k - nl) * G; if (l != 0 || q >= 16) break; su = 256 + q; }
                int b, h, qrow0, krow0, NT;
                if (su < 256) { b = su >> 6; h = (su >> 4) & 3; qrow0 = b * SEQ + (su & 15) * 256; krow0 = b * NKEY; NT = NKEY / 64; }
                else { const int q = su - 256; b = q >> 2; h = q & 3; qrow0 = M_LAT + b * CTXL; krow0 = b * NKEY + SEQ; NT = CTXL / 64; }
                {
                    const float lam = ((const float*)(ws + WS_LAM))[l], li = ((const float*)(ws + WS_LAM))[2 + l];
                    const attn_c::bf16* q_ = (const attn_c::bf16*)(ws + WS_QC) + (size_t)qrow0 * 512 + (2 * h) * 64; const attn_c::bf16* k_ = (const attn_c::bf16*)(ws + WS_KC) + (size_t)krow0 * 512 + (2 * h) * 64;
                    const attn_c::bf16* v_ = (const attn_c::bf16*)(ws + WS_VC) + (size_t)krow0 * 512 + h * 128;
                    attn_body::attn_unit_v128<0, 8>(q_, 512, k_, v_, 512, (attn_c::bf16*)nullptr, 0, NT, (char*)lds, 0.f, 0.f, (const float*)nullptr);
                    attn_body::attn_unit_v128<1, 8>(q_ + 64, 512, k_ + 64, v_, 512, (attn_c::bf16*)(ws + WS_OABC) + (size_t)qrow0 * 1536 + 1024 + h * 128, 1536, NT, (char*)lds, lam, 1.f - li, p.in[20] + l * 128); }
            }
        }
        if (IN(pb + 2) && IN(pb + 4)) xcd_barrier(bar);
        if (KEN(6) && IN(pb + 4)) { const P p = load_p(); unsigned char* ws = p.ws;
            pg8::Gemm g{(const bf16*)(ws + WS_OABC), (const bf16*)(ws + WS_WP) + (size_t)l * D * 1536, nrows, D, 1536, 1536};
            pg8::StaticOrder S; S.init(nrows, D, G, bx);
            pg8::EpiMerge E{(const unsigned char*)(ws + WS_G), (bf16*)(ws + WS_MB)};
            for (int rep_ = 0; rep_ < NREP(6); ++rep_) pg8::gemm_phase<pg8::EpiMerge, pg8::StaticOrder, true, true>(ldsl, g, S, E);
            if (ALL_MEGA && l == 0 && (int)bx >= MT / 256 * 4 - G) {
                const P& pa = args.p; const int n2 = MT / 256 * 4 - G, rank = (int)bx - n2, nid = G - n2; float* scr = (float*)(lds + wave * 16384);
                for (int it = IT_EARLY + rank * NWAVES + wave; it < IT_DEF1; it += nid * NWAVES) prep_item(pa, it, scr, OPQ(lane)); }
        }
        SEAM(pb + 4);
        if (KEN(7) && IN(pb + 5)) { const P p = load_p(); unsigned char* ws = p.ws;
            pg8::Gemm g{(const bf16*)(ws + WS_MB), (const bf16*)(ws + WS_WOUT) + (size_t)l * D * D, M_LAT, D, D, D};
            pg8::StaticOrder S; S.init(M_LAT, D, G, bx);
            pg8::EpiResid E{l == 0 ? p.in[0] : (const float*)nullptr, (bf16*)(ws + WS_XB), modv(p, l, 0, 2)};
            pg8::gemm_phase<pg8::EpiResid, pg8::StaticOrder, true, true>(ldsl, g, S, E);
            if (l == 0) {
                pg8::Gemm gt{(const bf16*)(ws + WS_MB), (const bf16*)(ws + WS_WOUT), MT, D, 256, D};
                pg8::CtxSliceOrder St; St.init(4, G, bx);
                pg8::EpiCtxPartial Et{(bf16*)(ws + WS_CPO)};
                pg8::gemm_phase<pg8::EpiCtxPartial, pg8::CtxSliceOrder, true, true>(ldsl, gt, St, Et);
                }
        }
        SEAM(pb + 5);
        if (l == 0) {
            if (KEN(8) && IN(pb + 6)) { const P p = load_p(); for (int rep_ = 0; rep_ < NREP(8); ++rep_) ph_norm(p, l, 1, MT, OPQ(gw), NGW, OPQ(lane)); }
            SEAM(pb + 6);
            if (KEN(9) && IN(pb + 7)) { const P p = load_p(); unsigned char* ws = p.ws;
                pg8::Gemm g{(const bf16*)(ws + WS_H), (const bf16*)(ws + WS_FFN13), MT, 2 * DFF, D, D};
                pg8::StaticOrder S; S.init(MT, 2 * DFF, G, bx);
                pg8::EpiSwiglu E{(bf16*)(ws + WS_HMID), DFF, 1 << 20};
                for (int rep_ = 0; rep_ < NREP(9); ++rep_) pg8::gemm_phase<pg8::EpiSwiglu, pg8::StaticOrder, true, true>(ldsl, g, S, E);
            }
            SEAM(pb + 7);
            if (KEN(10) && IN(pb + 8)) { const P p = load_p(); unsigned char* ws = p.ws;
                pg8::Gemm g{(const bf16*)(ws + WS_HMID), (const bf16*)(ws + WS_FFN2), M_LAT, D, DFF, DFF};
                pg8::StaticOrder S; S.init(M_LAT, D, G, bx);
                pg8::EpiResid E{(const float*)nullptr, (bf16*)(ws + WS_XB), modv(p, 0, 0, 5)};
                pg8::gemm_phase<pg8::EpiResid, pg8::StaticOrder, true, true>(ldsl, g, S, E);
                {
                    pg8::Gemm gt{(const bf16*)(ws + WS_HMID), (const bf16*)(ws + WS_FFN2), MT, D, 256, DFF};
                    pg8::CtxSliceOrder St; St.init(11, G, bx);
                    pg8::EpiCtxPartial Et{(bf16*)(ws + WS_CPF)};
                    pg8::gemm_phase<pg8::EpiCtxPartial, pg8::CtxSliceOrder, true, true>(ldsl, gt, St, Et);
                    }
            }
            SEAM(pb + 8);
        } else {
            if (KEN(11) && IN(pb + 6)) { const P p = load_p(); ph_router(p, vcu, G, NWAVES, lds, OPQ(tid)); }
            if (IN(pb + 6) && IN(pb + 8)) xcd_barrier(bar);
            if (KEN(13) && IN(pb + 8)) { const P p = load_p(); unsigned char* ws = p.ws;
                int base[9]; moe_bases(p, base);
                pg8::Gemm g{(const bf16*)(ws + WS_H2PX), (const bf16*)(ws + WS_MOE13), base[8], 8 * 2 * DFFX, D / 2, D / 2, SC_W13, SC_ONE, 1};
                pg8::MoeOrder S; S.init(base, 28, G, bx);
                pg8::EpiSwigluF8 E{(unsigned char*)(ws + WS_HMX), DFFX, 28};
                for (int rep_ = 0; rep_ < NREP(13); ++rep_) pg8::gemm_phase<pg8::EpiSwigluF8, pg8::MoeOrder, true, true, true>(ldsl, g, S, E);
            }
            SEAM(pb + 8);
            if (KEN(14) && IN(pb + 9)) { const P p = load_p(); unsigned char* ws = p.ws;
                int base[9]; moe_bases(p, base);
                pg8::Gemm g{(const bf16*)(ws + WS_HMX), (const bf16*)(ws + WS_MOE2), base[8], 8 * D, DFFX / 2, DFFX / 2, SC_W2, SC_HM};
                pg8::MoeOrder S; S.init(base, 4, G, bx, 128);
                pg8::EpiMoeDown E{(bf16*)(ws + WS_H2P), (const float*)(ws + WS_EXPP)};
                for (int rep_ = 0; rep_ < NREP(14); ++rep_) pg8::gemm_phase<pg8::EpiMoeDown, pg8::MoeOrder, true, true, true>(ldsl, g, S, E);
                {
                    pg8::Gemm gt{(const bf16*)(ws + WS_HMX), (const bf16*)(ws + WS_MOE2), base[8], 8 * D, 256, DFFX / 2, SC_W2, SC_HM};
                    pg8::MoeTailOrder St; St.init(base, G, bx);
                    pg8::EpiMoeDownTail Et{(bf16*)(ws + WS_YPT), (const float*)(ws + WS_EXPP)};
                    pg8::gemm_phase<pg8::EpiMoeDownTail, pg8::MoeTailOrder, true, true, true>(ldsl, gt, St, Et); }
            }
            SEAM(pb + 9);
            if (KEN(15) && IN(pb + 10)) { const P p = load_p(); ph_final(p, OPQ(gw), NGW, OPQ(lane)); }
        }
    }
#undef IN
#undef SEAM
}
constexpr int N_PHASES = 21;

#if !ALL_MEGA
__global__ void __launch_bounds__(256) k_prep(P p) {
    __shared__ float scr[4][64 * 33];
    const int wave = threadIdx.x >> 6, lane = threadIdx.x & 63;
    for (int it = blockIdx.x * 4 + wave; it < IT_TOTAL; it += gridDim.x * 4) prep_item(p, it, scr[wave], lane);
}
__global__ void __launch_bounds__(512) k_mod(P p) { __shared__ float sm[8 * 5 * 64 + 5 * 1024]; for (int it = blockIdx.x; it < 192; it += gridDim.x) ph_mod_item(p, it, sm, threadIdx.x); if (blockIdx.x == 0) ph_misc(p, threadIdx.x, 512); }
__global__ void __launch_bounds__(256) k_norm(P p, int l, int which, int nrows) { ph_norm(p, l, which, nrows, blockIdx.x * 4 + (threadIdx.x >> 6), gridDim.x * 4, threadIdx.x & 63); }
__global__ void __launch_bounds__(256) k_router(P p) { __shared__ __attribute__((aligned(16))) unsigned char sm[4096 + 65536 - 4096]; ph_router(p, blockIdx.x, gridDim.x, 4, sm, threadIdx.x); }
__global__ void __launch_bounds__(256) k_final(P p) { ph_final(p, blockIdx.x * 4 + (threadIdx.x >> 6), gridDim.x * 4, threadIdx.x & 63); }
__global__ void __launch_bounds__(256) k_occomb(P p, int l, int nrows) { ph_occomb(p, l, nrows, blockIdx.x * 4 + (threadIdx.x >> 6), gridDim.x * 4, threadIdx.x & 63); }
__global__ void __launch_bounds__(512, 2) k_conv(P p, int l, int ntiles) { extern __shared__ __attribute__((aligned(16))) unsigned char sm[]; for (int t = blockIdx.x; t < ntiles; t += gridDim.x) { int tid = threadIdx.x; asm volatile("" : "+v"(tid)); conv_tile(p, l, t, sm, tid); } }
__global__ void __launch_bounds__(256) k_attn(P p, int typeC) {
    __shared__ float Ks[32][64], Vs[32][64];
    const int qb = blockIdx.x, vh = blockIdx.y, tid = threadIdx.x;
    const bf16 *Q, *K, *V; bf16* O; int qp, kp, op;
    if (!typeC) { Q = (const bf16*)(p.ws + WS_QA) + vh * 64; qp = 512; K = (const bf16*)(p.ws + WS_KA) + (vh / 4) * 64; V = (const bf16*)(p.ws + WS_VA) + (vh / 4) * 64; kp = 128; O = (bf16*)(p.ws + WS_OABC) + vh * 64; op = 1536; }
    else { Q = (const bf16*)(p.ws + WS_QC) + (vh >> 1) * 64; qp = 512; K = (const bf16*)(p.ws + WS_KC) + (vh >> 1) * 64; V = (const bf16*)(p.ws + WS_VC) + (vh >> 2) * 128 + (vh & 1) * 64; kp = 512; O = (bf16*)(p.ws + WS_OCR) + vh * 64; op = 1024; }
    int k0, nk; if (qb < 64) { k0 = (qb / 16) * NKEY; nk = NKEY; } else { k0 = (qb - 64) * NKEY + SEQ; nk = CTXL; }
    const int row = qb * 256 + tid;
    float q[64], o[64];
#pragma unroll
    for (int d = 0; d < 64; ++d) { q[d] = bf2f(Q[(size_t)row * qp + d]); o[d] = 0.f; }
    float m = -INFINITY, lsum = 0.f;
    for (int kt = 0; kt < nk; kt += 32) {
        __syncthreads();
        for (int i = tid; i < 32 * 64; i += 256) { const int kk = i >> 6, d = i & 63; Ks[kk][d] = bf2f(K[(size_t)(k0 + kt + kk) * kp + d]); Vs[kk][d] = bf2f(V[(size_t)(k0 + kt + kk) * kp + d]); }
        __syncthreads();
        float s[32]; float mx = m;
#pragma unroll
        for (int j = 0; j < 32; ++j) { float a = 0.f;
#pragma unroll
            for (int d = 0; d < 64; ++d) a += q[d] * Ks[j][d];
            s[j] = a; mx = fmaxf(mx, a); }
        const float alpha = exp2f(m - mx); m = mx; lsum *= alpha;
#pragma unroll
        for (int d = 0; d < 64; ++d) o[d] *= alpha;
#pragma unroll
        for (int j = 0; j < 32; ++j) { const float pj = exp2f(s[j] - m); lsum += pj;
#pragma unroll
            for (int d = 0; d < 64; ++d) o[d] += pj * Vs[j][d]; }
    }
    const float rl = 1.f / lsum;
#pragma unroll
    for (int d = 0; d < 64; d += 2) *(unsigned*)(O + (size_t)row * op + d) = pk2(o[d] * rl, o[d + 1] * rl);
}

struct TileCtx { float (*C)[257]; int rt64, pn, tid; };
template <class Epi> __global__ void __launch_bounds__(256) k_gemm(P p, Epi E, const bf16* A, int lda, const bf16* Bt, int ldb, int K) {
    extern __shared__ __attribute__((aligned(16))) float smem_g[];
    float (*As)[64] = (float (*)[64])smem_g;
    float (*Bs)[256] = (float (*)[256])(smem_g + 32 * 64);
    float (*Ct)[257] = (float (*)[257])(smem_g + 32 * 64 + 32 * 256);
    const int tid = threadIdx.x, tx = tid & 31, ty = tid >> 5, rt64 = blockIdx.x, pn = blockIdx.y;
    int bt; if (!E.map(p, rt64, pn, bt)) return;
    const bf16* Ab = A + (size_t)rt64 * 64 * lda; const bf16* Bb = Bt + (size_t)bt * 256 * ldb;
    float acc[8][8];
#pragma unroll
    for (int i = 0; i < 8; ++i)
#pragma unroll
        for (int j = 0; j < 8; ++j) acc[i][j] = 0.f;
    for (int k0 = 0; k0 < K; k0 += 32) {
        if (Epi::MIDK && (k0 == 512 || k0 == 1024)) E.mid(p, acc, rt64 * 64 + ty * 8, pn, tx, k0 / 512);
        __syncthreads();
        { const int r = tid >> 2, kq = (tid & 3) * 8; const u32x4 v = *(const u32x4*)(Ab + (size_t)r * lda + k0 + kq);
            As[kq + 0][r] = __uint_as_float(v.x << 16); As[kq + 1][r] = __uint_as_float(v.x & 0xffff0000u); As[kq + 2][r] = __uint_as_float(v.y << 16); As[kq + 3][r] = __uint_as_float(v.y & 0xffff0000u);
            As[kq + 4][r] = __uint_as_float(v.z << 16); As[kq + 5][r] = __uint_as_float(v.z & 0xffff0000u); As[kq + 6][r] = __uint_as_float(v.w << 16); As[kq + 7][r] = __uint_as_float(v.w & 0xffff0000u); }
#pragma unroll
        for (int q4 = 0; q4 < 4; ++q4) { const u32x4 v = *(const u32x4*)(Bb + (size_t)tid * ldb + k0 + q4 * 8); const int kq = q4 * 8;
            Bs[kq + 0][tid] = __uint_as_float(v.x << 16); Bs[kq + 1][tid] = __uint_as_float(v.x & 0xffff0000u); Bs[kq + 2][tid] = __uint_as_float(v.y << 16); Bs[kq + 3][tid] = __uint_as_float(v.y & 0xffff0000u);
            Bs[kq + 4][tid] = __uint_as_float(v.z << 16); Bs[kq + 5][tid] = __uint_as_float(v.z & 0xffff0000u); Bs[kq + 6][tid] = __uint_as_float(v.w << 16); Bs[kq + 7][tid] = __uint_as_float(v.w & 0xffff0000u); }
        __syncthreads();
#pragma unroll 4
        for (int k = 0; k < 32; ++k) { float a[8], b[8];
#pragma unroll
            for (int i = 0; i < 8; ++i) a[i] = As[k][ty * 8 + i];
#pragma unroll
            for (int j = 0; j < 8; ++j) b[j] = Bs[k][tx + 32 * j];
#pragma unroll
            for (int i = 0; i < 8; ++i)
#pragma unroll
                for (int j = 0; j < 8; ++j) acc[i][j] += a[i] * b[j]; }
    }
    if (Epi::MIDK) E.mid(p, acc, rt64 * 64 + ty * 8, pn, tx, 3);
#pragma unroll
    for (int i = 0; i < 8; ++i)
#pragma unroll
        for (int j = 0; j < 8; ++j) Ct[ty * 8 + i][tx + 32 * j] = acc[i][j];
    __syncthreads();
    TileCtx c{Ct, rt64, pn, tid};
    E.tile(p, c);
}
struct NInproj {
    static constexpr bool MIDK = false; int l;
    __device__ bool map(const P&, int, int pn, int& bt) const { bt = pn; return true; }
    __device__ void mid(const P&, float (&)[8][8], int, int, int, int) const {}
    __device__ void tile(const P& p, const TileCtx& t) const {
        const int c = t.tid, pn = t.pn, bj = c >> 7, hh = (c >> 5) & 3, j32 = c & 31, d = 32 * bj + j32, f = j32 & 15, nh = (j32 >> 4) & 1;
        const float* cosT = (const float*)(p.ws + WS_ROPE); const float* sinT = cosT + 1024;
        for (int r = 0; r < 64; ++r) {
            const int row = t.rt64 * 64 + r; const float v = t.C[r][c];
            if (pn < 3 || (pn >= 7 && pn < 11)) {
                const bool isq = pn < 2 || (pn >= 7 && pn < 9), isA = pn < 3, isv = (pn == 2 && hh >= 2);
                float x = v, xp = t.C[r][c ^ 16];
                if (isA && !isv) { float ss = 0.f;
                    for (int dd = 0; dd < 64; ++dd) { const float u = t.C[r][128 * (dd >> 5) + 32 * hh + (dd & 31)]; ss += u * u; }
                    const float rinv = 1.f / sqrtf(ss * (1.f / 64.f) + EPS); const float* g = p.in[isq ? 10 : 11] + l * 64;
                    x = x * rinv * g[d]; xp = xp * rinv * g[d ^ 16]; }
                float o = x;
                if (!isv && row < M_LAT) { const int tpos = row % SEQ, pos = bj ? (tpos % 64) : (tpos / 64); const float cs = cosT[pos * 16 + f], sn = sinT[pos * 16 + f];
                    o = nh ? (x * cs + xp * sn) : (x * cs - xp * sn); }
                if (isq) o *= C2;
                bf16* dst;
                if (pn < 2) dst = (bf16*)(p.ws + WS_QA) + (size_t)row * 512 + (4 * pn + hh) * 64 + d;
                else if (pn == 2) dst = (bf16*)(p.ws + (hh < 2 ? WS_KA : WS_VA)) + (size_t)keyrow(row) * 128 + (hh & 1) * 64 + d;
                else if (pn < 9) dst = (bf16*)(p.ws + WS_QC) + (size_t)row * 512 + (4 * (pn - 7) + hh) * 64 + d;
                else dst = (bf16*)(p.ws + WS_KC) + (size_t)keyrow(row) * 512 + (4 * (pn - 9) + hh) * 64 + d;
                *dst = (bf16)f2bf(o);
            } else if (pn < 7) {
                if (c < 128) { const float gt = t.C[r][c + 128]; ((bf16*)(p.ws + WS_Y))[(size_t)row * 512 + (pn - 3) * 128 + pcol(c)] = (bf16)f2bf(v * sigmoidf_(gt)); }
            } else if (pn < 13) {
                ((bf16*)(p.ws + WS_VC))[(size_t)keyrow(row) * 512 + (pn - 11) * 256 + pcol(c)] = (bf16)f2bf(v);
            } else {
                const int gc = (pn - 13) * 256 + pcol(c);
                ((bf16*)(p.ws + WS_G))[(size_t)row * 3072 + gc] = (bf16)f2bf(sigmoidf_(v + p.in[9][l * 3072 + gc]));
            }
        }
    }
};
struct NMerge {
    static constexpr bool MIDK = true; int pad_;
    __device__ bool map(const P&, int, int pn, int& bt) const { bt = pn; return true; }
    __device__ void mid(const P& p, float (&acc)[8][8], int row0, int pn, int tx, int seg  ) const {
        const bf16* G = (const bf16*)(p.ws + WS_G);
#pragma unroll
        for (int i = 0; i < 8; ++i)
#pragma unroll
            for (int j = 0; j < 8; ++j) { const int col = pn * 256 + pcol(tx + 32 * j); const size_t o = (size_t)(row0 + i) * 3072 + col;
                const float f = seg == 3 ? bf2f(G[o + 2048]) : bf2f(G[o + (seg - 1) * 1024]) / bf2f(G[o + seg * 1024]); acc[i][j] *= f; }
    }
    __device__ void tile(const P& p, const TileCtx& t) const {
        for (int r = 0; r < 64; ++r) ((bf16*)(p.ws + WS_MB))[(size_t)(t.rt64 * 64 + r) * D + t.pn * 256 + pcol(t.tid)] = (bf16)f2bf(t.C[r][t.tid]);
    }
};
struct NResid {
    static constexpr bool MIDK = false; int l, gj  , first  ;
    __device__ bool map(const P&, int, int pn, int& bt) const { bt = pn; return true; }
    __device__ void mid(const P&, float (&)[8][8], int, int, int, int) const {}
    __device__ void tile(const P& p, const TileCtx& t) const {
        for (int r = 0; r < 64; ++r) { const int row = t.rt64 * 64 + r, col = t.pn * 256 + t.tid;
            const float b = first ? x0_row(p, row)[col] : xs_row(p, row)[col];
            xs_row(p, row)[col] = b + modv(p, l, bidx(row), gj)[col] * t.C[r][t.tid]; }
    }
};
struct NSwiglu {
    static constexpr bool MIDK = false; int moe;
    __device__ bool map(const P& p, int rt64, int pn, int& bt) const {
        if (!moe) { bt = pn; return true; }
        int base[9]; moe_bases(p, base); if (rt64 * 64 >= base[8]) return false;
        int e = 0;
#pragma unroll
        for (int q = 1; q < 8; ++q) if (rt64 * 64 >= base[q]) e = q;
        bt = e * 28 + pn; return true;
    }
    __device__ void mid(const P&, float (&)[8][8], int, int, int, int) const {}
    __device__ void tile(const P& p, const TileCtx& t) const {
        if (t.tid >= 128) return;
        bf16* O = (bf16*)(p.ws + (moe ? WS_HMX : WS_HMID)); const int ld = moe ? DFFX : DFF;
        for (int r = 0; r < 64; ++r) O[(size_t)(t.rt64 * 64 + r) * ld + t.pn * 128 + pcol(t.tid)] = (bf16)f2bf(siluf_(t.C[r][t.tid]) * t.C[r][t.tid + 128]);
    }
};
struct NMoeDown {
    static constexpr bool MIDK = false; int pad_;
    __device__ bool map(const P& p, int rt64, int pn, int& bt) const {
        int base[9]; moe_bases(p, base); if (rt64 * 64 >= base[8]) return false;
        int e = 0;
#pragma unroll
        for (int q = 1; q < 8; ++q) if (rt64 * 64 >= base[q]) e = q;
        bt = e * 4 + pn; return true;
    }
    __device__ void mid(const P&, float (&)[8][8], int, int, int, int) const {}
    __device__ void tile(const P& p, const TileCtx& t) const {
        for (int r = 0; r < 64; ++r) { const int row = t.rt64 * 64 + r;
            ((bf16*)(p.ws + WS_H2P))[(size_t)row * D + t.pn * 256 + pcol(t.tid)] = (bf16)f2bf(((const float*)(p.ws + WS_ROWP))[row] * t.C[r][t.tid]); }
    }
};


#endif

constexpr int GEMM_LDS = (32 * 64 + 32 * 256 + 64 * 257) * 4;
constexpr int CONV_LDS = CONV_LDS_BYTES;
#if !ALL_MEGA
static void launch_naive_phase(const P& p, int ph, hipStream_t stream) {
    unsigned char* ws = p.ws;
    if (ph == 0) { k_prep<<<1024, 256, 0, stream>>>(p); k_mod<<<192, 512, 0, stream>>>(p); return; }
    const int l = ph >= 10 ? 1 : 0, k = ph - (l ? 10 : 1), nrows = l == 0 ? MT : M_LAT;
    switch (k) {
    case 0: k_norm<<<1024, 256, 0, stream>>>(p, l, 0, MT); break;
    case 1: k_gemm<NInproj><<<dim3(MT / 64, 25), 256, GEMM_LDS, stream>>>(p, NInproj{l}, (const bf16*)(ws + WS_H), D, (const bf16*)(ws + WS_WIN) + (size_t)l * IN_W * D, D, D); break;
    case 2: k_conv<<<320, 512, CONV_LDS, stream>>>(p, l, l == 0 ? CONV_TILES_ALL : CONV_TILES_LAT);
            k_attn<<<dim3(nrows / 256, 8), 256, 0, stream>>>(p, 0); k_attn<<<dim3(nrows / 256, 16), 256, 0, stream>>>(p, 1); break;
    case 3: k_occomb<<<1024, 256, 0, stream>>>(p, l, nrows); break;
    case 4: k_gemm<NMerge><<<dim3(nrows / 64, 4), 256, GEMM_LDS, stream>>>(p, NMerge{0}, (const bf16*)(ws + WS_OABC), 1536, (const bf16*)(ws + WS_WP) + (size_t)l * D * 1536, 1536, 1536); break;
    case 5: k_gemm<NResid><<<dim3(nrows / 64, 4), 256, GEMM_LDS, stream>>>(p, NResid{l, 2, l == 0}, (const bf16*)(ws + WS_MB), D, (const bf16*)(ws + WS_WOUT) + (size_t)l * D * D, D, D); break;
    case 6: if (l == 0) k_norm<<<1024, 256, 0, stream>>>(p, l, 1, MT); else k_router<<<1024, 256, 0, stream>>>(p); break;
    case 7: if (l == 0) k_gemm<NSwiglu><<<dim3(MT / 64, 22), 256, GEMM_LDS, stream>>>(p, NSwiglu{0}, (const bf16*)(ws + WS_H), D, (const bf16*)(ws + WS_FFN13), D, D);
            break;
    case 8: if (l == 0) k_gemm<NResid><<<dim3(MT / 64, 4), 256, GEMM_LDS, stream>>>(p, NResid{l, 5, 0}, (const bf16*)(ws + WS_HMID), DFF, (const bf16*)(ws + WS_FFN2), DFF, DFF);
            else k_gemm<NSwiglu><<<dim3(RMAX / 64, 28), 256, GEMM_LDS, stream>>>(p, NSwiglu{1}, (const bf16*)(ws + WS_H2P), D, (const bf16*)(ws + WS_MOE13), D, D); break;
    case 9: k_gemm<NMoeDown><<<dim3(RMAX / 64, 4), 256, GEMM_LDS, stream>>>(p, NMoeDown{0}, (const bf16*)(ws + WS_HMX), DFFX, (const bf16*)(ws + WS_MOE2), DFFX, DFFX); break;
    case 10: k_final<<<1024, 256, 0, stream>>>(p); break;
    }
}
#endif
extern "C" void kernel_launch(void* const* d_in, const int* in_sizes, int n_in, void* d_out, int out_size, void* d_ws, size_t ws_size, hipStream_t stream) {
    static int grid = 0;
    if (grid == 0) {
        if (n_in != 34 || out_size != M_LAT * D || ws_size < WS_END2) { fprintf(stderr, "kernel_launch: unexpected shapes (n_in %d out %d ws %zu need %zu)\n", n_in, out_size, ws_size, (size_t)WS_END2); grid = -1; return; }
        int dev = 0, cus = 0, per_cu = 0;
        if (hipGetDevice(&dev) != hipSuccess || hipDeviceGetAttribute(&cus, hipDeviceAttributeMultiprocessorCount, dev) != hipSuccess) { grid = -1; return; }
        if (hipFuncSetAttribute((const void*)mega, hipFuncAttributeMaxDynamicSharedMemorySize, LDS_BYTES) != hipSuccess) { fprintf(stderr, "kernel_launch: hipFuncSetAttribute failed\n"); grid = -1; return; }
#if !ALL_MEGA
        (void)hipFuncSetAttribute((const void*)k_gemm<NInproj>, hipFuncAttributeMaxDynamicSharedMemorySize, GEMM_LDS);
        (void)hipFuncSetAttribute((const void*)k_gemm<NMerge>, hipFuncAttributeMaxDynamicSharedMemorySize, GEMM_LDS);
        (void)hipFuncSetAttribute((const void*)k_gemm<NResid>, hipFuncAttributeMaxDynamicSharedMemorySize, GEMM_LDS);
        (void)hipFuncSetAttribute((const void*)k_gemm<NSwiglu>, hipFuncAttributeMaxDynamicSharedMemorySize, GEMM_LDS);
        (void)hipFuncSetAttribute((const void*)k_gemm<NMoeDown>, hipFuncAttributeMaxDynamicSharedMemorySize, GEMM_LDS);
        (void)hipFuncSetAttribute((const void*)k_conv, hipFuncAttributeMaxDynamicSharedMemorySize, CONV_LDS);
#endif
        if (hipOccupancyMaxActiveBlocksPerMultiprocessor(&per_cu, (const void*)mega, NWAVES * 64, LDS_BYTES) != hipSuccess || per_cu < 1) fprintf(stderr, "kernel_launch: occupancy query says %d\n", per_cu);
        (void)hipGetLastError();
        grid = cus;
    }
    if (grid < 0) return;
    P p{};
    for (int i = 0; i < 34; ++i) p.in[i] = (const float*)d_in[i];
    p.out = (float*)d_out; p.ws = (unsigned char*)d_ws;
    (void)hipMemsetAsync((char*)d_ws + WS_CTL, 0, CTL_ZERO_BYTES, stream);
    const unsigned mask = MEGA_MASK;
    int li = 0;
    for (int ph = 0; ph < N_PHASES;) {
        if ((mask >> ph) & 1u) { int hi = ph; while (hi < N_PHASES && ((mask >> hi) & 1u)) ++hi;
#if !ALL_MEGA && defined(DBG_INPROJ)
            if (ph == 2) launch_naive_phase(p, 2, stream);
#endif
            Args a{}; a.p = p; a.ph_lo = ph; a.ph_hi = hi; a.li = li++; a.pad = 0;
            hipLaunchKernelGGL(mega, dim3(grid), dim3(NWAVES * 64), LDS_BYTES, stream, a);
            ph = hi; }
#if !ALL_MEGA
        else { launch_naive_phase(p, ph, stream); ++ph; }
#else
        else ++ph;
#endif
    }
}
```

```cpp
#include <hip/hip_runtime.h>
#include <cstdint>
#include <cstdio>


#ifndef MEGA_MASK
#define MEGA_MASK 0x1FFFFF
#endif
#define ALL_MEGA ((MEGA_MASK) == 0x1FFFFF)
typedef unsigned short bf16;
typedef float f32x4 __attribute__((ext_vector_type(4)));
typedef unsigned u32x4 __attribute__((ext_vector_type(4)));
typedef unsigned u32x2 __attribute__((ext_vector_type(2)));

constexpr int D = 1024, NB = 4, SEQ = 4096, CTXL = 256;
constexpr int M_LAT = NB * SEQ, M_CTX = NB * CTXL, MT = M_LAT + M_CTX;
constexpr int NKEY = SEQ + CTXL;
constexpr int IN_W = 6400;
constexpr int DFF = 2816, DFFX = 3584, NEXP = 8;
constexpr int RMAX = 34816;
constexpr float EPS = 1e-6f;
constexpr float C2 = 0.125f * 1.4426950408889634f;

constexpr size_t MiB = 1u << 20;
constexpr size_t WS_CTL = 0, CTL_ZERO_BYTES = 1 * MiB;
constexpr size_t WS_MODV = 1 * MiB;
constexpr size_t WS_ROPE = WS_MODV + 256 * 1024;
constexpr size_t WS_LAM = WS_ROPE + 16 * 1024;
constexpr size_t WS_TOKE = 2 * MiB;
constexpr size_t WS_TOKS = WS_TOKE + 128 * 1024;
constexpr size_t WS_TOKP = WS_TOKS + 128 * 1024;
constexpr size_t WS_EXPP = 3 * MiB;
constexpr size_t WS_XSC = 4 * MiB;
constexpr size_t WS_MOE13 = 8 * MiB;
constexpr size_t WS_XB = 64 * MiB;
constexpr size_t WS_CPF = 96 * MiB;
constexpr size_t WS_CPO = 148 * MiB;
constexpr size_t WS_MOE2 = 120 * MiB;
constexpr size_t WS_A2 = 176 * MiB;
constexpr size_t WS_WIN = WS_A2;
constexpr size_t WS_WP = WS_WIN + 2 * (size_t)IN_W * D * 2;
constexpr size_t WS_WOUT = WS_WP + 2 * (size_t)D * 1536 * 2;
constexpr size_t WS_FFN13 = WS_WOUT + 2 * (size_t)D * D * 2;
constexpr size_t WS_FFN2 = WS_FFN13 + (size_t)2 * DFF * D * 2;
constexpr size_t WS_U = 228 * MiB;
static_assert(WS_FFN2 + (size_t)D * DFF * 2 <= WS_U, "A2");
static_assert(WS_MOE13 + (size_t)8 * 7168 * 1024 <= WS_XB && WS_XB + (size_t)M_LAT * D * 2 <= WS_CPF && WS_CPF + (size_t)11 * 1024 * 1024 * 2 <= WS_MOE2 && WS_MOE2 + (size_t)8 * 1024 * 3584 <= WS_CPO && WS_CPO + (size_t)4 * 1024 * 1024 * 2 <= WS_A2, "XB / ctx partials");
constexpr size_t WS_QA = WS_U;
constexpr size_t WS_KA = WS_QA + (size_t)MT * 512 * 2;
constexpr size_t WS_VA = WS_KA + (size_t)MT * 128 * 2;
constexpr size_t WS_Y = WS_VA + (size_t)MT * 128 * 2;
constexpr size_t WS_QC = WS_Y + (size_t)MT * 512 * 2;
constexpr size_t WS_KC = WS_QC + (size_t)MT * 512 * 2;
constexpr size_t WS_VC = WS_KC + (size_t)MT * 512 * 2;
constexpr size_t WS_G = WS_VC + (size_t)MT * 512 * 2;
constexpr size_t WS_OABC = WS_G + (size_t)MT * 3072 * 2;
constexpr size_t WS_H = WS_OABC;
constexpr size_t WS_H8 = WS_H + (size_t)MT * D * 2;
constexpr size_t WS_OCR = WS_OABC + (size_t)MT * 1536 * 2;
constexpr size_t WS_MB = WS_OCR;
constexpr size_t WS_END = WS_OCR + (size_t)MT * 1024 * 2;
constexpr size_t WS_HMID = WS_U;
static_assert(WS_HMID + (size_t)MT * DFF * 2 <= WS_G, "HMID overlay");
constexpr size_t WS_H2P = WS_A2;
constexpr size_t WS_HMX = WS_H2P + (size_t)RMAX * D * 2;
constexpr size_t WS_H2PX = WS_HMX + (size_t)RMAX * DFFX;
constexpr size_t WS_YPT = WS_H2PX + (size_t)8 * 16384 * D;
constexpr size_t WS_END2 = WS_YPT + (size_t)7 * 2048 * 1024 * 2;
static_assert(WS_HMX + (size_t)RMAX * DFFX * 2 <= WS_END2 && WS_END2 <= 582000000, "HMX overlay");
static_assert(WS_H2P + (size_t)RMAX * D * 2 <= WS_H, "H2P must not overlap H");

constexpr int CW_CNT = 64;

__device__ __forceinline__ float bf2f(bf16 v) { return __uint_as_float(((unsigned)v) << 16); }
__device__ __forceinline__ unsigned f2bf(float f) { unsigned u = __float_as_uint(f); return (u + 0x7fffu + ((u >> 16) & 1u)) >> 16; }
typedef float f32x2_pk __attribute__((ext_vector_type(2))); typedef __bf16 bf16x2_pk __attribute__((ext_vector_type(2)));
__device__ __forceinline__ unsigned pk2(float lo, float hi) { f32x2_pk v = {lo, hi}; bf16x2_pk b = __builtin_convertvector(v, bf16x2_pk); return __builtin_bit_cast(unsigned, b); }
__device__ __forceinline__ float sigmoidf_(float x) { return 1.f / (1.f + __expf(-x)); }
__device__ __forceinline__ float siluf_(float x) { return x * __builtin_amdgcn_rcpf(1.f + __expf(-x)); }
__device__ __forceinline__ float rsq_(float x) { return __builtin_amdgcn_rsqf(x); }
template <int CTRL> __device__ __forceinline__ float dpp_mov(float v) { return __builtin_bit_cast(float, __builtin_amdgcn_update_dpp(0, __builtin_bit_cast(int, v), CTRL, 0xf, 0xf, true)); }
__device__ __forceinline__ float xsum_row16(float v) {
    v += dpp_mov<0xB1>(v); v += dpp_mov<0x4E>(v); v += dpp_mov<0x141>(v); v += dpp_mov<0x140>(v); return v; }
__device__ __forceinline__ float xsum_x16(float v) { const auto rr = __builtin_amdgcn_permlane16_swap(__float_as_uint(v), __float_as_uint(v), false, false); return __uint_as_float(rr[0]) + __uint_as_float(rr[1]); }
__device__ __forceinline__ float xsum_x32(float v) { const auto rr = __builtin_amdgcn_permlane32_swap(__float_as_uint(v), __float_as_uint(v), false, false); return __uint_as_float(rr[0]) + __uint_as_float(rr[1]); }
__device__ __forceinline__ float wave_sum(float v) { return xsum_x32(xsum_x16(xsum_row16(v))); }
__host__ __device__ __forceinline__ int pcol5(int j) { return 8 * ((j >> 2) & 3) + 4 * ((j >> 4) & 1) + (j & 3); }
__host__ __device__ __forceinline__ int pcol(int c) { return (c & ~31) | pcol5(c & 31); }
__device__ __forceinline__ int keyrow(int r) { return r < M_LAT ? (r / SEQ) * NKEY + (r % SEQ) : ((r - M_LAT) / CTXL) * NKEY + SEQ + ((r - M_LAT) % CTXL); }
__device__ __forceinline__ int bidx(int r) { return r < M_LAT ? r / SEQ : 4; }

struct P {
    const float* in[34];
    float* out;
    unsigned char* ws;
};
__device__ __forceinline__ const float* modv(const P& p, int l, int bi, int j) { return (const float*)(p.ws + WS_MODV) + ((size_t)(l * 5 + bi) * 6 + j) * D; }
__device__ __forceinline__ float* xs_row(const P& p, int r) { return r < M_LAT ? p.out + (size_t)r * D : (float*)(p.ws + WS_XSC) + (size_t)(r - M_LAT) * D; }
__device__ __forceinline__ f32x4 ld_bf4(const bf16* q) { const u32x2 a = *(const u32x2*)q; return (f32x4){__uint_as_float(a.x << 16), __uint_as_float(a.x & 0xffff0000u), __uint_as_float(a.y << 16), __uint_as_float(a.y & 0xffff0000u)}; }
__device__ __forceinline__ const float* x0_row(const P& p, int r) { return r < M_LAT ? p.in[0] + (size_t)r * D : p.in[2] + (size_t)(r - M_LAT) * D; }

__host__ __device__ __forceinline__ int win_src_col(int np) {
    const int pn = np >> 8, c = np & 255, bj = c >> 7, hh = (c >> 5) & 3, j32 = c & 31, d = 32 * bj + j32;
    if (pn < 2) return (4 * pn + hh) * 64 + d;
    if (pn == 2) return hh < 2 ? 512 + hh * 64 + d : 640 + (hh - 2) * 64 + d;
    if (pn < 7) { const int ch = (pn - 3) * 128 + pcol(c & 127); return 768 + (bj ? 512 : 0) + ch; }
    if (pn < 9) return 1792 + (4 * (pn - 7) + hh) * 64 + d;
    if (pn < 11) return 2304 + (4 * (pn - 9) + hh) * 64 + d;
    if (pn < 13) return 2816 + (pn - 11) * 256 + pcol(c);
    return 3328 + (pn - 13) * 256 + pcol(c);
}
__device__ __forceinline__ void xpose_block(const float* src, int ldn, int k0, int scol, bf16* dst, int ldk, float* scr, int lane) {
    float ld_[32];
#pragma unroll
    for (int i = 0; i < 32; ++i) ld_[i] = src[(size_t)(k0 + 2 * i + (lane >> 5)) * ldn + scol];
#pragma unroll
    for (int i = 0; i < 32; ++i) scr[(2 * i + (lane >> 5)) * 33 + (lane & 31)] = ld_[i];
    asm volatile("s_waitcnt lgkmcnt(0)" ::: "memory");
    const int c = lane & 7;
#pragma unroll
    for (int j = 0; j < 4; ++j) { const int n = (lane >> 3) + 8 * j; const float* s = scr + (8 * c) * 33 + n;
        u32x4 o; o.x = pk2(s[0 * 33], s[1 * 33]); o.y = pk2(s[2 * 33], s[3 * 33]); o.z = pk2(s[4 * 33], s[5 * 33]); o.w = pk2(s[6 * 33], s[7 * 33]);
        *(u32x4*)(dst + (size_t)n * ldk + 8 * c) = o; }
    asm volatile("s_waitcnt lgkmcnt(0)" ::: "memory");
}
__device__ __forceinline__ unsigned pk4_fp8(float a, float b, float c, float d) { unsigned w = __builtin_amdgcn_cvt_pk_fp8_f32(a, b, 0u, false); return __builtin_amdgcn_cvt_pk_fp8_f32(c, d, w, true); }
__device__ __forceinline__ void xpose_block_f8(const float* src, int ldn, int k0, int scol, unsigned char* dst, int ldk, float* scr, int lane, float sc) {
    float ld_[32];
#pragma unroll
    for (int i = 0; i < 32; ++i) ld_[i] = src[(size_t)(k0 + 2 * i + (lane >> 5)) * ldn + scol];
#pragma unroll
    for (int i = 0; i < 32; ++i) scr[(2 * i + (lane >> 5)) * 33 + (lane & 31)] = ld_[i];
    asm volatile("s_waitcnt lgkmcnt(0)" ::: "memory");
    const int c = lane & 7;
#pragma unroll
    for (int j = 0; j < 4; ++j) { const int n = (lane >> 3) + 8 * j; const float* s = scr + (8 * c) * 33 + n;
        u32x2 o; o.x = pk4_fp8(s[0 * 33] * sc, s[1 * 33] * sc, s[2 * 33] * sc, s[3 * 33] * sc); o.y = pk4_fp8(s[4 * 33] * sc, s[5 * 33] * sc, s[6 * 33] * sc, s[7 * 33] * sc);
        *(u32x2*)(dst + (size_t)n * ldk + 8 * c) = o; }
    asm volatile("s_waitcnt lgkmcnt(0)" ::: "memory");
}
constexpr float F8_W13 = 32.f, F8_W2 = 64.f, F8_HM = 4.f;
constexpr int SC_W13 = 0x7a7a7a7a, SC_W2 = 0x79797979, SC_HM = 0x7d7d7d7d, SC_ONE = 0x7f7f7f7f;
constexpr int IT_WIN = 16 * 200, IT_WP = 8 * 32, IT_WOUT = 16 * 32, IT_F13 = 16 * 176, IT_F2 = 44 * 32, IT_M13 = 16 * 224, IT_M2 = 56 * 32;
constexpr int IT_EARLY = 2 * IT_WIN + 6 * IT_WP + 2 * IT_WOUT + IT_F13 + IT_F2;
constexpr int IT_TOTAL = IT_EARLY + 8 * IT_M13 + 8 * IT_M2;
constexpr int IT_PRO = IT_EARLY;
constexpr int L1A0 = IT_WIN, L1A1 = 2 * IT_WIN, L1B0 = 2 * IT_WIN + 3 * IT_WP, L1B1 = 2 * IT_WIN + 6 * IT_WP, L1C0 = L1B1 + IT_WOUT, L1C1 = L1B1 + 2 * IT_WOUT;
constexpr int N_L1 = (L1A1 - L1A0) + (L1B1 - L1B0) + (L1C1 - L1C0), N_PRO = IT_EARLY - N_L1;
__host__ __device__ __forceinline__ int pro_item(int j) {
    if (j < L1A0) return j; j += L1A1 - L1A0;
    if (j < L1B0) return j; j += L1B1 - L1B0;
    if (j < L1C0) return j; return j + (L1C1 - L1C0); }
__host__ __device__ __forceinline__ int l1_item(int j) {
    if (j < L1A1 - L1A0) return L1A0 + j; j -= L1A1 - L1A0;
    if (j < L1B1 - L1B0) return L1B0 + j; j -= L1B1 - L1B0;
    return L1C0 + j; }
constexpr int IT_DEF1 = IT_EARLY + 30000, IT_DEF2 = IT_DEF1 + 4000;
__device__ __forceinline__ void prep_item(const P& p, int it, float* scr, int lane) {
    const int nl = lane & 31;
    if (it < 2 * IT_WIN) { const int l = it / IT_WIN, r = it % IT_WIN, kb = r / 200, nb = r % 200;
        xpose_block(p.in[8] + (size_t)l * D * IN_W, IN_W, 64 * kb, win_src_col(32 * nb + nl), (bf16*)(p.ws + WS_WIN) + (size_t)l * IN_W * D + (size_t)(32 * nb) * D + 64 * kb, D, scr, lane); return; }
    it -= 2 * IT_WIN;
    if (it < 6 * IT_WP) { const int l = it / (3 * IT_WP), r3 = it % (3 * IT_WP), br = r3 / IT_WP, r = r3 % IT_WP, kb = r / 32, nb = r % 32;
        xpose_block((br == 0 ? p.in[21] : br == 1 ? p.in[22] : p.in[23]) + (size_t)l * 512 * D, D, 64 * kb, pcol(32 * nb + nl), (bf16*)(p.ws + WS_WP) + (size_t)l * D * 1536 + (size_t)(32 * nb) * 1536 + br * 512 + 64 * kb, 1536, scr, lane); return; }
    it -= 6 * IT_WP;
    if (it < 2 * IT_WOUT) { const int l = it / IT_WOUT, r = it % IT_WOUT, kb = r / 32, nb = r % 32;
        xpose_block(p.in[24] + (size_t)l * D * D, D, 64 * kb, 32 * nb + nl, (bf16*)(p.ws + WS_WOUT) + (size_t)l * D * D + (size_t)(32 * nb) * D + 64 * kb, D, scr, lane); return; }
    it -= 2 * IT_WOUT;
    if (it < IT_F13) { const int kb = it / 176, nb = it % 176, np = 32 * nb + nl, c = np & 255, j = np >> 8;
        xpose_block_f8(((c >> 7) ? p.in[26] : p.in[25]), DFF, 64 * kb, j * 128 + pcol(c & 127), (unsigned char*)(p.ws + WS_FFN13) + (size_t)(32 * nb) * D + 64 * kb, D, scr, lane, F8_W13); return; }
    it -= IT_F13;
    if (it < IT_F2) { const int kb = it / 32, nb = it % 32;
        xpose_block(p.in[27], D, 64 * kb, 32 * nb + nl, (bf16*)(p.ws + WS_FFN2) + (size_t)(32 * nb) * DFF + 64 * kb, DFF, scr, lane); return; }
    it -= IT_F2;
    if (it < 8 * IT_M13) { const int e = it / IT_M13, r = it % IT_M13, kb = r / 224, nb = r % 224, np = 32 * nb + nl, c = np & 255, j = np >> 8;
        xpose_block_f8(((c >> 7) ? p.in[31] : p.in[30]) + (size_t)e * D * DFFX, DFFX, 64 * kb, j * 128 + pcol(c & 127), (unsigned char*)(p.ws + WS_MOE13) + (size_t)e * 7168 * D + (size_t)(32 * nb) * D + 64 * kb, D, scr, lane, F8_W13); return; }
    it -= 8 * IT_M13;
    { const int e = it / IT_M2, r = it % IT_M2, kb = r / 32, nb = r % 32;
        xpose_block_f8(p.in[32] + (size_t)e * DFFX * D, D, 64 * kb, pcol(32 * nb + nl), (unsigned char*)(p.ws + WS_MOE2) + (size_t)e * D * DFFX + (size_t)(32 * nb) * DFFX + 64 * kb, DFFX, scr, lane, F8_W2); }
}

__device__ __forceinline__ void ph_mod_item(const P& p, int item, float* lds, int tid) {
    const int l = item / 96, n0 = (item % 96) * 64, w = tid >> 6, lane = tid & 63;
    const float* wm = p.in[4] + (size_t)l * D * 6144 + (size_t)(128 * w) * 6144 + n0 + lane;
    float* sl = lds + 8 * 5 * 64;
    for (int i = tid; i < 5 * D; i += 512) { const float v = i < 4 * D ? p.in[1][i] : p.in[3][i - 4 * D]; sl[i] = siluf_(v); }
    __syncthreads();
    float a0 = 0.f, a1 = 0.f, a2 = 0.f, a3 = 0.f, a4 = 0.f;
#pragma unroll 32
    for (int k = 0; k < 128; ++k) { const float wv = wm[(size_t)k * 6144]; const int kk = 128 * w + k;
        a0 += sl[kk] * wv; a1 += sl[D + kk] * wv; a2 += sl[2 * D + kk] * wv; a3 += sl[3 * D + kk] * wv; a4 += sl[4 * D + kk] * wv; }
    lds[(w * 5 + 0) * 64 + lane] = a0; lds[(w * 5 + 1) * 64 + lane] = a1; lds[(w * 5 + 2) * 64 + lane] = a2; lds[(w * 5 + 3) * 64 + lane] = a3; lds[(w * 5 + 4) * 64 + lane] = a4;
    __syncthreads();
    if (tid < 320) { const int bi = tid >> 6; float s = 0.f;
#pragma unroll
        for (int ww = 0; ww < 8; ++ww) s += lds[(ww * 5 + bi) * 64 + lane];
        ((float*)(p.ws + WS_MODV))[(size_t)(l * 5 + bi) * 6144 + n0 + lane] = s + p.in[5][l * 6144 + n0 + lane]; }
    __syncthreads();
}
__device__ __forceinline__ void ph_misc(const P& p, int tid, int nthreads) {
    if (tid < 16) { const int f = tid;
        const double CS[16][2] = {{0.5403023058681397174, 0.84147098480789650665}, {0.84600911028170792533, 0.5331684399140228157}, {0.95041528025518286254, 0.31098359290718572638},
            {0.98423023447009458711, 0.17689218624615003844}, {0.9950041652780257661, 0.099833416646828152307}, {0.99841927779266443401, 0.056204499214692484859},
            {0.99950004166527780258, 0.031617506402433710095}, {0.99984189028361432743, 0.017781856879666127606}, {0.99995000041666527778, 0.0099998333341666646825},
            {0.99998418865336578085, 0.0056233836139601852304}, {0.99999500000416666528, 0.0031622723897082476155}, {0.99999841886158658243, 0.0017782784728035290072},
            {0.99999950000004166667, 0.00099999983333334166667}, {0.99999984188612115825, 0.0005623412955523593817}, {0.99999995000000041667, 0.0003162277607463751926},
            {0.99999998418861174082, 0.00017782794006665673962}};
        double C = 1.0, S = 0.0, c1 = 0.0, s1 = 0.0;
#pragma unroll
        for (int q = 0; q < 16; ++q) if (q == f) { c1 = CS[q][0]; s1 = CS[q][1]; }
        float* t = (float*)(p.ws + WS_ROPE);
        for (int pos = 0; pos < 64; ++pos) { t[pos * 16 + f] = (float)C; t[1024 + pos * 16 + f] = (float)S; const double nc = C * c1 - S * s1, ns = S * c1 + C * s1; C = nc; S = ns; } }
    if (tid < 2) { const int l = tid; float s1 = 0.f, s2 = 0.f;
        for (int k = 0; k < 64; ++k) { s1 += p.in[16][l * 64 + k] * p.in[17][l * 64 + k]; s2 += p.in[18][l * 64 + k] * p.in[19][l * 64 + k]; }
        const float li = 0.8f - 0.6f * expf(-0.3f * (float)l);
        float* t = (float*)(p.ws + WS_LAM); t[l] = expf(s1) - expf(s2) + li; t[2 + l] = li; }
}

__device__ __forceinline__ void norm_row(const float* xrow, const float* g, const float* sc, const float* sh, bf16* orow, int lane, f32x4 (&hv)[4]) {
    f32x4 v[4]; float s = 0.f;
#pragma unroll
    for (int j = 0; j < 4; ++j) { v[j] = *(const f32x4*)(xrow + 4 * lane + 256 * j); s += (v[j].x * v[j].x + v[j].y * v[j].y) + (v[j].z * v[j].z + v[j].w * v[j].w); }
    const float rinv = rsq_(wave_sum(s) * (1.f / D) + EPS);
#pragma unroll
    for (int j = 0; j < 4; ++j) { const int c = 4 * lane + 256 * j; const f32x4 gv = *(const f32x4*)(g + c), scv = *(const f32x4*)(sc + c), shv = *(const f32x4*)(sh + c);
        hv[j] = (v[j] * rinv * gv) * (1.f + scv) + shv;
        u32x2 o; o.x = pk2(hv[j].x, hv[j].y); o.y = pk2(hv[j].z, hv[j].w); *(u32x2*)(orow + c) = o; }
}
__device__ __forceinline__ void ph_norm(const P& p, int l, int which  , int nrows, int gw, int NGW, int lane) {
    const bool first = which == 0 && l == 0; const int lim = first ? nrows : M_LAT;
    const float* g = (which ? p.in[7] : p.in[6]) + l * D;
    f32x4 vc[4], vn[4], gsc[4], shc[4]; int bcur = -1;
#define NLOAD(R, V) do { if (first) { const float* xr_ = x0_row(p, (R)); _Pragma("unroll") for (int j = 0; j < 4; ++j) V[j] = *(const f32x4*)(xr_ + 4 * lane + 256 * j); } \
        else { const bf16* xb_ = (const bf16*)(p.ws + WS_XB) + (size_t)(R) * D; _Pragma("unroll") for (int j = 0; j < 4; ++j) V[j] = ld_bf4(xb_ + 4 * lane + 256 * j); } } while (0)
    int r = gw; if (r < lim) NLOAD(r, vc);
    for (; r < lim; r += NGW) {
        const int rn = r + NGW; if (rn < lim) NLOAD(rn, vn);
        const int bi = bidx(r);
        if (bi != bcur) { bcur = bi; const float* sc = modv(p, l, bi, which ? 4 : 1); const float* sh = modv(p, l, bi, which ? 3 : 0);
#pragma unroll
            for (int j = 0; j < 4; ++j) { const int c = 4 * lane + 256 * j; gsc[j] = *(const f32x4*)(g + c) * (1.f + *(const f32x4*)(sc + c)); shc[j] = *(const f32x4*)(sh + c); } }
        float s = 0.f;
#pragma unroll
        for (int j = 0; j < 4; ++j) s += (vc[j].x * vc[j].x + vc[j].y * vc[j].y) + (vc[j].z * vc[j].z + vc[j].w * vc[j].w);
        const float rinv = rsq_(wave_sum(s) * (1.f / D) + EPS);
#pragma unroll
        for (int j = 0; j < 4; ++j) { const int c = 4 * lane + 256 * j;
            const f32x4 h = (vc[j] * rinv) * gsc[j] + shc[j];
            if (which == 0) { u32x2 o; o.x = pk2(h.x, h.y); o.y = pk2(h.z, h.w); *(u32x2*)((bf16*)(p.ws + WS_H) + (size_t)r * D + c) = o; }
            else *(unsigned*)((unsigned char*)(p.ws + WS_H8) + (size_t)r * D + c) = pk4_fp8(h.x, h.y, h.z, h.w); }
#pragma unroll
        for (int j = 0; j < 4; ++j) vc[j] = vn[j];
    }
#undef NLOAD
    if (first) return;
    for (; r < nrows; r += NGW) {
        const float* xr = xs_row(p, r); const int bi = bidx(r);
        {
            const int rc = r - M_LAT, nks = which == 1 ? 4 : 11; const bf16* P = (const bf16*)(p.ws + (which == 1 ? WS_CPO : WS_CPF)) + (size_t)rc * D;
            const float* base = which == 1 ? p.in[2] + (size_t)rc * D : xr; const float* gt = modv(p, 0, 4, which == 1 ? 2 : 5);
            const float* g = (which ? p.in[7] : p.in[6]) + l * D; const float* sc = modv(p, l, bi, which ? 4 : 1); const float* sh = modv(p, l, bi, which ? 3 : 0);
            f32x4 v[4]; float s = 0.f;
#pragma unroll
            for (int j = 0; j < 4; ++j) { const int c = 4 * lane + 256 * j; f32x4 y = (f32x4){0.f, 0.f, 0.f, 0.f};
                for (int ks = 0; ks < nks; ++ks) { const u32x2 a = *(const u32x2*)(P + (size_t)ks * 1024 * 1024 + c);
                    y.x += __uint_as_float(a.x << 16); y.y += __uint_as_float(a.x & 0xffff0000u); y.z += __uint_as_float(a.y << 16); y.w += __uint_as_float(a.y & 0xffff0000u); }
                v[j] = *(const f32x4*)(base + c) + *(const f32x4*)(gt + c) * y; s += (v[j].x * v[j].x + v[j].y * v[j].y) + (v[j].z * v[j].z + v[j].w * v[j].w);
                if (which == 1) *(f32x4*)((float*)(p.ws + WS_XSC) + (size_t)rc * D + c) = v[j]; }
            const float rinv = rsq_(wave_sum(s) * (1.f / D) + EPS); bf16* orow = (bf16*)(p.ws + WS_H) + (size_t)r * D;
#pragma unroll
            for (int j = 0; j < 4; ++j) { const int c = 4 * lane + 256 * j; const f32x4 gv = *(const f32x4*)(g + c), scv = *(const f32x4*)(sc + c), shv = *(const f32x4*)(sh + c);
                const f32x4 h = (v[j] * rinv * gv) * (1.f + scv) + shv;
                if (which == 0) { u32x2 o; o.x = pk2(h.x, h.y); o.y = pk2(h.z, h.w); *(u32x2*)(orow + c) = o; }
                else *(unsigned*)((unsigned char*)(p.ws + WS_H8) + (size_t)r * D + c) = pk4_fp8(h.x, h.y, h.z, h.w); }
        }
    }
}
__device__ __forceinline__ void router_row(const P& p, int r, int lane, unsigned* rowbuf  , const f32x4 (&v)[4], const f32x4 (&wr)[32], int& e1, int& e2, float& p1, float& p2) {
    const int bi = bidx(r); f32x4 hv[4];
    {
        const float* g = p.in[7] + 1 * D; const float* sc = modv(p, 1, bi, 4); const float* sh = modv(p, 1, bi, 3);
        float s = 0.f;
#pragma unroll
        for (int j = 0; j < 4; ++j) s += (v[j].x * v[j].x + v[j].y * v[j].y) + (v[j].z * v[j].z + v[j].w * v[j].w);
        const float rinv = rsq_(wave_sum(s) * (1.f / D) + EPS);
#pragma unroll
        for (int j = 0; j < 4; ++j) { const int c = 4 * lane + 256 * j; const f32x4 gv = *(const f32x4*)(g + c), scv = *(const f32x4*)(sc + c), shv = *(const f32x4*)(sh + c);
            hv[j] = (v[j] * rinv * gv) * (1.f + scv) + shv; rowbuf[lane + 64 * j] = pk4_fp8(hv[j].x, hv[j].y, hv[j].z, hv[j].w); } }
    float lg[8];
#pragma unroll
    for (int e = 0; e < 8; ++e) lg[e] = 0.f;
#pragma unroll
    for (int j = 0; j < 4; ++j)
#pragma unroll
        for (int i = 0; i < 4; ++i) { const f32x4 w0 = wr[(4 * j + i) * 2], w1 = wr[(4 * j + i) * 2 + 1]; const float h = hv[j][i];
            lg[0] += h * w0.x; lg[1] += h * w0.y; lg[2] += h * w0.z; lg[3] += h * w0.w; lg[4] += h * w1.x; lg[5] += h * w1.y; lg[6] += h * w1.z; lg[7] += h * w1.w; }
#pragma unroll
    for (int e = 0; e < 8; ++e) lg[e] = wave_sum(lg[e]) + p.in[29][e];
    e1 = 0; float v1 = lg[0];
#pragma unroll
    for (int e = 1; e < 8; ++e) if (lg[e] > v1) { v1 = lg[e]; e1 = e; }
    e2 = -1; float v2 = -INFINITY;
#pragma unroll
    for (int e = 0; e < 8; ++e) if (e != e1 && lg[e] > v2) { v2 = lg[e]; e2 = e; }
    p1 = 1.f / (1.f + expf(v2 - v1)); p2 = 1.f - p1;
}
__device__ __forceinline__ void ph_router(const P& p, int wg, int nwg, int nw, unsigned char* lds, int tid) {
    unsigned* cnt = (unsigned*)(p.ws + WS_CTL) + CW_CNT;
    const int wave = tid >> 6, lane = tid & 63;
    int* sE = (int*)lds; float* sP = (float*)(lds + 1024); unsigned* sC = (unsigned*)(lds + 2048); int* sS = (int*)(lds + 3072);
    unsigned* rows = (unsigned*)(lds + 4096);
    const int per = 64 / nw;
    f32x4 wr[32];
#pragma unroll
    for (int j = 0; j < 4; ++j)
#pragma unroll
        for (int i = 0; i < 4; ++i) { const int k = 4 * lane + 256 * j + i; wr[(4 * j + i) * 2] = *(const f32x4*)(p.in[28] + (size_t)k * 8); wr[(4 * j + i) * 2 + 1] = *(const f32x4*)(p.in[28] + (size_t)k * 8 + 4); }
    for (int j0 = 0; (j0 * nwg + wg) * nw < M_LAT; j0 += per) {
        if (tid < 16) sC[tid] = 0u;
        if (tid < 128) sE[tid] = -1;
        __syncthreads();
        f32x4 xv[4], xn[4];
#define RLOAD(R, V) do { const bf16* xb_ = (const bf16*)(p.ws + WS_XB) + (size_t)(R) * D; _Pragma("unroll") for (int j = 0; j < 4; ++j) V[j] = ld_bf4(xb_ + 4 * lane + 256 * j); } while (0)
        { const int r0 = (j0 * nwg + wg) * nw + wave; if (r0 < M_LAT) RLOAD(r0, xv); }
        for (int jj = 0; jj < per; ++jj) { const int r = ((j0 + jj) * nwg + wg) * nw + wave, li = jj * nw + wave;
            { const int rnx = ((j0 + jj + 1) * nwg + wg) * nw + wave; if (jj + 1 < per && rnx < M_LAT) RLOAD(rnx, xn); }
            if (r < M_LAT) { int e1, e2; float p1, p2; router_row(p, r, lane, rows + li * 256, xv, wr, e1, e2, p1, p2);
                if (lane == 0) { sE[2 * li] = e1; sE[2 * li + 1] = e2; sP[2 * li] = p1; sP[2 * li + 1] = p2; atomicAdd(&sC[e1], 1u); atomicAdd(&sC[e2], 1u); } }
#pragma unroll
            for (int j = 0; j < 4; ++j) xv[j] = xn[j]; }
#undef RLOAD
        __syncthreads();
        if (tid < 8) sC[8 + tid] = sC[tid] ? atomicAdd(cnt + tid, sC[tid]) : 0u;
        __syncthreads();
        if (tid < 128) { const int e = sE[tid]; if (e >= 0) { int pre = 0; for (int q = 0; q < tid; ++q) pre += (sE[q] == e) ? 1 : 0;
                const int li = tid >> 1, jj = li / nw, w = li % nw, r = ((j0 + jj) * nwg + wg) * nw + w;
                const int slot = (int)sC[8 + e] + pre; sS[tid] = slot;
                ((int*)(p.ws + WS_TOKE))[2 * r + (tid & 1)] = e; ((int*)(p.ws + WS_TOKS))[2 * r + (tid & 1)] = slot; ((float*)(p.ws + WS_EXPP))[e * 16384 + slot] = sP[tid]; } }
        __syncthreads();
        for (int i = tid; i < 128 * 64; i += nw * 64) { const int pr = i >> 6, ck = i & 63, e = sE[pr]; if (e >= 0) { const u32x4 v = *(const u32x4*)(rows + (pr >> 1) * 256 + ck * 4);
                *(u32x4*)((unsigned char*)(p.ws + WS_H2PX) + ((size_t)e * 16384 + sS[pr]) * D + ck * 16) = v; } }
        __syncthreads();
    }
}
__device__ __forceinline__ void moe_bases(const P& p, int (&base)[9]) {
    const unsigned* cnt = (const unsigned*)(p.ws + WS_CTL) + CW_CNT; int b = 0;
#pragma unroll
    for (int e = 0; e < 8; ++e) { base[e] = b; b += (int)((cnt[e] + 255u) & ~255u); }
    base[8] = b;
}
__device__ __forceinline__ void ph_final(const P& p, int gw, int NGW, int lane) {
    int base[9]; moe_bases(p, base);
    const int* te = (const int*)(p.ws + WS_TOKE); const int* ts = (const int*)(p.ws + WS_TOKS);
#define FROWS(R, ROWS) do { _Pragma("unroll") for (int k = 0; k < 2; ++k) { const int e = te[2 * (R) + k]; int bs = 0; _Pragma("unroll") for (int q = 0; q < 8; ++q) bs = (q == e) ? base[q] : bs; ROWS[k] = bs + ts[2 * (R) + k]; } } while (0)
#define FLOAD(R, ROWS, XV, YA) do { const bf16* xb_ = (const bf16*)(p.ws + WS_XB) + (size_t)(R) * D; _Pragma("unroll") for (int j = 0; j < 4; ++j) { const int c = 4 * lane + 256 * j; XV[j] = *(const u32x2*)(xb_ + c); \
        _Pragma("unroll") for (int k = 0; k < 2; ++k) YA[k][j] = ROWS[k] < 32768 ? *(const u32x2*)((const bf16*)(p.ws + WS_H2P) + (size_t)ROWS[k] * D + c) : (u32x2){0u, 0u}; } } while (0)
    int r = gw; int rc[2] = {0, 0}, rn[2] = {0, 0}; u32x2 xc[4], ya[2][4], xn[4], yn[2][4];
    f32x4 fg[4], g5c[4]; int bcur = -1;
#pragma unroll
    for (int j = 0; j < 4; ++j) fg[j] = *(const f32x4*)(p.in[33] + 4 * lane + 256 * j);
    if (r < M_LAT) { FROWS(r, rc); FLOAD(r, rc, xc, ya); }
    for (; r < M_LAT; r += NGW) {
        const int rnx = r + NGW; if (rnx < M_LAT) { FROWS(rnx, rn); FLOAD(rnx, rn, xn, yn); }
        float* xr = p.out + (size_t)r * D;
        { const int bi = bidx(r); if (bi != bcur) { bcur = bi; const float* g5 = modv(p, 1, bi, 5);
#pragma unroll
            for (int j = 0; j < 4; ++j) g5c[j] = *(const f32x4*)(g5 + 4 * lane + 256 * j); } }
        f32x4 v[4]; float s = 0.f;
#pragma unroll
        for (int j = 0; j < 4; ++j) { const int c = 4 * lane + 256 * j; const f32x4 g = g5c[j];
            const f32x4 x = (f32x4){__uint_as_float(xc[j].x << 16), __uint_as_float(xc[j].x & 0xffff0000u), __uint_as_float(xc[j].y << 16), __uint_as_float(xc[j].y & 0xffff0000u)};
            f32x4 y = (f32x4){0.f, 0.f, 0.f, 0.f};
#pragma unroll
            for (int k = 0; k < 2; ++k) { const u32x2 a = ya[k][j];
                y.x += __uint_as_float(a.x << 16); y.y += __uint_as_float(a.x & 0xffff0000u); y.z += __uint_as_float(a.y << 16); y.w += __uint_as_float(a.y & 0xffff0000u);
                if (rc[k] >= 32768) { for (int ks = 0; ks < 7; ++ks) { const u32x2 q = *(const u32x2*)((const bf16*)(p.ws + WS_YPT) + ((size_t)ks * 2048 + (rc[k] - 32768)) * D + c);
                    y.x += __uint_as_float(q.x << 16); y.y += __uint_as_float(q.x & 0xffff0000u); y.z += __uint_as_float(q.y << 16); y.w += __uint_as_float(q.y & 0xffff0000u); } } }
            v[j] = x + g * y; s += (v[j].x * v[j].x + v[j].y * v[j].y) + (v[j].z * v[j].z + v[j].w * v[j].w); }
        const float rinv = rsq_(wave_sum(s) * (1.f / D) + EPS);
#pragma unroll
        for (int j = 0; j < 4; ++j) { const int c = 4 * lane + 256 * j; *(f32x4*)(xr + c) = v[j] * rinv * fg[j]; }
        rc[0] = rn[0]; rc[1] = rn[1];
#pragma unroll
        for (int j = 0; j < 4; ++j) { xc[j] = xn[j]; ya[0][j] = yn[0][j]; ya[1][j] = yn[1][j]; }
    }
#undef FROWS
#undef FLOAD
}
__device__ __forceinline__ void ph_occomb(const P& p, int l, int nrows, int gw, int NGW, int lane) {
    const float lam = ((const float*)(p.ws + WS_LAM))[l], li = ((const float*)(p.ws + WS_LAM))[2 + l];
    const int h = lane >> 4, dv = (lane & 15) * 8, half = dv >> 6, d = dv & 63;
    for (int r = gw; r < nrows; r += NGW) {
        const u32x4 a = *(const u32x4*)((const bf16*)(p.ws + WS_OCR) + (size_t)r * 1024 + ((h * 2 + 0) * 2 + half) * 64 + d);
        const u32x4 b = *(const u32x4*)((const bf16*)(p.ws + WS_OCR) + (size_t)r * 1024 + ((h * 2 + 1) * 2 + half) * 64 + d);
        float df[8]; float s = 0.f;
#pragma unroll
        for (int i = 0; i < 4; ++i) { df[2 * i] = __uint_as_float(a[i] << 16) - lam * __uint_as_float(b[i] << 16); df[2 * i + 1] = __uint_as_float(a[i] & 0xffff0000u) - lam * __uint_as_float(b[i] & 0xffff0000u); }
#pragma unroll
        for (int i = 0; i < 8; ++i) s += df[i] * df[i];
        s += __shfl_xor(s, 1); s += __shfl_xor(s, 2); s += __shfl_xor(s, 4); s += __shfl_xor(s, 8);
        const float rinv = (1.f - li) / sqrtf(s * (1.f / 128.f) + EPS);
        const float* sg = p.in[20] + l * 128 + dv;
        u32x4 o; o.x = pk2(df[0] * rinv * sg[0], df[1] * rinv * sg[1]); o.y = pk2(df[2] * rinv * sg[2], df[3] * rinv * sg[3]);
        o.z = pk2(df[4] * rinv * sg[4], df[5] * rinv * sg[5]); o.w = pk2(df[6] * rinv * sg[6], df[7] * rinv * sg[7]);
        *(u32x4*)((bf16*)(p.ws + WS_OABC) + (size_t)r * 1536 + 1024 + h * 128 + dv) = o;
    }
}
__device__ __forceinline__ void occomb_rows32(const P& p, int l, int row0, int h, int lane) {
    const float lam = ((const float*)(p.ws + WS_LAM))[l], li = ((const float*)(p.ws + WS_LAM))[2 + l];
    const int rsel = lane >> 4, dv = (lane & 15) * 8, half = dv >> 6, d = dv & 63;
    const float* sg = p.in[20] + l * 128 + dv;
    const f32x4 g0 = *(const f32x4*)sg, g1 = *(const f32x4*)(sg + 4);
#pragma unroll 2
    for (int it = 0; it < 8; ++it) { const int r = row0 + it * 4 + rsel;
        const u32x4 a = *(const u32x4*)((const bf16*)(p.ws + WS_OCR) + (size_t)r * 1024 + ((h * 2 + 0) * 2 + half) * 64 + d);
        const u32x4 b = *(const u32x4*)((const bf16*)(p.ws + WS_OCR) + (size_t)r * 1024 + ((h * 2 + 1) * 2 + half) * 64 + d);
        float df[8]; float s = 0.f;
#pragma unroll
        for (int i = 0; i < 4; ++i) { df[2 * i] = __uint_as_float(a[i] << 16) - lam * __uint_as_float(b[i] << 16); df[2 * i + 1] = __uint_as_float(a[i] & 0xffff0000u) - lam * __uint_as_float(b[i] & 0xffff0000u); }
#pragma unroll
        for (int i = 0; i < 8; ++i) s += df[i] * df[i];
        s += __shfl_xor(s, 1); s += __shfl_xor(s, 2); s += __shfl_xor(s, 4); s += __shfl_xor(s, 8);
        const float rinv = (1.f - li) / sqrtf(s * (1.f / 128.f) + EPS);
        u32x4 o; o.x = pk2(df[0] * rinv * g0.x, df[1] * rinv * g0.y); o.y = pk2(df[2] * rinv * g0.z, df[3] * rinv * g0.w);
        o.z = pk2(df[4] * rinv * g1.x, df[5] * rinv * g1.y); o.w = pk2(df[6] * rinv * g1.z, df[7] * rinv * g1.w);
        *(u32x4*)((bf16*)(p.ws + WS_OABC) + (size_t)r * 1536 + 1024 + h * 128 + dv) = o; }
}
constexpr int CONV_TILES_LAT = M_LAT / 64, CONV_TILES_ALL = CONV_TILES_LAT + M_CTX / 16;
constexpr int CONV_LDS_BYTES = 94 * 1024 + 16 * 512 * 4;
__device__ __forceinline__ void conv_tile(const P& p, int l, int tile, unsigned char* lds, int tid) {
    int s0, len, t0, nsub;
    if (tile < CONV_TILES_LAT) { s0 = (tile >> 6) * SEQ; len = SEQ; t0 = (tile & 63) * 64; nsub = 4; } else { const int q = tile - CONV_TILES_LAT; s0 = M_LAT + (q >> 4) * CTXL; len = CTXL; t0 = (q & 15) * 16; nsub = 1; }
    bf16* yin = (bf16*)lds;
    float* outs = (float*)(lds + 94 * 1024);
    const bf16* Y = (const bf16*)(p.ws + WS_Y);
    const int nin = 16 * nsub + 30;
    {
        u32x4 v[12];
#pragma unroll
        for (int q = 0; q < 12; ++q) { const int i = tid + q * 512, rr = i >> 6, ck = i & 63, tt = t0 - 15 + rr;
            v[q] = (u32x4){0u, 0u, 0u, 0u}; if (i < nin * 64 && tt >= 0 && tt < len) v[q] = *(const u32x4*)(Y + (size_t)(s0 + tt) * 512 + ck * 8); }
#pragma unroll
        for (int q = 0; q < 12; ++q) { const int i = tid + q * 512, rr = i >> 6, ck = i & 63; if (i < nin * 64) *(u32x4*)(yin + rr * 512 + ck * 8) = v[q]; } }
    const int ch = tid, wave = tid >> 6, lane = tid & 63;
    float w[31];
    const float* wp = p.in[12] + (size_t)l * 31 * 512 + ch;
#pragma unroll
    for (int j = 0; j < 31; ++j) w[j] = wp[j * 512];
    const float bias = p.in[13][l * 512 + ch];
    const f32x4 lg0 = *(const f32x4*)(p.in[14] + l * 512 + lane * 8), lg1 = *(const f32x4*)(p.in[14] + l * 512 + lane * 8 + 4);
    const f32x4 lb0 = *(const f32x4*)(p.in[15] + l * 512 + lane * 8), lb1 = *(const f32x4*)(p.in[15] + l * 512 + lane * 8 + 4);
    __syncthreads();
#pragma unroll 1
    for (int sb = 0; sb < nsub; ++sb) {
        float a[16];
#pragma unroll
        for (int o = 0; o < 16; ++o) a[o] = bias;
#pragma unroll
        for (int i = 0; i < 46; ++i) { const float x = bf2f(yin[(sb * 16 + i) * 512 + ch]);
#pragma unroll
            for (int o = 0; o < 16; ++o) { const int j = i - o; if (j >= 0 && j < 31) a[o] += x * w[j]; } }
#pragma unroll
        for (int o = 0; o < 16; ++o) outs[o * 512 + ch] = a[o];
        __syncthreads();
#pragma unroll
        for (int rr = 0; rr < 2; ++rr) { const int o = 2 * wave + rr;
            f32x4 v0 = *(const f32x4*)(outs + o * 512 + lane * 8), v1 = *(const f32x4*)(outs + o * 512 + lane * 8 + 4);
            const float mean = wave_sum((v0.x + v0.y) + (v0.z + v0.w) + (v1.x + v1.y) + (v1.z + v1.w)) * (1.f / 512.f);
            v0 = v0 - mean; v1 = v1 - mean;
            const float var = wave_sum((v0.x * v0.x + v0.y * v0.y) + (v0.z * v0.z + v0.w * v0.w) + (v1.x * v1.x + v1.y * v1.y) + (v1.z * v1.z + v1.w * v1.w)) * (1.f / 512.f);
            const float rstd = rsq_(var + EPS);
            v0 = v0 * rstd * lg0 + lb0; v1 = v1 * rstd * lg1 + lb1;
            u32x4 ov; ov.x = pk2(siluf_(v0.x), siluf_(v0.y)); ov.y = pk2(siluf_(v0.z), siluf_(v0.w)); ov.z = pk2(siluf_(v1.x), siluf_(v1.y)); ov.w = pk2(siluf_(v1.z), siluf_(v1.w));
            *(u32x4*)((bf16*)(p.ws + WS_OABC) + (size_t)(s0 + t0 + sb * 16 + o) * 1536 + 512 + lane * 8) = ov; }
        __syncthreads();
    }
}


namespace pg8 {
#define PG8_LAS __attribute__((address_space(3)))
typedef unsigned short bf16_t;
typedef short bf16x8 __attribute__((ext_vector_type(8)));
typedef float f32x4 __attribute__((ext_vector_type(4)));
typedef unsigned u32x4 __attribute__((ext_vector_type(4)));
constexpr int BM = 256, BK = 64, HALF = 128, HTB = HALF * BK * 2  , STAGE_BYTES = 8 * HTB, NXCD = 8, WGM = 8;

__host__ __device__ __forceinline__ int lds_byte(int r, int c) { const int st = (r >> 4) * 2 + (c >> 5), rr = r & 15, cc = c & 31, ob = rr * 64 + cc * 2; return st * 1024 + (ob ^ (((ob >> 9) & 1) << 5)); }
__host__ __device__ __forceinline__ void stage_rc(int b, int& R, int& C) { const int st = b / 1024, sb = b % 1024, swz = sb ^ (((sb >> 9) & 1) << 5); R = (st >> 1) * 16 + swz / 64; C = (st & 1) * 32 + (swz % 64) / 2; }
__host__ __device__ __forceinline__ int perm32(int rho) { const int n = rho >> 4, i = rho & 15; return 8 * (i >> 2) + 4 * n + (i & 3); }

typedef int v4i_t __attribute__((ext_vector_type(4))); typedef int v8i_t __attribute__((ext_vector_type(8)));
__device__ __forceinline__ v8i_t pg8_cat(bf16x8 a, bf16x8 b) { const v4i_t x = __builtin_bit_cast(v4i_t, a), y = __builtin_bit_cast(v4i_t, b); return __builtin_shufflevector(x, y, 0, 1, 2, 3, 4, 5, 6, 7); }
struct Unit { int pm, pn, ko, pa; };
struct Gemm { const bf16_t* A; const bf16_t* Bt; int M, N, K, ld; int sc_w, sc_a; int a_pa; };

struct StaticOrder {
    int nM, nN, nwg, G, c;
    __host__ __device__ void init(int M, int N, int G_, int c_) { nM = M / BM; nN = N / BM; nwg = nM * nN; G = G_; c = c_; }
    __host__ __device__ bool next(int i, Unit& u) const {
        const long L = (long)i * G + c; if (L >= nwg) return false;
        int wgid = (int)L; { const int q = nwg / NXCD, r = nwg % NXCD, xcd = wgid % NXCD, off = wgid / NXCD; wgid = (xcd < r ? xcd * (q + 1) : r * (q + 1) + (xcd - r) * q) + off; }
        const int nig = WGM * nN, gid = wgid / nig, fm = gid * WGM, gsz = (nM - fm) < WGM ? (nM - fm) : WGM;
        u.pm = fm + ((wgid % nig) % gsz); u.pn = (wgid % nig) / gsz; u.ko = 0; u.pa = u.pm; return true;
    }
    __device__ __forceinline__ void a_ready(const Unit&) const {}
    __device__ __forceinline__ void done(const Unit&) const {}
};


typedef float f32x2_cv __attribute__((ext_vector_type(2))); typedef __bf16 bf16x2_cv __attribute__((ext_vector_type(2)));
__device__ __forceinline__ unsigned cvt_pk_bf16(float lo, float hi) { f32x2_cv v = {lo, hi}; bf16x2_cv b = __builtin_convertvector(v, bf16x2_cv); return __builtin_bit_cast(unsigned, b); }
typedef float f32x2 __attribute__((ext_vector_type(2)));

struct InprojL1Order {
    StaticOrder so; int G, c;
    __device__ void init(int G_, int c_) { so.init(16384, 6400, G_, c_); G = G_; c = c_; }
    __device__ bool next(int i, Unit& u) const {
        const int L = i * G + c;
        if (L < 1600) return so.next(i, u);
        const int q = L - 1600; if (q >= 20) return false;
        const int k = q % 5; u.pm = 64 + q / 5; u.pn = k == 0 ? 2 : 8 + k; u.ko = 0; u.pa = u.pm; return true;
    }
    __device__ __forceinline__ void a_ready(const Unit&) const {}
    __device__ __forceinline__ void done(const Unit&) const {}
};
struct MoeOrder {
    StaticOrder so; int nper; int t1, t2, t3, t4, t5, t6, t7;
    __device__ void init(const int (&base)[9], int nper_, int G_, int c_, int max_tiles = 1 << 20) { const int nt_ = (base[8] >> 8) < max_tiles ? (base[8] >> 8) : max_tiles; so.init(nt_ * BM, nper_ * BM, G_, c_); nper = nper_;
        t1 = base[1] >> 8; t2 = base[2] >> 8; t3 = base[3] >> 8; t4 = base[4] >> 8; t5 = base[5] >> 8; t6 = base[6] >> 8; t7 = base[7] >> 8; }
    __device__ bool next(int i, Unit& u) const {
        if (!so.next(i, u)) return false;
        const int e = (u.pm >= t1) + (u.pm >= t2) + (u.pm >= t3) + (u.pm >= t4) + (u.pm >= t5) + (u.pm >= t6) + (u.pm >= t7);
        const int te = e == 0 ? 0 : e == 1 ? t1 : e == 2 ? t2 : e == 3 ? t3 : e == 4 ? t4 : e == 5 ? t5 : e == 6 ? t6 : t7;
        u.pn += e * nper; u.pa = e * 64 + (u.pm - te); return true;
    }
    __device__ __forceinline__ void a_ready(const Unit&) const {}
    __device__ __forceinline__ void done(const Unit&) const {}
};

struct CtxSliceOrder {
    int nks, G, c;
    __device__ void init(int nks_, int G_, int c_) { nks = nks_; G = G_; c = c_; }
    __device__ bool next(int i, Unit& u) const {
        const int s = i * G + c; if (s >= 16 * nks) return false;
        const int q = s / nks, r = s % nks; u.pm = 64 + (q >> 2); u.pn = q & 3; u.ko = r * 256; u.pa = u.pm; return true;
    }
    __device__ __forceinline__ void a_ready(const Unit&) const {}
    __device__ __forceinline__ void done(const Unit&) const {}
};
struct MoeTailOrder {
    int ntail, G, c; int t1, t2, t3, t4, t5, t6, t7;
    __device__ void init(const int (&base)[9], int G_, int c_) { ntail = (base[8] >> 8) - 128; G = G_; c = c_;
        t1 = base[1] >> 8; t2 = base[2] >> 8; t3 = base[3] >> 8; t4 = base[4] >> 8; t5 = base[5] >> 8; t6 = base[6] >> 8; t7 = base[7] >> 8; }
    __device__ bool next(int i, Unit& u) const {
        const int s = i * G + c; if (s >= ntail * 28) return false;
        const int tile = s / 28, r = s % 28; u.pm = 128 + tile;
        const int e = (u.pm >= t1) + (u.pm >= t2) + (u.pm >= t3) + (u.pm >= t4) + (u.pm >= t5) + (u.pm >= t6) + (u.pm >= t7);
        const int te = e == 0 ? 0 : e == 1 ? t1 : e == 2 ? t2 : e == 3 ? t3 : e == 4 ? t4 : e == 5 ? t5 : e == 6 ? t6 : t7;
        u.pn = e * 4 + r / 7; u.ko = (r % 7) * 256; u.pa = e * 64 + (u.pm - te); return true;
    }
    __device__ __forceinline__ void a_ready(const Unit&) const {}
    __device__ __forceinline__ void done(const Unit&) const {}
};

__device__ __forceinline__ u32x4 pack8(f32x4 a, f32x4 b) { u32x4 w; w.x = cvt_pk_bf16(a[0], a[1]); w.y = cvt_pk_bf16(a[2], a[3]); w.z = cvt_pk_bf16(b[0], b[1]); w.w = cvt_pk_bf16(b[2], b[3]); return w; }
__device__ __forceinline__ float sigm(float x) { return __builtin_amdgcn_rcpf(1.f + __expf(-x)); }
__device__ __forceinline__ f32x4 sigm4(f32x4 v) { f32x4 r; r[0] = sigm(v[0]); r[1] = sigm(v[1]); r[2] = sigm(v[2]); r[3] = sigm(v[3]); return r; }
__device__ __forceinline__ f32x4 lo4(u32x4 g) { f32x4 r; r[0] = __uint_as_float(g.x << 16); r[1] = __uint_as_float(g.x & 0xffff0000u); r[2] = __uint_as_float(g.y << 16); r[3] = __uint_as_float(g.y & 0xffff0000u); return r; }
__device__ __forceinline__ f32x4 hi4(u32x4 g) { f32x4 r; r[0] = __uint_as_float(g.z << 16); r[1] = __uint_as_float(g.z & 0xffff0000u); r[2] = __uint_as_float(g.w << 16); r[3] = __uint_as_float(g.w & 0xffff0000u); return r; }
typedef unsigned u32x2 __attribute__((ext_vector_type(2)));

struct EpiInproj {
    static constexpr bool PERM = false, AFTER_DRAIN = false, MIDK = false, DUPABLE = true;
    unsigned char* ws; const float* qn_g; const float* kn_g; const float* b_gate;
    __device__ __forceinline__ void operator()(const f32x4 (&acc)[2][2][4][2], const Unit& u, int wr, int wc, int fr, int fq) const {
        const int pn = u.pn, pm = u.pm, row0 = pm * BM + wr * 64 + fr;
        const int kroff = pm < 64 ? (pm >> 4) * 256 : (pm - 64) * 4096 - 12288;
#ifndef DBG_INPROJ
#define DBG_INPROJ 15
#endif
        if (pn >= 13) { if (!(DBG_INPROJ & 1)) return;
            const int gc0 = (pn - 13) * 256 + wc * 32 + 8 * fq; f32x4 bv[2][2];
#pragma unroll
            for (int bj = 0; bj < 2; ++bj)
#pragma unroll
                for (int n = 0; n < 2; ++n) bv[bj][n] = *(const f32x4*)(b_gate + gc0 + 128 * bj + 4 * n);
            unsigned char* gb = ws + WS_G + (size_t)row0 * 3072 + (pn - 13) * 256 + (4 * wc + fq) * 16;
#pragma unroll
            for (int ai = 0; ai < 2; ++ai)
#pragma unroll
                for (int m = 0; m < 4; ++m) { u32x4 w;
#pragma unroll
                    for (int bj = 0; bj < 2; ++bj)
#pragma unroll
                        for (int n = 0; n < 2; ++n) { const f32x4 x = acc[ai][bj][m][n] + bv[bj][n]; unsigned d = 0u;
#pragma unroll
                            for (int e = 0; e < 4; ++e) { const float g255 = __builtin_amdgcn_rcpf(__builtin_fmaf(__expf(-x[e]), 1.f / 255.f, 1.f / 255.f));
                                d = __builtin_amdgcn_cvt_pk_u8_f32(__builtin_fmaxf(g255, 1.f), e, d); }
                            w[2 * bj + n] = d; }
                    *(u32x4*)(gb + (size_t)(ai * HALF + m * 16) * 3072) = w; }
        } else if (pn >= 11) { if (!(DBG_INPROJ & 2)) return;
            const int c0 = (pn - 11) * 256 + wc * 32 + 8 * fq;
#pragma unroll
            for (int ai = 0; ai < 2; ++ai)
#pragma unroll
                for (int m = 0; m < 4; ++m) { bf16_t* dst = (bf16_t*)(ws + WS_VC) + (size_t)(row0 + ai * HALF + m * 16 + kroff) * 512 + c0;
#pragma unroll
                    for (int bj = 0; bj < 2; ++bj) *(u32x4*)(dst + 128 * bj) = pack8(acc[ai][bj][m][0], acc[ai][bj][m][1]); }
        } else if (pn >= 3 && pn < 7) { if (!(DBG_INPROJ & 4)) return;
            const int c0 = (pn - 3) * 128 + wc * 32 + 8 * fq;
#pragma unroll
            for (int ai = 0; ai < 2; ++ai)
#pragma unroll
                for (int m = 0; m < 4; ++m) { bf16_t* dst = (bf16_t*)(ws + WS_Y) + (size_t)(row0 + ai * HALF + m * 16) * 512 + c0;
                    *(u32x4*)dst = pack8(acc[ai][0][m][0] * sigm4(acc[ai][1][m][0]), acc[ai][0][m][1] * sigm4(acc[ai][1][m][1])); }
        } else { if (!(DBG_INPROJ & 8)) return;
            const bool isv = (pn == 2 && wc >= 2), isq = pn < 2 || pn == 7 || pn == 8, normed = pn < 3 && !isv, roped = !isv && pm < 64;
            bf16_t* dst; int pitch, roff;
            if (pn < 2) { dst = (bf16_t*)(ws + WS_QA) + (4 * pn + wc) * 64; pitch = 512; roff = 0; }
            else if (pn == 2) { dst = (bf16_t*)(ws + (wc < 2 ? WS_KA : WS_VA)) + (wc & 1) * 64; pitch = 128; roff = kroff; }
            else if (pn < 9) { dst = (bf16_t*)(ws + WS_QC) + (4 * (pn - 7) + wc) * 64; pitch = 512; roff = 0; }
            else { dst = (bf16_t*)(ws + WS_KC) + (4 * (pn - 9) + wc) * 64; pitch = 512; roff = kroff; }
            dst += isv ? 4 * fq : 8 * fq;
            f32x4 gv[2][2];
            const float* g = isq ? qn_g : kn_g;
#pragma unroll
            for (int bj = 0; bj < 2; ++bj)
#pragma unroll
                for (int n = 0; n < 2; ++n) gv[bj][n] = normed ? *(const f32x4*)(g + 32 * bj + 16 * n + 4 * fq) : (f32x4){1.f, 1.f, 1.f, 1.f};
            const float qs = isq ? C2 : 1.f;
            const float* cosT = (const float*)(ws + WS_ROPE) + 4 * fq; const float* sinT = cosT + 1024;
#pragma unroll
            for (int ai = 0; ai < 2; ++ai)
#pragma unroll
                for (int m = 0; m < 4; ++m) { const int row = row0 + ai * HALF + m * 16;
                    f32x4 v[2][2];
#pragma unroll
                    for (int bj = 0; bj < 2; ++bj)
#pragma unroll
                        for (int n = 0; n < 2; ++n) v[bj][n] = acc[ai][bj][m][n];
                    if (normed) { float ss = 0.f;
#pragma unroll
                        for (int bj = 0; bj < 2; ++bj)
#pragma unroll
                            for (int n = 0; n < 2; ++n) ss += (v[bj][n][0] * v[bj][n][0] + v[bj][n][1] * v[bj][n][1]) + (v[bj][n][2] * v[bj][n][2] + v[bj][n][3] * v[bj][n][3]);
                        ss = ::xsum_x32(::xsum_x16(ss));
                        const float rinv = ::rsq_(ss * (1.f / 64.f) + EPS);
#pragma unroll
                        for (int bj = 0; bj < 2; ++bj)
#pragma unroll
                            for (int n = 0; n < 2; ++n) v[bj][n] = v[bj][n] * rinv * gv[bj][n]; }
                    if (roped) { const int t = row & 4095;
#pragma unroll
                        for (int bj = 0; bj < 2; ++bj) { const int pos = bj ? (t & 63) : (t >> 6); const f32x4 cs = *(const f32x4*)(cosT + pos * 16), sn = *(const f32x4*)(sinT + pos * 16);
                            const f32x4 x1 = v[bj][0], x2 = v[bj][1]; v[bj][0] = x1 * cs - x2 * sn; v[bj][1] = x2 * cs + x1 * sn; } }
                    bf16_t* rp = dst + (size_t)(row + roff) * pitch;
                    if (isv) {
#pragma unroll
                        for (int bj = 0; bj < 2; ++bj)
#pragma unroll
                            for (int n = 0; n < 2; ++n) { const f32x4 o = v[bj][n]; u32x2 w; w.x = cvt_pk_bf16(o[0], o[1]); w.y = cvt_pk_bf16(o[2], o[3]); *(u32x2*)(rp + 32 * bj + 16 * n) = w; } }
                    else {
#pragma unroll
                        for (int bj = 0; bj < 2; ++bj) *(u32x4*)(rp + 32 * bj) = pack8(v[bj][0] * qs, v[bj][1] * qs); }
                }
        }
    }
};
struct EpiMerge {
    static constexpr bool PERM = false, AFTER_DRAIN = false, MIDK = true, DUPABLE = false;
    const unsigned char* G; bf16_t* MB;
    static __device__ __forceinline__ float ub(unsigned w, int k) { return (float)((w >> (8 * k)) & 0xffu); }
    __device__ __forceinline__ void mid(f32x4 (&acc)[2][2][4][2], const Unit& u, int wr, int wc, int fr, int fq, int seg) const {
        const unsigned rowb = (unsigned)(u.pm * BM + wr * 64 + fr) * 3072u + (unsigned)((seg - 1) * 1024 + u.pn * 256 + (4 * wc + fq) * 16);
        const unsigned char* Gb = G;
#pragma unroll
        for (int ai = 0; ai < 2; ++ai) { u32x4 ga[4], gb[4];
#pragma unroll
            for (int m = 0; m < 4; ++m) { const unsigned o = rowb + (unsigned)(ai * HALF + m * 16) * 3072u; ga[m] = *(const u32x4*)(Gb + o); gb[m] = *(const u32x4*)(Gb + (o + 1024u)); }
#pragma unroll
            for (int m = 0; m < 4; ++m)
#pragma unroll
                for (int bj = 0; bj < 2; ++bj)
#pragma unroll
                    for (int n = 0; n < 2; ++n) { const unsigned a = ga[m][2 * bj + n], b = gb[m][2 * bj + n]; f32x4 r;
#pragma unroll
                        for (int e = 0; e < 4; ++e) r[e] = ub(a, e) * __builtin_amdgcn_rcpf(ub(b, e));
                        acc[ai][bj][m][n] *= r; }
            asm volatile("" ::: "memory"); }
    }
    __device__ __forceinline__ void operator()(const f32x4 (&acc)[2][2][4][2], const Unit& u, int wr, int wc, int fr, int fq) const {
        const int row0 = u.pm * BM + wr * 64 + fr, c0 = u.pn * 256 + wc * 32 + 8 * fq;
#pragma unroll
        for (int ai = 0; ai < 2; ++ai)
#pragma unroll
            for (int m = 0; m < 4; ++m) { const int row = row0 + ai * HALF + m * 16; const u32x4 g = *(const u32x4*)(G + (size_t)row * 3072 + 2048 + u.pn * 256 + (4 * wc + fq) * 16);
#pragma unroll
                for (int bj = 0; bj < 2; ++bj) { f32x4 g0, g1;
#pragma unroll
                    for (int e = 0; e < 4; ++e) { g0[e] = ub(g[2 * bj], e) * (1.f / 255.f); g1[e] = ub(g[2 * bj + 1], e) * (1.f / 255.f); }
                    *(u32x4*)(MB + (size_t)row * 1024 + c0 + 128 * bj) = pack8(acc[ai][bj][m][0] * g0, acc[ai][bj][m][1] * g1); } }
    }
};
struct EpiResid {
    static constexpr bool PERM = false, AFTER_DRAIN = false, MIDK = false, DUPABLE = false;
    __device__ __forceinline__ int nst(const Unit&) const { return 0; }
    const float* base_f32; bf16_t* xb; const float* gate;
    __device__ __forceinline__ void operator()(const f32x4 (&acc)[2][2][4][2], const Unit& u, int wr, int wc, int fr, int fq) const {
        const int pm = u.pm, c0 = u.pn * 256 + wc * 32 + 4 * fq, bi = pm >> 4, row0 = pm * BM + wr * 64 + fr;
        f32x4 gv[2][2];
#pragma unroll
        for (int bj = 0; bj < 2; ++bj)
#pragma unroll
            for (int n = 0; n < 2; ++n) gv[bj][n] = *(const f32x4*)(gate + (size_t)bi * 6 * 1024 + c0 + 128 * bj + 16 * n);
#pragma unroll
        for (int ai = 0; ai < 2; ++ai)
#pragma unroll
            for (int m = 0; m < 4; ++m) { const size_t off = (size_t)(row0 + ai * HALF + m * 16) * 1024 + c0;
#pragma unroll
                for (int bj = 0; bj < 2; ++bj)
#pragma unroll
                    for (int n = 0; n < 2; ++n) { const size_t o = off + 128 * bj + 16 * n; f32x4 b;
                        if (base_f32) b = *(const f32x4*)(base_f32 + o);
                        else { const u32x2 q = *(const u32x2*)(xb + o); b[0] = __uint_as_float(q.x << 16); b[1] = __uint_as_float(q.x & 0xffff0000u); b[2] = __uint_as_float(q.y << 16); b[3] = __uint_as_float(q.y & 0xffff0000u); }
                        const f32x4 r = b + gv[bj][n] * acc[ai][bj][m][n]; u32x2 w; w.x = cvt_pk_bf16(r[0], r[1]); w.y = cvt_pk_bf16(r[2], r[3]); *(u32x2*)(xb + o) = w; } }
    }
};
struct EpiSwiglu {
    static constexpr bool PERM = false, AFTER_DRAIN = false, MIDK = false, DUPABLE = false;
    bf16_t* O; int ld, nper;
    __device__ __forceinline__ void operator()(const f32x4 (&acc)[2][2][4][2], const Unit& u, int wr, int wc, int fr, int fq) const {
        const int row0 = u.pm * BM + wr * 64 + fr, c0 = (u.pn % nper) * 128 + wc * 32 + 8 * fq;
#pragma unroll
        for (int ai = 0; ai < 2; ++ai)
#pragma unroll
            for (int m = 0; m < 4; ++m) { const f32x4 a0 = acc[ai][0][m][0], a1 = acc[ai][0][m][1];
                *(u32x4*)(O + (size_t)(row0 + ai * HALF + m * 16) * ld + c0) = pack8(a0 * sigm4(a0) * acc[ai][1][m][0], a1 * sigm4(a1) * acc[ai][1][m][1]); }
    }
};
struct EpiSwigluF8 {
    static constexpr bool PERM = false, AFTER_DRAIN = false, MIDK = false, DUPABLE = false;
    unsigned char* O; int ld, nper;
    __device__ __forceinline__ void operator()(const f32x4 (&acc)[2][2][4][2], const Unit& u, int wr, int wc, int fr, int fq) const {
        const int row0 = u.pm * BM + wr * 64 + fr, c0 = (u.pn % nper) * 128 + wc * 32 + 8 * fq;
#pragma unroll
        for (int ai = 0; ai < 2; ++ai)
#pragma unroll
            for (int m = 0; m < 4; ++m) { const f32x4 a0 = acc[ai][0][m][0], a1 = acc[ai][0][m][1];
                const f32x4 y0 = a0 * sigm4(a0) * acc[ai][1][m][0] * 4.f, y1 = a1 * sigm4(a1) * acc[ai][1][m][1] * 4.f;
                u32x2 w; w.x = __builtin_amdgcn_cvt_pk_fp8_f32(y0[2], y0[3], __builtin_amdgcn_cvt_pk_fp8_f32(y0[0], y0[1], 0u, false), true);
                w.y = __builtin_amdgcn_cvt_pk_fp8_f32(y1[2], y1[3], __builtin_amdgcn_cvt_pk_fp8_f32(y1[0], y1[1], 0u, false), true);
                *(u32x2*)(O + (size_t)(row0 + ai * HALF + m * 16) * ld + c0) = w; }
    }
};
struct EpiCtxPartial {
    static constexpr bool PERM = false, AFTER_DRAIN = false, MIDK = false, DUPABLE = false;
    bf16_t* P;
    __device__ __forceinline__ void operator()(const f32x4 (&acc)[2][2][4][2], const Unit& u, int wr, int wc, int fr, int fq) const {
        const int row0 = (u.pm - 64) * BM + wr * 64 + fr, c0 = u.pn * 256 + wc * 32 + 4 * fq; bf16_t* Y = P + (size_t)(u.ko >> 8) * 1024 * 1024;
#pragma unroll
        for (int ai = 0; ai < 2; ++ai)
#pragma unroll
            for (int m = 0; m < 4; ++m) { const int row = row0 + ai * HALF + m * 16;
#pragma unroll
                for (int bj = 0; bj < 2; ++bj)
#pragma unroll
                    for (int n = 0; n < 2; ++n) { const f32x4 a = acc[ai][bj][m][n]; u32x2 w; w.x = cvt_pk_bf16(a[0], a[1]); w.y = cvt_pk_bf16(a[2], a[3]); *(u32x2*)(Y + (size_t)row * 1024 + c0 + 128 * bj + 16 * n) = w; } }
    }
};
struct EpiMoeDownTail {
    static constexpr bool PERM = false, AFTER_DRAIN = false, MIDK = false, DUPABLE = false;
    bf16_t* YPT; const float* rowp;
    __device__ __forceinline__ void operator()(const f32x4 (&acc)[2][2][4][2], const Unit& u, int wr, int wc, int fr, int fq) const {
        const int row0 = u.pm * BM + wr * 64 + fr, c0 = (u.pn & 3) * 256 + wc * 32 + 8 * fq; bf16_t* Y = YPT + (size_t)(u.ko >> 8) * 2048 * 1024 - (size_t)32768 * 1024;
#pragma unroll
        for (int ai = 0; ai < 2; ++ai)
#pragma unroll
            for (int m = 0; m < 4; ++m) { const int row = row0 + ai * HALF + m * 16; const float rp = rowp[u.pa * BM + wr * 64 + fr + ai * HALF + m * 16];
#pragma unroll
                for (int bj = 0; bj < 2; ++bj) *(u32x4*)(Y + (size_t)row * 1024 + c0 + 128 * bj) = pack8(acc[ai][bj][m][0] * rp, acc[ai][bj][m][1] * rp); }
    }
};
struct EpiMoeDown {
    static constexpr bool PERM = false, AFTER_DRAIN = false, MIDK = false, DUPABLE = false;
    bf16_t* YP; const float* rowp;
    __device__ __forceinline__ void operator()(const f32x4 (&acc)[2][2][4][2], const Unit& u, int wr, int wc, int fr, int fq) const {
        const int row0 = u.pm * BM + wr * 64 + fr, c0 = (u.pn & 3) * 256 + wc * 32 + 8 * fq;
#pragma unroll
        for (int ai = 0; ai < 2; ++ai)
#pragma unroll
            for (int m = 0; m < 4; ++m) { const int row = row0 + ai * HALF + m * 16; const float rp = rowp[u.pa * BM + wr * 64 + fr + ai * HALF + m * 16];
#pragma unroll
                for (int bj = 0; bj < 2; ++bj) *(u32x4*)(YP + (size_t)row * 1024 + c0 + 128 * bj) = pack8(acc[ai][bj][m][0] * rp, acc[ai][bj][m][1] * rp); }
    }
};

template <class Epi, class Sched, bool ALIGN_EPI = false, bool SP2 = false, bool F8 = false>
__device__ __forceinline__ void gemm_phase(PG8_LAS unsigned char* lds, const Gemm g, const Sched& S, const Epi& E) {
    int tid_o = threadIdx.x; asm volatile("" : "+v"(tid_o));
    const int tid = tid_o, wid = __builtin_amdgcn_readfirstlane(tid >> 6), lane = tid & 63, wr = wid >> 2, wc = wid & 3, fr = lane & 15, fq = lane >> 4;
    const int K = g.K, nt = K / BK;
    unsigned voffA[2], voffB[2];
#pragma unroll
    for (int i = 0; i < 2; ++i) { int R, C; stage_rc(tid * 16 + i * 8192, R, C); const int Rb = Epi::PERM ? ((R & ~31) + perm32(R & 31)) : R;
        voffA[i] = (unsigned)(R * g.ld + C) * 2u; voffB[i] = (unsigned)(Rb * g.ld + C) * 2u; }
    const size_t kstep = (size_t)(BK * 2);
    const size_t hstep = (size_t)HALF * g.ld * 2;
    const size_t tstep = 2 * hstep;
    const unsigned ldsw = (unsigned)wid * 1024u;
    const int aoff = lds_byte(wr * 64 + fr, fq * 8), boff = lds_byte(wc * 32 + fr, fq * 8);
#define PG8_SA(b, h) (((b) * 2 + (h)) * HTB)
#define PG8_SB(b, h) ((4 + (b) * 2 + (h)) * HTB)
#define PG8_STAGE(bufoff, gbase, voff) do { _Pragma("unroll") for (int _i = 0; _i < 2; ++_i) \
        __builtin_amdgcn_global_load_lds((const unsigned*)((const char*)(gbase) + (voff)[_i]), (PG8_LAS unsigned*)(lds + (bufoff) + ldsw + _i * 8192), 16, 0, 0); } while (0)
#define PG8_LDA(dst, b, h) do { if constexpr (F8) { _Pragma("unroll") for (int m = 0; m < 4; ++m) { const v4i_t x_ = *(const PG8_LAS v4i_t*)(lds + PG8_SA(b, h) + aoff + m * 2048), y_ = *(const PG8_LAS v4i_t*)(lds + PG8_SA(b, h) + aoff + m * 2048 + 1024); dst##8[m] = __builtin_shufflevector(x_, y_, 0, 1, 2, 3, 4, 5, 6, 7); } } \
        else { _Pragma("unroll") for (int m = 0; m < 4; ++m) _Pragma("unroll") for (int k = 0; k < 2; ++k) dst[m][k] = *(const PG8_LAS bf16x8*)(lds + PG8_SA(b, h) + aoff + m * 2048 + k * 1024); } } while (0)
#define PG8_LDB(dst, b, h) do { if constexpr (F8) { _Pragma("unroll") for (int n = 0; n < 2; ++n) { const v4i_t x_ = *(const PG8_LAS v4i_t*)(lds + PG8_SB(b, h) + boff + n * 2048), y_ = *(const PG8_LAS v4i_t*)(lds + PG8_SB(b, h) + boff + n * 2048 + 1024); dst##8[n] = __builtin_shufflevector(x_, y_, 0, 1, 2, 3, 4, 5, 6, 7); } } \
        else { _Pragma("unroll") for (int n = 0; n < 2; ++n) _Pragma("unroll") for (int k = 0; k < 2; ++k) dst[n][k] = *(const PG8_LAS bf16x8*)(lds + PG8_SB(b, h) + boff + n * 2048 + k * 1024); } } while (0)
#define PG8_MMA(ai, bj, At, Bt) do { if constexpr (F8) { __builtin_amdgcn_s_setprio(1); _Pragma("unroll") for (int m = 0; m < 4; ++m) _Pragma("unroll") for (int n = 0; n < 2; ++n) \
        asm volatile("v_mfma_scale_f32_16x16x128_f8f6f4 %0, %1, %2, %0, %3, %4 op_sel_hi:[0,0,0]" : "+v"(acc[ai][bj][m][n]) : "v"(Bt##8[n]), "v"(At##8[m]), "v"(scw_), "v"(sca_));     __builtin_amdgcn_s_setprio(0); } else { __builtin_amdgcn_s_setprio(1); _Pragma("unroll") for (int m = 0; m < 4; ++m) _Pragma("unroll") for (int n = 0; n < 2; ++n) _Pragma("unroll") for (int k = 0; k < 2; ++k) \
        acc[ai][bj][m][n] = __builtin_amdgcn_mfma_f32_16x16x32_bf16(Bt[n][k], At[m][k], acc[ai][bj][m][n], 0, 0, 0); __builtin_amdgcn_s_setprio(0); } } while (0)
#define PG8_WAIT_V(n) asm volatile("s_waitcnt vmcnt(" #n ")" ::: "memory")
#define PG8_WAIT_L(n) asm volatile("s_waitcnt lgkmcnt(" #n ")" ::: "memory")
#define PG8_BAR __builtin_amdgcn_s_barrier()
#define PG8_SCHED __builtin_amdgcn_sched_barrier(0)
    Unit cur, nxt; int ui = 0;
    if (!S.next(0, cur)) return;
    f32x4 acc[2][2][4][2];
#pragma unroll
    for (int a = 0; a < 2; ++a)
#pragma unroll
        for (int b = 0; b < 2; ++b)
#pragma unroll
            for (int m = 0; m < 4; ++m)
#pragma unroll
                for (int n = 0; n < 2; ++n) acc[a][b][m][n] = (f32x4){0.f, 0.f, 0.f, 0.f};
    int scw_ = g.sc_w, sca_ = g.sc_a; asm volatile("" : "+v"(scw_), "+v"(sca_));
    bf16x8 At[4][2], B0[2][2], B1[2][2]; v8i_t At8[4], B08[2], B18[2];
    const char* cA = (const char*)g.A + (size_t)(g.a_pa ? cur.pa : cur.pm) * tstep + (size_t)cur.ko * 2; const char* cB = (const char*)g.Bt + (size_t)cur.pn * tstep + (size_t)cur.ko * 2;
    S.a_ready(cur);
    if constexpr (SP2) {
        PG8_STAGE(PG8_SB(0, 0), cB, voffB); PG8_STAGE(PG8_SB(0, 1), cB + hstep, voffB); PG8_STAGE(PG8_SA(0, 0), cA, voffA); PG8_STAGE(PG8_SA(0, 1), cA + hstep, voffA);
        if (wr == 1) PG8_BAR;
        PG8_WAIT_V(2); PG8_BAR;
        PG8_STAGE(PG8_SB(1, 0), cB + kstep, voffB); PG8_STAGE(PG8_SA(1, 0), cA + kstep, voffA); PG8_STAGE(PG8_SB(1, 1), cB + hstep + kstep, voffB);
        PG8_WAIT_V(6); PG8_BAR;
    } else {
        PG8_STAGE(PG8_SB(0, 0), cB, voffB); PG8_STAGE(PG8_SA(0, 0), cA, voffA); PG8_STAGE(PG8_SB(0, 1), cB + hstep, voffB); PG8_STAGE(PG8_SA(0, 1), cA + hstep, voffA);
        if (wr == 1) PG8_BAR;
        PG8_WAIT_V(4); PG8_BAR;
        PG8_STAGE(PG8_SB(1, 0), cB + kstep, voffB); PG8_STAGE(PG8_SA(1, 0), cA + kstep, voffA); PG8_STAGE(PG8_SB(1, 1), cB + hstep + kstep, voffB);
        PG8_WAIT_V(6); PG8_BAR;
    }
    for (;;) {
        const bool has_next = S.next(ui + 1, nxt);
        const char* nA = has_next ? (const char*)g.A + (size_t)(g.a_pa ? nxt.pa : nxt.pm) * tstep + (size_t)nxt.ko * 2 : cA; const char* nB = has_next ? (const char*)g.Bt + (size_t)nxt.pn * tstep + (size_t)nxt.ko * 2 : cB;
#pragma unroll 1
        for (int t = 0; t < nt; t += 2) {
            const bool last = (t == nt - 2);
            const char* a1 = cA + (size_t)(t + 1) * kstep;
            const char* a2 = last ? nA : cA + (size_t)(t + 2) * kstep; const char* b2 = last ? nB : cB + (size_t)(t + 2) * kstep;
            const char* a3 = a2 + kstep; const char* b3 = b2 + kstep;
            if (last && has_next) S.a_ready(nxt);
            if constexpr (Epi::MIDK) { if (t == 8 || t == 16) E.mid(acc, cur, wr, wc, fr, fq, t >> 3); }
            if constexpr (SP2) {
            PG8_LDB(B0, 0, 0); PG8_LDB(B1, 0, 1); PG8_SCHED; PG8_LDA(At, 0, 0); PG8_STAGE(PG8_SA(1, 1), a1 + hstep, voffA);
            PG8_WAIT_V(8); PG8_WAIT_L(0); PG8_BAR; PG8_MMA(0, 0, At, B0); PG8_MMA(0, 1, At, B1); PG8_BAR; PG8_SCHED;
            PG8_LDA(At, 0, 1); PG8_STAGE(PG8_SB(0, 0), b2, voffB); PG8_STAGE(PG8_SB(0, 1), b2 + hstep, voffB); PG8_STAGE(PG8_SA(0, 0), a2, voffA);
            PG8_WAIT_V(8); PG8_WAIT_L(0); PG8_BAR; PG8_MMA(1, 0, At, B0); PG8_MMA(1, 1, At, B1); PG8_BAR; PG8_SCHED;
            PG8_LDB(B0, 1, 0); PG8_LDB(B1, 1, 1); PG8_SCHED; PG8_LDA(At, 1, 0); PG8_STAGE(PG8_SA(0, 1), a2 + hstep, voffA);
            PG8_WAIT_V(8); PG8_WAIT_L(0); PG8_BAR; PG8_MMA(0, 0, At, B0); PG8_MMA(0, 1, At, B1); PG8_BAR; PG8_SCHED;
            PG8_LDA(At, 1, 1); PG8_STAGE(PG8_SB(1, 0), b3, voffB); PG8_STAGE(PG8_SB(1, 1), b3 + hstep, voffB); PG8_STAGE(PG8_SA(1, 0), a3, voffA);
            PG8_WAIT_V(8); PG8_WAIT_L(0); PG8_BAR; PG8_MMA(1, 0, At, B0); PG8_MMA(1, 1, At, B1); PG8_BAR; PG8_SCHED;
            } else {
            PG8_LDB(B0, 0, 0); PG8_SCHED; PG8_LDA(At, 0, 0); PG8_STAGE(PG8_SA(1, 1), a1 + hstep, voffA);
            PG8_WAIT_L(8); PG8_BAR; PG8_WAIT_L(0); PG8_MMA(0, 0, At, B0); PG8_BAR; PG8_SCHED;
            PG8_LDB(B1, 0, 1); PG8_STAGE(PG8_SB(0, 0), b2, voffB);
            PG8_BAR; PG8_WAIT_L(0); PG8_MMA(0, 1, At, B1); PG8_BAR;
            PG8_LDA(At, 0, 1); PG8_STAGE(PG8_SA(0, 0), a2, voffA);
            PG8_BAR; PG8_WAIT_L(0); PG8_MMA(1, 0, At, B0); PG8_BAR; PG8_SCHED;
            PG8_STAGE(PG8_SB(0, 1), b2 + hstep, voffB);
            PG8_WAIT_V(6); PG8_BAR; PG8_MMA(1, 1, At, B1); PG8_BAR;
            PG8_LDB(B0, 1, 0); PG8_SCHED; PG8_LDA(At, 1, 0); PG8_STAGE(PG8_SA(0, 1), a2 + hstep, voffA);
            PG8_WAIT_L(8); PG8_BAR; PG8_WAIT_L(0); PG8_MMA(0, 0, At, B0); PG8_BAR; PG8_SCHED;
            PG8_LDB(B1, 1, 1); PG8_STAGE(PG8_SB(1, 0), b3, voffB);
            PG8_BAR; PG8_WAIT_L(0); PG8_MMA(0, 1, At, B1); PG8_BAR;
            PG8_LDA(At, 1, 1); PG8_STAGE(PG8_SA(1, 0), a3, voffA);
            PG8_BAR; PG8_WAIT_L(0); PG8_MMA(1, 0, At, B0); PG8_BAR; PG8_SCHED;
            PG8_STAGE(PG8_SB(1, 1), b3 + hstep, voffB);
            PG8_WAIT_V(6); PG8_BAR; PG8_MMA(1, 1, At, B1); PG8_BAR;
            }
        }
        if constexpr (F8) asm volatile("s_nop 15\n\ts_nop 7" ::: "memory");
        if constexpr (ALIGN_EPI) { if (wr == 0) PG8_BAR; }
        if constexpr (!Epi::AFTER_DRAIN) { E(acc, cur, wr, wc, fr, fq);
#ifdef DUP_EPI
            if constexpr (Epi::DUPABLE) { asm volatile("" ::: "memory"); E(acc, cur, wr, wc, fr, fq); }
#endif
            S.done(cur); }
        if (!has_next) break;
#pragma unroll
        for (int a = 0; a < 2; ++a)
#pragma unroll
            for (int b = 0; b < 2; ++b)
#pragma unroll
                for (int m = 0; m < 4; ++m)
#pragma unroll
                    for (int n = 0; n < 2; ++n) acc[a][b][m][n] = (f32x4){0.f, 0.f, 0.f, 0.f};
        cur = nxt; cA = nA; cB = nB; ++ui;
        if constexpr (ALIGN_EPI) { if (wr == 1) PG8_BAR; }
    }
    PG8_WAIT_V(0);
    if constexpr (!ALIGN_EPI) { if (wr == 0) PG8_BAR; }
    PG8_BAR;
    if constexpr (Epi::AFTER_DRAIN) { E.fused(acc, cur, wr, wc, fr, fq, lds, wid, lane); S.done(cur); }
#undef PG8_SA
#undef PG8_SB
#undef PG8_STAGE
#undef PG8_LDA
#undef PG8_LDB
#undef PG8_MMA
#undef PG8_WAIT_V
#undef PG8_WAIT_L
#undef PG8_BAR
#undef PG8_SCHED
}
}


#include <hip/hip_bf16.h>
#include <cmath>

namespace attn_body {
using bf16=__hip_bfloat16;
using bf16x8=__attribute__((ext_vector_type(8)))short;
using s16x4=__attribute__((ext_vector_type(4)))short;
using f32x16=__attribute__((ext_vector_type(16)))float;
using u32x4=__attribute__((ext_vector_type(4)))unsigned;
constexpr int D=64;
constexpr int NW=8,QBLK=32,QB=QBLK*NW,KVBLK=64;
constexpr int ATTN_UNIT_ROWS=QB;
__device__ __forceinline__ int crow(int r,int hi){return (r&3)+8*(r>>2)+4*hi;}
#define SBAR() __builtin_amdgcn_sched_barrier(0)
__device__ __forceinline__ void cmask(f32x16&p0,f32x16&p1,int jb,int qrel,int hi){
  const float NEG=-INFINITY; int kb=64*jb+4*hi;
  #pragma unroll
  for(int r=0;r<16;++r){int kv=kb+(r&3)+8*(r>>2); if(kv>qrel)p0[r]=NEG; if(kv+32>qrel)p1[r]=NEG;}
}

constexpr int NSLOT=3, SLOTB=8192;
constexpr int LDS_K=0, LDS_V=NSLOT*SLOTB, LDS_WS=2*NSLOT*SLOTB, LDS_OST=LDS_WS+NW*64*4, LDS_BYTES=LDS_OST+NW*4096;
constexpr float C2=0.125f*1.4426950408889634f;
__device__ __forceinline__ void glds16(const void*gsrc,unsigned lds_dst){unsigned keep;
  asm volatile("s_mov_b32 %0, m0\n\ts_mov_b32 m0, %2\n\ts_nop 0\n\tglobal_load_lds_dwordx4 %1, off\n\ts_mov_b32 m0, %0":"=&s"(keep):"v"(gsrc),"s"(lds_dst):"memory");}
__device__ __forceinline__ float max3f(float a,float b,float c){float r;asm("v_max3_f32 %0, %1, %2, %3":"=v"(r):"v"(a),"v"(b),"v"(c));return r;}
__device__ __forceinline__ float max2f(float a,float b){float r;asm("v_max_f32_e32 %0, %1, %2":"=v"(r):"v"(a),"v"(b));return r;}
__device__ __forceinline__ float fadd_s(float a,float b){float r;asm("v_add_f32_e32 %0, %1, %2":"=v"(r):"v"(a),"v"(b));return r;}
__device__ __forceinline__ float fsub_s(float a,float b){float r;asm("v_sub_f32_e32 %0, %1, %2":"=v"(r):"v"(a),"v"(b));return r;}
typedef float f32x2_t __attribute__((ext_vector_type(2))); typedef __bf16 bf16x2_t __attribute__((ext_vector_type(2)));
__device__ __forceinline__ unsigned cvtpk_s(float lo,float hi){f32x2_t v={lo,hi};bf16x2_t b=__builtin_convertvector(v,bf16x2_t);return __builtin_bit_cast(unsigned,b);}
#define WAIT_BAR(N) asm volatile("s_waitcnt vmcnt(" #N ") lgkmcnt(0)\n\ts_barrier":::"memory")

__device__ __forceinline__ void qkt(f32x16&p0,f32x16&p1,const char*Kslot,const bf16x8*qr,const f32x16&negm,int r32,int hi){
  const char*kb=Kslot+hi*1024+r32*16;
  #pragma unroll
  for(int d0=0;d0<4;++d0){
    const bf16x8 b0=*reinterpret_cast<const bf16x8*>(kb+d0*2048);
    const bf16x8 b1=*reinterpret_cast<const bf16x8*>(kb+d0*2048+512);
    if(d0==0){p0=__builtin_amdgcn_mfma_f32_32x32x16_bf16(b0,qr[0],negm,0,0,0);p1=__builtin_amdgcn_mfma_f32_32x32x16_bf16(b1,qr[0],negm,0,0,0);}
    else{p0=__builtin_amdgcn_mfma_f32_32x32x16_bf16(b0,qr[d0],p0,0,0,0);p1=__builtin_amdgcn_mfma_f32_32x32x16_bf16(b1,qr[d0],p1,0,0,0);}}
}
typedef __attribute__((address_space(3))) const char* lds_cptr;
typedef short v4i16_t __attribute__((ext_vector_type(4)));
__device__ __forceinline__ void kload8(bf16x8*kf,lds_cptr kp){
  kf[0]=*(const __attribute__((address_space(3))) bf16x8*)(kp);      kf[1]=*(const __attribute__((address_space(3))) bf16x8*)(kp+512);
  kf[2]=*(const __attribute__((address_space(3))) bf16x8*)(kp+2048); kf[3]=*(const __attribute__((address_space(3))) bf16x8*)(kp+2560);
  kf[4]=*(const __attribute__((address_space(3))) bf16x8*)(kp+4096); kf[5]=*(const __attribute__((address_space(3))) bf16x8*)(kp+4608);
  kf[6]=*(const __attribute__((address_space(3))) bf16x8*)(kp+6144); kf[7]=*(const __attribute__((address_space(3))) bf16x8*)(kp+6656);
}
__device__ __forceinline__ void kload2(bf16x8*kf,lds_cptr kp,int j){ kf[2*j]=*(const __attribute__((address_space(3))) bf16x8*)(kp+j*2048); kf[2*j+1]=*(const __attribute__((address_space(3))) bf16x8*)(kp+j*2048+512); }
__device__ __forceinline__ s16x4 vtr(lds_cptr p){ return __builtin_bit_cast(s16x4,__builtin_amdgcn_ds_read_tr16_b64_v4i16((__attribute__((address_space(3))) v4i16_t*)p)); }
__device__ __forceinline__ float rowmax(const f32x16&p0,const f32x16&p1){
  float a=max3f(p0[0],p0[1],p1[0]),b=max3f(p0[2],p0[3],p1[1]);a=max3f(a,p1[2],p1[3]);
  #pragma unroll
  for(int r=4;r<16;r+=4){a=max3f(a,p0[r],p0[r+1]);b=max3f(b,p0[r+2],p0[r+3]);a=max3f(a,p1[r],p1[r+1]);b=max3f(b,p1[r+2],p1[r+3]);}
  const float m=max2f(a,b);
  auto rr=__builtin_amdgcn_permlane32_swap(__float_as_uint(m),__float_as_uint(m),false,false);
  return max2f(__uint_as_float(rr[0]),__uint_as_float(rr[1]));
}
__device__ __forceinline__ void pv(f32x16*o,int vb,bf16x8 pa0,bf16x8 pa1,bf16x8 pa2,bf16x8 pa3){
  #pragma unroll
  for(int d0=0;d0<2;++d0){s16x4 lo[4],hi[4];
    #pragma unroll
    for(int ks=0;ks<4;++ks){
      asm volatile("ds_read_b64_tr_b16 %0,%1 offset:%c2":"=&v"(lo[ks]):"v"(vb),"i"(d0*4096+ks*1024):"memory");
      asm volatile("ds_read_b64_tr_b16 %0,%1 offset:%c2":"=&v"(hi[ks]):"v"(vb),"i"(d0*4096+ks*1024+512):"memory");}
    asm volatile("s_waitcnt lgkmcnt(0)":::"memory");SBAR();
    #define PK(k) (bf16x8){lo[k][0],lo[k][1],lo[k][2],lo[k][3],hi[k][0],hi[k][1],hi[k][2],hi[k][3]}
    o[d0]=__builtin_amdgcn_mfma_f32_32x32x16_bf16(pa0,PK(0),o[d0],0,0,0);
    o[d0]=__builtin_amdgcn_mfma_f32_32x32x16_bf16(pa1,PK(1),o[d0],0,0,0);
    o[d0]=__builtin_amdgcn_mfma_f32_32x32x16_bf16(pa2,PK(2),o[d0],0,0,0);
    o[d0]=__builtin_amdgcn_mfma_f32_32x32x16_bf16(pa3,PK(3),o[d0],0,0,0);
    #undef PK
  }
}

#ifndef ATTN_STORE16
#define ATTN_STORE16(p,v) (*(u32x4*)(p)=(v))
#endif
template<int THRL> __device__ __forceinline__ void attn_unit(const bf16*Qu,int qp,const bf16*__restrict__ Kh,const bf16*__restrict__ Vh,int kvp,bf16*Ou,int op,int NT,char*shm){
  int tid_o=threadIdx.x; asm volatile("":"+v"(tid_o)); const int tid=tid_o,lane=tid&63,r32=lane&31,hi=lane>>5; const int wid=__builtin_amdgcn_readfirstlane(tid>>6);
  const bf16*Qw=Qu+(long)(wid*QBLK)*qp;
  const unsigned lds0=(unsigned)(uintptr_t)shm;
  float*wsf=(float*)(shm+LDS_WS)+wid*64;
  const bf16*ksrc=Kh+(long)lane*kvp+wid*8;
  const bf16*vsrc=Vh+(long)(16*(wid&3)+(lane>>2))*kvp+(wid>>2)*32+(lane&3)*8;
  const unsigned kdst=lds0+LDS_K+wid*1024, vdst=lds0+LDS_V+wid*1024;
  #define DMA_K(t,slot) glds16(ksrc+(long)(t)*KVBLK*kvp,(unsigned)__builtin_amdgcn_readfirstlane(kdst+(slot)))
  #define DMA_V(t,slot) glds16(vsrc+(long)(t)*KVBLK*kvp,(unsigned)__builtin_amdgcn_readfirstlane(vdst+(slot)))
  const int vb0=(int)(lds0+LDS_V)+((lane>>4)&1)*32+(lane&3)*8+(4*hi+((lane&15)>>2))*64;
  const char*Kbase=shm+LDS_K; bf16x8 kf[8];
  const lds_cptr shm3=(lds_cptr)shm; const lds_cptr kp0=shm3+LDS_K+hi*1024+r32*16; const lds_cptr vp0=shm3+LDS_V+((lane>>4)&1)*32+(lane&3)*8+(4*hi+((lane&15)>>2))*64;
  DMA_K(0,0);DMA_V(0,0);DMA_K(1,SLOTB);
  bf16x8 qr[4];
  #pragma unroll
  for(int d0=0;d0<4;++d0)qr[d0]=*reinterpret_cast<const bf16x8*>(&Qw[(long)r32*qp+d0*16+hi*8]);
  float mhat=0.f,l_reg=0.f;f32x16 o[2];o[0]=f32x16{};o[1]=f32x16{};f32x16 negm=f32x16{};asm volatile("":"+v"(negm));
  #define CMASK(P0,P1,t) do{}while(0)
  bool resc=false;
  #define START(P0,P1) do{ const float rm=rowmax(P0,P1); resc=false; \
    { const float dl=rm; mhat=fadd_s(mhat,dl); \
      _Pragma("unroll") for(int r=0;r<16;++r){P0[r]=fsub_s(P0[r],dl);P1[r]=fsub_s(P1[r],dl);} \
      _Pragma("unroll") for(int r=0;r<16;++r)negm[r]=-mhat; asm volatile("":"+v"(negm)); } \
    _Pragma("unroll") for(int r=0;r<16;++r)P0[r]=__builtin_amdgcn_exp2f(P0[r]); }while(0)
  #define RESC() do{ if(resc){ asm volatile("s_waitcnt lgkmcnt(0)":::"memory"); \
      _Pragma("unroll") for(int d_=0;d_<2;++d_) _Pragma("unroll") for(int r=0;r<16;++r)o[d_][r]*=wsf[crow(r,hi)]; } }while(0)
  f32x16 pA0,pA1,pB0,pB1;
  int sl_prev=0,sl_cur=0,sl_next=SLOTB;
  #define ROT() do{sl_prev=sl_cur;sl_cur=sl_next;sl_next=(sl_next==(NSLOT-1)*SLOTB)?0:sl_next+SLOTB;}while(0)
  DMA_K(2,2*SLOTB);
  WAIT_BAR(3);
  qkt(pA0,pA1,Kbase,qr,negm,r32,hi);asm volatile("s_nop 15\n\ts_nop 7":"+v"(pA0),"+v"(pA1));CMASK(pA0,pA1,0);
  START(pA0,pA1);
  _Pragma("unroll") for(int r=0;r<16;++r)pA1[r]=__builtin_amdgcn_exp2f(pA1[r]);
  WAIT_BAR(0);
  DMA_K(3,0);DMA_V(1,SLOTB);
  ROT();
  kload8(kf,kp0+sl_cur);
  WAIT_BAR(2);
  s16x4 vlo[8],vhi[8]; u32x4 pw0,pw1,pw2,pw3;
  #define PKW(P,B) cvtpk_s(P[B],P[B+1])
  #define PAF(k) __builtin_bit_cast(bf16x8,pw##k)
  #define VFR(i) (bf16x8){vlo[i][0],vlo[i][1],vlo[i][2],vlo[i][3],vhi[i][0],vhi[i][1],vhi[i][2],vhi[i][3]}
  #define PIN(x) asm volatile("":"+v"(x))
  #define MX3(a,b,c) __builtin_fmaxf(__builtin_fmaxf((a),(b)),(c))
  #define GAPA(MF,A0,A1,A2,A3,W0,W1,PW) do{ MF; sacc+=A0; sacc+=A1; sacc+=A2; sacc+=A3; PIN(sacc); W0; W1; PIN(PW); SBAR(); }while(0)
  #define EX(v) __builtin_amdgcn_exp2f(v)
  #define GAPB(MF,X,B) do{ MF; X[B]=EX(X[B]); X[B+1]=EX(X[B+1]); X[B+2]=EX(X[B+2]); X[B+3]=EX(X[B+3]); PIN(X); SBAR(); }while(0)
  #define VRD(i) do{ vlo[i]=vtr(vp_+(((i)>>2)*4096+((i)&3)*1024)); vhi[i]=vtr(vp_+(((i)>>2)*4096+((i)&3)*1024+512)); }while(0)
  #define KRD(G,j) do{ if(G){ kload2(kf,kp0+sl_next,j); SBAR(); } }while(0)
  #define STEP(C0,C1,P0,P1,t,GK,GV,GL) do{ SBAR(); \
    const lds_cptr vp_=vp0+sl_prev; \
    VRD(0); SBAR(); float sacc=(P0[0]+P0[1]); \
    GAPA(C0=__builtin_amdgcn_mfma_f32_32x32x16_bf16(kf[0],qr[0],negm,0,0,0), P0[2],P0[3],P0[4],P0[5],     pw0[0]=PKW(P0,0), pw0[1]=PKW(P0,2), pw0); \
    VRD(4); SBAR(); GAPA(C1=__builtin_amdgcn_mfma_f32_32x32x16_bf16(kf[1],qr[0],negm,0,0,0), P0[6],P0[7],P0[8],P0[9],     pw0[2]=PKW(P0,4), pw0[3]=PKW(P0,6), pw0); \
    VRD(1); SBAR(); GAPA(C0=__builtin_amdgcn_mfma_f32_32x32x16_bf16(kf[2],qr[1],C0,0,0,0),   P0[10],P0[11],P0[12],P0[13], pw1[0]=PKW(P0,8), pw1[1]=PKW(P0,10), pw1); \
    VRD(5); SBAR(); GAPA(C1=__builtin_amdgcn_mfma_f32_32x32x16_bf16(kf[3],qr[1],C1,0,0,0),   P0[14],P0[15],P1[0],P1[1],   pw1[2]=PKW(P0,12),pw1[3]=PKW(P0,14), pw1); \
    VRD(2); SBAR(); GAPA(C0=__builtin_amdgcn_mfma_f32_32x32x16_bf16(kf[4],qr[2],C0,0,0,0),   P1[2],P1[3],P1[4],P1[5],     pw2[0]=PKW(P1,0), pw2[1]=PKW(P1,2), pw2); \
    VRD(6); SBAR(); GAPA(C1=__builtin_amdgcn_mfma_f32_32x32x16_bf16(kf[5],qr[2],C1,0,0,0),   P1[6],P1[7],P1[8],P1[9],     pw2[2]=PKW(P1,4), pw2[3]=PKW(P1,6), pw2); \
    VRD(3); SBAR(); GAPA(C0=__builtin_amdgcn_mfma_f32_32x32x16_bf16(kf[6],qr[3],C0,0,0,0),   P1[10],P1[11],P1[12],P1[13], pw3[0]=PKW(P1,8), pw3[1]=PKW(P1,10), pw3); \
    VRD(7); SBAR(); GAPA(C1=__builtin_amdgcn_mfma_f32_32x32x16_bf16(kf[7],qr[3],C1,0,0,0),   P1[14],P1[15],0.f,0.f,       pw3[2]=PKW(P1,12),pw3[3]=PKW(P1,14), pw3); \
    l_reg+=sacc; \
    if(GK){DMA_K((t)+3,sl_cur);} if(GV){DMA_V((t)+1,sl_next);} \
    CMASK(C0,C1,t); \
    { float a=MX3(C0[0],C0[1],C1[0]),b=MX3(C0[2],C0[3],C1[1]); a=MX3(a,C1[2],C1[3]); \
      _Pragma("unroll") for(int r=4;r<16;r+=4){a=MX3(a,C0[r],C0[r+1]);b=MX3(b,C0[r+2],C0[r+3]);a=MX3(a,C1[r],C1[r+1]);b=MX3(b,C1[r+2],C1[r+3]);} \
      float rm=__builtin_fmaxf(a,b); { auto rr=__builtin_amdgcn_permlane32_swap(__float_as_uint(rm),__float_as_uint(rm),false,false); rm=__builtin_fmaxf(__uint_as_float(rr[0]),__uint_as_float(rr[1])); } \
      resc=false; \
      if(__builtin_expect(__any(rm>(float)THRL),0)){ const float dl=__builtin_fmaxf(rm,0.f); mhat+=dl; \
        _Pragma("unroll") for(int r=0;r<16;++r){C0[r]-=dl;C1[r]-=dl;} \
        _Pragma("unroll") for(int r=0;r<16;++r)negm[r]=-mhat; asm volatile("":"+v"(negm)); \
        const float f=__builtin_amdgcn_exp2f(-dl); l_reg*=f; if(hi==0)wsf[r32]=f; resc=true; } } \
    SBAR(); \
    GAPB(o[0]=__builtin_amdgcn_mfma_f32_32x32x16_bf16(PAF(0),VFR(0),o[0],0,0,0), C0,0); \
    GAPB(o[1]=__builtin_amdgcn_mfma_f32_32x32x16_bf16(PAF(0),VFR(4),o[1],0,0,0), C0,4); \
    KRD(GL,0); GAPB(o[0]=__builtin_amdgcn_mfma_f32_32x32x16_bf16(PAF(1),VFR(1),o[0],0,0,0), C0,8); \
    KRD(GL,1); GAPB(o[1]=__builtin_amdgcn_mfma_f32_32x32x16_bf16(PAF(1),VFR(5),o[1],0,0,0), C0,12); \
    KRD(GL,2); GAPB(o[0]=__builtin_amdgcn_mfma_f32_32x32x16_bf16(PAF(2),VFR(2),o[0],0,0,0), C1,0); \
    KRD(GL,3); GAPB(o[1]=__builtin_amdgcn_mfma_f32_32x32x16_bf16(PAF(2),VFR(6),o[1],0,0,0), C1,4); \
    GAPB(o[0]=__builtin_amdgcn_mfma_f32_32x32x16_bf16(PAF(3),VFR(3),o[0],0,0,0), C1,8); \
    GAPB(o[1]=__builtin_amdgcn_mfma_f32_32x32x16_bf16(PAF(3),VFR(7),o[1],0,0,0), C1,12); \
    }while(0)
  int t=1;
  #undef CMASK
  #define CMASK(P0,P1,t) do{}while(0)
  for(;t+5<NT;t+=2){
    STEP(pB0,pB1,pA0,pA1,t,true,true,true);     WAIT_BAR(2); RESC(); ROT();
    STEP(pA0,pA1,pB0,pB1,t+1,true,true,true);   WAIT_BAR(2); RESC(); ROT();
  }
  #undef CMASK
  #define CMASK(P0,P1,t) do{}while(0)
  #define ENDW(tt) do{ if((tt)+3<NT){WAIT_BAR(2);} else if((tt)+2<NT){WAIT_BAR(1);} else {WAIT_BAR(0);} }while(0)
  for(;t+1<NT;t+=2){
    STEP(pB0,pB1,pA0,pA1,t,(t+3<NT),(t+1<NT),(t+1<NT));       ENDW(t);   RESC(); ROT();
    STEP(pA0,pA1,pB0,pB1,t+1,(t+4<NT),(t+2<NT),(t+2<NT));     ENDW(t+1); RESC(); ROT();
  }
  STEP(pB0,pB1,pA0,pA1,NT-1,false,false,false); RESC();
  { float sacc=pB0[0]+pB0[1]; _Pragma("unroll") for(int r=2;r<16;++r)sacc+=pB0[r]; _Pragma("unroll") for(int r=0;r<16;++r)sacc+=pB1[r]; l_reg+=sacc;
    pw0=(u32x4){PKW(pB0,0),PKW(pB0,2),PKW(pB0,4),PKW(pB0,6)};pw1=(u32x4){PKW(pB0,8),PKW(pB0,10),PKW(pB0,12),PKW(pB0,14)};pw2=(u32x4){PKW(pB1,0),PKW(pB1,2),PKW(pB1,4),PKW(pB1,6)};pw3=(u32x4){PKW(pB1,8),PKW(pB1,10),PKW(pB1,12),PKW(pB1,14)};
    SBAR(); pv(o,vb0+sl_cur,PAF(0),PAF(1),PAF(2),PAF(3)); }
  #undef PKW
  #undef PAF
  #undef VFR
  #undef PIN
  #undef MX3
  #undef GAPA
  #undef GAPB
  #undef EX
  #undef VRD
  #undef KRD
  #undef STEP
  #undef ENDW
  {auto rr=__builtin_amdgcn_permlane32_swap(__float_as_uint(l_reg),__float_as_uint(l_reg),false,false);l_reg=__uint_as_float(rr[0])+__uint_as_float(rr[1]);}
  if(hi==0)wsf[32+r32]=l_reg;asm volatile("s_waitcnt lgkmcnt(0)":::"memory");
  float rli[16];
  #pragma unroll
  for(int r=0;r<16;++r)rli[r]=__builtin_amdgcn_rcpf(wsf[32+crow(r,hi)]);
  bf16*Ow=Ou+(long)(wid*QBLK)*op;
  { bf16*stg=(bf16*)(shm+LDS_OST)+wid*2048;
    #pragma unroll
    for(int r=0;r<16;++r){const int orow=crow(r,hi);
      #pragma unroll
      for(int d0=0;d0<2;++d0)stg[orow*64+d0*32+r32]=__float2bfloat16(o[d0][r]*rli[r]);}
    asm volatile("s_waitcnt lgkmcnt(0)":::"memory");
    #pragma unroll
    for(int i=0;i<4;++i){const int row=i*8+(lane>>3),ch=lane&7; const u32x4 v=*(const u32x4*)(stg+row*64+ch*8); ATTN_STORE16(Ow+(long)row*op+ch*8,v);} }
  asm volatile("s_waitcnt lgkmcnt(0)\n\ts_barrier":::"memory");
  #undef DMA_K
  #undef DMA_V
  #undef CMASK
  #undef START
  #undef RESC
  #undef ROT
}
constexpr int ATTN_LDS_BYTES=LDS_BYTES;
constexpr int C2_KSL=8192, C2_VSL=16384, C2_LK=0, C2_LV=3*C2_KSL, C2_LWS=C2_LV+2*C2_VSL, C2_END=C2_LWS+NW*64*4, C2_STASH=65536;
static_assert(C2_END<=C2_STASH,"c2 lds");
template<int MODE,int THRL> __device__ __forceinline__ void attn_unit_v128(const bf16*Qu,int qp,const bf16*__restrict__ Kh,const bf16*__restrict__ Vh,int kvp,bf16*Ou,int op,int NT,char*shm,float lam,float oscale,const float*__restrict__ sg){
  int tid_o=threadIdx.x; asm volatile("":"+v"(tid_o)); const int tid=tid_o,lane=tid&63,r32=lane&31,hi=lane>>5; const int wid=__builtin_amdgcn_readfirstlane(tid>>6);
  const bf16*Qw=Qu+(long)(wid*QBLK)*qp;
  const unsigned lds0=(unsigned)(uintptr_t)shm;
  float*wsf=(float*)(shm+C2_LWS)+wid*64;
  const bf16*ksrc=Kh+(long)lane*kvp+wid*8;
  const bf16*vsrc=Vh+(long)(16*(wid&3)+(lane>>2))*kvp+(wid>>2)*32+(lane&3)*8;
  const unsigned kdst=lds0+C2_LK+wid*1024, vdst=lds0+C2_LV+wid*1024;
  #define XK(t,slot) glds16(ksrc+(long)(t)*KVBLK*kvp,(unsigned)__builtin_amdgcn_readfirstlane(kdst+(slot)))
  #define XV(t,slot) do{ glds16(vsrc+(long)(t)*KVBLK*kvp,(unsigned)__builtin_amdgcn_readfirstlane(vdst+(slot))); glds16(vsrc+64+(long)(t)*KVBLK*kvp,(unsigned)__builtin_amdgcn_readfirstlane(vdst+8192+(slot))); }while(0)
  const char*Kbase=shm+C2_LK; bf16x8 kf[8];
  const lds_cptr shm3=(lds_cptr)shm; const lds_cptr kp0=shm3+C2_LK+hi*1024+r32*16; const lds_cptr vp0=shm3+C2_LV+((lane>>4)&1)*32+(lane&3)*8+(4*hi+((lane&15)>>2))*64;
  const int vb0=(int)(lds0+C2_LV)+((lane>>4)&1)*32+(lane&3)*8+(4*hi+((lane&15)>>2))*64;
  XK(0,0);XV(0,0);XK(1,C2_KSL);
  bf16x8 qr[4];
  #pragma unroll
  for(int d0=0;d0<4;++d0)qr[d0]=*reinterpret_cast<const bf16x8*>(&Qw[(long)r32*qp+d0*16+hi*8]);
  float mhat=0.f,l_reg=0.f;f32x16 o[4];o[0]=f32x16{};o[1]=f32x16{};o[2]=f32x16{};o[3]=f32x16{};f32x16 negm=f32x16{};asm volatile("":"+v"(negm));
  bool resc=false;
  #define XRESC() do{ if(resc){ asm volatile("s_waitcnt lgkmcnt(0)":::"memory"); \
      _Pragma("unroll") for(int d_=0;d_<4;++d_) _Pragma("unroll") for(int r=0;r<16;++r)o[d_][r]*=wsf[crow(r,hi)]; } }while(0)
  f32x16 C0,C1; s16x4 vlo[8],vhi[8]; u32x4 pw0,pw1,pw2,pw3;
  int k_t=C2_KSL,k_t1=2*C2_KSL;
  int v_tm1=0,v_t=C2_VSL;
  #define XROT() do{ k_t=k_t1; k_t1=(k_t1==2*C2_KSL)?0:k_t1+C2_KSL; const int s_=v_tm1; v_tm1=v_t; v_t=s_; }while(0)
  XK(2,2*C2_KSL);
  WAIT_BAR(3);
  qkt(C0,C1,Kbase,qr,negm,r32,hi);asm volatile("s_nop 15\n\ts_nop 7":"+v"(C0),"+v"(C1));
  { const float rm=rowmax(C0,C1); mhat=fadd_s(mhat,rm);
    _Pragma("unroll") for(int r=0;r<16;++r){C0[r]=fsub_s(C0[r],rm);C1[r]=fsub_s(C1[r],rm);}
    _Pragma("unroll") for(int r=0;r<16;++r)negm[r]=-mhat; asm volatile("":"+v"(negm));
    _Pragma("unroll") for(int r=0;r<16;++r){C0[r]=__builtin_amdgcn_exp2f(C0[r]);C1[r]=__builtin_amdgcn_exp2f(C1[r]);}
    float sacc=0.f; _Pragma("unroll") for(int r=0;r<16;++r)sacc+=C0[r]; _Pragma("unroll") for(int r=0;r<16;++r)sacc+=C1[r]; l_reg=sacc;
    pw0=(u32x4){cvtpk_s(C0[0],C0[1]),cvtpk_s(C0[2],C0[3]),cvtpk_s(C0[4],C0[5]),cvtpk_s(C0[6],C0[7])}; pw1=(u32x4){cvtpk_s(C0[8],C0[9]),cvtpk_s(C0[10],C0[11]),cvtpk_s(C0[12],C0[13]),cvtpk_s(C0[14],C0[15])};
    pw2=(u32x4){cvtpk_s(C1[0],C1[1]),cvtpk_s(C1[2],C1[3]),cvtpk_s(C1[4],C1[5]),cvtpk_s(C1[6],C1[7])}; pw3=(u32x4){cvtpk_s(C1[8],C1[9]),cvtpk_s(C1[10],C1[11]),cvtpk_s(C1[12],C1[13]),cvtpk_s(C1[14],C1[15])};
    asm volatile("":"+v"(pw0),"+v"(pw1),"+v"(pw2),"+v"(pw3)); }
  WAIT_BAR(0);
  if(3<NT){XK(3,0);} XV(1,C2_VSL);
  kload8(kf,kp0+k_t);
  if(3<NT){WAIT_BAR(3);}else{WAIT_BAR(2);}
  #define PAF(k) __builtin_bit_cast(bf16x8,pw##k)
  #define VFR(i) (bf16x8){vlo[i][0],vlo[i][1],vlo[i][2],vlo[i][3],vhi[i][0],vhi[i][1],vhi[i][2],vhi[i][3]}
  #define PIN(x) asm volatile("":"+v"(x))
  #define MX3(a,b,c) __builtin_fmaxf(__builtin_fmaxf((a),(b)),(c))
  #define EX(v) __builtin_amdgcn_exp2f(v)
  #define VRD(s,f) do{ vlo[s]=vtr(vp_+((((f)&3))*4096+((f)>>2)*1024)); vhi[s]=vtr(vp_+((((f)&3))*4096+((f)>>2)*1024+512)); }while(0)
  #define KRD(G,j) do{ if(G){ kload2(kf,kp0+k_t1,j); SBAR(); } }while(0)
  #define QKG(MF,i) do{ VRD(i,i); SBAR(); MF; SBAR(); }while(0)
  #define PVG(f,RD,X0,X1,A0,A1,PK) do{ o[(f)&3]=__builtin_amdgcn_mfma_f32_32x32x16_bf16(PAFK(f),VFR((f)&7),o[(f)&3],0,0,0); RD; X0=EX(X0); X1=EX(X1); sacc+=A0; sacc+=A1; PIN(sacc); PK; PIN(C0); PIN(C1); SBAR(); }while(0)
  #define PAFK(f) (((f)>>2)==0?PAF(0):((f)>>2)==1?PAF(1):((f)>>2)==2?PAF(2):PAF(3))
  #define PKW(P,B) cvtpk_s(P[B],P[B+1])
  #define XSTEP(t,GK,GV,GL) do{ SBAR(); \
    if(GV){XV((t),v_t);} \
    const lds_cptr vp_=vp0+v_tm1; \
    QKG(C0=__builtin_amdgcn_mfma_f32_32x32x16_bf16(kf[0],qr[0],negm,0,0,0),0); \
    QKG(C1=__builtin_amdgcn_mfma_f32_32x32x16_bf16(kf[1],qr[0],negm,0,0,0),1); \
    QKG(C0=__builtin_amdgcn_mfma_f32_32x32x16_bf16(kf[2],qr[1],C0,0,0,0),2); \
    QKG(C1=__builtin_amdgcn_mfma_f32_32x32x16_bf16(kf[3],qr[1],C1,0,0,0),3); \
    QKG(C0=__builtin_amdgcn_mfma_f32_32x32x16_bf16(kf[4],qr[2],C0,0,0,0),4); \
    QKG(C1=__builtin_amdgcn_mfma_f32_32x32x16_bf16(kf[5],qr[2],C1,0,0,0),5); \
    QKG(C0=__builtin_amdgcn_mfma_f32_32x32x16_bf16(kf[6],qr[3],C0,0,0,0),6); \
    QKG(C1=__builtin_amdgcn_mfma_f32_32x32x16_bf16(kf[7],qr[3],C1,0,0,0),7); \
    if(GK){XK((t)+3,k_t);} \
    { float a=MX3(C0[0],C0[1],C1[0]),b=MX3(C0[2],C0[3],C1[1]); a=MX3(a,C1[2],C1[3]); \
      _Pragma("unroll") for(int r=4;r<16;r+=4){a=MX3(a,C0[r],C0[r+1]);b=MX3(b,C0[r+2],C0[r+3]);a=MX3(a,C1[r],C1[r+1]);b=MX3(b,C1[r+2],C1[r+3]);} \
      float rm=__builtin_fmaxf(a,b); { auto rr=__builtin_amdgcn_permlane32_swap(__float_as_uint(rm),__float_as_uint(rm),false,false); rm=__builtin_fmaxf(__uint_as_float(rr[0]),__uint_as_float(rr[1])); } \
      resc=false; \
      if(__builtin_expect(__any(rm>(float)THRL),0)){ const float dl=__builtin_fmaxf(rm,0.f); mhat+=dl; \
        _Pragma("unroll") for(int r=0;r<16;++r){C0[r]-=dl;C1[r]-=dl;} \
        _Pragma("unroll") for(int r=0;r<16;++r)negm[r]=-mhat; asm volatile("":"+v"(negm)); \
        const float f=__builtin_amdgcn_exp2f(-dl); l_reg*=f; if(hi==0)wsf[r32]=f; resc=true; } } \
    SBAR(); \
    float sacc=0.f; \
    PVG(0, VRD(0,8),  C0[0],C0[1],  0.f,0.f,      ;); \
    PVG(1, VRD(1,9),  C0[2],C0[3],  C0[0],C0[1],  ;); \
    PVG(2, VRD(2,10), C0[4],C0[5],  C0[2],C0[3],  ;); \
    KRD(GL,0); PVG(3, VRD(3,11), C0[6],C0[7],  C0[4],C0[5],  ;); \
    KRD(GL,1); PVG(4, VRD(4,12), C0[8],C0[9],  C0[6],C0[7],  pw0[0]=PKW(C0,0);pw0[1]=PKW(C0,2);PIN(pw0)); \
    KRD(GL,2); PVG(5, VRD(5,13), C0[10],C0[11],C0[8],C0[9],  pw0[2]=PKW(C0,4);pw0[3]=PKW(C0,6);PIN(pw0)); \
    KRD(GL,3); PVG(6, VRD(6,14), C0[12],C0[13],C0[10],C0[11],;); \
    PVG(7, VRD(7,15), C0[14],C0[15],C0[12],C0[13],;); \
    PVG(8, ;,         C1[0],C1[1],  C0[14],C0[15],pw1[0]=PKW(C0,8);pw1[1]=PKW(C0,10);PIN(pw1)); \
    PVG(9, ;,         C1[2],C1[3],  C1[0],C1[1],  pw1[2]=PKW(C0,12);pw1[3]=PKW(C0,14);PIN(pw1)); \
    PVG(10,;,         C1[4],C1[5],  C1[2],C1[3],  ;); \
    PVG(11,;,         C1[6],C1[7],  C1[4],C1[5],  ;); \
    PVG(12,;,         C1[8],C1[9],  C1[6],C1[7],  pw2[0]=PKW(C1,0);pw2[1]=PKW(C1,2);PIN(pw2)); \
    PVG(13,;,         C1[10],C1[11],C1[8],C1[9],  pw2[2]=PKW(C1,4);pw2[3]=PKW(C1,6);PIN(pw2)); \
    PVG(14,;,         C1[12],C1[13],C1[10],C1[11],;); \
    PVG(15,;,         C1[14],C1[15],C1[12],C1[13],;); \
    sacc+=C1[14]; sacc+=C1[15]; l_reg+=sacc; \
    pw3[0]=PKW(C1,8);pw3[1]=PKW(C1,10);pw3[2]=PKW(C1,12);pw3[3]=PKW(C1,14);PIN(pw3); SBAR(); \
    }while(0)
  int t=1;
  XSTEP(1,(4<NT),false,(2<NT)); if(4<NT){WAIT_BAR(1);}else{WAIT_BAR(0);} XRESC(); XROT(); t=2;
  for(;t+3<NT;++t){ XSTEP(t,true,true,true); WAIT_BAR(1); XRESC(); XROT(); }
  for(;t+1<NT;++t){ XSTEP(t,false,true,true); WAIT_BAR(0); XRESC(); XROT(); }
  XSTEP(NT-1,false,true,false); WAIT_BAR(0); XRESC();
  { const int vb=vb0+v_t;
    #pragma unroll
    for(int d0=0;d0<4;++d0){s16x4 lo[4],hh[4];
      #pragma unroll
      for(int ks=0;ks<4;++ks){
        asm volatile("ds_read_b64_tr_b16 %0,%1 offset:%c2":"=&v"(lo[ks]):"v"(vb),"i"(d0*4096+ks*1024):"memory");
        asm volatile("ds_read_b64_tr_b16 %0,%1 offset:%c2":"=&v"(hh[ks]):"v"(vb),"i"(d0*4096+ks*1024+512):"memory");}
      asm volatile("s_waitcnt lgkmcnt(0)":::"memory");SBAR();
      #define PKD(k) (bf16x8){lo[k][0],lo[k][1],lo[k][2],lo[k][3],hh[k][0],hh[k][1],hh[k][2],hh[k][3]}
      o[d0]=__builtin_amdgcn_mfma_f32_32x32x16_bf16(PAF(0),PKD(0),o[d0],0,0,0);
      o[d0]=__builtin_amdgcn_mfma_f32_32x32x16_bf16(PAF(1),PKD(1),o[d0],0,0,0);
      o[d0]=__builtin_amdgcn_mfma_f32_32x32x16_bf16(PAF(2),PKD(2),o[d0],0,0,0);
      o[d0]=__builtin_amdgcn_mfma_f32_32x32x16_bf16(PAF(3),PKD(3),o[d0],0,0,0);
      #undef PKD
    } }
  #undef PKW
  #undef PAFK
  #undef PVG
  #undef QKG
  #undef KRD
  #undef VRD
  #undef EX
  #undef MX3
  #undef PIN
  #undef VFR
  #undef PAF
  #undef XSTEP
  {auto rr=__builtin_amdgcn_permlane32_swap(__float_as_uint(l_reg),__float_as_uint(l_reg),false,false);l_reg=__uint_as_float(rr[0])+__uint_as_float(rr[1]);}
  if(hi==0)wsf[32+r32]=l_reg;asm volatile("s_waitcnt lgkmcnt(0)":::"memory");
  float rli[16];
  #pragma unroll
  for(int r=0;r<16;++r)rli[r]=__builtin_amdgcn_rcpf(wsf[32+crow(r,hi)]);
  unsigned*stash=(unsigned*)(shm+C2_STASH)+wid*2048;
  if constexpr(MODE==0){
    #pragma unroll
    for(int d0=0;d0<4;++d0)
      #pragma unroll
      for(int r=0;r<16;r+=2)stash[(d0*8+(r>>1))*64+lane]=cvtpk_s(o[d0][r]*rli[r],o[d0][r+1]*rli[r+1]);
  }else{
    float ss[16];
    #pragma unroll
    for(int r=0;r<16;++r)ss[r]=0.f;
    #pragma unroll
    for(int d0=0;d0<4;++d0)
      #pragma unroll
      for(int r=0;r<16;r+=2){const unsigned w=stash[(d0*8+(r>>1))*64+lane];
        const float da=__uint_as_float(w<<16)-lam*(o[d0][r]*rli[r]),db=__uint_as_float(w&0xffff0000u)-lam*(o[d0][r+1]*rli[r+1]);
        o[d0][r]=da;o[d0][r+1]=db;ss[r]+=da*da;ss[r+1]+=db*db;}
    #pragma unroll
    for(int r=0;r<16;++r){float v=::xsum_x16(::xsum_row16(ss[r]));
      ss[r]=oscale*::rsq_(v*(1.f/128.f)+1e-6f);}
    bf16*stg=(bf16*)stash;
    #pragma unroll
    for(int d0=0;d0<4;++d0){const float g=sg[d0*32+r32];
      #pragma unroll
      for(int r=0;r<16;++r)stg[crow(r,hi)*128+d0*32+r32]=__float2bfloat16(o[d0][r]*ss[r]*g);}
    asm volatile("s_waitcnt lgkmcnt(0)":::"memory");
    bf16*Ow=Ou+(long)(wid*QBLK)*op;
    #pragma unroll
    for(int i=0;i<8;++i){const int row=i*4+(lane>>4),ch=lane&15;const u32x4 v=*(const u32x4*)(stg+row*128+ch*8);*(u32x4*)(Ow+(long)row*op+ch*8)=v;}
  }
  asm volatile("s_waitcnt lgkmcnt(0)\n\ts_barrier":::"memory");
  #undef XK
  #undef XV
  #undef XRESC
  #undef XROT
}
#undef SBAR
#undef WAIT_BAR
}

namespace attn_c {
using bf16 = __hip_bfloat16;
constexpr int D = 128, DQK = 64, NW = 8, QBLK = 32, KVBLK = 64, SDEPTH = 2;
constexpr size_t SHM_V = KVBLK * D * 2, SHM_K = KVBLK * DQK * 2, SHM_ATTN = 2 * SHM_V + 2 * SHM_K + NW * 64 * 4;
constexpr float THR_L2 = 8.f * 1.4426950408889634f;
using bf16x8 = __attribute__((ext_vector_type(8))) short;
using s16x4  = __attribute__((ext_vector_type(4))) short;
using f32x16 = __attribute__((ext_vector_type(16))) float;
using f32x8  = __attribute__((ext_vector_type(8))) float;
using u32x4  = __attribute__((ext_vector_type(4))) unsigned;
#define KSWZ(row, colB) ((row) * 128 + ((colB) ^ ((((row) >> 1) & 7) << 4)))
#define SBAR_C() __builtin_amdgcn_sched_barrier(0)
__device__ __forceinline__ int crow(int r, int hi) { return (r & 3) + 8 * (r >> 2) + 4 * hi; }
__device__ __forceinline__ unsigned cvtpk(float lo, float hi) {
  typedef float f2_ __attribute__((ext_vector_type(2))); typedef __bf16 b2_ __attribute__((ext_vector_type(2))); f2_ v = {lo, hi}; b2_ b = __builtin_convertvector(v, b2_); return __builtin_bit_cast(unsigned, b);
}
template <typename TIn> struct Stage;
template <> struct Stage<bf16>  { using T = bf16x8;
  __device__ static __forceinline__ T ld8(const bf16* p) { return *reinterpret_cast<const bf16x8*>(p); }
  __device__ static __forceinline__ bf16x8 tobf(T x) { return x; } };
template <> struct Stage<float> { using T = f32x8;
  __device__ static __forceinline__ T ld8(const float* p) { return *reinterpret_cast<const f32x8*>(p); }
  __device__ static __forceinline__ bf16x8 tobf(T x) {
    u32x4 w = {cvtpk(x[0], x[1]), cvtpk(x[2], x[3]), cvtpk(x[4], x[5]), cvtpk(x[6], x[7])}; return *reinterpret_cast<bf16x8*>(&w); } };

__device__ __forceinline__ void partialSM(f32x16& p0, f32x16& p1, float& m_reg, float& mn, float& alpha) {
  constexpr float C = 1.f;
  float pmax = p0[0]; for (int r = 1; r < 16; ++r) pmax = fmaxf(pmax, p0[r]); for (int r = 0; r < 16; ++r) pmax = fmaxf(pmax, p1[r]);
  { auto rr = __builtin_amdgcn_permlane32_swap(__float_as_uint(pmax), __float_as_uint(pmax), false, false);
    pmax = fmaxf(__uint_as_float(rr[0]), __uint_as_float(rr[1])); }
  if (__builtin_expect(__all(pmax - m_reg <= THR_L2), 1)) { mn = m_reg; alpha = 1.f; }
  else { mn = fmaxf(m_reg, pmax); alpha = __builtin_amdgcn_exp2f((m_reg - mn) * C); m_reg = mn; }
  float mnC = -mn * C;
  for (int r = 0; r < 16; ++r) p0[r] = fmaf(p0[r], C, mnC); for (int r = 0; r < 16; ++r) p1[r] = fmaf(p1[r], C, mnC);
  for (int r = 0; r < 16; ++r) p0[r] = __builtin_amdgcn_exp2f(p0[r]);
}
__device__ __forceinline__ void finishSM(f32x16& p0, f32x16& p1, float alpha, float& l_reg, bf16x8& pa0, bf16x8& pa1, bf16x8& pa2, bf16x8& pa3) {
  for (int r = 0; r < 16; ++r) p1[r] = __builtin_amdgcn_exp2f(p1[r]);
  float ps = 0; for (int r = 0; r < 16; ++r) ps += p0[r]; for (int r = 0; r < 16; ++r) ps += p1[r];
  { auto rr = __builtin_amdgcn_permlane32_swap(__float_as_uint(ps), __float_as_uint(ps), false, false);
    ps = __uint_as_float(rr[0]) + __uint_as_float(rr[1]); }
  l_reg = l_reg * alpha + ps;
#define PK4(P, BASE, OUT) do { unsigned a0 = cvtpk(P[BASE + 0], P[BASE + 1]), a1 = cvtpk(P[BASE + 2], P[BASE + 3]);   \
    unsigned b0 = cvtpk(P[BASE + 4], P[BASE + 5]), b1 = cvtpk(P[BASE + 6], P[BASE + 7]);                              \
    auto r0 = __builtin_amdgcn_permlane32_swap(a0, b0, false, false); auto r1 = __builtin_amdgcn_permlane32_swap(a1, b1, false, false); \
    u32x4 w = {r0[0], r1[0], r0[1], r1[1]}; OUT = *reinterpret_cast<bf16x8*>(&w); } while (0)
  PK4(p0, 0, pa0); PK4(p0, 8, pa1); PK4(p1, 0, pa2); PK4(p1, 8, pa3);
#undef PK4
}
__device__ __forceinline__ void qkt(f32x16& p0, f32x16& p1, const bf16* Ks, const bf16x8* qr, int r32, int hi) {
  p0 = f32x16{}; p1 = f32x16{};
  for (int d0 = 0; d0 < 4; ++d0) { int cb = (d0 * 16 + hi * 8) * 2;
    bf16x8 b0 = *reinterpret_cast<const bf16x8*>((const char*)Ks + KSWZ(r32, cb));
    bf16x8 b1 = *reinterpret_cast<const bf16x8*>((const char*)Ks + KSWZ(32 + r32, cb));
    p0 = __builtin_amdgcn_mfma_f32_32x32x16_bf16(b0, qr[d0], p0, 0, 0, 0);
    p1 = __builtin_amdgcn_mfma_f32_32x32x16_bf16(b1, qr[d0], p1, 0, 0, 0); }
}
__device__ __forceinline__ int v_st(int k, int c) { const int kk = (k & ~0xC) | ((k & 4) << 1) | ((k & 8) >> 1); return ((kk >> 3) * 4 + (c >> 5)) * 512 + ((kk & 7) * 32 + (c & 31)) * 2; }
__device__ __forceinline__ int v_rd_base(int lane) { return ((lane & 3) << 3) | (((lane >> 2) & 3) << 6) | (((lane >> 4) & 1) << 5) | (((lane >> 5) & 1) << 8); }
constexpr int v_rd_off(int d0, int ks, int half) { return d0 * 512 + ks * 4096 + half * 2048; }
template <int OFF> __device__ __forceinline__ s16x4 tr_read(int vb) {
  s16x4 r; asm volatile("ds_read_b64_tr_b16 %0, %1 offset:%2" : "=&v"(r) : "v"(vb), "i"(OFF) : "memory"); return r;
}
template <int D0> __device__ __forceinline__ void pv_one(f32x16& od, int vb, bf16x8 pa0, bf16x8 pa1, bf16x8 pa2, bf16x8 pa3) {
  const s16x4 l0 = tr_read<v_rd_off(D0, 0, 0)>(vb), h0 = tr_read<v_rd_off(D0, 0, 1)>(vb), l1 = tr_read<v_rd_off(D0, 1, 0)>(vb), h1 = tr_read<v_rd_off(D0, 1, 1)>(vb);
  const s16x4 l2 = tr_read<v_rd_off(D0, 2, 0)>(vb), h2 = tr_read<v_rd_off(D0, 2, 1)>(vb), l3 = tr_read<v_rd_off(D0, 3, 0)>(vb), h3 = tr_read<v_rd_off(D0, 3, 1)>(vb);
  asm volatile("s_waitcnt lgkmcnt(0)" ::: "memory"); SBAR_C();
#define PK(L, H) (bf16x8){L[0], L[1], L[2], L[3], H[0], H[1], H[2], H[3]}
  od = __builtin_amdgcn_mfma_f32_32x32x16_bf16(pa0, PK(l0, h0), od, 0, 0, 0);
  od = __builtin_amdgcn_mfma_f32_32x32x16_bf16(pa1, PK(l1, h1), od, 0, 0, 0);
  od = __builtin_amdgcn_mfma_f32_32x32x16_bf16(pa2, PK(l2, h2), od, 0, 0, 0);
  od = __builtin_amdgcn_mfma_f32_32x32x16_bf16(pa3, PK(l3, h3), od, 0, 0, 0);
#undef PK
}
__device__ __forceinline__ void pv_d0(f32x16* o, int vb, bf16x8 pa0, bf16x8 pa1, bf16x8 pa2, bf16x8 pa3) {
  pv_one<0>(o[0], vb, pa0, pa1, pa2, pa3); pv_one<1>(o[1], vb, pa0, pa1, pa2, pa3); pv_one<2>(o[2], vb, pa0, pa1, pa2, pa3); pv_one<3>(o[3], vb, pa0, pa1, pa2, pa3);
}

template <int MODE> __device__ __forceinline__ void attn_c_unit(const bf16* __restrict__ Qb, int ldq, const bf16* __restrict__ Kh, const bf16* __restrict__ Vh, int ldk,
                                            bf16* __restrict__ Ob, int ldo, int seq, char* lds, float lam, float oscale, const float* __restrict__ sg) {
  typedef bf16 TQ; const int LDQ = ldq, LDK = ldk, LDO = ldo;
  using St = Stage<bf16>; using SQ = Stage<bf16>;
  int tid_o = threadIdx.x; asm volatile("" : "+v"(tid_o)); const int tid = tid_o, wid = tid >> 6, lane = tid & 63, r32 = lane & 31, hi = lane >> 5;
  bf16* V_lds = (bf16*)lds; bf16* K_lds = (bf16*)(lds + 2 * SHM_V);
  float* ws = (float*)(lds + 2 * SHM_V + 2 * SHM_K) + wid * 64; float* li_l = ws; float* al_l = ws + 32;
  float m_reg = -1e30f, l_reg = 0; f32x16 o[4] = {}; bf16x8 qr[4];
  const TQ* Qw = Qb + (long)(wid * QBLK + r32) * LDQ + hi * 8;
#pragma unroll
  for (int d0 = 0; d0 < 4; ++d0) qr[d0] = SQ::tobf(SQ::ld8(Qw + d0 * 16));
  const int sr = tid >> 4, sc = (tid & 15) * 8, vst0 = v_st(sr, sc), vst1 = v_st(32 + sr, sc), kr = tid >> 3, kcb = (tid & 7) * 16;
  const int vb0 = (int)(uintptr_t)V_lds + v_rd_base(lane);
  struct { typename St::T vs0, vs1, ks0; } sr_[SDEPTH];
#define SLOAD(i, k0) do { sr_[i].vs0 = St::ld8(&Vh[(long)((k0) + sr) * LDK + sc]); sr_[i].vs1 = St::ld8(&Vh[(long)((k0) + 32 + sr) * LDK + sc]); \
    sr_[i].ks0 = St::ld8(&Kh[(long)((k0) + kr) * LDK + (kcb >> 1)]); } while (0)
#define SWRITE(b, i) do { *(bf16x8*)((char*)V_lds + (b) * SHM_V + vst0) = St::tobf(sr_[i].vs0);          \
    *(bf16x8*)((char*)V_lds + (b) * SHM_V + vst1) = St::tobf(sr_[i].vs1);                               \
    *(bf16x8*)((char*)K_lds + (b) * SHM_K + KSWZ(kr, kcb)) = St::tobf(sr_[i].ks0); } while (0)
#define SWAIT() do { if constexpr (SDEPTH == 2) asm volatile("s_waitcnt vmcnt(3)" ::: "memory"); else asm volatile("s_waitcnt vmcnt(0)" ::: "memory"); } while (0)
#define RESC(a) do { if (__any((a) < 1.f)) { if (hi == 0) al_l[r32] = (a); asm volatile("s_waitcnt lgkmcnt(0)" ::: "memory"); \
    for (int d = 0; d < 4; ++d) for (int r = 0; r < 16; ++r) o[d][r] *= al_l[crow(r, hi)]; } } while (0)
  f32x16 pA0, pA1, pB0, pB1; float mnA, mnB, alA, alB; bf16x8 pa0, pa1, pa2, pa3; const int NT = seq / KVBLK;
  constexpr int SE = 0, SO = SDEPTH - 1;
  SLOAD(SE, 0); asm volatile("s_waitcnt vmcnt(0)" ::: "memory"); SWRITE(0, SE); __syncthreads();
  qkt(pA0, pA1, K_lds, qr, r32, hi); partialSM(pA0, pA1, m_reg, mnA, alA);
  SLOAD(SO, KVBLK); if constexpr (SDEPTH == 2) { if (2 < NT) SLOAD(SE, 2 * KVBLK); }
  SWAIT(); SWRITE(1, SO); __syncthreads();
  for (int j = 1; j + 1 < NT; j += 2) {
    SBAR_C(); qkt(pB0, pB1, (bf16*)((char*)K_lds + SHM_K), qr, r32, hi);
    finishSM(pA0, pA1, alA, l_reg, pa0, pa1, pa2, pa3); SBAR_C();
    SLOAD(SO, (j + SDEPTH) * KVBLK); SBAR_C();
    pv_d0(o, vb0, pa0, pa1, pa2, pa3); partialSM(pB0, pB1, m_reg, mnB, alB);
    __syncthreads(); SWAIT(); SWRITE(0, SE);
    RESC(alB); __syncthreads();
    SBAR_C(); qkt(pA0, pA1, K_lds, qr, r32, hi);
    finishSM(pB0, pB1, alB, l_reg, pa0, pa1, pa2, pa3); SBAR_C();
    if (SDEPTH == 1 || j + 3 < NT) SLOAD(SE, (j + 1 + SDEPTH) * KVBLK); SBAR_C();
    pv_d0(o, vb0 + (int)SHM_V, pa0, pa1, pa2, pa3); partialSM(pA0, pA1, m_reg, mnA, alA);
    __syncthreads(); SWAIT(); SWRITE(1, SO);
    RESC(alA); __syncthreads();
  }
  SBAR_C(); qkt(pB0, pB1, (bf16*)((char*)K_lds + SHM_K), qr, r32, hi);
  finishSM(pA0, pA1, alA, l_reg, pa0, pa1, pa2, pa3); SBAR_C();
  pv_d0(o, vb0, pa0, pa1, pa2, pa3); partialSM(pB0, pB1, m_reg, mnB, alB);
  __syncthreads(); RESC(alB);
  finishSM(pB0, pB1, alB, l_reg, pa0, pa1, pa2, pa3); SBAR_C();
  pv_d0(o, vb0 + (int)SHM_V, pa0, pa1, pa2, pa3);
  if (hi == 0) li_l[r32] = l_reg; asm volatile("s_waitcnt lgkmcnt(0)" ::: "memory");
  float rli[16];
#pragma unroll
  for (int r = 0; r < 16; ++r) rli[r] = __builtin_amdgcn_rcpf(li_l[crow(r, hi)]);
  unsigned* stash = (unsigned*)(lds + 65536) + wid * 2048;
  if constexpr (MODE == 0) {
#pragma unroll
    for (int d0 = 0; d0 < 4; ++d0)
#pragma unroll
      for (int r = 0; r < 16; r += 2) stash[(d0 * 8 + (r >> 1)) * 64 + lane] = cvtpk(o[d0][r] * rli[r], o[d0][r + 1] * rli[r + 1]);
  } else {
    float ss[16];
#pragma unroll
    for (int r = 0; r < 16; ++r) ss[r] = 0.f;
#pragma unroll
    for (int d0 = 0; d0 < 4; ++d0)
#pragma unroll
      for (int r = 0; r < 16; r += 2) { const unsigned w = stash[(d0 * 8 + (r >> 1)) * 64 + lane];
        const float da = __uint_as_float(w << 16) - lam * (o[d0][r] * rli[r]), db = __uint_as_float(w & 0xffff0000u) - lam * (o[d0][r + 1] * rli[r + 1]);
        o[d0][r] = da; o[d0][r + 1] = db; ss[r] += da * da; ss[r + 1] += db * db; }
#pragma unroll
    for (int r = 0; r < 16; ++r) { float v = ss[r]; v += __shfl_xor(v, 1); v += __shfl_xor(v, 2); v += __shfl_xor(v, 4); v += __shfl_xor(v, 8); v += __shfl_xor(v, 16);
      ss[r] = oscale / sqrtf(v * (1.f / 128.f) + 1e-6f); }
    bf16* stg = (bf16*)stash;
#pragma unroll
    for (int d0 = 0; d0 < 4; ++d0) { const float g = sg[d0 * 32 + r32];
#pragma unroll
      for (int r = 0; r < 16; ++r) stg[crow(r, hi) * 128 + d0 * 32 + r32] = __float2bfloat16(o[d0][r] * ss[r] * g); }
    asm volatile("s_waitcnt lgkmcnt(0)" ::: "memory");
    bf16* Ow = Ob + (long)(wid * QBLK) * LDO;
#pragma unroll
    for (int i = 0; i < 8; ++i) { const int row = i * 4 + (lane >> 4), ch = lane & 15; const u32x4 v = *(const u32x4*)(stg + row * 128 + ch * 8); *(u32x4*)(Ow + (long)row * LDO + ch * 8) = v; }
  }
  __syncthreads();
#undef SLOAD
#undef SWRITE
#undef SWAIT
#undef RESC
}


#undef KSWZ
}


#define LAS __attribute__((address_space(3)))

#define XB_TMO      128
#define XB_XCNT(j)  (256  + 64 * (j))
#define XB_XSUB(j)  (1280 + 64 * (j))
#define XB_XGEN(j)  (2304 + 64 * (j))
#define XB_TOP      3328
#define XB_TOPGEN   3392
#define XCD_BAR_WORDS 3456
#define XB_SPIN_CAP (1u << 18)

__device__ __forceinline__ unsigned xb_ld(unsigned* p)              { return __hip_atomic_load(p, __ATOMIC_RELAXED, __HIP_MEMORY_SCOPE_AGENT); }
__device__ __forceinline__ unsigned xb_add(unsigned* p, unsigned v) { return __hip_atomic_fetch_add(p, v, __ATOMIC_RELAXED, __HIP_MEMORY_SCOPE_AGENT); }
__device__ __forceinline__ unsigned xb_xcc_id() { return (unsigned)__builtin_amdgcn_s_getreg((3 << 11) | 20) & 0xFu; }
#define XB_SPIN(cond, bar) do { unsigned _sp = 0; while (cond) { __builtin_amdgcn_s_sleep(1); \
    if ((++_sp & 255u) == 0u) { if (xb_ld(&(bar)[XB_TMO])) break; if (_sp > XB_SPIN_CAP) { atomicAdd(&(bar)[XB_TMO], 1u); break; } } } } while (0)

struct XcdBarrier {
    unsigned* bar; unsigned x;
    volatile LAS unsigned* st;
};

__device__ __forceinline__ XcdBarrier xcd_barrier_post(unsigned* bar, volatile LAS unsigned* st) {
    XcdBarrier b; b.bar = bar; b.x = xb_xcc_id(); b.st = st;
    if (threadIdx.x == 0) (void)xb_add(&bar[XB_XCNT(b.x)], 1u);
    return b;
}
__device__ __forceinline__ void xcd_barrier_complete(unsigned* bar, unsigned x, unsigned& nloc, unsigned& nx) {
    const unsigned G = gridDim.x * gridDim.y * gridDim.z;
    unsigned sum, cnt, mine, sp = 0u;
    for (;;) {
        sum = 0u; cnt = 0u; mine = 0u;
#pragma unroll
        for (unsigned j = 0; j < 16; ++j) { const unsigned c = xb_ld(&bar[XB_XCNT(j)]); sum += c; cnt += (c > 0u) ? 1u : 0u; mine = (j == x) ? c : mine; }
        if (sum == G) break;
        __builtin_amdgcn_s_sleep(1);
        if ((++sp & 255u) == 0u) { if (xb_ld(&bar[XB_TMO])) break; if (sp > XB_SPIN_CAP) { atomicAdd(&bar[XB_TMO], 1u); break; } }
    }
    nloc = mine > 0u ? mine : 1u; nx = cnt > 0u ? cnt : 1u;
}

__device__ __forceinline__ void xcd_barrier(const XcdBarrier& b) {
    asm volatile("s_waitcnt vmcnt(0)" ::: "memory");
    __syncthreads();
    if (threadIdx.x == 0) {
        unsigned* bar = b.bar;
        __builtin_amdgcn_s_waitcnt(0);
        unsigned nloc = b.st[0], nx = b.st[1];
        if (nloc == 0u) { xcd_barrier_complete(bar, b.x, nloc, nx); b.st[0] = nloc; b.st[1] = nx; }
        const unsigned old = xb_add(&bar[XB_XSUB(b.x)], 1u);
        const unsigned gen = old / nloc;
        if (old + 1u == (gen + 1u) * nloc) {
            __builtin_amdgcn_fence(__ATOMIC_RELEASE, "agent");
            asm volatile("s_waitcnt vmcnt(0)" ::: "memory");
            const unsigned og = xb_add(&bar[XB_TOP], 1u);
            const unsigned tg = og / nx;
            if (og + 1u == (tg + 1u) * nx) xb_add(&bar[XB_TOPGEN], 1u);
            else XB_SPIN(xb_ld(&bar[XB_TOPGEN]) == tg, bar);
            __builtin_amdgcn_fence(__ATOMIC_ACQUIRE, "agent");
            xb_add(&bar[XB_XGEN(b.x)], 1u);
            asm volatile("s_waitcnt vmcnt(0)" ::: "memory");
        } else {
            XB_SPIN(xb_ld(&bar[XB_XGEN(b.x)]) == gen, bar);
            __builtin_amdgcn_fence(__ATOMIC_ACQUIRE, "agent");
            asm volatile("s_waitcnt vmcnt(0)" ::: "memory");
        }
    }
    __syncthreads();
}

constexpr int NWAVES = 8, RING_BYTES = 131072, LDSCTL_OFF = RING_BYTES, MISC_OFF = LDSCTL_OFF + 320, LDS_BYTES = 147456;
constexpr int CW_BAR = 4096;
#ifndef KMASK
#define KMASK 0xFFFF
#endif
#define KEN(k) (((KMASK) >> (k)) & 1)
#ifndef DUPMASK
#define DUPMASK 0
#endif
#define NREP(k) ((((DUPMASK) >> (k)) & 1) ? 2 : 1)
struct Args { P p; int ph_lo, ph_hi, li, pad; };

struct InprojOrder {
    pg8::StaticOrder so; int G, c, nmain, nextra;
    __device__ void init(int l, int G_, int c_) { so.init(l == 0 ? MT : M_LAT, IN_W, G_, c_); G = G_; c = c_; nmain = so.nwg; nextra = l == 0 ? 0 : 20; }
    __device__ bool next(int i, pg8::Unit& u) const {
        const int L = i * G + c;
        if (L < nmain) return so.next(i, u);
        const int q = L - nmain; if (q >= nextra) return false;
        const int k = q % 5; u.pm = 64 + q / 5; u.pn = k == 0 ? 2 : 8 + k; u.ko = 0; u.pa = u.pm; return true;
    }
    __device__ __forceinline__ void a_ready(const pg8::Unit&) const {}
    __device__ __forceinline__ void done(const pg8::Unit&) const {}
};

__device__ __forceinline__ P load_p() {
    const __attribute__((address_space(4))) P* k = (const __attribute__((address_space(4))) P*)__builtin_amdgcn_kernarg_segment_ptr();
    asm volatile("" : "+s"(k));
    P r;
#pragma unroll
    for (int i = 0; i < 34; ++i) r.in[i] = k->in[i];
    r.out = k->out; r.ws = k->ws; return r;
}
__global__ void __launch_bounds__(NWAVES * 64, 2) mega(Args args) {
    extern __shared__ __attribute__((aligned(16))) unsigned char lds[];
    LAS unsigned char* ldsl = (LAS unsigned char*)lds;
    const int tid = threadIdx.x, lane = tid & 63, wave = __builtin_amdgcn_readfirstlane(tid >> 6);
    const int G = gridDim.x, bx = blockIdx.x, vcu = (G % 8 == 0) ? (bx % 8) * (G / 8) + bx / 8 : bx;
    const int gw = vcu * NWAVES + wave, NGW = G * NWAVES;
    for (int u = tid; u < (LDS_BYTES - LDSCTL_OFF) / 4; u += NWAVES * 64) ((LAS unsigned*)(ldsl + LDSCTL_OFF))[u] = 0u;
    __syncthreads();
    XcdBarrier bar = xcd_barrier_post((unsigned*)(args.p.ws + WS_CTL) + CW_BAR + args.li * XCD_BAR_WORDS, (volatile LAS unsigned*)(ldsl + MISC_OFF) + 8);
    const int lo = args.ph_lo, hi = args.ph_hi;
#define IN(k) (lo <= (k) && (k) < hi)
#define OPQ(x) ({ int t_ = (x); asm volatile("" : "+v"(t_)); t_; })
#define SEAM(k) do { if (IN(k) && IN((k) + 1)) { xcd_barrier(bar); if (NREP(16) == 2) xcd_barrier(bar); } } while (0)

    if (KEN(0) && IN(0)) { const P& p = args.p;
        for (int rep_ = 0; rep_ < NREP(0); ++rep_) {
        for (int it = vcu; it < 192; it += G) ph_mod_item(p, it, (float*)lds, OPQ(tid));
        if (vcu == G - 1) ph_misc(p, tid, NWAVES * 64);
        float* scr = (float*)(lds + wave * 16384);
        if (ALL_MEGA) { for (int j = gw; j < N_PRO; j += NGW) prep_item(p, pro_item(j), scr, OPQ(lane)); }
        else for (int it = gw; it < IT_TOTAL; it += NGW) prep_item(p, it, scr, OPQ(lane));
        __syncthreads(); }
    }
    SEAM(0);

    for (int l = 0; l < 2; ++l) {
        const int pb = l == 0 ? 1 : 10;
        const int nrows = l == 0 ? MT : M_LAT;
        if (KEN(1) && IN(pb)) { const P p = load_p(); for (int rep_ = 0; rep_ < NREP(1); ++rep_) ph_norm(p, l, 0, MT, OPQ(gw), NGW, OPQ(lane)); }
        SEAM(pb);
        if (KEN(2) && IN(pb + 1)) { const P p = load_p(); unsigned char* ws = p.ws;
            pg8::Gemm g{(const bf16*)(ws + WS_H), (const bf16*)(ws + WS_WIN) + (size_t)l * IN_W * D, MT, IN_W, D, D};
            InprojOrder S; S.init(l, G, bx);
            pg8::EpiInproj E{ws, p.in[10] + l * 64, p.in[11] + l * 64, p.in[9] + l * 3072};
            for (int rep_ = 0; rep_ < NREP(2); ++rep_) pg8::gemm_phase<pg8::EpiInproj, InprojOrder, true, true>(ldsl, g, S, E);
            if (ALL_MEGA && l == 0) {
                const int nfull = (MT / 256 * 25) % G; const P& pa = args.p; float* scr = (float*)(lds + wave * 16384);
                const int rank = nfull != 0 ? (int)bx - nfull : (int)bx, nid = nfull != 0 ? G - nfull : G;
                if (rank >= 0) for (int j = rank * NWAVES + wave; j < N_L1; j += nid * NWAVES) prep_item(pa, l1_item(j), scr, OPQ(lane)); }
            if (ALL_MEGA && l == 1) {
                const int nfull = (M_LAT / 256 * 25 + 20) % G;
                if (nfull != 0 && (int)bx >= nfull) { const P& pa = args.p; const int rank = (int)bx - nfull, nid = G - nfull; float* scr = (float*)(lds + wave * 16384);
                    for (int it = IT_DEF1 + rank * NWAVES + wave; it < IT_TOTAL; it += nid * NWAVES) prep_item(pa, it, scr, OPQ(lane)); }
                else if (nfull == 0) { const P& pa = args.p; float* scr = (float*)(lds + wave * 16384);
                    for (int it = IT_DEF1 + (int)bx * NWAVES + wave; it < IT_TOTAL; it += G * NWAVES) prep_item(pa, it, scr, OPQ(lane)); } }
        }
        SEAM(pb + 1);
        if (IN(pb + 2)) { const P p = load_p(); unsigned char* ws = p.ws;
            if (KEN(3)) for (int rep_ = 0; rep_ < NREP(3); ++rep_) for (int t = vcu; t < (l == 0 ? CONV_TILES_ALL : CONV_TILES_LAT); t += G) conv_tile(p, l, t, lds, OPQ(tid));
            __syncthreads();
            if (KEN(4)) for (int rep_ = 0; rep_ < NREP(4); ++rep_) for (int k = 0;; ++k) {
                const int nl = vcu < 512 ? (512 - vcu + G - 1) / G : 0; int u;
                if (k < nl) u = vcu + k * G; else { const int q = (vcu + G - 32 % G) % G + (k - nl) * G; if (l != 0 || q >= 32) break; u = 512 + q; }
                int b, vh, qrow0, krow0, NT;
                if (u < 512) { b = u >> 7; vh = (u >> 4) & 7; qrow0 = b * SEQ + (u & 15) * 256; krow0 = b * NKEY; NT = NKEY / 64; }
                else { const int q = u - 512; b = q >> 3; vh = q & 7; qrow0 = M_LAT + b * CTXL; krow0 = b * NKEY + SEQ; NT = CTXL / 64; }
                attn_body::attn_unit<8>((const attn_body::bf16*)(ws + WS_QA) + (size_t)qrow0 * 512 + vh * 64, 512, (const attn_body::bf16*)(ws + WS_KA) + (size_t)krow0 * 128 + (vh >> 2) * 64,
                                        (const attn_body::bf16*)(ws + WS_VA) + (size_t)krow0 * 128 + (vh >> 2) * 64, 128, (attn_body::bf16*)(ws + WS_OABC) + (size_t)qrow0 * 1536 + vh * 64, 1536, NT, (char*)lds);
            }
            if (KEN(4)) for (int rep_ = 0; rep_ < NREP(4); ++rep_) for (int k = 0;; ++k) {
                const int nl = vcu < 256 ? (256 - vcu + G - 1) / G : 0; int su;
                if (k < nl) su = vcu + k * G; else { const int q = (vcu + G - 64 % G) % G + (k - nl) * G; if (l != 0 || q >= 16) break; su = 256 + q; }
                int b, h, qrow0, krow0, NT;
                if (su < 256) { b = su >> 6; h = (su >> 4) & 3; qrow0 = b * SEQ + (su & 15) * 256; krow0 = b * NKEY; NT = NKEY / 64; }
                else { const int q = su - 256; b = q >> 2; h = q & 3; qrow0 = M_LAT + b * CTXL; krow0 = b * NKEY + SEQ; NT = CTXL / 64; }
                {
                    const float lam = ((const float*)(ws + WS_LAM))[l], li = ((const float*)(ws + WS_LAM))[2 + l];
                    const attn_c::bf16* q_ = (const attn_c::bf16*)(ws + WS_QC) + (size_t)qrow0 * 512 + (2 * h) * 64; const attn_c::bf16* k_ = (const attn_c::bf16*)(ws + WS_KC) + (size_t)krow0 * 512 + (2 * h) * 64;
                    const attn_c::bf16* v_ = (const attn_c::bf16*)(ws + WS_VC) + (size_t)krow0 * 512 + h * 128;
                    attn_body::attn_unit_v128<0, 8>(q_, 512, k_, v_, 512, (attn_c::bf16*)nullptr, 0, NT, (char*)lds, 0.f, 0.f, (const float*)nullptr);
                    attn_body::attn_unit_v128<1, 8>(q_ + 64, 512, k_ + 64, v_, 512, (attn_c::bf16*)(ws + WS_OABC) + (size_t)qrow0 * 1536 + 1024 + h * 128, 1536, NT, (char*)lds, lam, 1.f - li, p.in[20] + l * 128); }
            }
        }
        if (IN(pb + 2) && IN(pb + 4)) xcd_barrier(bar);
        if (KEN(6) && IN(pb + 4)) { const P p = load_p(); unsigned char* ws = p.ws;
            pg8::Gemm g{(const bf16*)(ws + WS_OABC), (const bf16*)(ws + WS_WP) + (size_t)l * D * 1536, nrows, D, 1536, 1536};
            pg8::StaticOrder S; S.init(nrows, D, G, bx);
            pg8::EpiMerge E{(const unsigned char*)(ws + WS_G), (bf16*)(ws + WS_MB)};
            for (int rep_ = 0; rep_ < NREP(6); ++rep_) pg8::gemm_phase<pg8::EpiMerge, pg8::StaticOrder, true, true>(ldsl, g, S, E);
            if (ALL_MEGA && l == 0 && (int)bx >= MT / 256 * 4 - G) {
                const P& pa = args.p; const int n2 = MT / 256 * 4 - G, rank = (int)bx - n2, nid = G - n2; float* scr = (float*)(lds + wave * 16384);
                for (int it = IT_EARLY + rank * NWAVES + wave; it < IT_DEF1; it += nid * NWAVES) prep_item(pa, it, scr, OPQ(lane)); }
        }
        SEAM(pb + 4);
        if (KEN(7) && IN(pb + 5)) { const P p = load_p(); unsigned char* ws = p.ws;
            pg8::Gemm g{(const bf16*)(ws + WS_MB), (const bf16*)(ws + WS_WOUT) + (size_t)l * D * D, M_LAT, D, D, D};
            pg8::StaticOrder S; S.init(M_LAT, D, G, bx);
            pg8::EpiResid E{l == 0 ? p.in[0] : (const float*)nullptr, (bf16*)(ws + WS_XB), modv(p, l, 0, 2)};
            pg8::gemm_phase<pg8::EpiResid, pg8::StaticOrder, true, true>(ldsl, g, S, E);
            if (l == 0) {
                pg8::Gemm gt{(const bf16*)(ws + WS_MB), (const bf16*)(ws + WS_WOUT), MT, D, 256, D};
                pg8::CtxSliceOrder St; St.init(4, G, bx);
                pg8::EpiCtxPartial Et{(bf16*)(ws + WS_CPO)};
                pg8::gemm_phase<pg8::EpiCtxPartial, pg8::CtxSliceOrder, true, true>(ldsl, gt, St, Et);
                }
        }
        SEAM(pb + 5);
        if (l == 0) {
            if (KEN(8) && IN(pb + 6)) { const P p = load_p(); for (int rep_ = 0; rep_ < NREP(8); ++rep_) ph_norm(p, l, 1, MT, OPQ(gw), NGW, OPQ(lane)); }
            SEAM(pb + 6);
            if (KEN(9) && IN(pb + 7)) { const P p = load_p(); unsigned char* ws = p.ws;
                pg8::Gemm g{(const bf16*)(ws + WS_H8), (const bf16*)(ws + WS_FFN13), MT, 2 * DFF, D / 2, D / 2, SC_W13, SC_ONE};
                pg8::StaticOrder S; S.init(MT, 2 * DFF, G, bx);
                pg8::EpiSwiglu E{(bf16*)(ws + WS_HMID), DFF, 1 << 20};
                for (int rep_ = 0; rep_ < NREP(9); ++rep_) pg8::gemm_phase<pg8::EpiSwiglu, pg8::StaticOrder, true, true, true>(ldsl, g, S, E);
            }
            SEAM(pb + 7);
            if (KEN(10) && IN(pb + 8)) { const P p = load_p(); unsigned char* ws = p.ws;
                pg8::Gemm g{(const bf16*)(ws + WS_HMID), (const bf16*)(ws + WS_FFN2), M_LAT, D, DFF, DFF};
                pg8::StaticOrder S; S.init(M_LAT, D, G, bx);
                pg8::EpiResid E{(const float*)nullptr, (bf16*)(ws + WS_XB), modv(p, 0, 0, 5)};
                pg8::gemm_phase<pg8::EpiResid, pg8::StaticOrder, true, true>(ldsl, g, S, E);
                {
                    pg8::Gemm gt{(const bf16*)(ws + WS_HMID), (const bf16*)(ws + WS_FFN2), MT, D, 256, DFF};
                    pg8::CtxSliceOrder St; St.init(11, G, bx);
                    pg8::EpiCtxPartial Et{(bf16*)(ws + WS_CPF)};
                    pg8::gemm_phase<pg8::EpiCtxPartial, pg8::CtxSliceOrder, true, true>(ldsl, gt, St, Et);
                    }
            }
            SEAM(pb + 8);
        } else {
            if (KEN(11) && IN(pb + 6)) { const P p = load_p(); ph_router(p, vcu, G, NWAVES, lds, OPQ(tid)); }
            if (IN(pb + 6) && IN(pb + 8)) xcd_barrier(bar);
            if (KEN(13) && IN(pb + 8)) { const P p = load_p(); unsigned char* ws = p.ws;
                int base[9]; moe_bases(p, base);
                pg8::Gemm g{(const bf16*)(ws + WS_H2PX), (const bf16*)(ws + WS_MOE13), base[8], 8 * 2 * DFFX, D / 2, D / 2, SC_W13, SC_ONE, 1};
                pg8::MoeOrder S; S.init(base, 28, G, bx);
                pg8::EpiSwigluF8 E{(unsigned char*)(ws + WS_HMX), DFFX, 28};
                for (int rep_ = 0; rep_ < NREP(13); ++rep_) pg8::gemm_phase<pg8::EpiSwigluF8, pg8::MoeOrder, true, true, true>(ldsl, g, S, E);
            }
            SEAM(pb + 8);
            if (KEN(14) && IN(pb + 9)) { const P p = load_p(); unsigned char* ws = p.ws;
                int base[9]; moe_bases(p, base);
                pg8::Gemm g{(const bf16*)(ws + WS_HMX), (const bf16*)(ws + WS_MOE2), base[8], 8 * D, DFFX / 2, DFFX / 2, SC_W2, SC_HM};
                pg8::MoeOrder S; S.init(base, 4, G, bx, 128);
                pg8::EpiMoeDown E{(bf16*)(ws + WS_H2P), (const float*)(ws + WS_EXPP)};
                for (int rep_ = 0; rep_ < NREP(14); ++rep_) pg8::gemm_phase<pg8::EpiMoeDown, pg8::MoeOrder, true, true, true>(ldsl, g, S, E);
                {
                    pg8::Gemm gt{(const bf16*)(ws + WS_HMX), (const bf16*)(ws + WS_MOE2), base[8], 8 * D, 256, DFFX / 2, SC_W2, SC_HM};
                    pg8::MoeTailOrder St; St.init(base, G, bx);
                    pg8::EpiMoeDownTail Et{(bf16*)(ws + WS_YPT), (const float*)(ws + WS_EXPP)};
                    pg8::gemm_phase<pg8::EpiMoeDownTail, pg8::MoeTailOrder, true, true, true>(ldsl, gt, St, Et); }
            }
            SEAM(pb + 9);
            if (KEN(15) && IN(pb + 10)) { const P p = load_p(); ph_final(p, OPQ(gw), NGW, OPQ(lane)); }
        }
    }
#undef IN
#undef SEAM
}
constexpr int N_PHASES = 21;

#if !ALL_MEGA
__global__ void __launch_bounds__(256) k_prep(P p) {
    __shared__ float scr[4][64 * 33];
    const int wave = threadIdx.x >> 6, lane = threadIdx.x & 63;
    for (int it = blockIdx.x * 4 + wave; it < IT_TOTAL; it += gridDim.x * 4) prep_item(p, it, scr[wave], lane);
}
__global__ void __launch_bounds__(512) k_mod(P p) { __shared__ float sm[8 * 5 * 64 + 5 * 1024]; for (int it = blockIdx.x; it < 192; it += gridDim.x) ph_mod_item(p, it, sm, threadIdx.x); if (blockIdx.x == 0) ph_misc(p, threadIdx.x, 512); }
__global__ void __launch_bounds__(256) k_norm(P p, int l, int which, int nrows) { ph_norm(p, l, which, nrows, blockIdx.x * 4 + (threadIdx.x >> 6), gridDim.x * 4, threadIdx.x & 63); }
__global__ void __launch_bounds__(256) k_router(P p) { __shared__ __attribute__((aligned(16))) unsigned char sm[4096 + 65536 - 4096]; ph_router(p, blockIdx.x, gridDim.x, 4, sm, threadIdx.x); }
__global__ void __launch_bounds__(256) k_final(P p) { ph_final(p, blockIdx.x * 4 + (threadIdx.x >> 6), gridDim.x * 4, threadIdx.x & 63); }
__global__ void __launch_bounds__(256) k_occomb(P p, int l, int nrows) { ph_occomb(p, l, nrows, blockIdx.x * 4 + (threadIdx.x >> 6), gridDim.x * 4, threadIdx.x & 63); }
__global__ void __launch_bounds__(512, 2) k_conv(P p, int l, int ntiles) { extern __shared__ __attribute__((aligned(16))) unsigned char sm[]; for (int t = blockIdx.x; t < ntiles; t += gridDim.x) { int tid = threadIdx.x; asm volatile("" : "+v"(tid)); conv_tile(p, l, t, sm, tid); } }
__global__ void __launch_bounds__(256) k_attn(P p, int typeC) {
    __shared__ float Ks[32][64], Vs[32][64];
    const int qb = blockIdx.x, vh = blockIdx.y, tid = threadIdx.x;
    const bf16 *Q, *K, *V; bf16* O; int qp, kp, op;
    if (!typeC) { Q = (const bf16*)(p.ws + WS_QA) + vh * 64; qp = 512; K = (const bf16*)(p.ws + WS_KA) + (vh / 4) * 64; V = (const bf16*)(p.ws + WS_VA) + (vh / 4) * 64; kp = 128; O = (bf16*)(p.ws + WS_OABC) + vh * 64; op = 1536; }
    else { Q = (const bf16*)(p.ws + WS_QC) + (vh >> 1) * 64; qp = 512; K = (const bf16*)(p.ws + WS_KC) + (vh >> 1) * 64; V = (const bf16*)(p.ws + WS_VC) + (vh >> 2) * 128 + (vh & 1) * 64; kp = 512; O = (bf16*)(p.ws + WS_OCR) + vh * 64; op = 1024; }
    int k0, nk; if (qb < 64) { k0 = (qb / 16) * NKEY; nk = NKEY; } else { k0 = (qb - 64) * NKEY + SEQ; nk = CTXL; }
    const int row = qb * 256 + tid;
    float q[64], o[64];
#pragma unroll
    for (int d = 0; d < 64; ++d) { q[d] = bf2f(Q[(size_t)row * qp + d]); o[d] = 0.f; }
    float m = -INFINITY, lsum = 0.f;
    for (int kt = 0; kt < nk; kt += 32) {
        __syncthreads();
        for (int i = tid; i < 32 * 64; i += 256) { const int kk = i >> 6, d = i & 63; Ks[kk][d] = bf2f(K[(size_t)(k0 + kt + kk) * kp + d]); Vs[kk][d] = bf2f(V[(size_t)(k0 + kt + kk) * kp + d]); }
        __syncthreads();
        float s[32]; float mx = m;
#pragma unroll
        for (int j = 0; j < 32; ++j) { float a = 0.f;
#pragma unroll
            for (int d = 0; d < 64; ++d) a += q[d] * Ks[j][d];
            s[j] = a; mx = fmaxf(mx, a); }
        const float alpha = exp2f(m - mx); m = mx; lsum *= alpha;
#pragma unroll
        for (int d = 0; d < 64; ++d) o[d] *= alpha;
#pragma unroll
        for (int j = 0; j < 32; ++j) { const float pj = exp2f(s[j] - m); lsum += pj;
#pragma unroll
            for (int d = 0; d < 64; ++d) o[d] += pj * Vs[j][d]; }
    }
    const float rl = 1.f / lsum;
#pragma unroll
    for (int d = 0; d < 64; d += 2) *(unsigned*)(O + (size_t)row * op + d) = pk2(o[d] * rl, o[d + 1] * rl);
}

struct TileCtx { float (*C)[257]; int rt64, pn, tid; };
template <class Epi> __global__ void __launch_bounds__(256) k_gemm(P p, Epi E, const bf16* A, int lda, const bf16* Bt, int ldb, int K) {
    extern __shared__ __attribute__((aligned(16))) float smem_g[];
    float (*As)[64] = (float (*)[64])smem_g;
    float (*Bs)[256] = (float (*)[256])(smem_g + 32 * 64);
    float (*Ct)[257] = (float (*)[257])(smem_g + 32 * 64 + 32 * 256);
    const int tid = threadIdx.x, tx = tid & 31, ty = tid >> 5, rt64 = blockIdx.x, pn = blockIdx.y;
    int bt; if (!E.map(p, rt64, pn, bt)) return;
    const bf16* Ab = A + (size_t)rt64 * 64 * lda; const bf16* Bb = Bt + (size_t)bt * 256 * ldb;
    float acc[8][8];
#pragma unroll
    for (int i = 0; i < 8; ++i)
#pragma unroll
        for (int j = 0; j < 8; ++j) acc[i][j] = 0.f;
    for (int k0 = 0; k0 < K; k0 += 32) {
        if (Epi::MIDK && (k0 == 512 || k0 == 1024)) E.mid(p, acc, rt64 * 64 + ty * 8, pn, tx, k0 / 512);
        __syncthreads();
        { const int r = tid >> 2, kq = (tid & 3) * 8; const u32x4 v = *(const u32x4*)(Ab + (size_t)r * lda + k0 + kq);
            As[kq + 0][r] = __uint_as_float(v.x << 16); As[kq + 1][r] = __uint_as_float(v.x & 0xffff0000u); As[kq + 2][r] = __uint_as_float(v.y << 16); As[kq + 3][r] = __uint_as_float(v.y & 0xffff0000u);
            As[kq + 4][r] = __uint_as_float(v.z << 16); As[kq + 5][r] = __uint_as_float(v.z & 0xffff0000u); As[kq + 6][r] = __uint_as_float(v.w << 16); As[kq + 7][r] = __uint_as_float(v.w & 0xffff0000u); }
#pragma unroll
        for (int q4 = 0; q4 < 4; ++q4) { const u32x4 v = *(const u32x4*)(Bb + (size_t)tid * ldb + k0 + q4 * 8); const int kq = q4 * 8;
            Bs[kq + 0][tid] = __uint_as_float(v.x << 16); Bs[kq + 1][tid] = __uint_as_float(v.x & 0xffff0000u); Bs[kq + 2][tid] = __uint_as_float(v.y << 16); Bs[kq + 3][tid] = __uint_as_float(v.y & 0xffff0000u);
            Bs[kq + 4][tid] = __uint_as_float(v.z << 16); Bs[kq + 5][tid] = __uint_as_float(v.z & 0xffff0000u); Bs[kq + 6][tid] = __uint_as_float(v.w << 16); Bs[kq + 7][tid] = __uint_as_float(v.w & 0xffff0000u); }
        __syncthreads();
#pragma unroll 4
        for (int k = 0; k < 32; ++k) { float a[8], b[8];
#pragma unroll
            for (int i = 0; i < 8; ++i) a[i] = As[k][ty * 8 + i];
#pragma unroll
            for (int j = 0; j < 8; ++j) b[j] = Bs[k][tx + 32 * j];
#pragma unroll
            for (int i = 0; i < 8; ++i)
#pragma unroll
                for (int j = 0; j < 8; ++j) acc[i][j] += a[i] * b[j]; }
    }
    if (Epi::MIDK) E.mid(p, acc, rt64 * 64 + ty * 8, pn, tx, 3);
#pragma unroll
    for (int i = 0; i < 8; ++i)
#pragma unroll
        for (int j = 0; j < 8; ++j) Ct[ty * 8 + i][tx + 32 * j] = acc[i][j];
    __syncthreads();
    TileCtx c{Ct, rt64, pn, tid};
    E.tile(p, c);
}
struct NInproj {
    static constexpr bool MIDK = false; int l;
    __device__ bool map(const P&, int, int pn, int& bt) const { bt = pn; return true; }
    __device__ void mid(const P&, float (&)[8][8], int, int, int, int) const {}
    __device__ void tile(const P& p, const TileCtx& t) const {
        const int c = t.tid, pn = t.pn, bj = c >> 7, hh = (c >> 5) & 3, j32 = c & 31, d = 32 * bj + j32, f = j32 & 15, nh = (j32 >> 4) & 1;
        const float* cosT = (const float*)(p.ws + WS_ROPE); const float* sinT = cosT + 1024;
        for (int r = 0; r < 64; ++r) {
            const int row = t.rt64 * 64 + r; const float v = t.C[r][c];
            if (pn < 3 || (pn >= 7 && pn < 11)) {
                const bool isq = pn < 2 || (pn >= 7 && pn < 9), isA = pn < 3, isv = (pn == 2 && hh >= 2);
                float x = v, xp = t.C[r][c ^ 16];
                if (isA && !isv) { float ss = 0.f;
                    for (int dd = 0; dd < 64; ++dd) { const float u = t.C[r][128 * (dd >> 5) + 32 * hh + (dd & 31)]; ss += u * u; }
                    const float rinv = 1.f / sqrtf(ss * (1.f / 64.f) + EPS); const float* g = p.in[isq ? 10 : 11] + l * 64;
                    x = x * rinv * g[d]; xp = xp * rinv * g[d ^ 16]; }
                float o = x;
                if (!isv && row < M_LAT) { const int tpos = row % SEQ, pos = bj ? (tpos % 64) : (tpos / 64); const float cs = cosT[pos * 16 + f], sn = sinT[pos * 16 + f];
                    o = nh ? (x * cs + xp * sn) : (x * cs - xp * sn); }
                if (isq) o *= C2;
                bf16* dst;
                if (pn < 2) dst = (bf16*)(p.ws + WS_QA) + (size_t)row * 512 + (4 * pn + hh) * 64 + d;
                else if (pn == 2) dst = (bf16*)(p.ws + (hh < 2 ? WS_KA : WS_VA)) + (size_t)keyrow(row) * 128 + (hh & 1) * 64 + d;
                else if (pn < 9) dst = (bf16*)(p.ws + WS_QC) + (size_t)row * 512 + (4 * (pn - 7) + hh) * 64 + d;
                else dst = (bf16*)(p.ws + WS_KC) + (size_t)keyrow(row) * 512 + (4 * (pn - 9) + hh) * 64 + d;
                *dst = (bf16)f2bf(o);
            } else if (pn < 7) {
                if (c < 128) { const float gt = t.C[r][c + 128]; ((bf16*)(p.ws + WS_Y))[(size_t)row * 512 + (pn - 3) * 128 + pcol(c)] = (bf16)f2bf(v * sigmoidf_(gt)); }
            } else if (pn < 13) {
                ((bf16*)(p.ws + WS_VC))[(size_t)keyrow(row) * 512 + (pn - 11) * 256 + pcol(c)] = (bf16)f2bf(v);
            } else {
                const int gc = (pn - 13) * 256 + pcol(c);
                ((bf16*)(p.ws + WS_G))[(size_t)row * 3072 + gc] = (bf16)f2bf(sigmoidf_(v + p.in[9][l * 3072 + gc]));
            }
        }
    }
};
struct NMerge {
    static constexpr bool MIDK = true; int pad_;
    __device__ bool map(const P&, int, int pn, int& bt) const { bt = pn; return true; }
    __device__ void mid(const P& p, float (&acc)[8][8], int row0, int pn, int tx, int seg  ) const {
        const bf16* G = (const bf16*)(p.ws + WS_G);
#pragma unroll
        for (int i = 0; i < 8; ++i)
#pragma unroll
            for (int j = 0; j < 8; ++j) { const int col = pn * 256 + pcol(tx + 32 * j); const size_t o = (size_t)(row0 + i) * 3072 + col;
                const float f = seg == 3 ? bf2f(G[o + 2048]) : bf2f(G[o + (seg - 1) * 1024]) / bf2f(G[o + seg * 1024]); acc[i][j] *= f; }
    }
    __device__ void tile(const P& p, const TileCtx& t) const {
        for (int r = 0; r < 64; ++r) ((bf16*)(p.ws + WS_MB))[(size_t)(t.rt64 * 64 + r) * D + t.pn * 256 + pcol(t.tid)] = (bf16)f2bf(t.C[r][t.tid]);
    }
};
struct NResid {
    static constexpr bool MIDK = false; int l, gj  , first  ;
    __device__ bool map(const P&, int, int pn, int& bt) const { bt = pn; return true; }
    __device__ void mid(const P&, float (&)[8][8], int, int, int, int) const {}
    __device__ void tile(const P& p, const TileCtx& t) const {
        for (int r = 0; r < 64; ++r) { const int row = t.rt64 * 64 + r, col = t.pn * 256 + t.tid;
            const float b = first ? x0_row(p, row)[col] : xs_row(p, row)[col];
            xs_row(p, row)[col] = b + modv(p, l, bidx(row), gj)[col] * t.C[r][t.tid]; }
    }
};
struct NSwiglu {
    static constexpr bool MIDK = false; int moe;
    __device__ bool map(const P& p, int rt64, int pn, int& bt) const {
        if (!moe) { bt = pn; return true; }
        int base[9]; moe_bases(p, base); if (rt64 * 64 >= base[8]) return false;
        int e = 0;
#pragma unroll
        for (int q = 1; q < 8; ++q) if (rt64 * 64 >= base[q]) e = q;
        bt = e * 28 + pn; return true;
    }
    __device__ void mid(const P&, float (&)[8][8], int, int, int, int) const {}
    __device__ void tile(const P& p, const TileCtx& t) const {
        if (t.tid >= 128) return;
        bf16* O = (bf16*)(p.ws + (moe ? WS_HMX : WS_HMID)); const int ld = moe ? DFFX : DFF;
        for (int r = 0; r < 64; ++r) O[(size_t)(t.rt64 * 64 + r) * ld + t.pn * 128 + pcol(t.tid)] = (bf16)f2bf(siluf_(t.C[r][t.tid]) * t.C[r][t.tid + 128]);
    }
};
struct NMoeDown {
    static constexpr bool MIDK = false; int pad_;
    __device__ bool map(const P& p, int rt64, int pn, int& bt) const {
        int base[9]; moe_bases(p, base); if (rt64 * 64 >= base[8]) return false;
        int e = 0;
#pragma unroll
        for (int q = 1; q < 8; ++q) if (rt64 * 64 >= base[q]) e = q;
        bt = e * 4 + pn; return true;
    }
    __device__ void mid(const P&, float (&)[8][8], int, int, int, int) const {}
    __device__ void tile(const P& p, const TileCtx& t) const {
        for (int r = 0; r < 64; ++r) { const int row = t.rt64 * 64 + r;
            ((bf16*)(p.ws + WS_H2P))[(size_t)row * D + t.pn * 256 + pcol(t.tid)] = (bf16)f2bf(((const float*)(p.ws + WS_ROWP))[row] * t.C[r][t.tid]); }
    }
};


#endif

constexpr int GEMM_LDS = (32 * 64 + 32 * 256 + 64 * 257) * 4;
constexpr int CONV_LDS = CONV_LDS_BYTES;
#if !ALL_MEGA
static void launch_naive_phase(const P& p, int ph, hipStream_t stream) {
    unsigned char* ws = p.ws;
    if (ph == 0) { k_prep<<<1024, 256, 0, stream>>>(p); k_mod<<<192, 512, 0, stream>>>(p); return; }
    const int l = ph >= 10 ? 1 : 0, k = ph - (l ? 10 : 1), nrows = l == 0 ? MT : M_LAT;
    switch (k) {
    case 0: k_norm<<<1024, 256, 0, stream>>>(p, l, 0, MT); break;
    case 1: k_gemm<NInproj><<<dim3(MT / 64, 25), 256, GEMM_LDS, stream>>>(p, NInproj{l}, (const bf16*)(ws + WS_H), D, (const bf16*)(ws + WS_WIN) + (size_t)l * IN_W * D, D, D); break;
    case 2: k_conv<<<320, 512, CONV_LDS, stream>>>(p, l, l == 0 ? CONV_TILES_ALL : CONV_TILES_LAT);
            k_attn<<<dim3(nrows / 256, 8), 256, 0, stream>>>(p, 0); k_attn<<<dim3(nrows / 256, 16), 256, 0, stream>>>(p, 1); break;
    case 3: k_occomb<<<1024, 256, 0, stream>>>(p, l, nrows); break;
    case 4: k_gemm<NMerge><<<dim3(nrows / 64, 4), 256, GEMM_LDS, stream>>>(p, NMerge{0}, (const bf16*)(ws + WS_OABC), 1536, (const bf16*)(ws + WS_WP) + (size_t)l * D * 1536, 1536, 1536); break;
    case 5: k_gemm<NResid><<<dim3(nrows / 64, 4), 256, GEMM_LDS, stream>>>(p, NResid{l, 2, l == 0}, (const bf16*)(ws + WS_MB), D, (const bf16*)(ws + WS_WOUT) + (size_t)l * D * D, D, D); break;
    case 6: if (l == 0) k_norm<<<1024, 256, 0, stream>>>(p, l, 1, MT); else k_router<<<1024, 256, 0, stream>>>(p); break;
    case 7: if (l == 0) k_gemm<NSwiglu><<<dim3(MT / 64, 22), 256, GEMM_LDS, stream>>>(p, NSwiglu{0}, (const bf16*)(ws + WS_H), D, (const bf16*)(ws + WS_FFN13), D, D);
            break;
    case 8: if (l == 0) k_gemm<NResid><<<dim3(MT / 64, 4), 256, GEMM_LDS, stream>>>(p, NResid{l, 5, 0}, (const bf16*)(ws + WS_HMID), DFF, (const bf16*)(ws + WS_FFN2), DFF, DFF);
            else k_gemm<NSwiglu><<<dim3(RMAX / 64, 28), 256, GEMM_LDS, stream>>>(p, NSwiglu{1}, (const bf16*)(ws + WS_H2P), D, (const bf16*)(ws + WS_MOE13), D, D); break;
    case 9: k_gemm<NMoeDown><<<dim3(RMAX / 64, 4), 256, GEMM_LDS, stream>>>(p, NMoeDown{0}, (const bf16*)(ws + WS_HMX), DFFX, (const bf16*)(ws + WS_MOE2), DFFX, DFFX); break;
    case 10: k_final<<<1024, 256, 0, stream>>>(p); break;
    }
}
#endif
extern "C" void kernel_launch(void* const* d_in, const int* in_sizes, int n_in, void* d_out, int out_size, void* d_ws, size_t ws_size, hipStream_t stream) {
    static int grid = 0;
    if (grid == 0) {
        if (n_in != 34 || out_size != M_LAT * D || ws_size < WS_END2) { fprintf(stderr, "kernel_launch: unexpected shapes (n_in %d out %d ws %zu need %zu)\n", n_in, out_size, ws_size, (size_t)WS_END2); grid = -1; return; }
        int dev = 0, cus = 0, per_cu = 0;
        if (hipGetDevice(&dev) != hipSuccess || hipDeviceGetAttribute(&cus, hipDeviceAttributeMultiprocessorCount, dev) != hipSuccess) { grid = -1; return; }
        if (hipFuncSetAttribute((const void*)mega, hipFuncAttributeMaxDynamicSharedMemorySize, LDS_BYTES) != hipSuccess) { fprintf(stderr, "kernel_launch: hipFuncSetAttribute failed\n"); grid = -1; return; }
#if !ALL_MEGA
        (void)hipFuncSetAttribute((const void*)k_gemm<NInproj>, hipFuncAttributeMaxDynamicSharedMemorySize, GEMM_LDS);
        (void)hipFuncSetAttribute((const void*)k_gemm<NMerge>, hipFuncAttributeMaxDynamicSharedMemorySize, GEMM_LDS);
        (void)hipFuncSetAttribute((const void*)k_gemm<NResid>, hipFuncAttributeMaxDynamicSharedMemorySize, GEMM_LDS);
        (void)hipFuncSetAttribute((const void*)k_gemm<NSwiglu>, hipFuncAttributeMaxDynamicSharedMemorySize, GEMM_LDS);
        (void)hipFuncSetAttribute((const void*)k_gemm<NMoeDown>, hipFuncAttributeMaxDynamicSharedMemorySize, GEMM_LDS);
        (void)hipFuncSetAttribute((const void*)k_conv, hipFuncAttributeMaxDynamicSharedMemorySize, CONV_LDS);
#endif
        if (hipOccupancyMaxActiveBlocksPerMultiprocessor(&per_cu, (const void*)mega, NWAVES * 64, LDS_BYTES) != hipSuccess || per_cu < 1) fprintf(stderr, "kernel_launch: occupancy query says %d\n", per_cu);
        (void)hipGetLastError();
        grid = cus;
    }
    if (grid < 0) return;
    P p{};
    for (int i = 0; i < 34; ++i) p.in[i] = (const float*)d_in[i];
    p.out = (float*)d_out; p.ws = (unsigned char*)d_ws;
    (void)hipMemsetAsync((char*)d_ws + WS_CTL, 0, CTL_ZERO_BYTES, stream);
    const unsigned mask = MEGA_MASK;
    int li = 0;
    for (int ph = 0; ph < N_PHASES;) {
        if ((mask >> ph) & 1u) { int hi = ph; while (hi < N_PHASES && ((mask >> hi) & 1u)) ++hi;
#if !ALL_MEGA && defined(DBG_INPROJ)
            if (ph == 2) launch_naive_phase(p, 2, stream);
#endif
            Args a{}; a.p = p; a.ph_lo = ph; a.ph_hi = hi; a.li = li++; a.pad = 0;
            hipLaunchKernelGGL(mega, dim3(grid), dim3(NWAVES * 64), LDS_BYTES, stream, a);
            ph = hi; }
#if !ALL_MEGA
        else { launch_naive_phase(p, ph, stream); ++ph; }
#else
        else ++ph;
#endif
    }
}
```

```cpp
#include <hip/hip_runtime.h>
#include <cstdint>
#include <cstdio>


#ifndef MEGA_MASK
#define MEGA_MASK 0x1FFFFF
#endif
#define ALL_MEGA ((MEGA_MASK) == 0x1FFFFF)
typedef unsigned short bf16;
typedef float f32x4 __attribute__((ext_vector_type(4)));
typedef unsigned u32x4 __attribute__((ext_vector_type(4)));
typedef unsigned u32x2 __attribute__((ext_vector_type(2)));

constexpr int D = 1024, NB = 4, SEQ = 4096, CTXL = 256;
constexpr int M_LAT = NB * SEQ, M_CTX = NB * CTXL, MT = M_LAT + M_CTX;
constexpr int NKEY = SEQ + CTXL;
constexpr int IN_W = 6400;
constexpr int DFF = 2816, DFFX = 3584, NEXP = 8;
constexpr int RMAX = 34816;
constexpr float EPS = 1e-6f;
constexpr float C2 = 0.125f * 1.4426950408889634f;

constexpr size_t MiB = 1u << 20;
constexpr size_t WS_CTL = 0, CTL_ZERO_BYTES = 1 * MiB;
constexpr size_t WS_MODV = 1 * MiB;
constexpr size_t WS_ROPE = WS_MODV + 256 * 1024;
constexpr size_t WS_LAM = WS_ROPE + 16 * 1024;
constexpr size_t WS_TOKE = 2 * MiB;
constexpr size_t WS_TOKS = WS_TOKE + 128 * 1024;
constexpr size_t WS_TOKP = WS_TOKS + 128 * 1024;
constexpr size_t WS_EXPP = 3 * MiB;
constexpr size_t WS_XSC = 4 * MiB;
constexpr size_t WS_MOE13 = 8 * MiB;
constexpr size_t WS_XB = 64 * MiB;
constexpr size_t WS_CPF = 96 * MiB;
constexpr size_t WS_CPO = 148 * MiB;
constexpr size_t WS_MOE2 = 120 * MiB;
constexpr size_t WS_A2 = 176 * MiB;
constexpr size_t WS_WIN = WS_A2;
constexpr size_t WS_WP = WS_WIN + 2 * (size_t)IN_W * D * 2;
constexpr size_t WS_WOUT = WS_WP + 2 * (size_t)D * 1536 * 2;
constexpr size_t WS_FFN13 = WS_WOUT + 2 * (size_t)D * D * 2;
constexpr size_t WS_FFN2 = WS_FFN13 + (size_t)2 * DFF * D * 2;
constexpr size_t WS_U = 228 * MiB;
static_assert(WS_FFN2 + (size_t)D * DFF * 2 <= WS_U, "A2");
static_assert(WS_MOE13 + (size_t)8 * 7168 * 1024 <= WS_XB && WS_XB + (size_t)M_LAT * D * 2 <= WS_CPF && WS_CPF + (size_t)11 * 1024 * 1024 * 2 <= WS_MOE2 && WS_MOE2 + (size_t)8 * 1024 * 3584 <= WS_CPO && WS_CPO + (size_t)4 * 1024 * 1024 * 2 <= WS_A2, "XB / ctx partials");
constexpr size_t WS_QA = WS_U;
constexpr size_t WS_KA = WS_QA + (size_t)MT * 512 * 2;
constexpr size_t WS_VA = WS_KA + (size_t)MT * 128 * 2;
constexpr size_t WS_Y = WS_VA + (size_t)MT * 128 * 2;
constexpr size_t WS_QC = WS_Y + (size_t)MT * 512 * 2;
constexpr size_t WS_KC = WS_QC + (size_t)MT * 512 * 2;
constexpr size_t WS_VC = WS_KC + (size_t)MT * 512 * 2;
constexpr size_t WS_G = WS_VC + (size_t)MT * 512 * 2;
constexpr size_t WS_OABC = WS_G + (size_t)MT * 3072 * 2;
constexpr size_t WS_H = WS_OABC;
constexpr size_t WS_H8 = WS_H + (size_t)MT * D * 2;
constexpr size_t WS_OCR = WS_OABC + (size_t)MT * 1536 * 2;
constexpr size_t WS_MB = WS_OCR;
constexpr size_t WS_END = WS_OCR + (size_t)MT * 1024 * 2;
constexpr size_t WS_HMID = WS_U;
static_assert(WS_HMID + (size_t)MT * DFF * 2 <= WS_G, "HMID overlay");
constexpr size_t WS_H2P = WS_A2;
constexpr size_t WS_HMX = WS_H2P + (size_t)RMAX * D * 2;
constexpr size_t WS_H2PX = WS_HMX + (size_t)RMAX * DFFX;
constexpr size_t WS_YPT = WS_H2PX + (size_t)8 * 16384 * D;
constexpr size_t WS_END2 = WS_YPT + (size_t)7 * 2048 * 1024 * 2;
static_assert(WS_HMX + (size_t)RMAX * DFFX * 2 <= WS_END2 && WS_END2 <= 582000000, "HMX overlay");
static_assert(WS_H2P + (size_t)RMAX * D * 2 <= WS_H, "H2P must not overlap H");

constexpr int CW_CNT = 64;

__device__ __forceinline__ float bf2f(bf16 v) { return __uint_as_float(((unsigned)v) << 16); }
__device__ __forceinline__ unsigned f2bf(float f) { unsigned u = __float_as_uint(f); return (u + 0x7fffu + ((u >> 16) & 1u)) >> 16; }
typedef float f32x2_pk __attribute__((ext_vector_type(2))); typedef __bf16 bf16x2_pk __attribute__((ext_vector_type(2)));
__device__ __forceinline__ unsigned pk2(float lo, float hi) { f32x2_pk v = {lo, hi}; bf16x2_pk b = __builtin_convertvector(v, bf16x2_pk); return __builtin_bit_cast(unsigned, b); }
__device__ __forceinline__ float sigmoidf_(float x) { return 1.f / (1.f + __expf(-x)); }
__device__ __forceinline__ float siluf_(float x) { return x * __builtin_amdgcn_rcpf(1.f + __expf(-x)); }
__device__ __forceinline__ float rsq_(float x) { return __builtin_amdgcn_rsqf(x); }
template <int CTRL> __device__ __forceinline__ float dpp_mov(float v) { return __builtin_bit_cast(float, __builtin_amdgcn_update_dpp(0, __builtin_bit_cast(int, v), CTRL, 0xf, 0xf, true)); }
__device__ __forceinline__ float xsum_row16(float v) {
    v += dpp_mov<0xB1>(v); v += dpp_mov<0x4E>(v); v += dpp_mov<0x141>(v); v += dpp_mov<0x140>(v); return v; }
__device__ __forceinline__ float xsum_x16(float v) { const auto rr = __builtin_amdgcn_permlane16_swap(__float_as_uint(v), __float_as_uint(v), false, false); return __uint_as_float(rr[0]) + __uint_as_float(rr[1]); }
__device__ __forceinline__ float xsum_x32(float v) { const auto rr = __builtin_amdgcn_permlane32_swap(__float_as_uint(v), __float_as_uint(v), false, false); return __uint_as_float(rr[0]) + __uint_as_float(rr[1]); }
__device__ __forceinline__ float wave_sum(float v) { return xsum_x32(xsum_x16(xsum_row16(v))); }
__host__ __device__ __forceinline__ int pcol5(int j) { return 8 * ((j >> 2) & 3) + 4 * ((j >> 4) & 1) + (j & 3); }
__host__ __device__ __forceinline__ int pcol(int c) { return (c & ~31) | pcol5(c & 31); }
__device__ __forceinline__ int keyrow(int r) { return r < M_LAT ? (r / SEQ) * NKEY + (r % SEQ) : ((r - M_LAT) / CTXL) * NKEY + SEQ + ((r - M_LAT) % CTXL); }
__device__ __forceinline__ int bidx(int r) { return r < M_LAT ? r / SEQ : 4; }

struct P {
    const float* in[34];
    float* out;
    unsigned char* ws;
};
__device__ __forceinline__ const float* modv(const P& p, int l, int bi, int j) { return (const float*)(p.ws + WS_MODV) + ((size_t)(l * 5 + bi) * 6 + j) * D; }
__device__ __forceinline__ float* xs_row(const P& p, int r) { return r < M_LAT ? p.out + (size_t)r * D : (float*)(p.ws + WS_XSC) + (size_t)(r - M_LAT) * D; }
__device__ __forceinline__ f32x4 ld_bf4(const bf16* q) { const u32x2 a = *(const u32x2*)q; return (f32x4){__uint_as_float(a.x << 16), __uint_as_float(a.x & 0xffff0000u), __uint_as_float(a.y << 16), __uint_as_float(a.y & 0xffff0000u)}; }
__device__ __forceinline__ const float* x0_row(const P& p, int r) { return r < M_LAT ? p.in[0] + (size_t)r * D : p.in[2] + (size_t)(r - M_LAT) * D; }

__host__ __device__ __forceinline__ int win_src_col(int np) {
    const int pn = np >> 8, c = np & 255, bj = c >> 7, hh = (c >> 5) & 3, j32 = c & 31, d = 32 * bj + j32;
    if (pn < 2) return (4 * pn + hh) * 64 + d;
    if (pn == 2) return hh < 2 ? 512 + hh * 64 + d : 640 + (hh - 2) * 64 + d;
    if (pn < 7) { const int ch = (pn - 3) * 128 + pcol(c & 127); return 768 + (bj ? 512 : 0) + ch; }
    if (pn < 9) return 1792 + (4 * (pn - 7) + hh) * 64 + d;
    if (pn < 11) return 2304 + (4 * (pn - 9) + hh) * 64 + d;
    if (pn < 13) return 2816 + (pn - 11) * 256 + pcol(c);
    return 3328 + (pn - 13) * 256 + pcol(c);
}
__device__ __forceinline__ void xpose_block(const float* src, int ldn, int k0, int scol, bf16* dst, int ldk, float* scr, int lane) {
    float ld_[32];
#pragma unroll
    for (int i = 0; i < 32; ++i) ld_[i] = src[(size_t)(k0 + 2 * i + (lane >> 5)) * ldn + scol];
#pragma unroll
    for (int i = 0; i < 32; ++i) scr[(2 * i + (lane >> 5)) * 33 + (lane & 31)] = ld_[i];
    asm volatile("s_waitcnt lgkmcnt(0)" ::: "memory");
    const int c = lane & 7;
#pragma unroll
    for (int j = 0; j < 4; ++j) { const int n = (lane >> 3) + 8 * j; const float* s = scr + (8 * c) * 33 + n;
        u32x4 o; o.x = pk2(s[0 * 33], s[1 * 33]); o.y = pk2(s[2 * 33], s[3 * 33]); o.z = pk2(s[4 * 33], s[5 * 33]); o.w = pk2(s[6 * 33], s[7 * 33]);
        *(u32x4*)(dst + (size_t)n * ldk + 8 * c) = o; }
    asm volatile("s_waitcnt lgkmcnt(0)" ::: "memory");
}
__device__ __forceinline__ unsigned pk4_fp8(float a, float b, float c, float d) { unsigned w = __builtin_amdgcn_cvt_pk_fp8_f32(a, b, 0u, false); return __builtin_amdgcn_cvt_pk_fp8_f32(c, d, w, true); }
__device__ __forceinline__ void xpose_block_f8(const float* src, int ldn, int k0, int scol, unsigned char* dst, int ldk, float* scr, int lane, float sc) {
    float ld_[32];
#pragma unroll
    for (int i = 0; i < 32; ++i) ld_[i] = src[(size_t)(k0 + 2 * i + (lane >> 5)) * ldn + scol];
#pragma unroll
    for (int i = 0; i < 32; ++i) scr[(2 * i + (lane >> 5)) * 33 + (lane & 31)] = ld_[i];
    asm volatile("s_waitcnt lgkmcnt(0)" ::: "memory");
    const int c = lane & 7;
#pragma unroll
    for (int j = 0; j < 4; ++j) { const int n = (lane >> 3) + 8 * j; const float* s = scr + (8 * c) * 33 + n;
        u32x2 o; o.x = pk4_fp8(s[0 * 33] * sc, s[1 * 33] * sc, s[2 * 33] * sc, s[3 * 33] * sc); o.y = pk4_fp8(s[4 * 33] * sc, s[5 * 33] * sc, s[6 * 33] * sc, s[7 * 33] * sc);
        *(u32x2*)(dst + (size_t)n * ldk + 8 * c) = o; }
    asm volatile("s_waitcnt lgkmcnt(0)" ::: "memory");
}
constexpr float F8_W13 = 32.f, F8_W2 = 64.f, F8_HM = 4.f;
constexpr int SC_W13 = 0x7a7a7a7a, SC_W2 = 0x79797979, SC_HM = 0x7d7d7d7d, SC_ONE = 0x7f7f7f7f;
constexpr int IT_WIN = 16 * 200, IT_WP = 8 * 32, IT_WOUT = 16 * 32, IT_F13 = 16 * 176, IT_F2 = 44 * 32, IT_M13 = 16 * 224, IT_M2 = 56 * 32;
constexpr int IT_EARLY = 2 * IT_WIN + 6 * IT_WP + 2 * IT_WOUT + IT_F13 + IT_F2;
constexpr int IT_TOTAL = IT_EARLY + 8 * IT_M13 + 8 * IT_M2;
constexpr int IT_PRO = IT_EARLY;
constexpr int L1A0 = IT_WIN, L1A1 = 2 * IT_WIN, L1B0 = 2 * IT_WIN + 3 * IT_WP, L1B1 = 2 * IT_WIN + 6 * IT_WP, L1C0 = L1B1 + IT_WOUT, L1C1 = L1B1 + 2 * IT_WOUT;
constexpr int N_L1 = (L1A1 - L1A0) + (L1B1 - L1B0) + (L1C1 - L1C0), N_PRO = IT_EARLY - N_L1;
__host__ __device__ __forceinline__ int pro_item(int j) {
    if (j < L1A0) return j; j += L1A1 - L1A0;
    if (j < L1B0) return j; j += L1B1 - L1B0;
    if (j < L1C0) return j; return j + (L1C1 - L1C0); }
__host__ __device__ __forceinline__ int l1_item(int j) {
    if (j < L1A1 - L1A0) return L1A0 + j; j -= L1A1 - L1A0;
    if (j < L1B1 - L1B0) return L1B0 + j; j -= L1B1 - L1B0;
    return L1C0 + j; }
constexpr int IT_DEF1 = IT_EARLY + 30000, IT_DEF2 = IT_DEF1 + 4000;
__device__ __forceinline__ void prep_item(const P& p, int it, float* scr, int lane) {
    const int nl = lane & 31;
    if (it < 2 * IT_WIN) { const int l = it / IT_WIN, r = it % IT_WIN, kb = r / 200, nb = r % 200;
        xpose_block(p.in[8] + (size_t)l * D * IN_W, IN_W, 64 * kb, win_src_col(32 * nb + nl), (bf16*)(p.ws + WS_WIN) + (size_t)l * IN_W * D + (size_t)(32 * nb) * D + 64 * kb, D, scr, lane); return; }
    it -= 2 * IT_WIN;
    if (it < 6 * IT_WP) { const int l = it / (3 * IT_WP), r3 = it % (3 * IT_WP), br = r3 / IT_WP, r = r3 % IT_WP, kb = r / 32, nb = r % 32;
        xpose_block((br == 0 ? p.in[21] : br == 1 ? p.in[22] : p.in[23]) + (size_t)l * 512 * D, D, 64 * kb, pcol(32 * nb + nl), (bf16*)(p.ws + WS_WP) + (size_t)l * D * 1536 + (size_t)(32 * nb) * 1536 + br * 512 + 64 * kb, 1536, scr, lane); return; }
    it -= 6 * IT_WP;
    if (it < 2 * IT_WOUT) { const int l = it / IT_WOUT, r = it % IT_WOUT, kb = r / 32, nb = r % 32;
        xpose_block(p.in[24] + (size_t)l * D * D, D, 64 * kb, 32 * nb + nl, (bf16*)(p.ws + WS_WOUT) + (size_t)l * D * D + (size_t)(32 * nb) * D + 64 * kb, D, scr, lane); return; }
    it -= 2 * IT_WOUT;
    if (it < IT_F13) { const int kb = it / 176, nb = it % 176, np = 32 * nb + nl, c = np & 255, j = np >> 8;
        xpose_block_f8(((c >> 7) ? p.in[26] : p.in[25]), DFF, 64 * kb, j * 128 + pcol(c & 127), (unsigned char*)(p.ws + WS_FFN13) + (size_t)(32 * nb) * D + 64 * kb, D, scr, lane, F8_W13); return; }
    it -= IT_F13;
    if (it < IT_F2) { const int kb = it / 32, nb = it % 32;
        xpose_block(p.in[27], D, 64 * kb, 32 * nb + nl, (bf16*)(p.ws + WS_FFN2) + (size_t)(32 * nb) * DFF + 64 * kb, DFF, scr, lane); return; }
    it -= IT_F2;
    if (it < 8 * IT_M13) { const int e = it / IT_M13, r = it % IT_M13, kb = r / 224, nb = r % 224, np = 32 * nb + nl, c = np & 255, j = np >> 8;
        xpose_block_f8(((c >> 7) ? p.in[31] : p.in[30]) + (size_t)e * D * DFFX, DFFX, 64 * kb, j * 128 + pcol(c & 127), (unsigned char*)(p.ws + WS_MOE13) + (size_t)e * 7168 * D + (size_t)(32 * nb) * D + 64 * kb, D, scr, lane, F8_W13); return; }
    it -= 8 * IT_M13;
    { const int e = it / IT_M2, r = it % IT_M2, kb = r / 32, nb = r % 32;
        xpose_block_f8(p.in[32] + (size_t)e * DFFX * D, D, 64 * kb, pcol(32 * nb + nl), (unsigned char*)(p.ws + WS_MOE2) + (size_t)e * D * DFFX + (size_t)(32 * nb) * DFFX + 64 * kb, DFFX, scr, lane, F8_W2); }
}

__device__ __forceinline__ void ph_mod_item(const P& p, int item, float* lds, int tid) {
    const int l = item / 96, n0 = (item % 96) * 64, w = tid >> 6, lane = tid & 63;
    const float* wm = p.in[4] + (size_t)l * D * 6144 + (size_t)(128 * w) * 6144 + n0 + lane;
    float* sl = lds + 8 * 5 * 64;
    for (int i = tid; i < 5 * D; i += 512) { const float v = i < 4 * D ? p.in[1][i] : p.in[3][i - 4 * D]; sl[i] = siluf_(v); }
    __syncthreads();
    float a0 = 0.f, a1 = 0.f, a2 = 0.f, a3 = 0.f, a4 = 0.f;
#pragma unroll 32
    for (int k = 0; k < 128; ++k) { const float wv = wm[(size_t)k * 6144]; const int kk = 128 * w + k;
        a0 += sl[kk] * wv; a1 += sl[D + kk] * wv; a2 += sl[2 * D + kk] * wv; a3 += sl[3 * D + kk] * wv; a4 += sl[4 * D + kk] * wv; }
    lds[(w * 5 + 0) * 64 + lane] = a0; lds[(w * 5 + 1) * 64 + lane] = a1; lds[(w * 5 + 2) * 64 + lane] = a2; lds[(w * 5 + 3) * 64 + lane] = a3; lds[(w * 5 + 4) * 64 + lane] = a4;
    __syncthreads();
    if (tid < 320) { const int bi = tid >> 6; float s = 0.f;
#pragma unroll
        for (int ww = 0; ww < 8; ++ww) s += lds[(ww * 5 + bi) * 64 + lane];
        ((float*)(p.ws + WS_MODV))[(size_t)(l * 5 + bi) * 6144 + n0 + lane] = s + p.in[5][l * 6144 + n0 + lane]; }
    __syncthreads();
}
__device__ __forceinline__ void ph_misc(const P& p, int tid, int nthreads) {
    if (tid < 16) { const int f = tid;
        const double CS[16][2] = {{0.5403023058681397174, 0.84147098480789650665}, {0.84600911028170792533, 0.5331684399140228157}, {0.95041528025518286254, 0.31098359290718572638},
            {0.98423023447009458711, 0.17689218624615003844}, {0.9950041652780257661, 0.099833416646828152307}, {0.99841927779266443401, 0.056204499214692484859},
            {0.99950004166527780258, 0.031617506402433710095}, {0.99984189028361432743, 0.017781856879666127606}, {0.99995000041666527778, 0.0099998333341666646825},
            {0.99998418865336578085, 0.0056233836139601852304}, {0.99999500000416666528, 0.0031622723897082476155}, {0.99999841886158658243, 0.0017782784728035290072},
            {0.99999950000004166667, 0.00099999983333334166667}, {0.99999984188612115825, 0.0005623412955523593817}, {0.99999995000000041667, 0.0003162277607463751926},
            {0.99999998418861174082, 0.00017782794006665673962}};
        double C = 1.0, S = 0.0, c1 = 0.0, s1 = 0.0;
#pragma unroll
        for (int q = 0; q < 16; ++q) if (q == f) { c1 = CS[q][0]; s1 = CS[q][1]; }
        float* t = (float*)(p.ws + WS_ROPE);
        for (int pos = 0; pos < 64; ++pos) { t[pos * 16 + f] = (float)C; t[1024 + pos * 16 + f] = (float)S; const double nc = C * c1 - S * s1, ns = S * c1 + C * s1; C = nc; S = ns; } }
    if (tid < 2) { const int l = tid; float s1 = 0.f, s2 = 0.f;
        for (int k = 0; k < 64; ++k) { s1 += p.in[16][l * 64 + k] * p.in[17][l * 64 + k]; s2 += p.in[18][l * 64 + k] * p.in[19][l * 64 + k]; }
        const float li = 0.8f - 0.6f * expf(-0.3f * (float)l);
        float* t = (float*)(p.ws + WS_LAM); t[l] = expf(s1) - expf(s2) + li; t[2 + l] = li; }
}

__device__ __forceinline__ void norm_row(const float* xrow, const float* g, const float* sc, const float* sh, bf16* orow, int lane, f32x4 (&hv)[4]) {
    f32x4 v[4]; float s = 0.f;
#pragma unroll
    for (int j = 0; j < 4; ++j) { v[j] = *(const f32x4*)(xrow + 4 * lane + 256 * j); s += (v[j].x * v[j].x + v[j].y * v[j].y) + (v[j].z * v[j].z + v[j].w * v[j].w); }
    const float rinv = rsq_(wave_sum(s) * (1.f / D) + EPS);
#pragma unroll
    for (int j = 0; j < 4; ++j) { const int c = 4 * lane + 256 * j; const f32x4 gv = *(const f32x4*)(g + c), scv = *(const f32x4*)(sc + c), shv = *(const f32x4*)(sh + c);
        hv[j] = (v[j] * rinv * gv) * (1.f + scv) + shv;
        u32x2 o; o.x = pk2(hv[j].x, hv[j].y); o.y = pk2(hv[j].z, hv[j].w); *(u32x2*)(orow + c) = o; }
}
__device__ __forceinline__ void ph_norm(const P& p, int l, int which  , int nrows, int gw, int NGW, int lane) {
    const bool first = which == 0 && l == 0; const int lim = first ? nrows : M_LAT;
    const float* g = (which ? p.in[7] : p.in[6]) + l * D;
    f32x4 vc[4], vn[4];
#define NLOAD(R, V) do { if (first) { const float* xr_ = x0_row(p, (R)); _Pragma("unroll") for (int j = 0; j < 4; ++j) V[j] = *(const f32x4*)(xr_ + 4 * lane + 256 * j); } \
        else { const bf16* xb_ = (const bf16*)(p.ws + WS_XB) + (size_t)(R) * D; _Pragma("unroll") for (int j = 0; j < 4; ++j) V[j] = ld_bf4(xb_ + 4 * lane + 256 * j); } } while (0)
    int r = gw; if (r < lim) NLOAD(r, vc);
    for (; r < lim; r += NGW) {
        const int rn = r + NGW; if (rn < lim) NLOAD(rn, vn);
        const int bi = bidx(r); const float* sc = modv(p, l, bi, which ? 4 : 1); const float* sh = modv(p, l, bi, which ? 3 : 0);
        float s = 0.f;
#pragma unroll
        for (int j = 0; j < 4; ++j) s += (vc[j].x * vc[j].x + vc[j].y * vc[j].y) + (vc[j].z * vc[j].z + vc[j].w * vc[j].w);
        const float rinv = rsq_(wave_sum(s) * (1.f / D) + EPS);
#pragma unroll
        for (int j = 0; j < 4; ++j) { const int c = 4 * lane + 256 * j; const f32x4 gv = *(const f32x4*)(g + c), scv = *(const f32x4*)(sc + c), shv = *(const f32x4*)(sh + c);
            const f32x4 h = (vc[j] * rinv * gv) * (1.f + scv) + shv;
            if (which == 0) { u32x2 o; o.x = pk2(h.x, h.y); o.y = pk2(h.z, h.w); *(u32x2*)((bf16*)(p.ws + WS_H) + (size_t)r * D + c) = o; }
            else *(unsigned*)((unsigned char*)(p.ws + WS_H8) + (size_t)r * D + c) = pk4_fp8(h.x, h.y, h.z, h.w); }
#pragma unroll
        for (int j = 0; j < 4; ++j) vc[j] = vn[j];
    }
#undef NLOAD
    if (first) return;
    for (; r < nrows; r += NGW) {
        const float* xr = xs_row(p, r); const int bi = bidx(r);
        {
            const int rc = r - M_LAT, nks = which == 1 ? 4 : 11; const bf16* P = (const bf16*)(p.ws + (which == 1 ? WS_CPO : WS_CPF)) + (size_t)rc * D;
            const float* base = which == 1 ? p.in[2] + (size_t)rc * D : xr; const float* gt = modv(p, 0, 4, which == 1 ? 2 : 5);
            const float* g = (which ? p.in[7] : p.in[6]) + l * D; const float* sc = modv(p, l, bi, which ? 4 : 1); const float* sh = modv(p, l, bi, which ? 3 : 0);
            f32x4 v[4]; float s = 0.f;
#pragma unroll
            for (int j = 0; j < 4; ++j) { const int c = 4 * lane + 256 * j; f32x4 y = (f32x4){0.f, 0.f, 0.f, 0.f};
                for (int ks = 0; ks < nks; ++ks) { const u32x2 a = *(const u32x2*)(P + (size_t)ks * 1024 * 1024 + c);
                    y.x += __uint_as_float(a.x << 16); y.y += __uint_as_float(a.x & 0xffff0000u); y.z += __uint_as_float(a.y << 16); y.w += __uint_as_float(a.y & 0xffff0000u); }
                v[j] = *(const f32x4*)(base + c) + *(const f32x4*)(gt + c) * y; s += (v[j].x * v[j].x + v[j].y * v[j].y) + (v[j].z * v[j].z + v[j].w * v[j].w);
                if (which == 1) *(f32x4*)((float*)(p.ws + WS_XSC) + (size_t)rc * D + c) = v[j]; }
            const float rinv = rsq_(wave_sum(s) * (1.f / D) + EPS); bf16* orow = (bf16*)(p.ws + WS_H) + (size_t)r * D;
#pragma unroll
            for (int j = 0; j < 4; ++j) { const int c = 4 * lane + 256 * j; const f32x4 gv = *(const f32x4*)(g + c), scv = *(const f32x4*)(sc + c), shv = *(const f32x4*)(sh + c);
                const f32x4 h = (v[j] * rinv * gv) * (1.f + scv) + shv;
                if (which == 0) { u32x2 o; o.x = pk2(h.x, h.y); o.y = pk2(h.z, h.w); *(u32x2*)(orow + c) = o; }
                else *(unsigned*)((unsigned char*)(p.ws + WS_H8) + (size_t)r * D + c) = pk4_fp8(h.x, h.y, h.z, h.w); }
        }
    }
}
__device__ __forceinline__ void router_row(const P& p, int r, int lane, unsigned* rowbuf  , const f32x4 (&v)[4], const f32x4 (&wr)[32], int& e1, int& e2, float& p1, float& p2) {
    const int bi = bidx(r); f32x4 hv[4];
    {
        const float* g = p.in[7] + 1 * D; const float* sc = modv(p, 1, bi, 4); const float* sh = modv(p, 1, bi, 3);
        float s = 0.f;
#pragma unroll
        for (int j = 0; j < 4; ++j) s += (v[j].x * v[j].x + v[j].y * v[j].y) + (v[j].z * v[j].z + v[j].w * v[j].w);
        const float rinv = rsq_(wave_sum(s) * (1.f / D) + EPS);
#pragma unroll
        for (int j = 0; j < 4; ++j) { const int c = 4 * lane + 256 * j; const f32x4 gv = *(const f32x4*)(g + c), scv = *(const f32x4*)(sc + c), shv = *(const f32x4*)(sh + c);
            hv[j] = (v[j] * rinv * gv) * (1.f + scv) + shv; rowbuf[lane + 64 * j] = pk4_fp8(hv[j].x, hv[j].y, hv[j].z, hv[j].w); } }
    float lg[8];
#pragma unroll
    for (int e = 0; e < 8; ++e) lg[e] = 0.f;
#pragma unroll
    for (int j = 0; j < 4; ++j)
#pragma unroll
        for (int i = 0; i < 4; ++i) { const f32x4 w0 = wr[(4 * j + i) * 2], w1 = wr[(4 * j + i) * 2 + 1]; const float h = hv[j][i];
            lg[0] += h * w0.x; lg[1] += h * w0.y; lg[2] += h * w0.z; lg[3] += h * w0.w; lg[4] += h * w1.x; lg[5] += h * w1.y; lg[6] += h * w1.z; lg[7] += h * w1.w; }
#pragma unroll
    for (int e = 0; e < 8; ++e) lg[e] = wave_sum(lg[e]) + p.in[29][e];
    e1 = 0; float v1 = lg[0];
#pragma unroll
    for (int e = 1; e < 8; ++e) if (lg[e] > v1) { v1 = lg[e]; e1 = e; }
    e2 = -1; float v2 = -INFINITY;
#pragma unroll
    for (int e = 0; e < 8; ++e) if (e != e1 && lg[e] > v2) { v2 = lg[e]; e2 = e; }
    p1 = 1.f / (1.f + expf(v2 - v1)); p2 = 1.f - p1;
}
__device__ __forceinline__ void ph_router(const P& p, int wg, int nwg, int nw, unsigned char* lds, int tid) {
    unsigned* cnt = (unsigned*)(p.ws + WS_CTL) + CW_CNT;
    const int wave = tid >> 6, lane = tid & 63;
    int* sE = (int*)lds; float* sP = (float*)(lds + 1024); unsigned* sC = (unsigned*)(lds + 2048); int* sS = (int*)(lds + 3072);
    unsigned* rows = (unsigned*)(lds + 4096);
    const int per = 64 / nw;
    f32x4 wr[32];
#pragma unroll
    for (int j = 0; j < 4; ++j)
#pragma unroll
        for (int i = 0; i < 4; ++i) { const int k = 4 * lane + 256 * j + i; wr[(4 * j + i) * 2] = *(const f32x4*)(p.in[28] + (size_t)k * 8); wr[(4 * j + i) * 2 + 1] = *(const f32x4*)(p.in[28] + (size_t)k * 8 + 4); }
    for (int j0 = 0; (j0 * nwg + wg) * nw < M_LAT; j0 += per) {
        if (tid < 16) sC[tid] = 0u;
        if (tid < 128) sE[tid] = -1;
        __syncthreads();
        f32x4 xv[4], xn[4];
#define RLOAD(R, V) do { const bf16* xb_ = (const bf16*)(p.ws + WS_XB) + (size_t)(R) * D; _Pragma("unroll") for (int j = 0; j < 4; ++j) V[j] = ld_bf4(xb_ + 4 * lane + 256 * j); } while (0)
        { const int r0 = (j0 * nwg + wg) * nw + wave; if (r0 < M_LAT) RLOAD(r0, xv); }
        for (int jj = 0; jj < per; ++jj) { const int r = ((j0 + jj) * nwg + wg) * nw + wave, li = jj * nw + wave;
            { const int rnx = ((j0 + jj + 1) * nwg + wg) * nw + wave; if (jj + 1 < per && rnx < M_LAT) RLOAD(rnx, xn); }
            if (r < M_LAT) { int e1, e2; float p1, p2; router_row(p, r, lane, rows + li * 256, xv, wr, e1, e2, p1, p2);
                if (lane == 0) { sE[2 * li] = e1; sE[2 * li + 1] = e2; sP[2 * li] = p1; sP[2 * li + 1] = p2; atomicAdd(&sC[e1], 1u); atomicAdd(&sC[e2], 1u); } }
#pragma unroll
            for (int j = 0; j < 4; ++j) xv[j] = xn[j]; }
#undef RLOAD
        __syncthreads();
        if (tid < 8) sC[8 + tid] = sC[tid] ? atomicAdd(cnt + tid, sC[tid]) : 0u;
        __syncthreads();
        if (tid < 128) { const int e = sE[tid]; if (e >= 0) { int pre = 0; for (int q = 0; q < tid; ++q) pre += (sE[q] == e) ? 1 : 0;
                const int li = tid >> 1, jj = li / nw, w = li % nw, r = ((j0 + jj) * nwg + wg) * nw + w;
                const int slot = (int)sC[8 + e] + pre; sS[tid] = slot;
                ((int*)(p.ws + WS_TOKE))[2 * r + (tid & 1)] = e; ((int*)(p.ws + WS_TOKS))[2 * r + (tid & 1)] = slot; ((float*)(p.ws + WS_EXPP))[e * 16384 + slot] = sP[tid]; } }
        __syncthreads();
        for (int i = tid; i < 128 * 64; i += nw * 64) { const int pr = i >> 6, ck = i & 63, e = sE[pr]; if (e >= 0) { const u32x4 v = *(const u32x4*)(rows + (pr >> 1) * 256 + ck * 4);
                *(u32x4*)((unsigned char*)(p.ws + WS_H2PX) + ((size_t)e * 16384 + sS[pr]) * D + ck * 16) = v; } }
        __syncthreads();
    }
}
__device__ __forceinline__ void moe_bases(const P& p, int (&base)[9]) {
    const unsigned* cnt = (const unsigned*)(p.ws + WS_CTL) + CW_CNT; int b = 0;
#pragma unroll
    for (int e = 0; e < 8; ++e) { base[e] = b; b += (int)((cnt[e] + 255u) & ~255u); }
    base[8] = b;
}
__device__ __forceinline__ void ph_final(const P& p, int gw, int NGW, int lane) {
    int base[9]; moe_bases(p, base);
    const int* te = (const int*)(p.ws + WS_TOKE); const int* ts = (const int*)(p.ws + WS_TOKS);
#define FROWS(R, ROWS) do { _Pragma("unroll") for (int k = 0; k < 2; ++k) { const int e = te[2 * (R) + k]; int bs = 0; _Pragma("unroll") for (int q = 0; q < 8; ++q) bs = (q == e) ? base[q] : bs; ROWS[k] = bs + ts[2 * (R) + k]; } } while (0)
#define FLOAD(R, ROWS, XV, YA) do { const bf16* xb_ = (const bf16*)(p.ws + WS_XB) + (size_t)(R) * D; _Pragma("unroll") for (int j = 0; j < 4; ++j) { const int c = 4 * lane + 256 * j; XV[j] = *(const u32x2*)(xb_ + c); \
        _Pragma("unroll") for (int k = 0; k < 2; ++k) YA[k][j] = ROWS[k] < 32768 ? *(const u32x2*)((const bf16*)(p.ws + WS_H2P) + (size_t)ROWS[k] * D + c) : (u32x2){0u, 0u}; } } while (0)
    int r = gw; int rc[2] = {0, 0}, rn[2] = {0, 0}; u32x2 xc[4], ya[2][4], xn[4], yn[2][4];
    if (r < M_LAT) { FROWS(r, rc); FLOAD(r, rc, xc, ya); }
    for (; r < M_LAT; r += NGW) {
        const int rnx = r + NGW; if (rnx < M_LAT) { FROWS(rnx, rn); FLOAD(rnx, rn, xn, yn); }
        float* xr = p.out + (size_t)r * D; const float* g5 = modv(p, 1, bidx(r), 5);
        f32x4 v[4]; float s = 0.f;
#pragma unroll
        for (int j = 0; j < 4; ++j) { const int c = 4 * lane + 256 * j; const f32x4 g = *(const f32x4*)(g5 + c);
            const f32x4 x = (f32x4){__uint_as_float(xc[j].x << 16), __uint_as_float(xc[j].x & 0xffff0000u), __uint_as_float(xc[j].y << 16), __uint_as_float(xc[j].y & 0xffff0000u)};
            f32x4 y = (f32x4){0.f, 0.f, 0.f, 0.f};
#pragma unroll
            for (int k = 0; k < 2; ++k) { const u32x2 a = ya[k][j];
                y.x += __uint_as_float(a.x << 16); y.y += __uint_as_float(a.x & 0xffff0000u); y.z += __uint_as_float(a.y << 16); y.w += __uint_as_float(a.y & 0xffff0000u);
                if (rc[k] >= 32768) { for (int ks = 0; ks < 7; ++ks) { const u32x2 q = *(const u32x2*)((const bf16*)(p.ws + WS_YPT) + ((size_t)ks * 2048 + (rc[k] - 32768)) * D + c);
                    y.x += __uint_as_float(q.x << 16); y.y += __uint_as_float(q.x & 0xffff0000u); y.z += __uint_as_float(q.y << 16); y.w += __uint_as_float(q.y & 0xffff0000u); } } }
            v[j] = x + g * y; s += (v[j].x * v[j].x + v[j].y * v[j].y) + (v[j].z * v[j].z + v[j].w * v[j].w); }
        const float rinv = rsq_(wave_sum(s) * (1.f / D) + EPS);
#pragma unroll
        for (int j = 0; j < 4; ++j) { const int c = 4 * lane + 256 * j; *(f32x4*)(xr + c) = v[j] * rinv * *(const f32x4*)(p.in[33] + c); }
        rc[0] = rn[0]; rc[1] = rn[1];
#pragma unroll
        for (int j = 0; j < 4; ++j) { xc[j] = xn[j]; ya[0][j] = yn[0][j]; ya[1][j] = yn[1][j]; }
    }
#undef FROWS
#undef FLOAD
}
__device__ __forceinline__ void ph_occomb(const P& p, int l, int nrows, int gw, int NGW, int lane) {
    const float lam = ((const float*)(p.ws + WS_LAM))[l], li = ((const float*)(p.ws + WS_LAM))[2 + l];
    const int h = lane >> 4, dv = (lane & 15) * 8, half = dv >> 6, d = dv & 63;
    for (int r = gw; r < nrows; r += NGW) {
        const u32x4 a = *(const u32x4*)((const bf16*)(p.ws + WS_OCR) + (size_t)r * 1024 + ((h * 2 + 0) * 2 + half) * 64 + d);
        const u32x4 b = *(const u32x4*)((const bf16*)(p.ws + WS_OCR) + (size_t)r * 1024 + ((h * 2 + 1) * 2 + half) * 64 + d);
        float df[8]; float s = 0.f;
#pragma unroll
        for (int i = 0; i < 4; ++i) { df[2 * i] = __uint_as_float(a[i] << 16) - lam * __uint_as_float(b[i] << 16); df[2 * i + 1] = __uint_as_float(a[i] & 0xffff0000u) - lam * __uint_as_float(b[i] & 0xffff0000u); }
#pragma unroll
        for (int i = 0; i < 8; ++i) s += df[i] * df[i];
        s += __shfl_xor(s, 1); s += __shfl_xor(s, 2); s += __shfl_xor(s, 4); s += __shfl_xor(s, 8);
        const float rinv = (1.f - li) / sqrtf(s * (1.f / 128.f) + EPS);
        const float* sg = p.in[20] + l * 128 + dv;
        u32x4 o; o.x = pk2(df[0] * rinv * sg[0], df[1] * rinv * sg[1]); o.y = pk2(df[2] * rinv * sg[2], df[3] * rinv * sg[3]);
        o.z = pk2(df[4] * rinv * sg[4], df[5] * rinv * sg[5]); o.w = pk2(df[6] * rinv * sg[6], df[7] * rinv * sg[7]);
        *(u32x4*)((bf16*)(p.ws + WS_OABC) + (size_t)r * 1536 + 1024 + h * 128 + dv) = o;
    }
}
__device__ __forceinline__ void occomb_rows32(const P& p, int l, int row0, int h, int lane) {
    const float lam = ((const float*)(p.ws + WS_LAM))[l], li = ((const float*)(p.ws + WS_LAM))[2 + l];
    const int rsel = lane >> 4, dv = (lane & 15) * 8, half = dv >> 6, d = dv & 63;
    const float* sg = p.in[20] + l * 128 + dv;
    const f32x4 g0 = *(const f32x4*)sg, g1 = *(const f32x4*)(sg + 4);
#pragma unroll 2
    for (int it = 0; it < 8; ++it) { const int r = row0 + it * 4 + rsel;
        const u32x4 a = *(const u32x4*)((const bf16*)(p.ws + WS_OCR) + (size_t)r * 1024 + ((h * 2 + 0) * 2 + half) * 64 + d);
        const u32x4 b = *(const u32x4*)((const bf16*)(p.ws + WS_OCR) + (size_t)r * 1024 + ((h * 2 + 1) * 2 + half) * 64 + d);
        float df[8]; float s = 0.f;
#pragma unroll
        for (int i = 0; i < 4; ++i) { df[2 * i] = __uint_as_float(a[i] << 16) - lam * __uint_as_float(b[i] << 16); df[2 * i + 1] = __uint_as_float(a[i] & 0xffff0000u) - lam * __uint_as_float(b[i] & 0xffff0000u); }
#pragma unroll
        for (int i = 0; i < 8; ++i) s += df[i] * df[i];
        s += __shfl_xor(s, 1); s += __shfl_xor(s, 2); s += __shfl_xor(s, 4); s += __shfl_xor(s, 8);
        const float rinv = (1.f - li) / sqrtf(s * (1.f / 128.f) + EPS);
        u32x4 o; o.x = pk2(df[0] * rinv * g0.x, df[1] * rinv * g0.y); o.y = pk2(df[2] * rinv * g0.z, df[3] * rinv * g0.w);
        o.z = pk2(df[4] * rinv * g1.x, df[5] * rinv * g1.y); o.w = pk2(df[6] * rinv * g1.z, df[7] * rinv * g1.w);
        *(u32x4*)((bf16*)(p.ws + WS_OABC) + (size_t)r * 1536 + 1024 + h * 128 + dv) = o; }
}
constexpr int CONV_TILES_LAT = M_LAT / 64, CONV_TILES_ALL = CONV_TILES_LAT + M_CTX / 16;
constexpr int CONV_LDS_BYTES = 94 * 1024 + 16 * 512 * 4;
__device__ __forceinline__ void conv_tile(const P& p, int l, int tile, unsigned char* lds, int tid) {
    int s0, len, t0, nsub;
    if (tile < CONV_TILES_LAT) { s0 = (tile >> 6) * SEQ; len = SEQ; t0 = (tile & 63) * 64; nsub = 4; } else { const int q = tile - CONV_TILES_LAT; s0 = M_LAT + (q >> 4) * CTXL; len = CTXL; t0 = (q & 15) * 16; nsub = 1; }
    bf16* yin = (bf16*)lds;
    float* outs = (float*)(lds + 94 * 1024);
    const bf16* Y = (const bf16*)(p.ws + WS_Y);
    const int nin = 16 * nsub + 30;
    {
        u32x4 v[12];
#pragma unroll
        for (int q = 0; q < 12; ++q) { const int i = tid + q * 512, rr = i >> 6, ck = i & 63, tt = t0 - 15 + rr;
            v[q] = (u32x4){0u, 0u, 0u, 0u}; if (i < nin * 64 && tt >= 0 && tt < len) v[q] = *(const u32x4*)(Y + (size_t)(s0 + tt) * 512 + ck * 8); }
#pragma unroll
        for (int q = 0; q < 12; ++q) { const int i = tid + q * 512, rr = i >> 6, ck = i & 63; if (i < nin * 64) *(u32x4*)(yin + rr * 512 + ck * 8) = v[q]; } }
    const int ch = tid, wave = tid >> 6, lane = tid & 63;
    typedef float f32x2c __attribute__((ext_vector_type(2)));
    f32x2c wq[32];
    const float* wp = p.in[12] + (size_t)l * 31 * 512 + ch;
    { float wprev = 0.f;
#pragma unroll
      for (int j = 0; j < 32; ++j) { const float wj = j < 31 ? wp[j * 512] : 0.f; wq[j] = (f32x2c){wj, wprev}; wprev = wj; } }
    const float bias = p.in[13][l * 512 + ch];
    const f32x4 lg0 = *(const f32x4*)(p.in[14] + l * 512 + lane * 8), lg1 = *(const f32x4*)(p.in[14] + l * 512 + lane * 8 + 4);
    const f32x4 lb0 = *(const f32x4*)(p.in[15] + l * 512 + lane * 8), lb1 = *(const f32x4*)(p.in[15] + l * 512 + lane * 8 + 4);
    __syncthreads();
#pragma unroll 1
    for (int sb = 0; sb < nsub; ++sb) {
        f32x2c a2[8];
#pragma unroll
        for (int o = 0; o < 8; ++o) a2[o] = (f32x2c){bias, bias};
#pragma unroll
        for (int i = 0; i < 46; ++i) { const float x = bf2f(yin[(sb * 16 + i) * 512 + ch]); const f32x2c x2 = (f32x2c){x, x};
#pragma unroll
            for (int o = 0; o < 8; ++o) { const int j = i - 2 * o; if (j >= 0 && j < 32) a2[o] = x2 * wq[j] + a2[o]; } }
#pragma unroll
        for (int o = 0; o < 8; ++o) { outs[(2 * o) * 512 + ch] = a2[o][0]; outs[(2 * o + 1) * 512 + ch] = a2[o][1]; }
        __syncthreads();
#pragma unroll
        for (int rr = 0; rr < 2; ++rr) { const int o = 2 * wave + rr;
            f32x4 v0 = *(const f32x4*)(outs + o * 512 + lane * 8), v1 = *(const f32x4*)(outs + o * 512 + lane * 8 + 4);
            const float mean = wave_sum((v0.x + v0.y) + (v0.z + v0.w) + (v1.x + v1.y) + (v1.z + v1.w)) * (1.f / 512.f);
            v0 = v0 - mean; v1 = v1 - mean;
            const float var = wave_sum((v0.x * v0.x + v0.y * v0.y) + (v0.z * v0.z + v0.w * v0.w) + (v1.x * v1.x + v1.y * v1.y) + (v1.z * v1.z + v1.w * v1.w)) * (1.f / 512.f);
            const float rstd = rsq_(var + EPS);
            v0 = v0 * rstd * lg0 + lb0; v1 = v1 * rstd * lg1 + lb1;
            u32x4 ov; ov.x = pk2(siluf_(v0.x), siluf_(v0.y)); ov.y = pk2(siluf_(v0.z), siluf_(v0.w)); ov.z = pk2(siluf_(v1.x), siluf_(v1.y)); ov.w = pk2(siluf_(v1.z), siluf_(v1.w));
            *(u32x4*)((bf16*)(p.ws + WS_OABC) + (size_t)(s0 + t0 + sb * 16 + o) * 1536 + 512 + lane * 8) = ov; }
        __syncthreads();
    }
}


namespace pg8 {
#define PG8_LAS __attribute__((address_space(3)))
typedef unsigned short bf16_t;
typedef short bf16x8 __attribute__((ext_vector_type(8)));
typedef float f32x4 __attribute__((ext_vector_type(4)));
typedef unsigned u32x4 __attribute__((ext_vector_type(4)));
constexpr int BM = 256, BK = 64, HALF = 128, HTB = HALF * BK * 2  , STAGE_BYTES = 8 * HTB, NXCD = 8, WGM = 8;

__host__ __device__ __forceinline__ int lds_byte(int r, int c) { const int st = (r >> 4) * 2 + (c >> 5), rr = r & 15, cc = c & 31, ob = rr * 64 + cc * 2; return st * 1024 + (ob ^ (((ob >> 9) & 1) << 5)); }
__host__ __device__ __forceinline__ void stage_rc(int b, int& R, int& C) { const int st = b / 1024, sb = b % 1024, swz = sb ^ (((sb >> 9) & 1) << 5); R = (st >> 1) * 16 + swz / 64; C = (st & 1) * 32 + (swz % 64) / 2; }
__host__ __device__ __forceinline__ int perm32(int rho) { const int n = rho >> 4, i = rho & 15; return 8 * (i >> 2) + 4 * n + (i & 3); }

typedef int v4i_t __attribute__((ext_vector_type(4))); typedef int v8i_t __attribute__((ext_vector_type(8)));
__device__ __forceinline__ v8i_t pg8_cat(bf16x8 a, bf16x8 b) { const v4i_t x = __builtin_bit_cast(v4i_t, a), y = __builtin_bit_cast(v4i_t, b); return __builtin_shufflevector(x, y, 0, 1, 2, 3, 4, 5, 6, 7); }
struct Unit { int pm, pn, ko, pa; };
struct Gemm { const bf16_t* A; const bf16_t* Bt; int M, N, K, ld; int sc_w, sc_a; int a_pa; };

struct StaticOrder {
    int nM, nN, nwg, G, c;
    __host__ __device__ void init(int M, int N, int G_, int c_) { nM = M / BM; nN = N / BM; nwg = nM * nN; G = G_; c = c_; }
    __host__ __device__ bool next(int i, Unit& u) const {
        const long L = (long)i * G + c; if (L >= nwg) return false;
        int wgid = (int)L; { const int q = nwg / NXCD, r = nwg % NXCD, xcd = wgid % NXCD, off = wgid / NXCD; wgid = (xcd < r ? xcd * (q + 1) : r * (q + 1) + (xcd - r) * q) + off; }
        const int nig = WGM * nN, gid = wgid / nig, fm = gid * WGM, gsz = (nM - fm) < WGM ? (nM - fm) : WGM;
        u.pm = fm + ((wgid % nig) % gsz); u.pn = (wgid % nig) / gsz; u.ko = 0; u.pa = u.pm; return true;
    }
    __device__ __forceinline__ void a_ready(const Unit&) const {}
    __device__ __forceinline__ void done(const Unit&) const {}
};


typedef float f32x2_cv __attribute__((ext_vector_type(2))); typedef __bf16 bf16x2_cv __attribute__((ext_vector_type(2)));
__device__ __forceinline__ unsigned cvt_pk_bf16(float lo, float hi) { f32x2_cv v = {lo, hi}; bf16x2_cv b = __builtin_convertvector(v, bf16x2_cv); return __builtin_bit_cast(unsigned, b); }
typedef float f32x2 __attribute__((ext_vector_type(2)));

struct InprojL1Order {
    StaticOrder so; int G, c;
    __device__ void init(int G_, int c_) { so.init(16384, 6400, G_, c_); G = G_; c = c_; }
    __device__ bool next(int i, Unit& u) const {
        const int L = i * G + c;
        if (L < 1600) return so.next(i, u);
        const int q = L - 1600; if (q >= 20) return false;
        const int k = q % 5; u.pm = 64 + q / 5; u.pn = k == 0 ? 2 : 8 + k; u.ko = 0; u.pa = u.pm; return true;
    }
    __device__ __forceinline__ void a_ready(const Unit&) const {}
    __device__ __forceinline__ void done(const Unit&) const {}
};
struct MoeOrder {
    StaticOrder so; int nper; int t1, t2, t3, t4, t5, t6, t7;
    __device__ void init(const int (&base)[9], int nper_, int G_, int c_, int max_tiles = 1 << 20) { const int nt_ = (base[8] >> 8) < max_tiles ? (base[8] >> 8) : max_tiles; so.init(nt_ * BM, nper_ * BM, G_, c_); nper = nper_;
        t1 = base[1] >> 8; t2 = base[2] >> 8; t3 = base[3] >> 8; t4 = base[4] >> 8; t5 = base[5] >> 8; t6 = base[6] >> 8; t7 = base[7] >> 8; }
    __device__ bool next(int i, Unit& u) const {
        if (!so.next(i, u)) return false;
        const int e = (u.pm >= t1) + (u.pm >= t2) + (u.pm >= t3) + (u.pm >= t4) + (u.pm >= t5) + (u.pm >= t6) + (u.pm >= t7);
        const int te = e == 0 ? 0 : e == 1 ? t1 : e == 2 ? t2 : e == 3 ? t3 : e == 4 ? t4 : e == 5 ? t5 : e == 6 ? t6 : t7;
        u.pn += e * nper; u.pa = e * 64 + (u.pm - te); return true;
    }
    __device__ __forceinline__ void a_ready(const Unit&) const {}
    __device__ __forceinline__ void done(const Unit&) const {}
};

struct CtxSliceOrder {
    int nks, G, c;
    __device__ void init(int nks_, int G_, int c_) { nks = nks_; G = G_; c = c_; }
    __device__ bool next(int i, Unit& u) const {
        const int s = i * G + c; if (s >= 16 * nks) return false;
        const int q = s / nks, r = s % nks; u.pm = 64 + (q >> 2); u.pn = q & 3; u.ko = r * 256; u.pa = u.pm; return true;
    }
    __device__ __forceinline__ void a_ready(const Unit&) const {}
    __device__ __forceinline__ void done(const Unit&) const {}
};
struct MoeTailOrder {
    int ntail, G, c; int t1, t2, t3, t4, t5, t6, t7;
    __device__ void init(const int (&base)[9], int G_, int c_) { ntail = (base[8] >> 8) - 128; G = G_; c = c_;
        t1 = base[1] >> 8; t2 = base[2] >> 8; t3 = base[3] >> 8; t4 = base[4] >> 8; t5 = base[5] >> 8; t6 = base[6] >> 8; t7 = base[7] >> 8; }
    __device__ bool next(int i, Unit& u) const {
        const int s = i * G + c; if (s >= ntail * 28) return false;
        const int tile = s / 28, r = s % 28; u.pm = 128 + tile;
        const int e = (u.pm >= t1) + (u.pm >= t2) + (u.pm >= t3) + (u.pm >= t4) + (u.pm >= t5) + (u.pm >= t6) + (u.pm >= t7);
        const int te = e == 0 ? 0 : e == 1 ? t1 : e == 2 ? t2 : e == 3 ? t3 : e == 4 ? t4 : e == 5 ? t5 : e == 6 ? t6 : t7;
        u.pn = e * 4 + r / 7; u.ko = (r % 7) * 256; u.pa = e * 64 + (u.pm - te); return true;
    }
    __device__ __forceinline__ void a_ready(const Unit&) const {}
    __device__ __forceinline__ void done(const Unit&) const {}
};

__device__ __forceinline__ u32x4 pack8(f32x4 a, f32x4 b) { u32x4 w; w.x = cvt_pk_bf16(a[0], a[1]); w.y = cvt_pk_bf16(a[2], a[3]); w.z = cvt_pk_bf16(b[0], b[1]); w.w = cvt_pk_bf16(b[2], b[3]); return w; }
__device__ __forceinline__ float sigm(float x) { return __builtin_amdgcn_rcpf(1.f + __expf(-x)); }
__device__ __forceinline__ f32x4 sigm4(f32x4 v) { f32x4 r; r[0] = sigm(v[0]); r[1] = sigm(v[1]); r[2] = sigm(v[2]); r[3] = sigm(v[3]); return r; }
__device__ __forceinline__ f32x4 lo4(u32x4 g) { f32x4 r; r[0] = __uint_as_float(g.x << 16); r[1] = __uint_as_float(g.x & 0xffff0000u); r[2] = __uint_as_float(g.y << 16); r[3] = __uint_as_float(g.y & 0xffff0000u); return r; }
__device__ __forceinline__ f32x4 hi4(u32x4 g) { f32x4 r; r[0] = __uint_as_float(g.z << 16); r[1] = __uint_as_float(g.z & 0xffff0000u); r[2] = __uint_as_float(g.w << 16); r[3] = __uint_as_float(g.w & 0xffff0000u); return r; }
typedef unsigned u32x2 __attribute__((ext_vector_type(2)));

struct EpiInproj {
    static constexpr bool PERM = false, AFTER_DRAIN = false, MIDK = false, DUPABLE = true;
    unsigned char* ws; const float* qn_g; const float* kn_g; const float* b_gate;
    __device__ __forceinline__ void operator()(const f32x4 (&acc)[2][2][4][2], const Unit& u, int wr, int wc, int fr, int fq) const {
        const int pn = u.pn, pm = u.pm, row0 = pm * BM + wr * 64 + fr;
        const int kroff = pm < 64 ? (pm >> 4) * 256 : (pm - 64) * 4096 - 12288;
#ifndef DBG_INPROJ
#define DBG_INPROJ 15
#endif
        if (pn >= 13) { if (!(DBG_INPROJ & 1)) return;
            const int gc0 = (pn - 13) * 256 + wc * 32 + 8 * fq; f32x4 bv[2][2];
#pragma unroll
            for (int bj = 0; bj < 2; ++bj)
#pragma unroll
                for (int n = 0; n < 2; ++n) bv[bj][n] = *(const f32x4*)(b_gate + gc0 + 128 * bj + 4 * n);
            unsigned char* gb = ws + WS_G + (size_t)row0 * 3072 + (pn - 13) * 256 + (4 * wc + fq) * 16;
#pragma unroll
            for (int ai = 0; ai < 2; ++ai)
#pragma unroll
                for (int m = 0; m < 4; ++m) { u32x4 w;
#pragma unroll
                    for (int bj = 0; bj < 2; ++bj)
#pragma unroll
                        for (int n = 0; n < 2; ++n) { const f32x4 x = acc[ai][bj][m][n] + bv[bj][n]; unsigned d = 0u;
#pragma unroll
                            for (int e = 0; e < 4; ++e) { const float g255 = __builtin_amdgcn_rcpf(__builtin_fmaf(__expf(-x[e]), 1.f / 255.f, 1.f / 255.f));
                                d = __builtin_amdgcn_cvt_pk_u8_f32(__builtin_fmaxf(g255, 1.f), e, d); }
                            w[2 * bj + n] = d; }
                    *(u32x4*)(gb + (size_t)(ai * HALF + m * 16) * 3072) = w; }
        } else if (pn >= 11) { if (!(DBG_INPROJ & 2)) return;
            const int c0 = (pn - 11) * 256 + wc * 32 + 8 * fq;
#pragma unroll
            for (int ai = 0; ai < 2; ++ai)
#pragma unroll
                for (int m = 0; m < 4; ++m) { bf16_t* dst = (bf16_t*)(ws + WS_VC) + (size_t)(row0 + ai * HALF + m * 16 + kroff) * 512 + c0;
#pragma unroll
                    for (int bj = 0; bj < 2; ++bj) *(u32x4*)(dst + 128 * bj) = pack8(acc[ai][bj][m][0], acc[ai][bj][m][1]); }
        } else if (pn >= 3 && pn < 7) { if (!(DBG_INPROJ & 4)) return;
            const int c0 = (pn - 3) * 128 + wc * 32 + 8 * fq;
#pragma unroll
            for (int ai = 0; ai < 2; ++ai)
#pragma unroll
                for (int m = 0; m < 4; ++m) { bf16_t* dst = (bf16_t*)(ws + WS_Y) + (size_t)(row0 + ai * HALF + m * 16) * 512 + c0;
                    *(u32x4*)dst = pack8(acc[ai][0][m][0] * sigm4(acc[ai][1][m][0]), acc[ai][0][m][1] * sigm4(acc[ai][1][m][1])); }
        } else { if (!(DBG_INPROJ & 8)) return;
            const bool isv = (pn == 2 && wc >= 2), isq = pn < 2 || pn == 7 || pn == 8, normed = pn < 3 && !isv, roped = !isv && pm < 64;
            bf16_t* dst; int pitch, roff;
            if (pn < 2) { dst = (bf16_t*)(ws + WS_QA) + (4 * pn + wc) * 64; pitch = 512; roff = 0; }
            else if (pn == 2) { dst = (bf16_t*)(ws + (wc < 2 ? WS_KA : WS_VA)) + (wc & 1) * 64; pitch = 128; roff = kroff; }
            else if (pn < 9) { dst = (bf16_t*)(ws + WS_QC) + (4 * (pn - 7) + wc) * 64; pitch = 512; roff = 0; }
            else { dst = (bf16_t*)(ws + WS_KC) + (4 * (pn - 9) + wc) * 64; pitch = 512; roff = kroff; }
            dst += isv ? 4 * fq : 8 * fq;
            f32x4 gv[2][2];
            const float* g = isq ? qn_g : kn_g;
#pragma unroll
            for (int bj = 0; bj < 2; ++bj)
#pragma unroll
                for (int n = 0; n < 2; ++n) gv[bj][n] = normed ? *(const f32x4*)(g + 32 * bj + 16 * n + 4 * fq) : (f32x4){1.f, 1.f, 1.f, 1.f};
            const float qs = isq ? C2 : 1.f;
            const float* cosT = (const float*)(ws + WS_ROPE) + 4 * fq; const float* sinT = cosT + 1024;
#pragma unroll
            for (int ai = 0; ai < 2; ++ai)
#pragma unroll
                for (int m = 0; m < 4; ++m) { const int row = row0 + ai * HALF + m * 16;
                    f32x4 v[2][2];
#pragma unroll
                    for (int bj = 0; bj < 2; ++bj)
#pragma unroll
                        for (int n = 0; n < 2; ++n) v[bj][n] = acc[ai][bj][m][n];
                    if (normed) { float ss = 0.f;
#pragma unroll
                        for (int bj = 0; bj < 2; ++bj)
#pragma unroll
                            for (int n = 0; n < 2; ++n) ss += (v[bj][n][0] * v[bj][n][0] + v[bj][n][1] * v[bj][n][1]) + (v[bj][n][2] * v[bj][n][2] + v[bj][n][3] * v[bj][n][3]);
                        ss = ::xsum_x32(::xsum_x16(ss));
                        const float rinv = ::rsq_(ss * (1.f / 64.f) + EPS);
#pragma unroll
                        for (int bj = 0; bj < 2; ++bj)
#pragma unroll
                            for (int n = 0; n < 2; ++n) v[bj][n] = v[bj][n] * rinv * gv[bj][n]; }
                    if (roped) { const int t = row & 4095;
#pragma unroll
                        for (int bj = 0; bj < 2; ++bj) { const int pos = bj ? (t & 63) : (t >> 6); const f32x4 cs = *(const f32x4*)(cosT + pos * 16), sn = *(const f32x4*)(sinT + pos * 16);
                            const f32x4 x1 = v[bj][0], x2 = v[bj][1]; v[bj][0] = x1 * cs - x2 * sn; v[bj][1] = x2 * cs + x1 * sn; } }
                    bf16_t* rp = dst + (size_t)(row + roff) * pitch;
                    if (isv) {
#pragma unroll
                        for (int bj = 0; bj < 2; ++bj)
#pragma unroll
                            for (int n = 0; n < 2; ++n) { const f32x4 o = v[bj][n]; u32x2 w; w.x = cvt_pk_bf16(o[0], o[1]); w.y = cvt_pk_bf16(o[2], o[3]); *(u32x2*)(rp + 32 * bj + 16 * n) = w; } }
                    else {
#pragma unroll
                        for (int bj = 0; bj < 2; ++bj) *(u32x4*)(rp + 32 * bj) = pack8(v[bj][0] * qs, v[bj][1] * qs); }
                }
        }
    }
};
struct EpiMerge {
    static constexpr bool PERM = false, AFTER_DRAIN = false, MIDK = true, DUPABLE = false;
    const unsigned char* G; bf16_t* MB;
    static __device__ __forceinline__ float ub(unsigned w, int k) { return (float)((w >> (8 * k)) & 0xffu); }
    __device__ __forceinline__ void mid(f32x4 (&acc)[2][2][4][2], const Unit& u, int wr, int wc, int fr, int fq, int seg) const {
        const unsigned rowb = (unsigned)(u.pm * BM + wr * 64 + fr) * 3072u + (unsigned)((seg - 1) * 1024 + u.pn * 256 + (4 * wc + fq) * 16);
        const unsigned char* Gb = G;
#pragma unroll
        for (int ai = 0; ai < 2; ++ai) { u32x4 ga[4], gb[4];
#pragma unroll
            for (int m = 0; m < 4; ++m) { const unsigned o = rowb + (unsigned)(ai * HALF + m * 16) * 3072u; ga[m] = *(const u32x4*)(Gb + o); gb[m] = *(const u32x4*)(Gb + (o + 1024u)); }
#pragma unroll
            for (int m = 0; m < 4; ++m)
#pragma unroll
                for (int bj = 0; bj < 2; ++bj)
#pragma unroll
                    for (int n = 0; n < 2; ++n) { const unsigned a = ga[m][2 * bj + n], b = gb[m][2 * bj + n]; f32x4 r;
#pragma unroll
                        for (int e = 0; e < 4; ++e) r[e] = ub(a, e) * __builtin_amdgcn_rcpf(ub(b, e));
                        acc[ai][bj][m][n] *= r; }
            asm volatile("" ::: "memory"); }
    }
    __device__ __forceinline__ void operator()(const f32x4 (&acc)[2][2][4][2], const Unit& u, int wr, int wc, int fr, int fq) const {
        const int row0 = u.pm * BM + wr * 64 + fr, c0 = u.pn * 256 + wc * 32 + 8 * fq;
#pragma unroll
        for (int ai = 0; ai < 2; ++ai)
#pragma unroll
            for (int m = 0; m < 4; ++m) { const int row = row0 + ai * HALF + m * 16; const u32x4 g = *(const u32x4*)(G + (size_t)row * 3072 + 2048 + u.pn * 256 + (4 * wc + fq) * 16);
#pragma unroll
                for (int bj = 0; bj < 2; ++bj) { f32x4 g0, g1;
#pragma unroll
                    for (int e = 0; e < 4; ++e) { g0[e] = ub(g[2 * bj], e) * (1.f / 255.f); g1[e] = ub(g[2 * bj + 1], e) * (1.f / 255.f); }
                    *(u32x4*)(MB + (size_t)row * 1024 + c0 + 128 * bj) = pack8(acc[ai][bj][m][0] * g0, acc[ai][bj][m][1] * g1); } }
    }
};
struct EpiResid {
    static constexpr bool PERM = false, AFTER_DRAIN = false, MIDK = false, DUPABLE = false;
    __device__ __forceinline__ int nst(const Unit&) const { return 0; }
    const float* base_f32; bf16_t* xb; const float* gate;
    __device__ __forceinline__ void operator()(const f32x4 (&acc)[2][2][4][2], const Unit& u, int wr, int wc, int fr, int fq) const {
        const int pm = u.pm, c0 = u.pn * 256 + wc * 32 + 4 * fq, bi = pm >> 4, row0 = pm * BM + wr * 64 + fr;
        f32x4 gv[2][2];
#pragma unroll
        for (int bj = 0; bj < 2; ++bj)
#pragma unroll
            for (int n = 0; n < 2; ++n) gv[bj][n] = *(const f32x4*)(gate + (size_t)bi * 6 * 1024 + c0 + 128 * bj + 16 * n);
#pragma unroll
        for (int ai = 0; ai < 2; ++ai)
#pragma unroll
            for (int m = 0; m < 4; ++m) { const size_t off = (size_t)(row0 + ai * HALF + m * 16) * 1024 + c0;
#pragma unroll
                for (int bj = 0; bj < 2; ++bj)
#pragma unroll
                    for (int n = 0; n < 2; ++n) { const size_t o = off + 128 * bj + 16 * n; f32x4 b;
                        if (base_f32) b = *(const f32x4*)(base_f32 + o);
                        else { const u32x2 q = *(const u32x2*)(xb + o); b[0] = __uint_as_float(q.x << 16); b[1] = __uint_as_float(q.x & 0xffff0000u); b[2] = __uint_as_float(q.y << 16); b[3] = __uint_as_float(q.y & 0xffff0000u); }
                        const f32x4 r = b + gv[bj][n] * acc[ai][bj][m][n]; u32x2 w; w.x = cvt_pk_bf16(r[0], r[1]); w.y = cvt_pk_bf16(r[2], r[3]); *(u32x2*)(xb + o) = w; } }
    }
};
struct EpiSwiglu {
    static constexpr bool PERM = false, AFTER_DRAIN = false, MIDK = false, DUPABLE = false;
    bf16_t* O; int ld, nper;
    __device__ __forceinline__ void operator()(const f32x4 (&acc)[2][2][4][2], const Unit& u, int wr, int wc, int fr, int fq) const {
        const int row0 = u.pm * BM + wr * 64 + fr, c0 = (u.pn % nper) * 128 + wc * 32 + 8 * fq;
#pragma unroll
        for (int ai = 0; ai < 2; ++ai)
#pragma unroll
            for (int m = 0; m < 4; ++m) { const f32x4 a0 = acc[ai][0][m][0], a1 = acc[ai][0][m][1];
                *(u32x4*)(O + (size_t)(row0 + ai * HALF + m * 16) * ld + c0) = pack8(a0 * sigm4(a0) * acc[ai][1][m][0], a1 * sigm4(a1) * acc[ai][1][m][1]); }
    }
};
struct EpiSwigluF8 {
    static constexpr bool PERM = false, AFTER_DRAIN = false, MIDK = false, DUPABLE = false;
    unsigned char* O; int ld, nper;
    __device__ __forceinline__ void operator()(const f32x4 (&acc)[2][2][4][2], const Unit& u, int wr, int wc, int fr, int fq) const {
        const int row0 = u.pm * BM + wr * 64 + fr, c0 = (u.pn % nper) * 128 + wc * 32 + 8 * fq;
#pragma unroll
        for (int ai = 0; ai < 2; ++ai)
#pragma unroll
            for (int m = 0; m < 4; ++m) { const f32x4 a0 = acc[ai][0][m][0], a1 = acc[ai][0][m][1];
                const f32x4 y0 = a0 * sigm4(a0) * acc[ai][1][m][0] * 4.f, y1 = a1 * sigm4(a1) * acc[ai][1][m][1] * 4.f;
                u32x2 w; w.x = __builtin_amdgcn_cvt_pk_fp8_f32(y0[2], y0[3], __builtin_amdgcn_cvt_pk_fp8_f32(y0[0], y0[1], 0u, false), true);
                w.y = __builtin_amdgcn_cvt_pk_fp8_f32(y1[2], y1[3], __builtin_amdgcn_cvt_pk_fp8_f32(y1[0], y1[1], 0u, false), true);
                *(u32x2*)(O + (size_t)(row0 + ai * HALF + m * 16) * ld + c0) = w; }
    }
};
struct EpiCtxPartial {
    static constexpr bool PERM = false, AFTER_DRAIN = false, MIDK = false, DUPABLE = false;
    bf16_t* P;
    __device__ __forceinline__ void operator()(const f32x4 (&acc)[2][2][4][2], const Unit& u, int wr, int wc, int fr, int fq) const {
        const int row0 = (u.pm - 64) * BM + wr * 64 + fr, c0 = u.pn * 256 + wc * 32 + 4 * fq; bf16_t* Y = P + (size_t)(u.ko >> 8) * 1024 * 1024;
#pragma unroll
        for (int ai = 0; ai < 2; ++ai)
#pragma unroll
            for (int m = 0; m < 4; ++m) { const int row = row0 + ai * HALF + m * 16;
#pragma unroll
                for (int bj = 0; bj < 2; ++bj)
#pragma unroll
                    for (int n = 0; n < 2; ++n) { const f32x4 a = acc[ai][bj][m][n]; u32x2 w; w.x = cvt_pk_bf16(a[0], a[1]); w.y = cvt_pk_bf16(a[2], a[3]); *(u32x2*)(Y + (size_t)row * 1024 + c0 + 128 * bj + 16 * n) = w; } }
    }
};
struct EpiMoeDownTail {
    static constexpr bool PERM = false, AFTER_DRAIN = false, MIDK = false, DUPABLE = false;
    bf16_t* YPT; const float* rowp;
    __device__ __forceinline__ void operator()(const f32x4 (&acc)[2][2][4][2], const Unit& u, int wr, int wc, int fr, int fq) const {
        const int row0 = u.pm * BM + wr * 64 + fr, c0 = (u.pn & 3) * 256 + wc * 32 + 8 * fq; bf16_t* Y = YPT + (size_t)(u.ko >> 8) * 2048 * 1024 - (size_t)32768 * 1024;
#pragma unroll
        for (int ai = 0; ai < 2; ++ai)
#pragma unroll
            for (int m = 0; m < 4; ++m) { const int row = row0 + ai * HALF + m * 16; const float rp = rowp[u.pa * BM + wr * 64 + fr + ai * HALF + m * 16];
#pragma unroll
                for (int bj = 0; bj < 2; ++bj) *(u32x4*)(Y + (size_t)row * 1024 + c0 + 128 * bj) = pack8(acc[ai][bj][m][0] * rp, acc[ai][bj][m][1] * rp); }
    }
};
struct EpiMoeDown {
    static constexpr bool PERM = false, AFTER_DRAIN = false, MIDK = false, DUPABLE = false;
    bf16_t* YP; const float* rowp;
    __device__ __forceinline__ void operator()(const f32x4 (&acc)[2][2][4][2], const Unit& u, int wr, int wc, int fr, int fq) const {
        const int row0 = u.pm * BM + wr * 64 + fr, c0 = (u.pn & 3) * 256 + wc * 32 + 8 * fq;
#pragma unroll
        for (int ai = 0; ai < 2; ++ai)
#pragma unroll
            for (int m = 0; m < 4; ++m) { const int row = row0 + ai * HALF + m * 16; const float rp = rowp[u.pa * BM + wr * 64 + fr + ai * HALF + m * 16];
#pragma unroll
                for (int bj = 0; bj < 2; ++bj) *(u32x4*)(YP + (size_t)row * 1024 + c0 + 128 * bj) = pack8(acc[ai][bj][m][0] * rp, acc[ai][bj][m][1] * rp); }
    }
};

template <class Epi, class Sched, bool ALIGN_EPI = false, bool SP2 = false, bool F8 = false>
__device__ __forceinline__ void gemm_phase(PG8_LAS unsigned char* lds, const Gemm g, const Sched& S, const Epi& E) {
    int tid_o = threadIdx.x; asm volatile("" : "+v"(tid_o));
    const int tid = tid_o, wid = __builtin_amdgcn_readfirstlane(tid >> 6), lane = tid & 63, wr = wid >> 2, wc = wid & 3, fr = lane & 15, fq = lane >> 4;
    const int K = g.K, nt = K / BK;
    unsigned voffA[2], voffB[2];
#pragma unroll
    for (int i = 0; i < 2; ++i) { int R, C; stage_rc(tid * 16 + i * 8192, R, C); const int Rb = Epi::PERM ? ((R & ~31) + perm32(R & 31)) : R;
        voffA[i] = (unsigned)(R * g.ld + C) * 2u; voffB[i] = (unsigned)(Rb * g.ld + C) * 2u; }
    const size_t kstep = (size_t)(BK * 2);
    const size_t hstep = (size_t)HALF * g.ld * 2;
    const size_t tstep = 2 * hstep;
    const unsigned ldsw = (unsigned)wid * 1024u;
    const int aoff = lds_byte(wr * 64 + fr, fq * 8), boff = lds_byte(wc * 32 + fr, fq * 8);
#define PG8_SA(b, h) (((b) * 2 + (h)) * HTB)
#define PG8_SB(b, h) ((4 + (b) * 2 + (h)) * HTB)
#define PG8_STAGE(bufoff, gbase, voff) do { _Pragma("unroll") for (int _i = 0; _i < 2; ++_i) \
        __builtin_amdgcn_global_load_lds((const unsigned*)((const char*)(gbase) + (voff)[_i]), (PG8_LAS unsigned*)(lds + (bufoff) + ldsw + _i * 8192), 16, 0, 0); } while (0)
#define PG8_LDA(dst, b, h) do { if constexpr (F8) { _Pragma("unroll") for (int m = 0; m < 4; ++m) { const v4i_t x_ = *(const PG8_LAS v4i_t*)(lds + PG8_SA(b, h) + aoff + m * 2048), y_ = *(const PG8_LAS v4i_t*)(lds + PG8_SA(b, h) + aoff + m * 2048 + 1024); dst##8[m] = __builtin_shufflevector(x_, y_, 0, 1, 2, 3, 4, 5, 6, 7); } } \
        else { _Pragma("unroll") for (int m = 0; m < 4; ++m) _Pragma("unroll") for (int k = 0; k < 2; ++k) dst[m][k] = *(const PG8_LAS bf16x8*)(lds + PG8_SA(b, h) + aoff + m * 2048 + k * 1024); } } while (0)
#define PG8_LDB(dst, b, h) do { if constexpr (F8) { _Pragma("unroll") for (int n = 0; n < 2; ++n) { const v4i_t x_ = *(const PG8_LAS v4i_t*)(lds + PG8_SB(b, h) + boff + n * 2048), y_ = *(const PG8_LAS v4i_t*)(lds + PG8_SB(b, h) + boff + n * 2048 + 1024); dst##8[n] = __builtin_shufflevector(x_, y_, 0, 1, 2, 3, 4, 5, 6, 7); } } \
        else { _Pragma("unroll") for (int n = 0; n < 2; ++n) _Pragma("unroll") for (int k = 0; k < 2; ++k) dst[n][k] = *(const PG8_LAS bf16x8*)(lds + PG8_SB(b, h) + boff + n * 2048 + k * 1024); } } while (0)
#define PG8_MMA(ai, bj, At, Bt) do { if constexpr (F8) { __builtin_amdgcn_s_setprio(1); _Pragma("unroll") for (int m = 0; m < 4; ++m) _Pragma("unroll") for (int n = 0; n < 2; ++n) \
        asm volatile("v_mfma_scale_f32_16x16x128_f8f6f4 %0, %1, %2, %0, %3, %4 op_sel_hi:[0,0,0]" : "+v"(acc[ai][bj][m][n]) : "v"(Bt##8[n]), "v"(At##8[m]), "v"(scw_), "v"(sca_));     __builtin_amdgcn_s_setprio(0); } else { __builtin_amdgcn_s_setprio(1); _Pragma("unroll") for (int m = 0; m < 4; ++m) _Pragma("unroll") for (int n = 0; n < 2; ++n) _Pragma("unroll") for (int k = 0; k < 2; ++k) \
        acc[ai][bj][m][n] = __builtin_amdgcn_mfma_f32_16x16x32_bf16(Bt[n][k], At[m][k], acc[ai][bj][m][n], 0, 0, 0); __builtin_amdgcn_s_setprio(0); } } while (0)
#define PG8_WAIT_V(n) asm volatile("s_waitcnt vmcnt(" #n ")" ::: "memory")
#define PG8_WAIT_L(n) asm volatile("s_waitcnt lgkmcnt(" #n ")" ::: "memory")
#define PG8_BAR __builtin_amdgcn_s_barrier()
#define PG8_SCHED __builtin_amdgcn_sched_barrier(0)
    Unit cur, nxt; int ui = 0;
    if (!S.next(0, cur)) return;
    f32x4 acc[2][2][4][2];
#pragma unroll
    for (int a = 0; a < 2; ++a)
#pragma unroll
        for (int b = 0; b < 2; ++b)
#pragma unroll
            for (int m = 0; m < 4; ++m)
#pragma unroll
                for (int n = 0; n < 2; ++n) acc[a][b][m][n] = (f32x4){0.f, 0.f, 0.f, 0.f};
    int scw_ = g.sc_w, sca_ = g.sc_a; asm volatile("" : "+v"(scw_), "+v"(sca_));
    bf16x8 At[4][2], B0[2][2], B1[2][2]; v8i_t At8[4], B08[2], B18[2];
    const char* cA = (const char*)g.A + (size_t)(g.a_pa ? cur.pa : cur.pm) * tstep + (size_t)cur.ko * 2; const char* cB = (const char*)g.Bt + (size_t)cur.pn * tstep + (size_t)cur.ko * 2;
    S.a_ready(cur);
    if constexpr (SP2) {
        PG8_STAGE(PG8_SB(0, 0), cB, voffB); PG8_STAGE(PG8_SB(0, 1), cB + hstep, voffB); PG8_STAGE(PG8_SA(0, 0), cA, voffA); PG8_STAGE(PG8_SA(0, 1), cA + hstep, voffA);
        if (wr == 1) PG8_BAR;
        PG8_WAIT_V(2); PG8_BAR;
        PG8_STAGE(PG8_SB(1, 0), cB + kstep, voffB); PG8_STAGE(PG8_SA(1, 0), cA + kstep, voffA); PG8_STAGE(PG8_SB(1, 1), cB + hstep + kstep, voffB);
        PG8_WAIT_V(6); PG8_BAR;
    } else {
        PG8_STAGE(PG8_SB(0, 0), cB, voffB); PG8_STAGE(PG8_SA(0, 0), cA, voffA); PG8_STAGE(PG8_SB(0, 1), cB + hstep, voffB); PG8_STAGE(PG8_SA(0, 1), cA + hstep, voffA);
        if (wr == 1) PG8_BAR;
        PG8_WAIT_V(4); PG8_BAR;
        PG8_STAGE(PG8_SB(1, 0), cB + kstep, voffB); PG8_STAGE(PG8_SA(1, 0), cA + kstep, voffA); PG8_STAGE(PG8_SB(1, 1), cB + hstep + kstep, voffB);
        PG8_WAIT_V(6); PG8_BAR;
    }
    for (;;) {
        const bool has_next = S.next(ui + 1, nxt);
        const char* nA = has_next ? (const char*)g.A + (size_t)(g.a_pa ? nxt.pa : nxt.pm) * tstep + (size_t)nxt.ko * 2 : cA; const char* nB = has_next ? (const char*)g.Bt + (size_t)nxt.pn * tstep + (size_t)nxt.ko * 2 : cB;
#pragma unroll 1
        for (int t = 0; t < nt; t += 2) {
            const bool last = (t == nt - 2);
            const char* a1 = cA + (size_t)(t + 1) * kstep;
            const char* a2 = last ? nA : cA + (size_t)(t + 2) * kstep; const char* b2 = last ? nB : cB + (size_t)(t + 2) * kstep;
            const char* a3 = a2 + kstep; const char* b3 = b2 + kstep;
            if (last && has_next) S.a_ready(nxt);
            if constexpr (Epi::MIDK) { if (t == 8 || t == 16) E.mid(acc, cur, wr, wc, fr, fq, t >> 3); }
            if constexpr (SP2) {
            PG8_LDB(B0, 0, 0); PG8_LDB(B1, 0, 1); PG8_SCHED; PG8_LDA(At, 0, 0); PG8_STAGE(PG8_SA(1, 1), a1 + hstep, voffA);
            PG8_WAIT_V(8); PG8_WAIT_L(0); PG8_BAR; PG8_MMA(0, 0, At, B0); PG8_MMA(0, 1, At, B1); PG8_BAR; PG8_SCHED;
            PG8_LDA(At, 0, 1); PG8_STAGE(PG8_SB(0, 0), b2, voffB); PG8_STAGE(PG8_SB(0, 1), b2 + hstep, voffB); PG8_STAGE(PG8_SA(0, 0), a2, voffA);
            PG8_WAIT_V(8); PG8_WAIT_L(0); PG8_BAR; PG8_MMA(1, 0, At, B0); PG8_MMA(1, 1, At, B1); PG8_BAR; PG8_SCHED;
            PG8_LDB(B0, 1, 0); PG8_LDB(B1, 1, 1); PG8_SCHED; PG8_LDA(At, 1, 0); PG8_STAGE(PG8_SA(0, 1), a2 + hstep, voffA);
            PG8_WAIT_V(8); PG8_WAIT_L(0); PG8_BAR; PG8_MMA(0, 0, At, B0); PG8_MMA(0, 1, At, B1); PG8_BAR; PG8_SCHED;
            PG8_LDA(At, 1, 1); PG8_STAGE(PG8_SB(1, 0), b3, voffB); PG8_STAGE(PG8_SB(1, 1), b3 + hstep, voffB); PG8_STAGE(PG8_SA(1, 0), a3, voffA);
            PG8_WAIT_V(8); PG8_WAIT_L(0); PG8_BAR; PG8_MMA(1, 0, At, B0); PG8_MMA(1, 1, At, B1); PG8_BAR; PG8_SCHED;
            } else {
            PG8_LDB(B0, 0, 0); PG8_SCHED; PG8_LDA(At, 0, 0); PG8_STAGE(PG8_SA(1, 1), a1 + hstep, voffA);
            PG8_WAIT_L(8); PG8_BAR; PG8_WAIT_L(0); PG8_MMA(0, 0, At, B0); PG8_BAR; PG8_SCHED;
            PG8_LDB(B1, 0, 1); PG8_STAGE(PG8_SB(0, 0), b2, voffB);
            PG8_BAR; PG8_WAIT_L(0); PG8_MMA(0, 1, At, B1); PG8_BAR;
            PG8_LDA(At, 0, 1); PG8_STAGE(PG8_SA(0, 0), a2, voffA);
            PG8_BAR; PG8_WAIT_L(0); PG8_MMA(1, 0, At, B0); PG8_BAR; PG8_SCHED;
            PG8_STAGE(PG8_SB(0, 1), b2 + hstep, voffB);
            PG8_WAIT_V(6); PG8_BAR; PG8_MMA(1, 1, At, B1); PG8_BAR;
            PG8_LDB(B0, 1, 0); PG8_SCHED; PG8_LDA(At, 1, 0); PG8_STAGE(PG8_SA(0, 1), a2 + hstep, voffA);
            PG8_WAIT_L(8); PG8_BAR; PG8_WAIT_L(0); PG8_MMA(0, 0, At, B0); PG8_BAR; PG8_SCHED;
            PG8_LDB(B1, 1, 1); PG8_STAGE(PG8_SB(1, 0), b3, voffB);
            PG8_BAR; PG8_WAIT_L(0); PG8_MMA(0, 1, At, B1); PG8_BAR;
            PG8_LDA(At, 1, 1); PG8_STAGE(PG8_SA(1, 0), a3, voffA);
            PG8_BAR; PG8_WAIT_L(0); PG8_MMA(1, 0, At, B0); PG8_BAR; PG8_SCHED;
            PG8_STAGE(PG8_SB(1, 1), b3 + hstep, voffB);
            PG8_WAIT_V(6); PG8_BAR; PG8_MMA(1, 1, At, B1); PG8_BAR;
            }
        }
        if constexpr (F8) asm volatile("s_nop 15\n\ts_nop 7" ::: "memory");
        if constexpr (ALIGN_EPI) { if (wr == 0) PG8_BAR; }
        if constexpr (!Epi::AFTER_DRAIN) { E(acc, cur, wr, wc, fr, fq);
#ifdef DUP_EPI
            if constexpr (Epi::DUPABLE) { asm volatile("" ::: "memory"); E(acc, cur, wr, wc, fr, fq); }
#endif
            S.done(cur); }
        if (!has_next) break;
#pragma unroll
        for (int a = 0; a < 2; ++a)
#pragma unroll
            for (int b = 0; b < 2; ++b)
#pragma unroll
                for (int m = 0; m < 4; ++m)
#pragma unroll
                    for (int n = 0; n < 2; ++n) acc[a][b][m][n] = (f32x4){0.f, 0.f, 0.f, 0.f};
        cur = nxt; cA = nA; cB = nB; ++ui;
        if constexpr (ALIGN_EPI) { if (wr == 1) PG8_BAR; }
    }
    PG8_WAIT_V(0);
    if constexpr (!ALIGN_EPI) { if (wr == 0) PG8_BAR; }
    PG8_BAR;
    if constexpr (Epi::AFTER_DRAIN) { E.fused(acc, cur, wr, wc, fr, fq, lds, wid, lane); S.done(cur); }
#undef PG8_SA
#undef PG8_SB
#undef PG8_STAGE
#undef PG8_LDA
#undef PG8_LDB
#undef PG8_MMA
#undef PG8_WAIT_V
#undef PG8_WAIT_L
#undef PG8_BAR
#undef PG8_SCHED
}
}


#include <hip/hip_bf16.h>
#include <cmath>

namespace attn_body {
using bf16=__hip_bfloat16;
using bf16x8=__attribute__((ext_vector_type(8)))short;
using s16x4=__attribute__((ext_vector_type(4)))short;
using f32x16=__attribute__((ext_vector_type(16)))float;
using u32x4=__attribute__((ext_vector_type(4)))unsigned;
constexpr int D=64;
constexpr int NW=8,QBLK=32,QB=QBLK*NW,KVBLK=64;
constexpr int ATTN_UNIT_ROWS=QB;
__device__ __forceinline__ int crow(int r,int hi){return (r&3)+8*(r>>2)+4*hi;}
#define SBAR() __builtin_amdgcn_sched_barrier(0)
__device__ __forceinline__ void cmask(f32x16&p0,f32x16&p1,int jb,int qrel,int hi){
  const float NEG=-INFINITY; int kb=64*jb+4*hi;
  #pragma unroll
  for(int r=0;r<16;++r){int kv=kb+(r&3)+8*(r>>2); if(kv>qrel)p0[r]=NEG; if(kv+32>qrel)p1[r]=NEG;}
}

constexpr int NSLOT=3, SLOTB=8192;
constexpr int LDS_K=0, LDS_V=NSLOT*SLOTB, LDS_WS=2*NSLOT*SLOTB, LDS_OST=LDS_WS+NW*64*4, LDS_BYTES=LDS_OST+NW*4096;
constexpr float C2=0.125f*1.4426950408889634f;
__device__ __forceinline__ void glds16(const void*gsrc,unsigned lds_dst){unsigned keep;
  asm volatile("s_mov_b32 %0, m0\n\ts_mov_b32 m0, %2\n\ts_nop 0\n\tglobal_load_lds_dwordx4 %1, off\n\ts_mov_b32 m0, %0":"=&s"(keep):"v"(gsrc),"s"(lds_dst):"memory");}
__device__ __forceinline__ float max3f(float a,float b,float c){float r;asm("v_max3_f32 %0, %1, %2, %3":"=v"(r):"v"(a),"v"(b),"v"(c));return r;}
__device__ __forceinline__ float max2f(float a,float b){float r;asm("v_max_f32_e32 %0, %1, %2":"=v"(r):"v"(a),"v"(b));return r;}
__device__ __forceinline__ float fadd_s(float a,float b){float r;asm("v_add_f32_e32 %0, %1, %2":"=v"(r):"v"(a),"v"(b));return r;}
__device__ __forceinline__ float fsub_s(float a,float b){float r;asm("v_sub_f32_e32 %0, %1, %2":"=v"(r):"v"(a),"v"(b));return r;}
typedef float f32x2_t __attribute__((ext_vector_type(2))); typedef __bf16 bf16x2_t __attribute__((ext_vector_type(2)));
__device__ __forceinline__ unsigned cvtpk_s(float lo,float hi){f32x2_t v={lo,hi};bf16x2_t b=__builtin_convertvector(v,bf16x2_t);return __builtin_bit_cast(unsigned,b);}
#define WAIT_BAR(N) asm volatile("s_waitcnt vmcnt(" #N ") lgkmcnt(0)\n\ts_barrier":::"memory")

__device__ __forceinline__ void qkt(f32x16&p0,f32x16&p1,const char*Kslot,const bf16x8*qr,const f32x16&negm,int r32,int hi){
  const char*kb=Kslot+hi*1024+r32*16;
  #pragma unroll
  for(int d0=0;d0<4;++d0){
    const bf16x8 b0=*reinterpret_cast<const bf16x8*>(kb+d0*2048);
    const bf16x8 b1=*reinterpret_cast<const bf16x8*>(kb+d0*2048+512);
    if(d0==0){p0=__builtin_amdgcn_mfma_f32_32x32x16_bf16(b0,qr[0],negm,0,0,0);p1=__builtin_amdgcn_mfma_f32_32x32x16_bf16(b1,qr[0],negm,0,0,0);}
    else{p0=__builtin_amdgcn_mfma_f32_32x32x16_bf16(b0,qr[d0],p0,0,0,0);p1=__builtin_amdgcn_mfma_f32_32x32x16_bf16(b1,qr[d0],p1,0,0,0);}}
}
typedef __attribute__((address_space(3))) const char* lds_cptr;
typedef short v4i16_t __attribute__((ext_vector_type(4)));
__device__ __forceinline__ void kload8(bf16x8*kf,lds_cptr kp){
  kf[0]=*(const __attribute__((address_space(3))) bf16x8*)(kp);      kf[1]=*(const __attribute__((address_space(3))) bf16x8*)(kp+512);
  kf[2]=*(const __attribute__((address_space(3))) bf16x8*)(kp+2048); kf[3]=*(const __attribute__((address_space(3))) bf16x8*)(kp+2560);
  kf[4]=*(const __attribute__((address_space(3))) bf16x8*)(kp+4096); kf[5]=*(const __attribute__((address_space(3))) bf16x8*)(kp+4608);
  kf[6]=*(const __attribute__((address_space(3))) bf16x8*)(kp+6144); kf[7]=*(const __attribute__((address_space(3))) bf16x8*)(kp+6656);
}
__device__ __forceinline__ void kload2(bf16x8*kf,lds_cptr kp,int j){ kf[2*j]=*(const __attribute__((address_space(3))) bf16x8*)(kp+j*2048); kf[2*j+1]=*(const __attribute__((address_space(3))) bf16x8*)(kp+j*2048+512); }
__device__ __forceinline__ s16x4 vtr(lds_cptr p){ return __builtin_bit_cast(s16x4,__builtin_amdgcn_ds_read_tr16_b64_v4i16((__attribute__((address_space(3))) v4i16_t*)p)); }
__device__ __forceinline__ float rowmax(const f32x16&p0,const f32x16&p1){
  float a=max3f(p0[0],p0[1],p1[0]),b=max3f(p0[2],p0[3],p1[1]);a=max3f(a,p1[2],p1[3]);
  #pragma unroll
  for(int r=4;r<16;r+=4){a=max3f(a,p0[r],p0[r+1]);b=max3f(b,p0[r+2],p0[r+3]);a=max3f(a,p1[r],p1[r+1]);b=max3f(b,p1[r+2],p1[r+3]);}
  const float m=max2f(a,b);
  auto rr=__builtin_amdgcn_permlane32_swap(__float_as_uint(m),__float_as_uint(m),false,false);
  return max2f(__uint_as_float(rr[0]),__uint_as_float(rr[1]));
}
__device__ __forceinline__ void pv(f32x16*o,int vb,bf16x8 pa0,bf16x8 pa1,bf16x8 pa2,bf16x8 pa3){
  #pragma unroll
  for(int d0=0;d0<2;++d0){s16x4 lo[4],hi[4];
    #pragma unroll
    for(int ks=0;ks<4;++ks){
      asm volatile("ds_read_b64_tr_b16 %0,%1 offset:%c2":"=&v"(lo[ks]):"v"(vb),"i"(d0*4096+ks*1024):"memory");
      asm volatile("ds_read_b64_tr_b16 %0,%1 offset:%c2":"=&v"(hi[ks]):"v"(vb),"i"(d0*4096+ks*1024+512):"memory");}
    asm volatile("s_waitcnt lgkmcnt(0)":::"memory");SBAR();
    #define PK(k) (bf16x8){lo[k][0],lo[k][1],lo[k][2],lo[k][3],hi[k][0],hi[k][1],hi[k][2],hi[k][3]}
    o[d0]=__builtin_amdgcn_mfma_f32_32x32x16_bf16(pa0,PK(0),o[d0],0,0,0);
    o[d0]=__builtin_amdgcn_mfma_f32_32x32x16_bf16(pa1,PK(1),o[d0],0,0,0);
    o[d0]=__builtin_amdgcn_mfma_f32_32x32x16_bf16(pa2,PK(2),o[d0],0,0,0);
    o[d0]=__builtin_amdgcn_mfma_f32_32x32x16_bf16(pa3,PK(3),o[d0],0,0,0);
    #undef PK
  }
}

#ifndef ATTN_STORE16
#define ATTN_STORE16(p,v) (*(u32x4*)(p)=(v))
#endif
template<int THRL> __device__ __forceinline__ void attn_unit(const bf16*Qu,int qp,const bf16*__restrict__ Kh,const bf16*__restrict__ Vh,int kvp,bf16*Ou,int op,int NT,char*shm){
  int tid_o=threadIdx.x; asm volatile("":"+v"(tid_o)); const int tid=tid_o,lane=tid&63,r32=lane&31,hi=lane>>5; const int wid=__builtin_amdgcn_readfirstlane(tid>>6);
  const bf16*Qw=Qu+(long)(wid*QBLK)*qp;
  const unsigned lds0=(unsigned)(uintptr_t)shm;
  float*wsf=(float*)(shm+LDS_WS)+wid*64;
  const bf16*ksrc=Kh+(long)lane*kvp+wid*8;
  const bf16*vsrc=Vh+(long)(16*(wid&3)+(lane>>2))*kvp+(wid>>2)*32+(lane&3)*8;
  const unsigned kdst=lds0+LDS_K+wid*1024, vdst=lds0+LDS_V+wid*1024;
  #define DMA_K(t,slot) glds16(ksrc+(long)(t)*KVBLK*kvp,(unsigned)__builtin_amdgcn_readfirstlane(kdst+(slot)))
  #define DMA_V(t,slot) glds16(vsrc+(long)(t)*KVBLK*kvp,(unsigned)__builtin_amdgcn_readfirstlane(vdst+(slot)))
  const int vb0=(int)(lds0+LDS_V)+((lane>>4)&1)*32+(lane&3)*8+(4*hi+((lane&15)>>2))*64;
  const char*Kbase=shm+LDS_K; bf16x8 kf[8];
  const lds_cptr shm3=(lds_cptr)shm; const lds_cptr kp0=shm3+LDS_K+hi*1024+r32*16; const lds_cptr vp0=shm3+LDS_V+((lane>>4)&1)*32+(lane&3)*8+(4*hi+((lane&15)>>2))*64;
  DMA_K(0,0);DMA_V(0,0);DMA_K(1,SLOTB);
  bf16x8 qr[4];
  #pragma unroll
  for(int d0=0;d0<4;++d0)qr[d0]=*reinterpret_cast<const bf16x8*>(&Qw[(long)r32*qp+d0*16+hi*8]);
  float mhat=0.f,l_reg=0.f;f32x16 o[2];o[0]=f32x16{};o[1]=f32x16{};f32x16 negm=f32x16{};asm volatile("":"+v"(negm));
  #define CMASK(P0,P1,t) do{}while(0)
  bool resc=false;
  #define START(P0,P1) do{ const float rm=rowmax(P0,P1); resc=false; \
    { const float dl=rm; mhat=fadd_s(mhat,dl); \
      _Pragma("unroll") for(int r=0;r<16;++r){P0[r]=fsub_s(P0[r],dl);P1[r]=fsub_s(P1[r],dl);} \
      _Pragma("unroll") for(int r=0;r<16;++r)negm[r]=-mhat; asm volatile("":"+v"(negm)); } \
    _Pragma("unroll") for(int r=0;r<16;++r)P0[r]=__builtin_amdgcn_exp2f(P0[r]); }while(0)
  #define RESC() do{ if(resc){ asm volatile("s_waitcnt lgkmcnt(0)":::"memory"); \
      _Pragma("unroll") for(int d_=0;d_<2;++d_) _Pragma("unroll") for(int r=0;r<16;++r)o[d_][r]*=wsf[crow(r,hi)]; } }while(0)
  f32x16 pA0,pA1,pB0,pB1;
  int sl_prev=0,sl_cur=0,sl_next=SLOTB;
  #define ROT() do{sl_prev=sl_cur;sl_cur=sl_next;sl_next=(sl_next==(NSLOT-1)*SLOTB)?0:sl_next+SLOTB;}while(0)
  DMA_K(2,2*SLOTB);
  WAIT_BAR(3);
  qkt(pA0,pA1,Kbase,qr,negm,r32,hi);asm volatile("s_nop 15\n\ts_nop 7":"+v"(pA0),"+v"(pA1));CMASK(pA0,pA1,0);
  START(pA0,pA1);
  _Pragma("unroll") for(int r=0;r<16;++r)pA1[r]=__builtin_amdgcn_exp2f(pA1[r]);
  WAIT_BAR(0);
  DMA_K(3,0);DMA_V(1,SLOTB);
  ROT();
  kload8(kf,kp0+sl_cur);
  WAIT_BAR(2);
  s16x4 vlo[8],vhi[8]; u32x4 pw0,pw1,pw2,pw3;
  #define PKW(P,B) cvtpk_s(P[B],P[B+1])
  #define PAF(k) __builtin_bit_cast(bf16x8,pw##k)
  #define VFR(i) (bf16x8){vlo[i][0],vlo[i][1],vlo[i][2],vlo[i][3],vhi[i][0],vhi[i][1],vhi[i][2],vhi[i][3]}
  #define PIN(x) asm volatile("":"+v"(x))
  #define MX3(a,b,c) __builtin_fmaxf(__builtin_fmaxf((a),(b)),(c))
  #define GAPA(MF,A0,A1,A2,A3,W0,W1,PW) do{ MF; sacc+=A0; sacc+=A1; sacc+=A2; sacc+=A3; PIN(sacc); W0; W1; PIN(PW); SBAR(); }while(0)
  #define EX(v) __builtin_amdgcn_exp2f(v)
  #define GAPB(MF,X,B) do{ MF; X[B]=EX(X[B]); X[B+1]=EX(X[B+1]); X[B+2]=EX(X[B+2]); X[B+3]=EX(X[B+3]); PIN(X); SBAR(); }while(0)
  #define VRD(i) do{ vlo[i]=vtr(vp_+(((i)>>2)*4096+((i)&3)*1024)); vhi[i]=vtr(vp_+(((i)>>2)*4096+((i)&3)*1024+512)); }while(0)
  #define KRD(G,j) do{ if(G){ kload2(kf,kp0+sl_next,j); SBAR(); } }while(0)
  #define STEP(C0,C1,P0,P1,t,GK,GV,GL) do{ SBAR(); \
    const lds_cptr vp_=vp0+sl_prev; \
    VRD(0); SBAR(); float sacc=(P0[0]+P0[1]); \
    GAPA(C0=__builtin_amdgcn_mfma_f32_32x32x16_bf16(kf[0],qr[0],negm,0,0,0), P0[2],P0[3],P0[4],P0[5],     pw0[0]=PKW(P0,0), pw0[1]=PKW(P0,2), pw0); \
    VRD(4); SBAR(); GAPA(C1=__builtin_amdgcn_mfma_f32_32x32x16_bf16(kf[1],qr[0],negm,0,0,0), P0[6],P0[7],P0[8],P0[9],     pw0[2]=PKW(P0,4), pw0[3]=PKW(P0,6), pw0); \
    VRD(1); SBAR(); GAPA(C0=__builtin_amdgcn_mfma_f32_32x32x16_bf16(kf[2],qr[1],C0,0,0,0),   P0[10],P0[11],P0[12],P0[13], pw1[0]=PKW(P0,8), pw1[1]=PKW(P0,10), pw1); \
    VRD(5); SBAR(); GAPA(C1=__builtin_amdgcn_mfma_f32_32x32x16_bf16(kf[3],qr[1],C1,0,0,0),   P0[14],P0[15],P1[0],P1[1],   pw1[2]=PKW(P0,12),pw1[3]=PKW(P0,14), pw1); \
    VRD(2); SBAR(); GAPA(C0=__builtin_amdgcn_mfma_f32_32x32x16_bf16(kf[4],qr[2],C0,0,0,0),   P1[2],P1[3],P1[4],P1[5],     pw2[0]=PKW(P1,0), pw2[1]=PKW(P1,2), pw2); \
    VRD(6); SBAR(); GAPA(C1=__builtin_amdgcn_mfma_f32_32x32x16_bf16(kf[5],qr[2],C1,0,0,0),   P1[6],P1[7],P1[8],P1[9],     pw2[2]=PKW(P1,4), pw2[3]=PKW(P1,6), pw2); \
    VRD(3); SBAR(); GAPA(C0=__builtin_amdgcn_mfma_f32_32x32x16_bf16(kf[6],qr[3],C0,0,0,0),   P1[10],P1[11],P1[12],P1[13], pw3[0]=PKW(P1,8), pw3[1]=PKW(P1,10), pw3); \
    VRD(7); SBAR(); GAPA(C1=__builtin_amdgcn_mfma_f32_32x32x16_bf16(kf[7],qr[3],C1,0,0,0),   P1[14],P1[15],0.f,0.f,       pw3[2]=PKW(P1,12),pw3[3]=PKW(P1,14), pw3); \
    l_reg+=sacc; \
    if(GK){DMA_K((t)+3,sl_cur);} if(GV){DMA_V((t)+1,sl_next);} \
    CMASK(C0,C1,t); \
    { float a=MX3(C0[0],C0[1],C1[0]),b=MX3(C0[2],C0[3],C1[1]); a=MX3(a,C1[2],C1[3]); \
      _Pragma("unroll") for(int r=4;r<16;r+=4){a=MX3(a,C0[r],C0[r+1]);b=MX3(b,C0[r+2],C0[r+3]);a=MX3(a,C1[r],C1[r+1]);b=MX3(b,C1[r+2],C1[r+3]);} \
      float rm=__builtin_fmaxf(a,b); { auto rr=__builtin_amdgcn_permlane32_swap(__float_as_uint(rm),__float_as_uint(rm),false,false); rm=__builtin_fmaxf(__uint_as_float(rr[0]),__uint_as_float(rr[1])); } \
      resc=false; \
      if(__builtin_expect(__any(rm>(float)THRL),0)){ const float dl=__builtin_fmaxf(rm,0.f); mhat+=dl; \
        _Pragma("unroll") for(int r=0;r<16;++r){C0[r]-=dl;C1[r]-=dl;} \
        _Pragma("unroll") for(int r=0;r<16;++r)negm[r]=-mhat; asm volatile("":"+v"(negm)); \
        const float f=__builtin_amdgcn_exp2f(-dl); l_reg*=f; if(hi==0)wsf[r32]=f; resc=true; } } \
    SBAR(); \
    GAPB(o[0]=__builtin_amdgcn_mfma_f32_32x32x16_bf16(PAF(0),VFR(0),o[0],0,0,0), C0,0); \
    GAPB(o[1]=__builtin_amdgcn_mfma_f32_32x32x16_bf16(PAF(0),VFR(4),o[1],0,0,0), C0,4); \
    KRD(GL,0); GAPB(o[0]=__builtin_amdgcn_mfma_f32_32x32x16_bf16(PAF(1),VFR(1),o[0],0,0,0), C0,8); \
    KRD(GL,1); GAPB(o[1]=__builtin_amdgcn_mfma_f32_32x32x16_bf16(PAF(1),VFR(5),o[1],0,0,0), C0,12); \
    KRD(GL,2); GAPB(o[0]=__builtin_amdgcn_mfma_f32_32x32x16_bf16(PAF(2),VFR(2),o[0],0,0,0), C1,0); \
    KRD(GL,3); GAPB(o[1]=__builtin_amdgcn_mfma_f32_32x32x16_bf16(PAF(2),VFR(6),o[1],0,0,0), C1,4); \
    GAPB(o[0]=__builtin_amdgcn_mfma_f32_32x32x16_bf16(PAF(3),VFR(3),o[0],0,0,0), C1,8); \
    GAPB(o[1]=__builtin_amdgcn_mfma_f32_32x32x16_bf16(PAF(3),VFR(7),o[1],0,0,0), C1,12); \
    }while(0)
  int t=1;
  #undef CMASK
  #define CMASK(P0,P1,t) do{}while(0)
  for(;t+5<NT;t+=2){
    STEP(pB0,pB1,pA0,pA1,t,true,true,true);     WAIT_BAR(2); RESC(); ROT();
    STEP(pA0,pA1,pB0,pB1,t+1,true,true,true);   WAIT_BAR(2); RESC(); ROT();
  }
  #undef CMASK
  #define CMASK(P0,P1,t) do{}while(0)
  #define ENDW(tt) do{ if((tt)+3<NT){WAIT_BAR(2);} else if((tt)+2<NT){WAIT_BAR(1);} else {WAIT_BAR(0);} }while(0)
  for(;t+1<NT;t+=2){
    STEP(pB0,pB1,pA0,pA1,t,(t+3<NT),(t+1<NT),(t+1<NT));       ENDW(t);   RESC(); ROT();
    STEP(pA0,pA1,pB0,pB1,t+1,(t+4<NT),(t+2<NT),(t+2<NT));     ENDW(t+1); RESC(); ROT();
  }
  STEP(pB0,pB1,pA0,pA1,NT-1,false,false,false); RESC();
  { float sacc=pB0[0]+pB0[1]; _Pragma("unroll") for(int r=2;r<16;++r)sacc+=pB0[r]; _Pragma("unroll") for(int r=0;r<16;++r)sacc+=pB1[r]; l_reg+=sacc;
    pw0=(u32x4){PKW(pB0,0),PKW(pB0,2),PKW(pB0,4),PKW(pB0,6)};pw1=(u32x4){PKW(pB0,8),PKW(pB0,10),PKW(pB0,12),PKW(pB0,14)};pw2=(u32x4){PKW(pB1,0),PKW(pB1,2),PKW(pB1,4),PKW(pB1,6)};pw3=(u32x4){PKW(pB1,8),PKW(pB1,10),PKW(pB1,12),PKW(pB1,14)};
    SBAR(); pv(o,vb0+sl_cur,PAF(0),PAF(1),PAF(2),PAF(3)); }
  #undef PKW
  #undef PAF
  #undef VFR
  #undef PIN
  #undef MX3
  #undef GAPA
  #undef GAPB
  #undef EX
  #undef VRD
  #undef KRD
  #undef STEP
  #undef ENDW
  {auto rr=__builtin_amdgcn_permlane32_swap(__float_as_uint(l_reg),__float_as_uint(l_reg),false,false);l_reg=__uint_as_float(rr[0])+__uint_as_float(rr[1]);}
  if(hi==0)wsf[32+r32]=l_reg;asm volatile("s_waitcnt lgkmcnt(0)":::"memory");
  float rli[16];
  #pragma unroll
  for(int r=0;r<16;++r)rli[r]=__builtin_amdgcn_rcpf(wsf[32+crow(r,hi)]);
  bf16*Ow=Ou+(long)(wid*QBLK)*op;
  { bf16*stg=(bf16*)(shm+LDS_OST)+wid*2048;
    #pragma unroll
    for(int r=0;r<16;++r){const int orow=crow(r,hi);
      #pragma unroll
      for(int d0=0;d0<2;++d0)stg[orow*64+d0*32+r32]=__float2bfloat16(o[d0][r]*rli[r]);}
    asm volatile("s_waitcnt lgkmcnt(0)":::"memory");
    #pragma unroll
    for(int i=0;i<4;++i){const int row=i*8+(lane>>3),ch=lane&7; const u32x4 v=*(const u32x4*)(stg+row*64+ch*8); ATTN_STORE16(Ow+(long)row*op+ch*8,v);} }
  asm volatile("s_waitcnt lgkmcnt(0)\n\ts_barrier":::"memory");
  #undef DMA_K
  #undef DMA_V
  #undef CMASK
  #undef START
  #undef RESC
  #undef ROT
}
constexpr int ATTN_LDS_BYTES=LDS_BYTES;
constexpr int C2_KSL=8192, C2_VSL=16384, C2_LK=0, C2_LV=3*C2_KSL, C2_LWS=C2_LV+2*C2_VSL, C2_END=C2_LWS+NW*64*4, C2_STASH=65536;
static_assert(C2_END<=C2_STASH,"c2 lds");
template<int MODE,int THRL> __device__ __forceinline__ void attn_unit_v128(const bf16*Qu,int qp,const bf16*__restrict__ Kh,const bf16*__restrict__ Vh,int kvp,bf16*Ou,int op,int NT,char*shm,float lam,float oscale,const float*__restrict__ sg){
  int tid_o=threadIdx.x; asm volatile("":"+v"(tid_o)); const int tid=tid_o,lane=tid&63,r32=lane&31,hi=lane>>5; const int wid=__builtin_amdgcn_readfirstlane(tid>>6);
  const bf16*Qw=Qu+(long)(wid*QBLK)*qp;
  const unsigned lds0=(unsigned)(uintptr_t)shm;
  float*wsf=(float*)(shm+C2_LWS)+wid*64;
  const bf16*ksrc=Kh+(long)lane*kvp+wid*8;
  const bf16*vsrc=Vh+(long)(16*(wid&3)+(lane>>2))*kvp+(wid>>2)*32+(lane&3)*8;
  const unsigned kdst=lds0+C2_LK+wid*1024, vdst=lds0+C2_LV+wid*1024;
  #define XK(t,slot) glds16(ksrc+(long)(t)*KVBLK*kvp,(unsigned)__builtin_amdgcn_readfirstlane(kdst+(slot)))
  #define XV(t,slot) do{ glds16(vsrc+(long)(t)*KVBLK*kvp,(unsigned)__builtin_amdgcn_readfirstlane(vdst+(slot))); glds16(vsrc+64+(long)(t)*KVBLK*kvp,(unsigned)__builtin_amdgcn_readfirstlane(vdst+8192+(slot))); }while(0)
  const char*Kbase=shm+C2_LK; bf16x8 kf[8];
  const lds_cptr shm3=(lds_cptr)shm; const lds_cptr kp0=shm3+C2_LK+hi*1024+r32*16; const lds_cptr vp0=shm3+C2_LV+((lane>>4)&1)*32+(lane&3)*8+(4*hi+((lane&15)>>2))*64;
  const int vb0=(int)(lds0+C2_LV)+((lane>>4)&1)*32+(lane&3)*8+(4*hi+((lane&15)>>2))*64;
  XK(0,0);XV(0,0);XK(1,C2_KSL);
  bf16x8 qr[4];
  #pragma unroll
  for(int d0=0;d0<4;++d0)qr[d0]=*reinterpret_cast<const bf16x8*>(&Qw[(long)r32*qp+d0*16+hi*8]);
  float mhat=0.f,l_reg=0.f;f32x16 o[4];o[0]=f32x16{};o[1]=f32x16{};o[2]=f32x16{};o[3]=f32x16{};f32x16 negm=f32x16{};asm volatile("":"+v"(negm));
  bool resc=false;
  #define XRESC() do{ if(resc){ asm volatile("s_waitcnt lgkmcnt(0)":::"memory"); \
      _Pragma("unroll") for(int d_=0;d_<4;++d_) _Pragma("unroll") for(int r=0;r<16;++r)o[d_][r]*=wsf[crow(r,hi)]; } }while(0)
  f32x16 C0,C1; s16x4 vlo[8],vhi[8]; u32x4 pw0,pw1,pw2,pw3;
  int k_t=C2_KSL,k_t1=2*C2_KSL;
  int v_tm1=0,v_t=C2_VSL;
  #define XROT() do{ k_t=k_t1; k_t1=(k_t1==2*C2_KSL)?0:k_t1+C2_KSL; const int s_=v_tm1; v_tm1=v_t; v_t=s_; }while(0)
  XK(2,2*C2_KSL);
  WAIT_BAR(3);
  qkt(C0,C1,Kbase,qr,negm,r32,hi);asm volatile("s_nop 15\n\ts_nop 7":"+v"(C0),"+v"(C1));
  { const float rm=rowmax(C0,C1); mhat=fadd_s(mhat,rm);
    _Pragma("unroll") for(int r=0;r<16;++r){C0[r]=fsub_s(C0[r],rm);C1[r]=fsub_s(C1[r],rm);}
    _Pragma("unroll") for(int r=0;r<16;++r)negm[r]=-mhat; asm volatile("":"+v"(negm));
    _Pragma("unroll") for(int r=0;r<16;++r){C0[r]=__builtin_amdgcn_exp2f(C0[r]);C1[r]=__builtin_amdgcn_exp2f(C1[r]);}
    float sacc=0.f; _Pragma("unroll") for(int r=0;r<16;++r)sacc+=C0[r]; _Pragma("unroll") for(int r=0;r<16;++r)sacc+=C1[r]; l_reg=sacc;
    pw0=(u32x4){cvtpk_s(C0[0],C0[1]),cvtpk_s(C0[2],C0[3]),cvtpk_s(C0[4],C0[5]),cvtpk_s(C0[6],C0[7])}; pw1=(u32x4){cvtpk_s(C0[8],C0[9]),cvtpk_s(C0[10],C0[11]),cvtpk_s(C0[12],C0[13]),cvtpk_s(C0[14],C0[15])};
    pw2=(u32x4){cvtpk_s(C1[0],C1[1]),cvtpk_s(C1[2],C1[3]),cvtpk_s(C1[4],C1[5]),cvtpk_s(C1[6],C1[7])}; pw3=(u32x4){cvtpk_s(C1[8],C1[9]),cvtpk_s(C1[10],C1[11]),cvtpk_s(C1[12],C1[13]),cvtpk_s(C1[14],C1[15])};
    asm volatile("":"+v"(pw0),"+v"(pw1),"+v"(pw2),"+v"(pw3)); }
  WAIT_BAR(0);
  if(3<NT){XK(3,0);} XV(1,C2_VSL);
  kload8(kf,kp0+k_t);
  if(3<NT){WAIT_BAR(3);}else{WAIT_BAR(2);}
  #define PAF(k) __builtin_bit_cast(bf16x8,pw##k)
  #define VFR(i) (bf16x8){vlo[i][0],vlo[i][1],vlo[i][2],vlo[i][3],vhi[i][0],vhi[i][1],vhi[i][2],vhi[i][3]}
  #define PIN(x) asm volatile("":"+v"(x))
  #define MX3(a,b,c) __builtin_fmaxf(__builtin_fmaxf((a),(b)),(c))
  #define EX(v) __builtin_amdgcn_exp2f(v)
  #define VRD(s,f) do{ vlo[s]=vtr(vp_+((((f)&3))*4096+((f)>>2)*1024)); vhi[s]=vtr(vp_+((((f)&3))*4096+((f)>>2)*1024+512)); }while(0)
  #define KRD(G,j) do{ if(G){ kload2(kf,kp0+k_t1,j); SBAR(); } }while(0)
  #define QKG(MF,i) do{ VRD(i,i); SBAR(); MF; SBAR(); }while(0)
  #define PVG(f,RD,X0,X1,A0,A1,PK) do{ o[(f)&3]=__builtin_amdgcn_mfma_f32_32x32x16_bf16(PAFK(f),VFR((f)&7),o[(f)&3],0,0,0); RD; X0=EX(X0); X1=EX(X1); sacc+=A0; sacc+=A1; PIN(sacc); PK; PIN(C0); PIN(C1); SBAR(); }while(0)
  #define PAFK(f) (((f)>>2)==0?PAF(0):((f)>>2)==1?PAF(1):((f)>>2)==2?PAF(2):PAF(3))
  #define PKW(P,B) cvtpk_s(P[B],P[B+1])
  #define XSTEP(t,GK,GV,GL) do{ SBAR(); \
    if(GV){XV((t),v_t);} \
    const lds_cptr vp_=vp0+v_tm1; \
    QKG(C0=__builtin_amdgcn_mfma_f32_32x32x16_bf16(kf[0],qr[0],negm,0,0,0),0); \
    QKG(C1=__builtin_amdgcn_mfma_f32_32x32x16_bf16(kf[1],qr[0],negm,0,0,0),1); \
    QKG(C0=__builtin_amdgcn_mfma_f32_32x32x16_bf16(kf[2],qr[1],C0,0,0,0),2); \
    QKG(C1=__builtin_amdgcn_mfma_f32_32x32x16_bf16(kf[3],qr[1],C1,0,0,0),3); \
    QKG(C0=__builtin_amdgcn_mfma_f32_32x32x16_bf16(kf[4],qr[2],C0,0,0,0),4); \
    QKG(C1=__builtin_amdgcn_mfma_f32_32x32x16_bf16(kf[5],qr[2],C1,0,0,0),5); \
    QKG(C0=__builtin_amdgcn_mfma_f32_32x32x16_bf16(kf[6],qr[3],C0,0,0,0),6); \
    QKG(C1=__builtin_amdgcn_mfma_f32_32x32x16_bf16(kf[7],qr[3],C1,0,0,0),7); \
    if(GK){XK((t)+3,k_t);} \
    { float a=MX3(C0[0],C0[1],C1[0]),b=MX3(C0[2],C0[3],C1[1]); a=MX3(a,C1[2],C1[3]); \
      _Pragma("unroll") for(int r=4;r<16;r+=4){a=MX3(a,C0[r],C0[r+1]);b=MX3(b,C0[r+2],C0[r+3]);a=MX3(a,C1[r],C1[r+1]);b=MX3(b,C1[r+2],C1[r+3]);} \
      float rm=__builtin_fmaxf(a,b); { auto rr=__builtin_amdgcn_permlane32_swap(__float_as_uint(rm),__float_as_uint(rm),false,false); rm=__builtin_fmaxf(__uint_as_float(rr[0]),__uint_as_float(rr[1])); } \
      resc=false; \
      if(__builtin_expect(__any(rm>(float)THRL),0)){ const float dl=__builtin_fmaxf(rm,0.f); mhat+=dl; \
        _Pragma("unroll") for(int r=0;r<16;++r){C0[r]-=dl;C1[r]-=dl;} \
        _Pragma("unroll") for(int r=0;r<16;++r)negm[r]=-mhat; asm volatile("":"+v"(negm)); \
        const float f=__builtin_amdgcn_exp2f(-dl); l_reg*=f; if(hi==0)wsf[r32]=f; resc=true; } } \
    SBAR(); \
    float sacc=0.f; \
    PVG(0, VRD(0,8),  C0[0],C0[1],  0.f,0.f,      ;); \
    PVG(1, VRD(1,9),  C0[2],C0[3],  C0[0],C0[1],  ;); \
    PVG(2, VRD(2,10), C0[4],C0[5],  C0[2],C0[3],  ;); \
    KRD(GL,0); PVG(3, VRD(3,11), C0[6],C0[7],  C0[4],C0[5],  ;); \
    KRD(GL,1); PVG(4, VRD(4,12), C0[8],C0[9],  C0[6],C0[7],  pw0[0]=PKW(C0,0);pw0[1]=PKW(C0,2);PIN(pw0)); \
    KRD(GL,2); PVG(5, VRD(5,13), C0[10],C0[11],C0[8],C0[9],  pw0[2]=PKW(C0,4);pw0[3]=PKW(C0,6);PIN(pw0)); \
    KRD(GL,3); PVG(6, VRD(6,14), C0[12],C0[13],C0[10],C0[11],;); \
    PVG(7, VRD(7,15), C0[14],C0[15],C0[12],C0[13],;); \
    PVG(8, ;,         C1[0],C1[1],  C0[14],C0[15],pw1[0]=PKW(C0,8);pw1[1]=PKW(C0,10);PIN(pw1)); \
    PVG(9, ;,         C1[2],C1[3],  C1[0],C1[1],  pw1[2]=PKW(C0,12);pw1[3]=PKW(C0,14);PIN(pw1)); \
    PVG(10,;,         C1[4],C1[5],  C1[2],C1[3],  ;); \
    PVG(11,;,         C1[6],C1[7],  C1[4],C1[5],  ;); \
    PVG(12,;,         C1[8],C1[9],  C1[6],C1[7],  pw2[0]=PKW(C1,0);pw2[1]=PKW(C1,2);PIN(pw2)); \
    PVG(13,;,         C1[10],C1[11],C1[8],C1[9],  pw2[2]=PKW(C1,4);pw2[3]=PKW(C1,6);PIN(pw2)); \
    PVG(14,;,         C1[12],C1[13],C1[10],C1[11],;); \
    PVG(15,;,         C1[14],C1[15],C1[12],C1[13],;); \
    sacc+=C1[14]; sacc+=C1[15]; l_reg+=sacc; \
    pw3[0]=PKW(C1,8);pw3[1]=PKW(C1,10);pw3[2]=PKW(C1,12);pw3[3]=PKW(C1,14);PIN(pw3); SBAR(); \
    }while(0)
  int t=1;
  XSTEP(1,(4<NT),false,(2<NT)); if(4<NT){WAIT_BAR(1);}else{WAIT_BAR(0);} XRESC(); XROT(); t=2;
  for(;t+3<NT;++t){ XSTEP(t,true,true,true); WAIT_BAR(1); XRESC(); XROT(); }
  for(;t+1<NT;++t){ XSTEP(t,false,true,true); WAIT_BAR(0); XRESC(); XROT(); }
  XSTEP(NT-1,false,true,false); WAIT_BAR(0); XRESC();
  { const int vb=vb0+v_t;
    #pragma unroll
    for(int d0=0;d0<4;++d0){s16x4 lo[4],hh[4];
      #pragma unroll
      for(int ks=0;ks<4;++ks){
        asm volatile("ds_read_b64_tr_b16 %0,%1 offset:%c2":"=&v"(lo[ks]):"v"(vb),"i"(d0*4096+ks*1024):"memory");
        asm volatile("ds_read_b64_tr_b16 %0,%1 offset:%c2":"=&v"(hh[ks]):"v"(vb),"i"(d0*4096+ks*1024+512):"memory");}
      asm volatile("s_waitcnt lgkmcnt(0)":::"memory");SBAR();
      #define PKD(k) (bf16x8){lo[k][0],lo[k][1],lo[k][2],lo[k][3],hh[k][0],hh[k][1],hh[k][2],hh[k][3]}
      o[d0]=__builtin_amdgcn_mfma_f32_32x32x16_bf16(PAF(0),PKD(0),o[d0],0,0,0);
      o[d0]=__builtin_amdgcn_mfma_f32_32x32x16_bf16(PAF(1),PKD(1),o[d0],0,0,0);
      o[d0]=__builtin_amdgcn_mfma_f32_32x32x16_bf16(PAF(2),PKD(2),o[d0],0,0,0);
      o[d0]=__builtin_amdgcn_mfma_f32_32x32x16_bf16(PAF(3),PKD(3),o[d0],0,0,0);
      #undef PKD
    } }
  #undef PKW
  #undef PAFK
  #undef PVG
  #undef QKG
  #undef KRD
  #undef VRD
  #undef EX
  #undef MX3
  #undef PIN
  #undef VFR
  #undef PAF
  #undef XSTEP
  {auto rr=__builtin_amdgcn_permlane32_swap(__float_as_uint(l_reg),__float_as_uint(l_reg),false,false);l_reg=__uint_as_float(rr[0])+__uint_as_float(rr[1]);}
  if(hi==0)wsf[32+r32]=l_reg;asm volatile("s_waitcnt lgkmcnt(0)":::"memory");
  float rli[16];
  #pragma unroll
  for(int r=0;r<16;++r)rli[r]=__builtin_amdgcn_rcpf(wsf[32+crow(r,hi)]);
  unsigned*stash=(unsigned*)(shm+C2_STASH)+wid*2048;
  if constexpr(MODE==0){
    #pragma unroll
    for(int d0=0;d0<4;++d0)
      #pragma unroll
      for(int r=0;r<16;r+=2)stash[(d0*8+(r>>1))*64+lane]=cvtpk_s(o[d0][r]*rli[r],o[d0][r+1]*rli[r+1]);
  }else{
    float ss[16];
    #pragma unroll
    for(int r=0;r<16;++r)ss[r]=0.f;
    #pragma unroll
    for(int d0=0;d0<4;++d0)
      #pragma unroll
      for(int r=0;r<16;r+=2){const unsigned w=stash[(d0*8+(r>>1))*64+lane];
        const float da=__uint_as_float(w<<16)-lam*(o[d0][r]*rli[r]),db=__uint_as_float(w&0xffff0000u)-lam*(o[d0][r+1]*rli[r+1]);
        o[d0][r]=da;o[d0][r+1]=db;ss[r]+=da*da;ss[r+1]+=db*db;}
    #pragma unroll
    for(int r=0;r<16;++r){float v=::xsum_x16(::xsum_row16(ss[r]));
      ss[r]=oscale*::rsq_(v*(1.f/128.f)+1e-6f);}
    bf16*stg=(bf16*)stash;
    #pragma unroll
    for(int d0=0;d0<4;++d0){const float g=sg[d0*32+r32];
      #pragma unroll
      for(int r=0;r<16;++r)stg[crow(r,hi)*128+d0*32+r32]=__float2bfloat16(o[d0][r]*ss[r]*g);}
    asm volatile("s_waitcnt lgkmcnt(0)":::"memory");
    bf16*Ow=Ou+(long)(wid*QBLK)*op;
    #pragma unroll
    for(int i=0;i<8;++i){const int row=i*4+(lane>>4),ch=lane&15;const u32x4 v=*(const u32x4*)(stg+row*128+ch*8);*(u32x4*)(Ow+(long)row*op+ch*8)=v;}
  }
  asm volatile("s_waitcnt lgkmcnt(0)\n\ts_barrier":::"memory");
  #undef XK
  #undef XV
  #undef XRESC
  #undef XROT
}
#undef SBAR
#undef WAIT_BAR
}

namespace attn_c {
using bf16 = __hip_bfloat16;
constexpr int D = 128, DQK = 64, NW = 8, QBLK = 32, KVBLK = 64, SDEPTH = 2;
constexpr size_t SHM_V = KVBLK * D * 2, SHM_K = KVBLK * DQK * 2, SHM_ATTN = 2 * SHM_V + 2 * SHM_K + NW * 64 * 4;
constexpr float THR_L2 = 8.f * 1.4426950408889634f;
using bf16x8 = __attribute__((ext_vector_type(8))) short;
using s16x4  = __attribute__((ext_vector_type(4))) short;
using f32x16 = __attribute__((ext_vector_type(16))) float;
using f32x8  = __attribute__((ext_vector_type(8))) float;
using u32x4  = __attribute__((ext_vector_type(4))) unsigned;
#define KSWZ(row, colB) ((row) * 128 + ((colB) ^ ((((row) >> 1) & 7) << 4)))
#define SBAR_C() __builtin_amdgcn_sched_barrier(0)
__device__ __forceinline__ int crow(int r, int hi) { return (r & 3) + 8 * (r >> 2) + 4 * hi; }
__device__ __forceinline__ unsigned cvtpk(float lo, float hi) {
  typedef float f2_ __attribute__((ext_vector_type(2))); typedef __bf16 b2_ __attribute__((ext_vector_type(2))); f2_ v = {lo, hi}; b2_ b = __builtin_convertvector(v, b2_); return __builtin_bit_cast(unsigned, b);
}
template <typename TIn> struct Stage;
template <> struct Stage<bf16>  { using T = bf16x8;
  __device__ static __forceinline__ T ld8(const bf16* p) { return *reinterpret_cast<const bf16x8*>(p); }
  __device__ static __forceinline__ bf16x8 tobf(T x) { return x; } };
template <> struct Stage<float> { using T = f32x8;
  __device__ static __forceinline__ T ld8(const float* p) { return *reinterpret_cast<const f32x8*>(p); }
  __device__ static __forceinline__ bf16x8 tobf(T x) {
    u32x4 w = {cvtpk(x[0], x[1]), cvtpk(x[2], x[3]), cvtpk(x[4], x[5]), cvtpk(x[6], x[7])}; return *reinterpret_cast<bf16x8*>(&w); } };

__device__ __forceinline__ void partialSM(f32x16& p0, f32x16& p1, float& m_reg, float& mn, float& alpha) {
  constexpr float C = 1.f;
  float pmax = p0[0]; for (int r = 1; r < 16; ++r) pmax = fmaxf(pmax, p0[r]); for (int r = 0; r < 16; ++r) pmax = fmaxf(pmax, p1[r]);
  { auto rr = __builtin_amdgcn_permlane32_swap(__float_as_uint(pmax), __float_as_uint(pmax), false, false);
    pmax = fmaxf(__uint_as_float(rr[0]), __uint_as_float(rr[1])); }
  if (__builtin_expect(__all(pmax - m_reg <= THR_L2), 1)) { mn = m_reg; alpha = 1.f; }
  else { mn = fmaxf(m_reg, pmax); alpha = __builtin_amdgcn_exp2f((m_reg - mn) * C); m_reg = mn; }
  float mnC = -mn * C;
  for (int r = 0; r < 16; ++r) p0[r] = fmaf(p0[r], C, mnC); for (int r = 0; r < 16; ++r) p1[r] = fmaf(p1[r], C, mnC);
  for (int r = 0; r < 16; ++r) p0[r] = __builtin_amdgcn_exp2f(p0[r]);
}
__device__ __forceinline__ void finishSM(f32x16& p0, f32x16& p1, float alpha, float& l_reg, bf16x8& pa0, bf16x8& pa1, bf16x8& pa2, bf16x8& pa3) {
  for (int r = 0; r < 16; ++r) p1[r] = __builtin_amdgcn_exp2f(p1[r]);
  float ps = 0; for (int r = 0; r < 16; ++r) ps += p0[r]; for (int r = 0; r < 16; ++r) ps += p1[r];
  { auto rr = __builtin_amdgcn_permlane32_swap(__float_as_uint(ps), __float_as_uint(ps), false, false);
    ps = __uint_as_float(rr[0]) + __uint_as_float(rr[1]); }
  l_reg = l_reg * alpha + ps;
#define PK4(P, BASE, OUT) do { unsigned a0 = cvtpk(P[BASE + 0], P[BASE + 1]), a1 = cvtpk(P[BASE + 2], P[BASE + 3]);   \
    unsigned b0 = cvtpk(P[BASE + 4], P[BASE + 5]), b1 = cvtpk(P[BASE + 6], P[BASE + 7]);                              \
    auto r0 = __builtin_amdgcn_permlane32_swap(a0, b0, false, false); auto r1 = __builtin_amdgcn_permlane32_swap(a1, b1, false, false); \
    u32x4 w = {r0[0], r1[0], r0[1], r1[1]}; OUT = *reinterpret_cast<bf16x8*>(&w); } while (0)
  PK4(p0, 0, pa0); PK4(p0, 8, pa1); PK4(p1, 0, pa2); PK4(p1, 8, pa3);
#undef PK4
}
__device__ __forceinline__ void qkt(f32x16& p0, f32x16& p1, const bf16* Ks, const bf16x8* qr, int r32, int hi) {
  p0 = f32x16{}; p1 = f32x16{};
  for (int d0 = 0; d0 < 4; ++d0) { int cb = (d0 * 16 + hi * 8) * 2;
    bf16x8 b0 = *reinterpret_cast<const bf16x8*>((const char*)Ks + KSWZ(r32, cb));
    bf16x8 b1 = *reinterpret_cast<const bf16x8*>((const char*)Ks + KSWZ(32 + r32, cb));
    p0 = __builtin_amdgcn_mfma_f32_32x32x16_bf16(b0, qr[d0], p0, 0, 0, 0);
    p1 = __builtin_amdgcn_mfma_f32_32x32x16_bf16(b1, qr[d0], p1, 0, 0, 0); }
}
__device__ __forceinline__ int v_st(int k, int c) { const int kk = (k & ~0xC) | ((k & 4) << 1) | ((k & 8) >> 1); return ((kk >> 3) * 4 + (c >> 5)) * 512 + ((kk & 7) * 32 + (c & 31)) * 2; }
__device__ __forceinline__ int v_rd_base(int lane) { return ((lane & 3) << 3) | (((lane >> 2) & 3) << 6) | (((lane >> 4) & 1) << 5) | (((lane >> 5) & 1) << 8); }
constexpr int v_rd_off(int d0, int ks, int half) { return d0 * 512 + ks * 4096 + half * 2048; }
template <int OFF> __device__ __forceinline__ s16x4 tr_read(int vb) {
  s16x4 r; asm volatile("ds_read_b64_tr_b16 %0, %1 offset:%2" : "=&v"(r) : "v"(vb), "i"(OFF) : "memory"); return r;
}
template <int D0> __device__ __forceinline__ void pv_one(f32x16& od, int vb, bf16x8 pa0, bf16x8 pa1, bf16x8 pa2, bf16x8 pa3) {
  const s16x4 l0 = tr_read<v_rd_off(D0, 0, 0)>(vb), h0 = tr_read<v_rd_off(D0, 0, 1)>(vb), l1 = tr_read<v_rd_off(D0, 1, 0)>(vb), h1 = tr_read<v_rd_off(D0, 1, 1)>(vb);
  const s16x4 l2 = tr_read<v_rd_off(D0, 2, 0)>(vb), h2 = tr_read<v_rd_off(D0, 2, 1)>(vb), l3 = tr_read<v_rd_off(D0, 3, 0)>(vb), h3 = tr_read<v_rd_off(D0, 3, 1)>(vb);
  asm volatile("s_waitcnt lgkmcnt(0)" ::: "memory"); SBAR_C();
#define PK(L, H) (bf16x8){L[0], L[1], L[2], L[3], H[0], H[1], H[2], H[3]}
  od = __builtin_amdgcn_mfma_f32_32x32x16_bf16(pa0, PK(l0, h0), od, 0, 0, 0);
  od = __builtin_amdgcn_mfma_f32_32x32x16_bf16(pa1, PK(l1, h1), od, 0, 0, 0);
  od = __builtin_amdgcn_mfma_f32_32x32x16_bf16(pa2, PK(l2, h2), od, 0, 0, 0);
  od = __builtin_amdgcn_mfma_f32_32x32x16_bf16(pa3, PK(l3, h3), od, 0, 0, 0);
#undef PK
}
__device__ __forceinline__ void pv_d0(f32x16* o, int vb, bf16x8 pa0, bf16x8 pa1, bf16x8 pa2, bf16x8 pa3) {
  pv_one<0>(o[0], vb, pa0, pa1, pa2, pa3); pv_one<1>(o[1], vb, pa0, pa1, pa2, pa3); pv_one<2>(o[2], vb, pa0, pa1, pa2, pa3); pv_one<3>(o[3], vb, pa0, pa1, pa2, pa3);
}

template <int MODE> __device__ __forceinline__ void attn_c_unit(const bf16* __restrict__ Qb, int ldq, const bf16* __restrict__ Kh, const bf16* __restrict__ Vh, int ldk,
                                            bf16* __restrict__ Ob, int ldo, int seq, char* lds, float lam, float oscale, const float* __restrict__ sg) {
  typedef bf16 TQ; const int LDQ = ldq, LDK = ldk, LDO = ldo;
  using St = Stage<bf16>; using SQ = Stage<bf16>;
  int tid_o = threadIdx.x; asm volatile("" : "+v"(tid_o)); const int tid = tid_o, wid = tid >> 6, lane = tid & 63, r32 = lane & 31, hi = lane >> 5;
  bf16* V_lds = (bf16*)lds; bf16* K_lds = (bf16*)(lds + 2 * SHM_V);
  float* ws = (float*)(lds + 2 * SHM_V + 2 * SHM_K) + wid * 64; float* li_l = ws; float* al_l = ws + 32;
  float m_reg = -1e30f, l_reg = 0; f32x16 o[4] = {}; bf16x8 qr[4];
  const TQ* Qw = Qb + (long)(wid * QBLK + r32) * LDQ + hi * 8;
#pragma unroll
  for (int d0 = 0; d0 < 4; ++d0) qr[d0] = SQ::tobf(SQ::ld8(Qw + d0 * 16));
  const int sr = tid >> 4, sc = (tid & 15) * 8, vst0 = v_st(sr, sc), vst1 = v_st(32 + sr, sc), kr = tid >> 3, kcb = (tid & 7) * 16;
  const int vb0 = (int)(uintptr_t)V_lds + v_rd_base(lane);
  struct { typename St::T vs0, vs1, ks0; } sr_[SDEPTH];
#define SLOAD(i, k0) do { sr_[i].vs0 = St::ld8(&Vh[(long)((k0) + sr) * LDK + sc]); sr_[i].vs1 = St::ld8(&Vh[(long)((k0) + 32 + sr) * LDK + sc]); \
    sr_[i].ks0 = St::ld8(&Kh[(long)((k0) + kr) * LDK + (kcb >> 1)]); } while (0)
#define SWRITE(b, i) do { *(bf16x8*)((char*)V_lds + (b) * SHM_V + vst0) = St::tobf(sr_[i].vs0);          \
    *(bf16x8*)((char*)V_lds + (b) * SHM_V + vst1) = St::tobf(sr_[i].vs1);                               \
    *(bf16x8*)((char*)K_lds + (b) * SHM_K + KSWZ(kr, kcb)) = St::tobf(sr_[i].ks0); } while (0)
#define SWAIT() do { if constexpr (SDEPTH == 2) asm volatile("s_waitcnt vmcnt(3)" ::: "memory"); else asm volatile("s_waitcnt vmcnt(0)" ::: "memory"); } while (0)
#define RESC(a) do { if (__any((a) < 1.f)) { if (hi == 0) al_l[r32] = (a); asm volatile("s_waitcnt lgkmcnt(0)" ::: "memory"); \
    for (int d = 0; d < 4; ++d) for (int r = 0; r < 16; ++r) o[d][r] *= al_l[crow(r, hi)]; } } while (0)
  f32x16 pA0, pA1, pB0, pB1; float mnA, mnB, alA, alB; bf16x8 pa0, pa1, pa2, pa3; const int NT = seq / KVBLK;
  constexpr int SE = 0, SO = SDEPTH - 1;
  SLOAD(SE, 0); asm volatile("s_waitcnt vmcnt(0)" ::: "memory"); SWRITE(0, SE); __syncthreads();
  qkt(pA0, pA1, K_lds, qr, r32, hi); partialSM(pA0, pA1, m_reg, mnA, alA);
  SLOAD(SO, KVBLK); if constexpr (SDEPTH == 2) { if (2 < NT) SLOAD(SE, 2 * KVBLK); }
  SWAIT(); SWRITE(1, SO); __syncthreads();
  for (int j = 1; j + 1 < NT; j += 2) {
    SBAR_C(); qkt(pB0, pB1, (bf16*)((char*)K_lds + SHM_K), qr, r32, hi);
    finishSM(pA0, pA1, alA, l_reg, pa0, pa1, pa2, pa3); SBAR_C();
    SLOAD(SO, (j + SDEPTH) * KVBLK); SBAR_C();
    pv_d0(o, vb0, pa0, pa1, pa2, pa3); partialSM(pB0, pB1, m_reg, mnB, alB);
    __syncthreads(); SWAIT(); SWRITE(0, SE);
    RESC(alB); __syncthreads();
    SBAR_C(); qkt(pA0, pA1, K_lds, qr, r32, hi);
    finishSM(pB0, pB1, alB, l_reg, pa0, pa1, pa2, pa3); SBAR_C();
    if (SDEPTH == 1 || j + 3 < NT) SLOAD(SE, (j + 1 + SDEPTH) * KVBLK); SBAR_C();
    pv_d0(o, vb0 + (int)SHM_V, pa0, pa1, pa2, pa3); partialSM(pA0, pA1, m_reg, mnA, alA);
    __syncthreads(); SWAIT(); SWRITE(1, SO);
    RESC(alA); __syncthreads();
  }
  SBAR_C(); qkt(pB0, pB1, (bf16*)((char*)K_lds + SHM_K), qr, r32, hi);
  finishSM(pA0, pA1, alA, l_reg, pa0, pa1, pa2, pa3); SBAR_C();
  pv_d0(o, vb0, pa0, pa1, pa2, pa3); partialSM(pB0, pB1, m_reg, mnB, alB);
  __syncthreads(); RESC(alB);
  finishSM(pB0, pB1, alB, l_reg, pa0, pa1, pa2, pa3); SBAR_C();
  pv_d0(o, vb0 + (int)SHM_V, pa0, pa1, pa2, pa3);
  if (hi == 0) li_l[r32] = l_reg; asm volatile("s_waitcnt lgkmcnt(0)" ::: "memory");
  float rli[16];
#pragma unroll
  for (int r = 0; r < 16; ++r) rli[r] = __builtin_amdgcn_rcpf(li_l[crow(r, hi)]);
  unsigned* stash = (unsigned*)(lds + 65536) + wid * 2048;
  if constexpr (MODE == 0) {
#pragma unroll
    for (int d0 = 0; d0 < 4; ++d0)
#pragma unroll
      for (int r = 0; r < 16; r += 2) stash[(d0 * 8 + (r >> 1)) * 64 + lane] = cvtpk(o[d0][r] * rli[r], o[d0][r + 1] * rli[r + 1]);
  } else {
    float ss[16];
#pragma unroll
    for (int r = 0; r < 16; ++r) ss[r] = 0.f;
#pragma unroll
    for (int d0 = 0; d0 < 4; ++d0)
#pragma unroll
      for (int r = 0; r < 16; r += 2) { const unsigned w = stash[(d0 * 8 + (r >> 1)) * 64 + lane];
        const float da = __uint_as_float(w << 16) - lam * (o[d0][r] * rli[r]), db = __uint_as_float(w & 0xffff0000u) - lam * (o[d0][r + 1] * rli[r + 1]);
        o[d0][r] = da; o[d0][r + 1] = db; ss[r] += da * da; ss[r + 1] += db * db; }
#pragma unroll
    for (int r = 0; r < 16; ++r) { float v = ss[r]; v += __shfl_xor(v, 1); v += __shfl_xor(v, 2); v += __shfl_xor(v, 4); v += __shfl_xor(v, 8); v += __shfl_xor(v, 16);
      ss[r] = oscale / sqrtf(v * (1.f / 128.f) + 1e-6f); }
    bf16* stg = (bf16*)stash;
#pragma unroll
    for (int d0 = 0; d0 < 4; ++d0) { const float g = sg[d0 * 32 + r32];
#pragma unroll
      for (int r = 0; r < 16; ++r) stg[crow(r, hi) * 128 + d0 * 32 + r32] = __float2bfloat16(o[d0][r] * ss[r] * g); }
    asm volatile("s_waitcnt lgkmcnt(0)" ::: "memory");
    bf16* Ow = Ob + (long)(wid * QBLK) * LDO;
#pragma unroll
    for (int i = 0; i < 8; ++i) { const int row = i * 4 + (lane >> 4), ch = lane & 15; const u32x4 v = *(const u32x4*)(stg + row * 128 + ch * 8); *(u32x4*)(Ow + (long)row * LDO + ch * 8) = v; }
  }
  __syncthreads();
#undef SLOAD
#undef SWRITE
#undef SWAIT
#undef RESC
}


#undef KSWZ
}


#define LAS __attribute__((address_space(3)))

#define XB_TMO      128
#define XB_XCNT(j)  (256  + 64 * (j))
#define XB_XSUB(j)  (1280 + 64 * (j))
#define XB_XGEN(j)  (2304 + 64 * (j))
#define XB_TOP      3328
#define XB_TOPGEN   3392
#define XCD_BAR_WORDS 3456
#define XB_SPIN_CAP (1u << 18)

__device__ __forceinline__ unsigned xb_ld(unsigned* p)              { return __hip_atomic_load(p, __ATOMIC_RELAXED, __HIP_MEMORY_SCOPE_AGENT); }
__device__ __forceinline__ unsigned xb_add(unsigned* p, unsigned v) { return __hip_atomic_fetch_add(p, v, __ATOMIC_RELAXED, __HIP_MEMORY_SCOPE_AGENT); }
__device__ __forceinline__ unsigned xb_xcc_id() { return (unsigned)__builtin_amdgcn_s_getreg((3 << 11) | 20) & 0xFu; }
#define XB_SPIN(cond, bar) do { unsigned _sp = 0; while (cond) { __builtin_amdgcn_s_sleep(1); \
    if ((++_sp & 255u) == 0u) { if (xb_ld(&(bar)[XB_TMO])) break; if (_sp > XB_SPIN_CAP) { atomicAdd(&(bar)[XB_TMO], 1u); break; } } } } while (0)

struct XcdBarrier {
    unsigned* bar; unsigned x;
    volatile LAS unsigned* st;
};

__device__ __forceinline__ XcdBarrier xcd_barrier_post(unsigned* bar, volatile LAS unsigned* st) {
    XcdBarrier b; b.bar = bar; b.x = xb_xcc_id(); b.st = st;
    if (threadIdx.x == 0) (void)xb_add(&bar[XB_XCNT(b.x)], 1u);
    return b;
}
__device__ __forceinline__ void xcd_barrier_complete(unsigned* bar, unsigned x, unsigned& nloc, unsigned& nx) {
    const unsigned G = gridDim.x * gridDim.y * gridDim.z;
    unsigned sum, cnt, mine, sp = 0u;
    for (;;) {
        sum = 0u; cnt = 0u; mine = 0u;
#pragma unroll
        for (unsigned j = 0; j < 16; ++j) { const unsigned c = xb_ld(&bar[XB_XCNT(j)]); sum += c; cnt += (c > 0u) ? 1u : 0u; mine = (j == x) ? c : mine; }
        if (sum == G) break;
        __builtin_amdgcn_s_sleep(1);
        if ((++sp & 255u) == 0u) { if (xb_ld(&bar[XB_TMO])) break; if (sp > XB_SPIN_CAP) { atomicAdd(&bar[XB_TMO], 1u); break; } }
    }
    nloc = mine > 0u ? mine : 1u; nx = cnt > 0u ? cnt : 1u;
}

__device__ __forceinline__ void xcd_barrier(const XcdBarrier& b) {
    asm volatile("s_waitcnt vmcnt(0)" ::: "memory");
    __syncthreads();
    if (threadIdx.x == 0) {
        unsigned* bar = b.bar;
        __builtin_amdgcn_s_waitcnt(0);
        unsigned nloc = b.st[0], nx = b.st[1];
        if (nloc == 0u) { xcd_barrier_complete(bar, b.x, nloc, nx); b.st[0] = nloc; b.st[1] = nx; }
        const unsigned old = xb_add(&bar[XB_XSUB(b.x)], 1u);
        const unsigned gen = old / nloc;
        if (old + 1u == (gen + 1u) * nloc) {
            __builtin_amdgcn_fence(__ATOMIC_RELEASE, "agent");
            asm volatile("s_waitcnt vmcnt(0)" ::: "memory");
            const unsigned og = xb_add(&bar[XB_TOP], 1u);
            const unsigned tg = og / nx;
            if (og + 1u == (tg + 1u) * nx) xb_add(&bar[XB_TOPGEN], 1u);
            else XB_SPIN(xb_ld(&bar[XB_TOPGEN]) == tg, bar);
            __builtin_amdgcn_fence(__ATOMIC_ACQUIRE, "agent");
            xb_add(&bar[XB_XGEN(b.x)], 1u);
            asm volatile("s_waitcnt vmcnt(0)" ::: "memory");
        } else {
            XB_SPIN(xb_ld(&bar[XB_XGEN(b.x)]) == gen, bar);
            __builtin_amdgcn_fence(__ATOMIC_ACQUIRE, "agent");
            asm volatile("s_waitcnt vmcnt(0)" ::: "memory");
        }
    }
    __syncthreads();
}

constexpr int NWAVES = 8, RING_BYTES = 131072, LDSCTL_OFF = RING_BYTES, MISC_OFF = LDSCTL_OFF + 320, LDS_BYTES = 147456;
constexpr int CW_BAR = 4096;
#ifndef KMASK
#define KMASK 0xFFFF
#endif
#define KEN(k) (((KMASK) >> (k)) & 1)
#ifndef DUPMASK
#define DUPMASK 0
#endif
#define NREP(k) ((((DUPMASK) >> (k)) & 1) ? 2 : 1)
struct Args { P p; int ph_lo, ph_hi, li, pad; };

struct InprojOrder {
    pg8::StaticOrder so; int G, c, nmain, nextra;
    __device__ void init(int l, int G_, int c_) { so.init(l == 0 ? MT : M_LAT, IN_W, G_, c_); G = G_; c = c_; nmain = so.nwg; nextra = l == 0 ? 0 : 20; }
    __device__ bool next(int i, pg8::Unit& u) const {
        const int L = i * G + c;
        if (L < nmain) return so.next(i, u);
        const int q = L - nmain; if (q >= nextra) return false;
        const int k = q % 5; u.pm = 64 + q / 5; u.pn = k == 0 ? 2 : 8 + k; u.ko = 0; u.pa = u.pm; return true;
    }
    __device__ __forceinline__ void a_ready(const pg8::Unit&) const {}
    __device__ __forceinline__ void done(const pg8::Unit&) const {}
};

__device__ __forceinline__ P load_p() {
    const __attribute__((address_space(4))) P* k = (const __attribute__((address_space(4))) P*)__builtin_amdgcn_kernarg_segment_ptr();
    asm volatile("" : "+s"(k));
    P r;
#pragma unroll
    for (int i = 0; i < 34; ++i) r.in[i] = k->in[i];
    r.out = k->out; r.ws = k->ws; return r;
}
__global__ void __launch_bounds__(NWAVES * 64, 2) mega(Args args) {
    extern __shared__ __attribute__((aligned(16))) unsigned char lds[];
    LAS unsigned char* ldsl = (LAS unsigned char*)lds;
    const int tid = threadIdx.x, lane = tid & 63, wave = __builtin_amdgcn_readfirstlane(tid >> 6);
    const int G = gridDim.x, bx = blockIdx.x, vcu = (G % 8 == 0) ? (bx % 8) * (G / 8) + bx / 8 : bx;
    const int gw = vcu * NWAVES + wave, NGW = G * NWAVES;
    for (int u = tid; u < (LDS_BYTES - LDSCTL_OFF) / 4; u += NWAVES * 64) ((LAS unsigned*)(ldsl + LDSCTL_OFF))[u] = 0u;
    __syncthreads();
    XcdBarrier bar = xcd_barrier_post((unsigned*)(args.p.ws + WS_CTL) + CW_BAR + args.li * XCD_BAR_WORDS, (volatile LAS unsigned*)(ldsl + MISC_OFF) + 8);
    const int lo = args.ph_lo, hi = args.ph_hi;
#define IN(k) (lo <= (k) && (k) < hi)
#define OPQ(x) ({ int t_ = (x); asm volatile("" : "+v"(t_)); t_; })
#define SEAM(k) do { if (IN(k) && IN((k) + 1)) { xcd_barrier(bar); if (NREP(16) == 2) xcd_barrier(bar); } } while (0)

    if (KEN(0) && IN(0)) { const P& p = args.p;
        for (int rep_ = 0; rep_ < NREP(0); ++rep_) {
        for (int it = vcu; it < 192; it += G) ph_mod_item(p, it, (float*)lds, OPQ(tid));
        if (vcu == G - 1) ph_misc(p, tid, NWAVES * 64);
        float* scr = (float*)(lds + wave * 16384);
        if (ALL_MEGA) { for (int j = gw; j < N_PRO; j += NGW) prep_item(p, pro_item(j), scr, OPQ(lane)); }
        else for (int it = gw; it < IT_TOTAL; it += NGW) prep_item(p, it, scr, OPQ(lane));
        __syncthreads(); }
    }
    SEAM(0);

    for (int l = 0; l < 2; ++l) {
        const int pb = l == 0 ? 1 : 10;
        const int nrows = l == 0 ? MT : M_LAT;
        if (KEN(1) && IN(pb)) { const P p = load_p(); for (int rep_ = 0; rep_ < NREP(1); ++rep_) ph_norm(p, l, 0, MT, OPQ(gw), NGW, OPQ(lane)); }
        SEAM(pb);
        if (KEN(2) && IN(pb + 1)) { const P p = load_p(); unsigned char* ws = p.ws;
            pg8::Gemm g{(const bf16*)(ws + WS_H), (const bf16*)(ws + WS_WIN) + (size_t)l * IN_W * D, MT, IN_W, D, D};
            InprojOrder S; S.init(l, G, bx);
            pg8::EpiInproj E{ws, p.in[10] + l * 64, p.in[11] + l * 64, p.in[9] + l * 3072};
            for (int rep_ = 0; rep_ < NREP(2); ++rep_) pg8::gemm_phase<pg8::EpiInproj, InprojOrder, true, true>(ldsl, g, S, E);
            if (ALL_MEGA && l == 0) {
                const int nfull = (MT / 256 * 25) % G; const P& pa = args.p; float* scr = (float*)(lds + wave * 16384);
                const int rank = nfull != 0 ? (int)bx - nfull : (int)bx, nid = nfull != 0 ? G - nfull : G;
                if (rank >= 0) for (int j = rank * NWAVES + wave; j < N_L1; j += nid * NWAVES) prep_item(pa, l1_item(j), scr, OPQ(lane)); }
            if (ALL_MEGA && l == 1) {
                const int nfull = (M_LAT / 256 * 25 + 20) % G;
                if (nfull != 0 && (int)bx >= nfull) { const P& pa = args.p; const int rank = (int)bx - nfull, nid = G - nfull; float* scr = (float*)(lds + wave * 16384);
                    for (int it = IT_DEF1 + rank * NWAVES + wave; it < IT_TOTAL; it += nid * NWAVES) prep_item(pa, it, scr, OPQ(lane)); }
                else if (nfull == 0) { const P& pa = args.p; float* scr = (float*)(lds + wave * 16384);
                    for (int it = IT_DEF1 + (int)bx * NWAVES + wave; it < IT_TOTAL; it += G * NWAVES) prep_item(pa, it, scr, OPQ(lane)); } }
        }
        SEAM(pb + 1);
        if (IN(pb + 2)) { const P p = load_p(); unsigned char* ws = p.ws;
            if (KEN(3)) for (int rep_ = 0; rep_ < NREP(3); ++rep_) for (int t = vcu; t < (l == 0 ? CONV_TILES_ALL : CONV_TILES_LAT); t += G) conv_tile(p, l, t, lds, OPQ(tid));
            __syncthreads();
            if (KEN(4)) for (int rep_ = 0; rep_ < NREP(4); ++rep_) for (int k = 0;; ++k) {
                const int nl = vcu < 512 ? (512 - vcu + G - 1) / G : 0; int u;
                if (k < nl) u = vcu + k * G; else { const int q = (vcu + G - 32 % G) % G + (k - nl) * G; if (l != 0 || q >= 32) break; u = 512 + q; }
                int b, vh, qrow0, krow0, NT;
                if (u < 512) { b = u >> 7; vh = (u >> 4) & 7; qrow0 = b * SEQ + (u & 15) * 256; krow0 = b * NKEY; NT = NKEY / 64; }
                else { const int q = u - 512; b = q >> 3; vh = q & 7; qrow0 = M_LAT + b * CTXL; krow0 = b * NKEY + SEQ; NT = CTXL / 64; }
                attn_body::attn_unit<8>((const attn_body::bf16*)(ws + WS_QA) + (size_t)qrow0 * 512 + vh * 64, 512, (const attn_body::bf16*)(ws + WS_KA) + (size_t)krow0 * 128 + (vh >> 2) * 64,
                                        (const attn_body::bf16*)(ws + WS_VA) + (size_t)krow0 * 128 + (vh >> 2) * 64, 128, (attn_body::bf16*)(ws + WS_OABC) + (size_t)qrow0 * 1536 + vh * 64, 1536, NT, (char*)lds);
            }
            if (KEN(4)) for (int rep_ = 0; rep_ < NREP(4); ++rep_) for (int k = 0;; ++k) {
                const int nl = vcu < 256 ? (256 - vcu + G - 1) / G : 0; int su;
                if (k < nl) su = vcu + k * G; else { const int q = (vcu + G - 64 % G) % G + (k - nl) * G; if (l != 0 || q >= 16) break; su = 256 + q; }
                int b, h, qrow0, krow0, NT;
                if (su < 256) { b = su >> 6; h = (su >> 4) & 3; qrow0 = b * SEQ + (su & 15) * 256; krow0 = b * NKEY; NT = NKEY / 64; }
                else { const int q = su - 256; b = q >> 2; h = q & 3; qrow0 = M_LAT + b * CTXL; krow0 = b * NKEY + SEQ; NT = CTXL / 64; }
                {
                    const float lam = ((const float*)(ws + WS_LAM))[l], li = ((const float*)(ws + WS_LAM))[2 + l];
                    const attn_c::bf16* q_ = (const attn_c::bf16*)(ws + WS_QC) + (size_t)qrow0 * 512 + (2 * h) * 64; const attn_c::bf16* k_ = (const attn_c::bf16*)(ws + WS_KC) + (size_t)krow0 * 512 + (2 * h) * 64;
                    const attn_c::bf16* v_ = (const attn_c::bf16*)(ws + WS_VC) + (size_t)krow0 * 512 + h * 128;
                    attn_body::attn_unit_v128<0, 8>(q_, 512, k_, v_, 512, (attn_c::bf16*)nullptr, 0, NT, (char*)lds, 0.f, 0.f, (const float*)nullptr);
                    attn_body::attn_unit_v128<1, 8>(q_ + 64, 512, k_ + 64, v_, 512, (attn_c::bf16*)(ws + WS_OABC) + (size_t)qrow0 * 1536 + 1024 + h * 128, 1536, NT, (char*)lds, lam, 1.f - li, p.in[20] + l * 128); }
            }
        }
        if (IN(pb + 2) && IN(pb + 4)) xcd_barrier(bar);
        if (KEN(6) && IN(pb + 4)) { const P p = load_p(); unsigned char* ws = p.ws;
            pg8::Gemm g{(const bf16*)(ws + WS_OABC), (const bf16*)(ws + WS_WP) + (size_t)l * D * 1536, nrows, D, 1536, 1536};
            pg8::StaticOrder S; S.init(nrows, D, G, bx);
            pg8::EpiMerge E{(const unsigned char*)(ws + WS_G), (bf16*)(ws + WS_MB)};
            for (int rep_ = 0; rep_ < NREP(6); ++rep_) pg8::gemm_phase<pg8::EpiMerge, pg8::StaticOrder, true, true>(ldsl, g, S, E);
            if (ALL_MEGA && l == 0 && (int)bx >= MT / 256 * 4 - G) {
                const P& pa = args.p; const int n2 = MT / 256 * 4 - G, rank = (int)bx - n2, nid = G - n2; float* scr = (float*)(lds + wave * 16384);
                for (int it = IT_EARLY + rank * NWAVES + wave; it < IT_DEF1; it += nid * NWAVES) prep_item(pa, it, scr, OPQ(lane)); }
        }
        SEAM(pb + 4);
        if (KEN(7) && IN(pb + 5)) { const P p = load_p(); unsigned char* ws = p.ws;
            pg8::Gemm g{(const bf16*)(ws + WS_MB), (const bf16*)(ws + WS_WOUT) + (size_t)l * D * D, M_LAT, D, D, D};
            pg8::StaticOrder S; S.init(M_LAT, D, G, bx);
            pg8::EpiResid E{l == 0 ? p.in[0] : (const float*)nullptr, (bf16*)(ws + WS_XB), modv(p, l, 0, 2)};
            pg8::gemm_phase<pg8::EpiResid, pg8::StaticOrder, true, true>(ldsl, g, S, E);
            if (l == 0) {
                pg8::Gemm gt{(const bf16*)(ws + WS_MB), (const bf16*)(ws + WS_WOUT), MT, D, 256, D};
                pg8::CtxSliceOrder St; St.init(4, G, bx);
                pg8::EpiCtxPartial Et{(bf16*)(ws + WS_CPO)};
                pg8::gemm_phase<pg8::EpiCtxPartial, pg8::CtxSliceOrder, true, true>(ldsl, gt, St, Et);
                }
        }
        SEAM(pb + 5);
        if (l == 0) {
            if (KEN(8) && IN(pb + 6)) { const P p = load_p(); for (int rep_ = 0; rep_ < NREP(8); ++rep_) ph_norm(p, l, 1, MT, OPQ(gw), NGW, OPQ(lane)); }
            SEAM(pb + 6);
            if (KEN(9) && IN(pb + 7)) { const P p = load_p(); unsigned char* ws = p.ws;
                pg8::Gemm g{(const bf16*)(ws + WS_H8), (const bf16*)(ws + WS_FFN13), MT, 2 * DFF, D / 2, D / 2, SC_W13, SC_ONE};
                pg8::StaticOrder S; S.init(MT, 2 * DFF, G, bx);
                pg8::EpiSwiglu E{(bf16*)(ws + WS_HMID), DFF, 1 << 20};
                for (int rep_ = 0; rep_ < NREP(9); ++rep_) pg8::gemm_phase<pg8::EpiSwiglu, pg8::StaticOrder, true, true, true>(ldsl, g, S, E);
            }
            SEAM(pb + 7);
            if (KEN(10) && IN(pb + 8)) { const P p = load_p(); unsigned char* ws = p.ws;
                pg8::Gemm g{(const bf16*)(ws + WS_HMID), (const bf16*)(ws + WS_FFN2), M_LAT, D, DFF, DFF};
                pg8::StaticOrder S; S.init(M_LAT, D, G, bx);
                pg8::EpiResid E{(const float*)nullptr, (bf16*)(ws + WS_XB), modv(p, 0, 0, 5)};
                pg8::gemm_phase<pg8::EpiResid, pg8::StaticOrder, true, true>(ldsl, g, S, E);
                {
                    pg8::Gemm gt{(const bf16*)(ws + WS_HMID), (const bf16*)(ws + WS_FFN2), MT, D, 256, DFF};
                    pg8::CtxSliceOrder St; St.init(11, G, bx);
                    pg8::EpiCtxPartial Et{(bf16*)(ws + WS_CPF)};
                    pg8::gemm_phase<pg8::EpiCtxPartial, pg8::CtxSliceOrder, true, true>(ldsl, gt, St, Et);
                    }
            }
            SEAM(pb + 8);
        } else {
            if (KEN(11) && IN(pb + 6)) { const P p = load_p(); ph_router(p, vcu, G, NWAVES, lds, OPQ(tid)); }
            if (IN(pb + 6) && IN(pb + 8)) xcd_barrier(bar);
            if (KEN(13) && IN(pb + 8)) { const P p = load_p(); unsigned char* ws = p.ws;
                int base[9]; moe_bases(p, base);
                pg8::Gemm g{(const bf16*)(ws + WS_H2PX), (const bf16*)(ws + WS_MOE13), base[8], 8 * 2 * DFFX, D / 2, D / 2, SC_W13, SC_ONE, 1};
                pg8::MoeOrder S; S.init(base, 28, G, bx);
                pg8::EpiSwigluF8 E{(unsigned char*)(ws + WS_HMX), DFFX, 28};
                for (int rep_ = 0; rep_ < NREP(13); ++rep_) pg8::gemm_phase<pg8::EpiSwigluF8, pg8::MoeOrder, true, true, true>(ldsl, g, S, E);
            }
            SEAM(pb + 8);
            if (KEN(14) && IN(pb + 9)) { const P p = load_p(); unsigned char* ws = p.ws;
                int base[9]; moe_bases(p, base);
                pg8::Gemm g{(const bf16*)(ws + WS_HMX), (const bf16*)(ws + WS_MOE2), base[8], 8 * D, DFFX / 2, DFFX / 2, SC_W2, SC_HM};
                pg8::MoeOrder S; S.init(base, 4, G, bx, 128);
                pg8::EpiMoeDown E{(bf16*)(ws + WS_H2P), (const float*)(ws + WS_EXPP)};
                for (int rep_ = 0; rep_ < NREP(14); ++rep_) pg8::gemm_phase<pg8::EpiMoeDown, pg8::MoeOrder, true, true, true>(ldsl, g, S, E);
                {
                    pg8::Gemm gt{(const bf16*)(ws + WS_HMX), (const bf16*)(ws + WS_MOE2), base[8], 8 * D, 256, DFFX / 2, SC_W2, SC_HM};
                    pg8::MoeTailOrder St; St.init(base, G, bx);
                    pg8::EpiMoeDownTail Et{(bf16*)(ws + WS_YPT), (const float*)(ws + WS_EXPP)};
                    pg8::gemm_phase<pg8::EpiMoeDownTail, pg8::MoeTailOrder, true, true, true>(ldsl, gt, St, Et); }
            }
            SEAM(pb + 9);
            if (KEN(15) && IN(pb + 10)) { const P p = load_p(); ph_final(p, OPQ(gw), NGW, OPQ(lane)); }
        }
    }
#undef IN
#undef SEAM
}
constexpr int N_PHASES = 21;

#if !ALL_MEGA
__global__ void __launch_bounds__(256) k_prep(P p) {
    __shared__ float scr[4][64 * 33];
    const int wave = threadIdx.x >> 6, lane = threadIdx.x & 63;
    for (int it = blockIdx.x * 4 + wave; it < IT_TOTAL; it += gridDim.x * 4) prep_item(p, it, scr[wave], lane);
}
__global__ void __launch_bounds__(512) k_mod(P p) { __shared__ float sm[8 * 5 * 64 + 5 * 1024]; for (int it = blockIdx.x; it < 192; it += gridDim.x) ph_mod_item(p, it, sm, threadIdx.x); if (blockIdx.x == 0) ph_misc(p, threadIdx.x, 512); }
__global__ void __launch_bounds__(256) k_norm(P p, int l, int which, int nrows) { ph_norm(p, l, which, nrows, blockIdx.x * 4 + (threadIdx.x >> 6), gridDim.x * 4, threadIdx.x & 63); }
__global__ void __launch_bounds__(256) k_router(P p) { __shared__ __attribute__((aligned(16))) unsigned char sm[4096 + 65536 - 4096]; ph_router(p, blockIdx.x, gridDim.x, 4, sm, threadIdx.x); }
__global__ void __launch_bounds__(256) k_final(P p) { ph_final(p, blockIdx.x * 4 + (threadIdx.x >> 6), gridDim.x * 4, threadIdx.x & 63); }
__global__ void __launch_bounds__(256) k_occomb(P p, int l, int nrows) { ph_occomb(p, l, nrows, blockIdx.x * 4 + (threadIdx.x >> 6), gridDim.x * 4, threadIdx.x & 63); }
__global__ void __launch_bounds__(512, 2) k_conv(P p, int l, int ntiles) { extern __shared__ __attribute__((aligned(16))) unsigned char sm[]; for (int t = blockIdx.x; t < ntiles; t += gridDim.x) { int tid = threadIdx.x; asm volatile("" : "+v"(tid)); conv_tile(p, l, t, sm, tid); } }
__global__ void __launch_bounds__(256) k_attn(P p, int typeC) {
    __shared__ float Ks[32][64], Vs[32][64];
    const int qb = blockIdx.x, vh = blockIdx.y, tid = threadIdx.x;
    const bf16 *Q, *K, *V; bf16* O; int qp, kp, op;
    if (!typeC) { Q = (const bf16*)(p.ws + WS_QA) + vh * 64; qp = 512; K = (const bf16*)(p.ws + WS_KA) + (vh / 4) * 64; V = (const bf16*)(p.ws + WS_VA) + (vh / 4) * 64; kp = 128; O = (bf16*)(p.ws + WS_OABC) + vh * 64; op = 1536; }
    else { Q = (const bf16*)(p.ws + WS_QC) + (vh >> 1) * 64; qp = 512; K = (const bf16*)(p.ws + WS_KC) + (vh >> 1) * 64; V = (const bf16*)(p.ws + WS_VC) + (vh >> 2) * 128 + (vh & 1) * 64; kp = 512; O = (bf16*)(p.ws + WS_OCR) + vh * 64; op = 1024; }
    int k0, nk; if (qb < 64) { k0 = (qb / 16) * NKEY; nk = NKEY; } else { k0 = (qb - 64) * NKEY + SEQ; nk = CTXL; }
    const int row = qb * 256 + tid;
    float q[64], o[64];
#pragma unroll
    for (int d = 0; d < 64; ++d) { q[d] = bf2f(Q[(size_t)row * qp + d]); o[d] = 0.f; }
    float m = -INFINITY, lsum = 0.f;
    for (int kt = 0; kt < nk; kt += 32) {
        __syncthreads();
        for (int i = tid; i < 32 * 64; i += 256) { const int kk = i >> 6, d = i & 63; Ks[kk][d] = bf2f(K[(size_t)(k0 + kt + kk) * kp + d]); Vs[kk][d] = bf2f(V[(size_t)(k0 + kt + kk) * kp + d]); }
        __syncthreads();
        float s[32]; float mx = m;
#pragma unroll
        for (int j = 0; j < 32; ++j) { float a = 0.f;
#pragma unroll
            for (int d = 0; d < 64; ++d) a += q[d] * Ks[j][d];
            s[j] = a; mx = fmaxf(mx, a); }
        const float alpha = exp2f(m - mx); m = mx; lsum *= alpha;
#pragma unroll
        for (int d = 0; d < 64; ++d) o[d] *= alpha;
#pragma unroll
        for (int j = 0; j < 32; ++j) { const float pj = exp2f(s[j] - m); lsum += pj;
#pragma unroll
            for (int d = 0; d < 64; ++d) o[d] += pj * Vs[j][d]; }
    }
    const float rl = 1.f / lsum;
#pragma unroll
    for (int d = 0; d < 64; d += 2) *(unsigned*)(O + (size_t)row * op + d) = pk2(o[d] * rl, o[d + 1] * rl);
}

struct TileCtx { float (*C)[257]; int rt64, pn, tid; };
template <class Epi> __global__ void __launch_bounds__(256) k_gemm(P p, Epi E, const bf16* A, int lda, const bf16* Bt, int ldb, int K) {
    extern __shared__ __attribute__((aligned(16))) float smem_g[];
    float (*As)[64] = (float (*)[64])smem_g;
    float (*Bs)[256] = (float (*)[256])(smem_g + 32 * 64);
    float (*Ct)[257] = (float (*)[257])(smem_g + 32 * 64 + 32 * 256);
    const int tid = threadIdx.x, tx = tid & 31, ty = tid >> 5, rt64 = blockIdx.x, pn = blockIdx.y;
    int bt; if (!E.map(p, rt64, pn, bt)) return;
    const bf16* Ab = A + (size_t)rt64 * 64 * lda; const bf16* Bb = Bt + (size_t)bt * 256 * ldb;
    float acc[8][8];
#pragma unroll
    for (int i = 0; i < 8; ++i)
#pragma unroll
        for (int j = 0; j < 8; ++j) acc[i][j] = 0.f;
    for (int k0 = 0; k0 < K; k0 += 32) {
        if (Epi::MIDK && (k0 == 512 || k0 == 1024)) E.mid(p, acc, rt64 * 64 + ty * 8, pn, tx, k0 / 512);
        __syncthreads();
        { const int r = tid >> 2, kq = (tid & 3) * 8; const u32x4 v = *(const u32x4*)(Ab + (size_t)r * lda + k0 + kq);
            As[kq + 0][r] = __uint_as_float(v.x << 16); As[kq + 1][r] = __uint_as_float(v.x & 0xffff0000u); As[kq + 2][r] = __uint_as_float(v.y << 16); As[kq + 3][r] = __uint_as_float(v.y & 0xffff0000u);
            As[kq + 4][r] = __uint_as_float(v.z << 16); As[kq + 5][r] = __uint_as_float(v.z & 0xffff0000u); As[kq + 6][r] = __uint_as_float(v.w << 16); As[kq + 7][r] = __uint_as_float(v.w & 0xffff0000u); }
#pragma unroll
        for (int q4 = 0; q4 < 4; ++q4) { const u32x4 v = *(const u32x4*)(Bb + (size_t)tid * ldb + k0 + q4 * 8); const int kq = q4 * 8;
            Bs[kq + 0][tid] = __uint_as_float(v.x << 16); Bs[kq + 1][tid] = __uint_as_float(v.x & 0xffff0000u); Bs[kq + 2][tid] = __uint_as_float(v.y << 16); Bs[kq + 3][tid] = __uint_as_float(v.y & 0xffff0000u);
            Bs[kq + 4][tid] = __uint_as_float(v.z << 16); Bs[kq + 5][tid] = __uint_as_float(v.z & 0xffff0000u); Bs[kq + 6][tid] = __uint_as_float(v.w << 16); Bs[kq + 7][tid] = __uint_as_float(v.w & 0xffff0000u); }
        __syncthreads();
#pragma unroll 4
        for (int k = 0; k < 32; ++k) { float a[8], b[8];
#pragma unroll
            for (int i = 0; i < 8; ++i) a[i] = As[k][ty * 8 + i];
#pragma unroll
            for (int j = 0; j < 8; ++j) b[j] = Bs[k][tx + 32 * j];
#pragma unroll
            for (int i = 0; i < 8; ++i)
#pragma unroll
                for (int j = 0; j < 8; ++j) acc[i][j] += a[i] * b[j]; }
    }
    if (Epi::MIDK) E.mid(p, acc, rt64 * 64 + ty * 8, pn, tx, 3);
#pragma unroll
    for (int i = 0; i < 8; ++i)
#pragma unroll
        for (int j = 0; j < 8; ++j) Ct[ty * 8 + i][tx + 32 * j] = acc[i][j];
    __syncthreads();
    TileCtx c{Ct, rt64, pn, tid};
    E.tile(p, c);
}
struct NInproj {
    static constexpr bool MIDK = false; int l;
    __device__ bool map(const P&, int, int pn, int& bt) const { bt = pn; return true; }
    __device__ void mid(const P&, float (&)[8][8], int, int, int, int) const {}
    __device__ void tile(const P& p, const TileCtx& t) const {
        const int c = t.tid, pn = t.pn, bj = c >> 7, hh = (c >> 5) & 3, j32 = c & 31, d = 32 * bj + j32, f = j32 & 15, nh = (j32 >> 4) & 1;
        const float* cosT = (const float*)(p.ws + WS_ROPE); const float* sinT = cosT + 1024;
        for (int r = 0; r < 64; ++r) {
            const int row = t.rt64 * 64 + r; const float v = t.C[r][c];
            if (pn < 3 || (pn >= 7 && pn < 11)) {
                const bool isq = pn < 2 || (pn >= 7 && pn < 9), isA = pn < 3, isv = (pn == 2 && hh >= 2);
                float x = v, xp = t.C[r][c ^ 16];
                if (isA && !isv) { float ss = 0.f;
                    for (int dd = 0; dd < 64; ++dd) { const float u = t.C[r][128 * (dd >> 5) + 32 * hh + (dd & 31)]; ss += u * u; }
                    const float rinv = 1.f / sqrtf(ss * (1.f / 64.f) + EPS); const float* g = p.in[isq ? 10 : 11] + l * 64;
                    x = x * rinv * g[d]; xp = xp * rinv * g[d ^ 16]; }
                float o = x;
                if (!isv && row < M_LAT) { const int tpos = row % SEQ, pos = bj ? (tpos % 64) : (tpos / 64); const float cs = cosT[pos * 16 + f], sn = sinT[pos * 16 + f];
                    o = nh ? (x * cs + xp * sn) : (x * cs - xp * sn); }
                if (isq) o *= C2;
                bf16* dst;
                if (pn < 2) dst = (bf16*)(p.ws + WS_QA) + (size_t)row * 512 + (4 * pn + hh) * 64 + d;
                else if (pn == 2) dst = (bf16*)(p.ws + (hh < 2 ? WS_KA : WS_VA)) + (size_t)keyrow(row) * 128 + (hh & 1) * 64 + d;
                else if (pn < 9) dst = (bf16*)(p.ws + WS_QC) + (size_t)row * 512 + (4 * (pn - 7) + hh) * 64 + d;
                else dst = (bf16*)(p.ws + WS_KC) + (size_t)keyrow(row) * 512 + (4 * (pn - 9) + hh) * 64 + d;
                *dst = (bf16)f2bf(o);
            } else if (pn < 7) {
                if (c < 128) { const float gt = t.C[r][c + 128]; ((bf16*)(p.ws + WS_Y))[(size_t)row * 512 + (pn - 3) * 128 + pcol(c)] = (bf16)f2bf(v * sigmoidf_(gt)); }
            } else if (pn < 13) {
                ((bf16*)(p.ws + WS_VC))[(size_t)keyrow(row) * 512 + (pn - 11) * 256 + pcol(c)] = (bf16)f2bf(v);
            } else {
                const int gc = (pn - 13) * 256 + pcol(c);
                ((bf16*)(p.ws + WS_G))[(size_t)row * 3072 + gc] = (bf16)f2bf(sigmoidf_(v + p.in[9][l * 3072 + gc]));
            }
        }
    }
};
struct NMerge {
    static constexpr bool MIDK = true; int pad_;
    __device__ bool map(const P&, int, int pn, int& bt) const { bt = pn; return true; }
    __device__ void mid(const P& p, float (&acc)[8][8], int row0, int pn, int tx, int seg  ) const {
        const bf16* G = (const bf16*)(p.ws + WS_G);
#pragma unroll
        for (int i = 0; i < 8; ++i)
#pragma unroll
            for (int j = 0; j < 8; ++j) { const int col = pn * 256 + pcol(tx + 32 * j); const size_t o = (size_t)(row0 + i) * 3072 + col;
                const float f = seg == 3 ? bf2f(G[o + 2048]) : bf2f(G[o + (seg - 1) * 1024]) / bf2f(G[o + seg * 1024]); acc[i][j] *= f; }
    }
    __device__ void tile(const P& p, const TileCtx& t) const {
        for (int r = 0; r < 64; ++r) ((bf16*)(p.ws + WS_MB))[(size_t)(t.rt64 * 64 + r) * D + t.pn * 256 + pcol(t.tid)] = (bf16)f2bf(t.C[r][t.tid]);
    }
};
struct NResid {
    static constexpr bool MIDK = false; int l, gj  , first  ;
    __device__ bool map(const P&, int, int pn, int& bt) const { bt = pn; return true; }
    __device__ void mid(const P&, float (&)[8][8], int, int, int, int) const {}
    __device__ void tile(const P& p, const TileCtx& t) const {
        for (int r = 0; r < 64; ++r) { const int row = t.rt64 * 64 + r, col = t.pn * 256 + t.tid;
            const float b = first ? x0_row(p, row)[col] : xs_row(p, row)[col];
            xs_row(p, row)[col] = b + modv(p, l, bidx(row), gj)[col] * t.C[r][t.tid]; }
    }
};
struct NSwiglu {
    static constexpr bool MIDK = false; int moe;
    __device__ bool map(const P& p, int rt64, int pn, int& bt) const {
        if (!moe) { bt = pn; return true; }
        int base[9]; moe_bases(p, base); if (rt64 * 64 >= base[8]) return false;
        int e = 0;
#pragma unroll
        for (int q = 1; q < 8; ++q) if (rt64 * 64 >= base[q]) e = q;
        bt = e * 28 + pn; return true;
    }
    __device__ void mid(const P&, float (&)[8][8], int, int, int, int) const {}
    __device__ void tile(const P& p, const TileCtx& t) const {
        if (t.tid >= 128) return;
        bf16* O = (bf16*)(p.ws + (moe ? WS_HMX : WS_HMID)); const int ld = moe ? DFFX : DFF;
        for (int r = 0; r < 64; ++r) O[(size_t)(t.rt64 * 64 + r) * ld + t.pn * 128 + pcol(t.tid)] = (bf16)f2bf(siluf_(t.C[r][t.tid]) * t.C[r][t.tid + 128]);
    }
};
struct NMoeDown {
    static constexpr bool MIDK = false; int pad_;
    __device__ bool map(const P& p, int rt64, int pn, int& bt) const {
        int base[9]; moe_bases(p, base); if (rt64 * 64 >= base[8]) return false;
        int e = 0;
#pragma unroll
        for (int q = 1; q < 8; ++q) if (rt64 * 64 >= base[q]) e = q;
        bt = e * 4 + pn; return true;
    }
    __device__ void mid(const P&, float (&)[8][8], int, int, int, int) const {}
    __device__ void tile(const P& p, const TileCtx& t) const {
        for (int r = 0; r < 64; ++r) { const int row = t.rt64 * 64 + r;
            ((bf16*)(p.ws + WS_H2P))[(size_t)row * D + t.pn * 256 + pcol(t.tid)] = (bf16)f2bf(((const float*)(p.ws + WS_ROWP))[row] * t.C[r][t.tid]); }
    }
};


#endif

constexpr int GEMM_LDS = (32 * 64 + 32 * 256 + 64 * 257) * 4;
constexpr int CONV_LDS = CONV_LDS_BYTES;
#if !ALL_MEGA
static void launch_naive_phase(const P& p, int ph, hipStream_t stream) {
    unsigned char* ws = p.ws;
    if (ph == 0) { k_prep<<<1024, 256, 0, stream>>>(p); k_mod<<<192, 512, 0, stream>>>(p); return; }
    const int l = ph >= 10 ? 1 : 0, k = ph - (l ? 10 : 1), nrows = l == 0 ? MT : M_LAT;
    switch (k) {
    case 0: k_norm<<<1024, 256, 0, stream>>>(p, l, 0, MT); break;
    case 1: k_gemm<NInproj><<<dim3(MT / 64, 25), 256, GEMM_LDS, stream>>>(p, NInproj{l}, (const bf16*)(ws + WS_H), D, (const bf16*)(ws + WS_WIN) + (size_t)l * IN_W * D, D, D); break;
    case 2: k_conv<<<320, 512, CONV_LDS, stream>>>(p, l, l == 0 ? CONV_TILES_ALL : CONV_TILES_LAT);
            k_attn<<<dim3(nrows / 256, 8), 256, 0, stream>>>(p, 0); k_attn<<<dim3(nrows / 256, 16), 256, 0, stream>>>(p, 1); break;
    case 3: k_occomb<<<1024, 256, 0, stream>>>(p, l, nrows); break;
    case 4: k_gemm<NMerge><<<dim3(nrows / 64, 4), 256, GEMM_LDS, stream>>>(p, NMerge{0}, (const bf16*)(ws + WS_OABC), 1536, (const bf16*)(ws + WS_WP) + (size_t)l * D * 1536, 1536, 1536); break;
    case 5: k_gemm<NResid><<<dim3(nrows / 64, 4), 256, GEMM_LDS, stream>>>(p, NResid{l, 2, l == 0}, (const bf16*)(ws + WS_MB), D, (const bf16*)(ws + WS_WOUT) + (size_t)l * D * D, D, D); break;
    case 6: if (l == 0) k_norm<<<1024, 256, 0, stream>>>(p, l, 1, MT); else k_router<<<1024, 256, 0, stream>>>(p); break;
    case 7: if (l == 0) k_gemm<NSwiglu><<<dim3(MT / 64, 22), 256, GEMM_LDS, stream>>>(p, NSwiglu{0}, (const bf16*)(ws + WS_H), D, (const bf16*)(ws + WS_FFN13), D, D);
            break;
    case 8: if (l == 0) k_gemm<NResid><<<dim3(MT / 64, 4), 256, GEMM_LDS, stream>>>(p, NResid{l, 5, 0}, (const bf16*)(ws + WS_HMID), DFF, (const bf16*)(ws + WS_FFN2), DFF, DFF);
            else k_gemm<NSwiglu><<<dim3(RMAX / 64, 28), 256, GEMM_LDS, stream>>>(p, NSwiglu{1}, (const bf16*)(ws + WS_H2P), D, (const bf16*)(ws + WS_MOE13), D, D); break;
    case 9: k_gemm<NMoeDown><<<dim3(RMAX / 64, 4), 256, GEMM_LDS, stream>>>(p, NMoeDown{0}, (const bf16*)(ws + WS_HMX), DFFX, (const bf16*)(ws + WS_MOE2), DFFX, DFFX); break;
    case 10: k_final<<<1024, 256, 0, stream>>>(p); break;
    }
}
#endif
extern "C" void kernel_launch(void* const* d_in, const int* in_sizes, int n_in, void* d_out, int out_size, void* d_ws, size_t ws_size, hipStream_t stream) {
    static int grid = 0;
    if (grid == 0) {
        if (n_in != 34 || out_size != M_LAT * D || ws_size < WS_END2) { fprintf(stderr, "kernel_launch: unexpected shapes (n_in %d out %d ws %zu need %zu)\n", n_in, out_size, ws_size, (size_t)WS_END2); grid = -1; return; }
        int dev = 0, cus = 0, per_cu = 0;
        if (hipGetDevice(&dev) != hipSuccess || hipDeviceGetAttribute(&cus, hipDeviceAttributeMultiprocessorCount, dev) != hipSuccess) { grid = -1; return; }
        if (hipFuncSetAttribute((const void*)mega, hipFuncAttributeMaxDynamicSharedMemorySize, LDS_BYTES) != hipSuccess) { fprintf(stderr, "kernel_launch: hipFuncSetAttribute failed\n"); grid = -1; return; }
#if !ALL_MEGA
        (void)hipFuncSetAttribute((const void*)k_gemm<NInproj>, hipFuncAttributeMaxDynamicSharedMemorySize, GEMM_LDS);
        (void)hipFuncSetAttribute((const void*)k_gemm<NMerge>, hipFuncAttributeMaxDynamicSharedMemorySize, GEMM_LDS);
        (void)hipFuncSetAttribute((const void*)k_gemm<NResid>, hipFuncAttributeMaxDynamicSharedMemorySize, GEMM_LDS);
        (void)hipFuncSetAttribute((const void*)k_gemm<NSwiglu>, hipFuncAttributeMaxDynamicSharedMemorySize, GEMM_LDS);
        (void)hipFuncSetAttribute((const void*)k_gemm<NMoeDown>, hipFuncAttributeMaxDynamicSharedMemorySize, GEMM_LDS);
        (void)hipFuncSetAttribute((const void*)k_conv, hipFuncAttributeMaxDynamicSharedMemorySize, CONV_LDS);
#endif
        if (hipOccupancyMaxActiveBlocksPerMultiprocessor(&per_cu, (const void*)mega, NWAVES * 64, LDS_BYTES) != hipSuccess || per_cu < 1) fprintf(stderr, "kernel_launch: occupancy query says %d\n", per_cu);
        (void)hipGetLastError();
        grid = cus;
    }
    if (grid < 0) return;
    P p{};
    for (int i = 0; i < 34; ++i) p.in[i] = (const float*)d_in[i];
    p.out = (float*)d_out; p.ws = (unsigned char*)d_ws;
    (void)hipMemsetAsync((char*)d_ws + WS_CTL, 0, CTL_ZERO_BYTES, stream);
    const unsigned mask = MEGA_MASK;
    int li = 0;
    for (int ph = 0; ph < N_PHASES;) {
        if ((mask >> ph) & 1u) { int hi = ph; while (hi < N_PHASES && ((mask >> hi) & 1u)) ++hi;
#if !ALL_MEGA && defined(DBG_INPROJ)
            if (ph == 2) launch_naive_phase(p, 2, stream);
#endif
            Args a{}; a.p = p; a.ph_lo = ph; a.ph_hi = hi; a.li = li++; a.pad = 0;
            hipLaunchKernelGGL(mega, dim3(grid), dim3(NWAVES * 64), LDS_BYTES, stream, a);
            ph = hi; }
#if !ALL_MEGA
        else { launch_naive_phase(p, ph, stream); ++ph; }
#else
        else ++ph;
#endif
    }
}
```

```cpp
#include <hip/hip_runtime.h>
#include <cstdint>
#include <cstdio>


#ifndef MEGA_MASK
#define MEGA_MASK 0x1FFFFF
#endif
#define ALL_MEGA ((MEGA_MASK) == 0x1FFFFF)
typedef unsigned short bf16;
typedef float f32x4 __attribute__((ext_vector_type(4)));
typedef unsigned u32x4 __attribute__((ext_vector_type(4)));
typedef unsigned u32x2 __attribute__((ext_vector_type(2)));

constexpr int D = 1024, NB = 4, SEQ = 4096, CTXL = 256;
constexpr int M_LAT = NB * SEQ, M_CTX = NB * CTXL, MT = M_LAT + M_CTX;
constexpr int NKEY = SEQ + CTXL;
constexpr int IN_W = 6400;
constexpr int DFF = 2816, DFFX = 3584, NEXP = 8;
constexpr int RMAX = 34816;
constexpr float EPS = 1e-6f;
constexpr float C2 = 0.125f * 1.4426950408889634f;

constexpr size_t MiB = 1u << 20;
constexpr size_t WS_CTL = 0, CTL_ZERO_BYTES = 1 * MiB;
constexpr size_t WS_MODV = 1 * MiB;
constexpr size_t WS_ROPE = WS_MODV + 256 * 1024;
constexpr size_t WS_LAM = WS_ROPE + 16 * 1024;
constexpr size_t WS_TOKE = 2 * MiB;
constexpr size_t WS_TOKS = WS_TOKE + 128 * 1024;
constexpr size_t WS_TOKP = WS_TOKS + 128 * 1024;
constexpr size_t WS_EXPP = 3 * MiB;
constexpr size_t WS_XSC = 4 * MiB;
constexpr size_t WS_MOE13 = 8 * MiB;
constexpr size_t WS_XB = 64 * MiB;
constexpr size_t WS_CPF = 96 * MiB;
constexpr size_t WS_CPO = 148 * MiB;
constexpr size_t WS_MOE2 = 120 * MiB;
constexpr size_t WS_A2 = 176 * MiB;
constexpr size_t WS_WIN = WS_A2;
constexpr size_t WS_WP = WS_WIN + 2 * (size_t)IN_W * D * 2;
constexpr size_t WS_WOUT = WS_WP + 2 * (size_t)D * 1536 * 2;
constexpr size_t WS_FFN13 = WS_WOUT + 2 * (size_t)D * D * 2;
constexpr size_t WS_FFN2 = WS_FFN13 + (size_t)2 * DFF * D * 2;
constexpr size_t WS_U = 228 * MiB;
static_assert(WS_FFN2 + (size_t)D * DFF * 2 <= WS_U, "A2");
static_assert(WS_MOE13 + (size_t)8 * 7168 * 1024 <= WS_XB && WS_XB + (size_t)M_LAT * D * 2 <= WS_CPF && WS_CPF + (size_t)11 * 1024 * 1024 * 2 <= WS_MOE2 && WS_MOE2 + (size_t)8 * 1024 * 3584 <= WS_CPO && WS_CPO + (size_t)4 * 1024 * 1024 * 2 <= WS_A2, "XB / ctx partials");
constexpr size_t WS_QA = WS_U;
constexpr size_t WS_KA = WS_QA + (size_t)MT * 512 * 2;
constexpr size_t WS_VA = WS_KA + (size_t)MT * 128 * 2;
constexpr size_t WS_Y = WS_VA + (size_t)MT * 128 * 2;
constexpr size_t WS_QC = WS_Y + (size_t)MT * 512 * 2;
constexpr size_t WS_KC = WS_QC + (size_t)MT * 512 * 2;
constexpr size_t WS_VC = WS_KC + (size_t)MT * 512 * 2;
constexpr size_t WS_G = WS_VC + (size_t)MT * 512 * 2;
constexpr size_t WS_OABC = WS_G + (size_t)MT * 3072 * 2;
constexpr size_t WS_H = WS_OABC;
constexpr size_t WS_H8 = WS_H + (size_t)MT * D * 2;
constexpr size_t WS_OCR = WS_OABC + (size_t)MT * 1536 * 2;
constexpr size_t WS_MB = WS_OCR;
constexpr size_t WS_END = WS_OCR + (size_t)MT * 1024 * 2;
constexpr size_t WS_HMID = WS_U;
static_assert(WS_HMID + (size_t)MT * DFF * 2 <= WS_G, "HMID overlay");
constexpr size_t WS_H2P = WS_A2;
constexpr size_t WS_HMX = WS_H2P + (size_t)RMAX * D * 2;
constexpr size_t WS_H2PX = WS_HMX + (size_t)RMAX * DFFX;
constexpr size_t WS_YPT = WS_H2PX + (size_t)8 * 16384 * D;
constexpr size_t WS_END2 = WS_YPT + (size_t)7 * 2048 * 1024 * 2;
static_assert(WS_HMX + (size_t)RMAX * DFFX * 2 <= WS_END2 && WS_END2 <= 582000000, "HMX overlay");
static_assert(WS_H2P + (size_t)RMAX * D * 2 <= WS_H, "H2P must not overlap H");

constexpr int CW_CNT = 64;

__device__ __forceinline__ float bf2f(bf16 v) { return __uint_as_float(((unsigned)v) << 16); }
__device__ __forceinline__ unsigned f2bf(float f) { unsigned u = __float_as_uint(f); return (u + 0x7fffu + ((u >> 16) & 1u)) >> 16; }
typedef float f32x2_pk __attribute__((ext_vector_type(2))); typedef __bf16 bf16x2_pk __attribute__((ext_vector_type(2)));
__device__ __forceinline__ unsigned pk2(float lo, float hi) { f32x2_pk v = {lo, hi}; bf16x2_pk b = __builtin_convertvector(v, bf16x2_pk); return __builtin_bit_cast(unsigned, b); }
__device__ __forceinline__ float sigmoidf_(float x) { return 1.f / (1.f + __expf(-x)); }
__device__ __forceinline__ float siluf_(float x) { return x * __builtin_amdgcn_rcpf(1.f + __expf(-x)); }
__device__ __forceinline__ float rsq_(float x) { return __builtin_amdgcn_rsqf(x); }
template <int CTRL> __device__ __forceinline__ float dpp_mov(float v) { return __builtin_bit_cast(float, __builtin_amdgcn_update_dpp(0, __builtin_bit_cast(int, v), CTRL, 0xf, 0xf, true)); }
__device__ __forceinline__ float xsum_row16(float v) {
    v += dpp_mov<0xB1>(v); v += dpp_mov<0x4E>(v); v += dpp_mov<0x141>(v); v += dpp_mov<0x140>(v); return v; }
__device__ __forceinline__ float xsum_x16(float v) { const auto rr = __builtin_amdgcn_permlane16_swap(__float_as_uint(v), __float_as_uint(v), false, false); return __uint_as_float(rr[0]) + __uint_as_float(rr[1]); }
__device__ __forceinline__ float xsum_x32(float v) { const auto rr = __builtin_amdgcn_permlane32_swap(__float_as_uint(v), __float_as_uint(v), false, false); return __uint_as_float(rr[0]) + __uint_as_float(rr[1]); }
__device__ __forceinline__ float wave_sum(float v) { return xsum_x32(xsum_x16(xsum_row16(v))); }
__host__ __device__ __forceinline__ int pcol5(int j) { return 8 * ((j >> 2) & 3) + 4 * ((j >> 4) & 1) + (j & 3); }
__host__ __device__ __forceinline__ int pcol(int c) { return (c & ~31) | pcol5(c & 31); }
__device__ __forceinline__ int keyrow(int r) { return r < M_LAT ? (r / SEQ) * NKEY + (r % SEQ) : ((r - M_LAT) / CTXL) * NKEY + SEQ + ((r - M_LAT) % CTXL); }
__device__ __forceinline__ int bidx(int r) { return r < M_LAT ? r / SEQ : 4; }

struct P {
    const float* in[34];
    float* out;
    unsigned char* ws;
};
__device__ __forceinline__ const float* modv(const P& p, int l, int bi, int j) { return (const float*)(p.ws + WS_MODV) + ((size_t)(l * 5 + bi) * 6 + j) * D; }
__device__ __forceinline__ float* xs_row(const P& p, int r) { return r < M_LAT ? p.out + (size_t)r * D : (float*)(p.ws + WS_XSC) + (size_t)(r - M_LAT) * D; }
__device__ __forceinline__ f32x4 ld_bf4(const bf16* q) { const u32x2 a = *(const u32x2*)q; return (f32x4){__uint_as_float(a.x << 16), __uint_as_float(a.x & 0xffff0000u), __uint_as_float(a.y << 16), __uint_as_float(a.y & 0xffff0000u)}; }
__device__ __forceinline__ const float* x0_row(const P& p, int r) { return r < M_LAT ? p.in[0] + (size_t)r * D : p.in[2] + (size_t)(r - M_LAT) * D; }

__host__ __device__ __forceinline__ int win_src_col(int np) {
    const int pn = np >> 8, c = np & 255, bj = c >> 7, hh = (c >> 5) & 3, j32 = c & 31, d = 32 * bj + j32;
    if (pn < 2) return (4 * pn + hh) * 64 + d;
    if (pn == 2) return hh < 2 ? 512 + hh * 64 + d : 640 + (hh - 2) * 64 + d;
    if (pn < 7) { const int ch = (pn - 3) * 128 + pcol(c & 127); return 768 + (bj ? 512 : 0) + ch; }
    if (pn < 9) return 1792 + (4 * (pn - 7) + hh) * 64 + d;
    if (pn < 11) return 2304 + (4 * (pn - 9) + hh) * 64 + d;
    if (pn < 13) return 2816 + (pn - 11) * 256 + pcol(c);
    return 3328 + (pn - 13) * 256 + pcol(c);
}
__device__ __forceinline__ void xpose_block(const float* src, int ldn, int k0, int scol, bf16* dst, int ldk, float* scr, int lane) {
    float ld_[32];
#pragma unroll
    for (int i = 0; i < 32; ++i) ld_[i] = src[(size_t)(k0 + 2 * i + (lane >> 5)) * ldn + scol];
#pragma unroll
    for (int i = 0; i < 32; ++i) scr[(2 * i + (lane >> 5)) * 33 + (lane & 31)] = ld_[i];
    asm volatile("s_waitcnt lgkmcnt(0)" ::: "memory");
    const int c = lane & 7;
#pragma unroll
    for (int j = 0; j < 4; ++j) { const int n = (lane >> 3) + 8 * j; const float* s = scr + (8 * c) * 33 + n;
        u32x4 o; o.x = pk2(s[0 * 33], s[1 * 33]); o.y = pk2(s[2 * 33], s[3 * 33]); o.z = pk2(s[4 * 33], s[5 * 33]); o.w = pk2(s[6 * 33], s[7 * 33]);
        *(u32x4*)(dst + (size_t)n * ldk + 8 * c) = o; }
    asm volatile("s_waitcnt lgkmcnt(0)" ::: "memory");
}
__device__ __forceinline__ unsigned pk4_fp8(float a, float b, float c, float d) { unsigned w = __builtin_amdgcn_cvt_pk_fp8_f32(a, b, 0u, false); return __builtin_amdgcn_cvt_pk_fp8_f32(c, d, w, true); }
__device__ __forceinline__ void xpose_block_f8(const float* src, int ldn, int k0, int scol, unsigned char* dst, int ldk, float* scr, int lane, float sc) {
    float ld_[32];
#pragma unroll
    for (int i = 0; i < 32; ++i) ld_[i] = src[(size_t)(k0 + 2 * i + (lane >> 5)) * ldn + scol];
#pragma unroll
    for (int i = 0; i < 32; ++i) scr[(2 * i + (lane >> 5)) * 33 + (lane & 31)] = ld_[i];
    asm volatile("s_waitcnt lgkmcnt(0)" ::: "memory");
    const int c = lane & 7;
#pragma unroll
    for (int j = 0; j < 4; ++j) { const int n = (lane >> 3) + 8 * j; const float* s = scr + (8 * c) * 33 + n;
        u32x2 o; o.x = pk4_fp8(s[0 * 33] * sc, s[1 * 33] * sc, s[2 * 33] * sc, s[3 * 33] * sc); o.y = pk4_fp8(s[4 * 33] * sc, s[5 * 33] * sc, s[6 * 33] * sc, s[7 * 33] * sc);
        *(u32x2*)(dst + (size_t)n * ldk + 8 * c) = o; }
    asm volatile("s_waitcnt lgkmcnt(0)" ::: "memory");
}
constexpr float F8_W13 = 32.f, F8_W2 = 64.f, F8_HM = 4.f;
constexpr int SC_W13 = 0x7a7a7a7a, SC_W2 = 0x79797979, SC_HM = 0x7d7d7d7d, SC_ONE = 0x7f7f7f7f;
constexpr int IT_WIN = 16 * 200, IT_WP = 8 * 32, IT_WOUT = 16 * 32, IT_F13 = 16 * 176, IT_F2 = 44 * 32, IT_M13 = 16 * 224, IT_M2 = 56 * 32;
constexpr int IT_EARLY = 2 * IT_WIN + 6 * IT_WP + 2 * IT_WOUT + IT_F13 + IT_F2;
constexpr int IT_TOTAL = IT_EARLY + 8 * IT_M13 + 8 * IT_M2;
constexpr int IT_PRO = IT_EARLY;
constexpr int L1A0 = IT_WIN, L1A1 = 2 * IT_WIN, L1B0 = 2 * IT_WIN + 3 * IT_WP, L1B1 = 2 * IT_WIN + 6 * IT_WP, L1C0 = L1B1 + IT_WOUT, L1C1 = L1B1 + 2 * IT_WOUT;
constexpr int N_L1 = (L1A1 - L1A0) + (L1B1 - L1B0) + (L1C1 - L1C0), N_PRO = IT_EARLY - N_L1;
__host__ __device__ __forceinline__ int pro_item(int j) {
    if (j < L1A0) return j; j += L1A1 - L1A0;
    if (j < L1B0) return j; j += L1B1 - L1B0;
    if (j < L1C0) return j; return j + (L1C1 - L1C0); }
__host__ __device__ __forceinline__ int l1_item(int j) {
    if (j < L1A1 - L1A0) return L1A0 + j; j -= L1A1 - L1A0;
    if (j < L1B1 - L1B0) return L1B0 + j; j -= L1B1 - L1B0;
    return L1C0 + j; }
constexpr int IT_DEF1 = IT_EARLY + 30000, IT_DEF2 = IT_DEF1 + 4000;
__device__ __forceinline__ void prep_item(const P& p, int it, float* scr, int lane) {
    const int nl = lane & 31;
    if (it < 2 * IT_WIN) { const int l = it / IT_WIN, r = it % IT_WIN, kb = r / 200, nb = r % 200;
        xpose_block(p.in[8] + (size_t)l * D * IN_W, IN_W, 64 * kb, win_src_col(32 * nb + nl), (bf16*)(p.ws + WS_WIN) + (size_t)l * IN_W * D + (size_t)(32 * nb) * D + 64 * kb, D, scr, lane); return; }
    it -= 2 * IT_WIN;
    if (it < 6 * IT_WP) { const int l = it / (3 * IT_WP), r3 = it % (3 * IT_WP), br = r3 / IT_WP, r = r3 % IT_WP, kb = r / 32, nb = r % 32;
        xpose_block((br == 0 ? p.in[21] : br == 1 ? p.in[22] : p.in[23]) + (size_t)l * 512 * D, D, 64 * kb, pcol(32 * nb + nl), (bf16*)(p.ws + WS_WP) + (size_t)l * D * 1536 + (size_t)(32 * nb) * 1536 + br * 512 + 64 * kb, 1536, scr, lane); return; }
    it -= 6 * IT_WP;
    if (it < 2 * IT_WOUT) { const int l = it / IT_WOUT, r = it % IT_WOUT, kb = r / 32, nb = r % 32;
        xpose_block(p.in[24] + (size_t)l * D * D, D, 64 * kb, 32 * nb + nl, (bf16*)(p.ws + WS_WOUT) + (size_t)l * D * D + (size_t)(32 * nb) * D + 64 * kb, D, scr, lane); return; }
    it -= 2 * IT_WOUT;
    if (it < IT_F13) { const int kb = it / 176, nb = it % 176, np = 32 * nb + nl, c = np & 255, j = np >> 8;
        xpose_block_f8(((c >> 7) ? p.in[26] : p.in[25]), DFF, 64 * kb, j * 128 + pcol(c & 127), (unsigned char*)(p.ws + WS_FFN13) + (size_t)(32 * nb) * D + 64 * kb, D, scr, lane, F8_W13); return; }
    it -= IT_F13;
    if (it < IT_F2) { const int kb = it / 32, nb = it % 32;
        xpose_block(p.in[27], D, 64 * kb, 32 * nb + nl, (bf16*)(p.ws + WS_FFN2) + (size_t)(32 * nb) * DFF + 64 * kb, DFF, scr, lane); return; }
    it -= IT_F2;
    if (it < 8 * IT_M13) { const int e = it / IT_M13, r = it % IT_M13, kb = r / 224, nb = r % 224, np = 32 * nb + nl, c = np & 255, j = np >> 8;
        xpose_block_f8(((c >> 7) ? p.in[31] : p.in[30]) + (size_t)e * D * DFFX, DFFX, 64 * kb, j * 128 + pcol(c & 127), (unsigned char*)(p.ws + WS_MOE13) + (size_t)e * 7168 * D + (size_t)(32 * nb) * D + 64 * kb, D, scr, lane, F8_W13); return; }
    it -= 8 * IT_M13;
    { const int e = it / IT_M2, r = it % IT_M2, kb = r / 32, nb = r % 32;
        xpose_block_f8(p.in[32] + (size_t)e * DFFX * D, D, 64 * kb, pcol(32 * nb + nl), (unsigned char*)(p.ws + WS_MOE2) + (size_t)e * D * DFFX + (size_t)(32 * nb) * DFFX + 64 * kb, DFFX, scr, lane, F8_W2); }
}

__device__ __forceinline__ void ph_mod_item(const P& p, int item, float* lds, int tid) {
    const int l = item / 96, n0 = (item % 96) * 64, w = tid >> 6, lane = tid & 63;
    const float* wm = p.in[4] + (size_t)l * D * 6144 + (size_t)(128 * w) * 6144 + n0 + lane;
    float* sl = lds + 8 * 5 * 64;
    for (int i = tid; i < 5 * D; i += 512) { const float v = i < 4 * D ? p.in[1][i] : p.in[3][i - 4 * D]; sl[i] = siluf_(v); }
    __syncthreads();
    float a0 = 0.f, a1 = 0.f, a2 = 0.f, a3 = 0.f, a4 = 0.f;
#pragma unroll 32
    for (int k = 0; k < 128; ++k) { const float wv = wm[(size_t)k * 6144]; const int kk = 128 * w + k;
        a0 += sl[kk] * wv; a1 += sl[D + kk] * wv; a2 += sl[2 * D + kk] * wv; a3 += sl[3 * D + kk] * wv; a4 += sl[4 * D + kk] * wv; }
    lds[(w * 5 + 0) * 64 + lane] = a0; lds[(w * 5 + 1) * 64 + lane] = a1; lds[(w * 5 + 2) * 64 + lane] = a2; lds[(w * 5 + 3) * 64 + lane] = a3; lds[(w * 5 + 4) * 64 + lane] = a4;
    __syncthreads();
    if (tid < 320) { const int bi = tid >> 6; float s = 0.f;
#pragma unroll
        for (int ww = 0; ww < 8; ++ww) s += lds[(ww * 5 + bi) * 64 + lane];
        ((float*)(p.ws + WS_MODV))[(size_t)(l * 5 + bi) * 6144 + n0 + lane] = s + p.in[5][l * 6144 + n0 + lane]; }
    __syncthreads();
}
__device__ __forceinline__ void ph_misc(const P& p, int tid, int nthreads) {
    if (tid < 16) { const int f = tid;
        const double CS[16][2] = {{0.5403023058681397174, 0.84147098480789650665}, {0.84600911028170792533, 0.5331684399140228157}, {0.95041528025518286254, 0.31098359290718572638},
            {0.98423023447009458711, 0.17689218624615003844}, {0.9950041652780257661, 0.099833416646828152307}, {0.99841927779266443401, 0.056204499214692484859},
            {0.99950004166527780258, 0.031617506402433710095}, {0.99984189028361432743, 0.017781856879666127606}, {0.99995000041666527778, 0.0099998333341666646825},
            {0.99998418865336578085, 0.0056233836139601852304}, {0.99999500000416666528, 0.0031622723897082476155}, {0.99999841886158658243, 0.0017782784728035290072},
            {0.99999950000004166667, 0.00099999983333334166667}, {0.99999984188612115825, 0.0005623412955523593817}, {0.99999995000000041667, 0.0003162277607463751926},
            {0.99999998418861174082, 0.00017782794006665673962}};
        double C = 1.0, S = 0.0, c1 = 0.0, s1 = 0.0;
#pragma unroll
        for (int q = 0; q < 16; ++q) if (q == f) { c1 = CS[q][0]; s1 = CS[q][1]; }
        float* t = (float*)(p.ws + WS_ROPE);
        for (int pos = 0; pos < 64; ++pos) { t[pos * 16 + f] = (float)C; t[1024 + pos * 16 + f] = (float)S; const double nc = C * c1 - S * s1, ns = S * c1 + C * s1; C = nc; S = ns; } }
    if (tid < 2) { const int l = tid; float s1 = 0.f, s2 = 0.f;
        for (int k = 0; k < 64; ++k) { s1 += p.in[16][l * 64 + k] * p.in[17][l * 64 + k]; s2 += p.in[18][l * 64 + k] * p.in[19][l * 64 + k]; }
        const float li = 0.8f - 0.6f * expf(-0.3f * (float)l);
        float* t = (float*)(p.ws + WS_LAM); t[l] = expf(s1) - expf(s2) + li; t[2 + l] = li;
        float mq = 0.f, mk = 0.f;
        for (int k = 0; k < 64; ++k) { mq = fmaxf(mq, fabsf(p.in[10][l * 64 + k])); mk = fmaxf(mk, fabsf(p.in[11][l * 64 + k])); }
        const float cref = 64.f * C2 * mq * mk * 1.02f + 0.25f;
        t[4 + l] = (cref < 60.f) ? cref : -1.f; }
}

__device__ __forceinline__ void norm_row(const float* xrow, const float* g, const float* sc, const float* sh, bf16* orow, int lane, f32x4 (&hv)[4]) {
    f32x4 v[4]; float s = 0.f;
#pragma unroll
    for (int j = 0; j < 4; ++j) { v[j] = *(const f32x4*)(xrow + 4 * lane + 256 * j); s += (v[j].x * v[j].x + v[j].y * v[j].y) + (v[j].z * v[j].z + v[j].w * v[j].w); }
    const float rinv = rsq_(wave_sum(s) * (1.f / D) + EPS);
#pragma unroll
    for (int j = 0; j < 4; ++j) { const int c = 4 * lane + 256 * j; const f32x4 gv = *(const f32x4*)(g + c), scv = *(const f32x4*)(sc + c), shv = *(const f32x4*)(sh + c);
        hv[j] = (v[j] * rinv * gv) * (1.f + scv) + shv;
        u32x2 o; o.x = pk2(hv[j].x, hv[j].y); o.y = pk2(hv[j].z, hv[j].w); *(u32x2*)(orow + c) = o; }
}
__device__ __forceinline__ void ph_norm(const P& p, int l, int which  , int nrows, int gw, int NGW, int lane) {
    const bool first = which == 0 && l == 0; const int lim = first ? nrows : M_LAT;
    const float* g = (which ? p.in[7] : p.in[6]) + l * D;
    f32x4 vc[4], vn[4];
#define NLOAD(R, V) do { if (first) { const float* xr_ = x0_row(p, (R)); _Pragma("unroll") for (int j = 0; j < 4; ++j) V[j] = *(const f32x4*)(xr_ + 4 * lane + 256 * j); } \
        else { const bf16* xb_ = (const bf16*)(p.ws + WS_XB) + (size_t)(R) * D; _Pragma("unroll") for (int j = 0; j < 4; ++j) V[j] = ld_bf4(xb_ + 4 * lane + 256 * j); } } while (0)
    int r = gw; if (r < lim) NLOAD(r, vc);
    for (; r < lim; r += NGW) {
        const int rn = r + NGW; if (rn < lim) NLOAD(rn, vn);
        const int bi = bidx(r); const float* sc = modv(p, l, bi, which ? 4 : 1); const float* sh = modv(p, l, bi, which ? 3 : 0);
        float s = 0.f;
#pragma unroll
        for (int j = 0; j < 4; ++j) s += (vc[j].x * vc[j].x + vc[j].y * vc[j].y) + (vc[j].z * vc[j].z + vc[j].w * vc[j].w);
        const float rinv = rsq_(wave_sum(s) * (1.f / D) + EPS);
#pragma unroll
        for (int j = 0; j < 4; ++j) { const int c = 4 * lane + 256 * j; const f32x4 gv = *(const f32x4*)(g + c), scv = *(const f32x4*)(sc + c), shv = *(const f32x4*)(sh + c);
            const f32x4 h = (vc[j] * rinv * gv) * (1.f + scv) + shv;
            if (which == 0) { u32x2 o; o.x = pk2(h.x, h.y); o.y = pk2(h.z, h.w); *(u32x2*)((bf16*)(p.ws + WS_H) + (size_t)r * D + c) = o; }
            else *(unsigned*)((unsigned char*)(p.ws + WS_H8) + (size_t)r * D + c) = pk4_fp8(h.x, h.y, h.z, h.w); }
#pragma unroll
        for (int j = 0; j < 4; ++j) vc[j] = vn[j];
    }
#undef NLOAD
    if (first) return;
    for (; r < nrows; r += NGW) {
        const float* xr = xs_row(p, r); const int bi = bidx(r);
        {
            const int rc = r - M_LAT, nks = which == 1 ? 4 : 11; const bf16* P = (const bf16*)(p.ws + (which == 1 ? WS_CPO : WS_CPF)) + (size_t)rc * D;
            const float* base = which == 1 ? p.in[2] + (size_t)rc * D : xr; const float* gt = modv(p, 0, 4, which == 1 ? 2 : 5);
            const float* g = (which ? p.in[7] : p.in[6]) + l * D; const float* sc = modv(p, l, bi, which ? 4 : 1); const float* sh = modv(p, l, bi, which ? 3 : 0);
            f32x4 v[4]; float s = 0.f;
#pragma unroll
            for (int j = 0; j < 4; ++j) { const int c = 4 * lane + 256 * j; f32x4 y = (f32x4){0.f, 0.f, 0.f, 0.f};
                for (int ks = 0; ks < nks; ++ks) { const u32x2 a = *(const u32x2*)(P + (size_t)ks * 1024 * 1024 + c);
                    y.x += __uint_as_float(a.x << 16); y.y += __uint_as_float(a.x & 0xffff0000u); y.z += __uint_as_float(a.y << 16); y.w += __uint_as_float(a.y & 0xffff0000u); }
                v[j] = *(const f32x4*)(base + c) + *(const f32x4*)(gt + c) * y; s += (v[j].x * v[j].x + v[j].y * v[j].y) + (v[j].z * v[j].z + v[j].w * v[j].w);
                if (which == 1) *(f32x4*)((float*)(p.ws + WS_XSC) + (size_t)rc * D + c) = v[j]; }
            const float rinv = rsq_(wave_sum(s) * (1.f / D) + EPS); bf16* orow = (bf16*)(p.ws + WS_H) + (size_t)r * D;
#pragma unroll
            for (int j = 0; j < 4; ++j) { const int c = 4 * lane + 256 * j; const f32x4 gv = *(const f32x4*)(g + c), scv = *(const f32x4*)(sc + c), shv = *(const f32x4*)(sh + c);
                const f32x4 h = (v[j] * rinv * gv) * (1.f + scv) + shv;
                if (which == 0) { u32x2 o; o.x = pk2(h.x, h.y); o.y = pk2(h.z, h.w); *(u32x2*)(orow + c) = o; }
                else *(unsigned*)((unsigned char*)(p.ws + WS_H8) + (size_t)r * D + c) = pk4_fp8(h.x, h.y, h.z, h.w); }
        }
    }
}
__device__ __forceinline__ void router_row(const P& p, int r, int lane, unsigned* rowbuf  , const f32x4 (&v)[4], const f32x4 (&wr)[32], int& e1, int& e2, float& p1, float& p2) {
    const int bi = bidx(r); f32x4 hv[4];
    {
        const float* g = p.in[7] + 1 * D; const float* sc = modv(p, 1, bi, 4); const float* sh = modv(p, 1, bi, 3);
        float s = 0.f;
#pragma unroll
        for (int j = 0; j < 4; ++j) s += (v[j].x * v[j].x + v[j].y * v[j].y) + (v[j].z * v[j].z + v[j].w * v[j].w);
        const float rinv = rsq_(wave_sum(s) * (1.f / D) + EPS);
#pragma unroll
        for (int j = 0; j < 4; ++j) { const int c = 4 * lane + 256 * j; const f32x4 gv = *(const f32x4*)(g + c), scv = *(const f32x4*)(sc + c), shv = *(const f32x4*)(sh + c);
            hv[j] = (v[j] * rinv * gv) * (1.f + scv) + shv; rowbuf[lane + 64 * j] = pk4_fp8(hv[j].x, hv[j].y, hv[j].z, hv[j].w); } }
    float lg[8];
#pragma unroll
    for (int e = 0; e < 8; ++e) lg[e] = 0.f;
#pragma unroll
    for (int j = 0; j < 4; ++j)
#pragma unroll
        for (int i = 0; i < 4; ++i) { const f32x4 w0 = wr[(4 * j + i) * 2], w1 = wr[(4 * j + i) * 2 + 1]; const float h = hv[j][i];
            lg[0] += h * w0.x; lg[1] += h * w0.y; lg[2] += h * w0.z; lg[3] += h * w0.w; lg[4] += h * w1.x; lg[5] += h * w1.y; lg[6] += h * w1.z; lg[7] += h * w1.w; }
#pragma unroll
    for (int e = 0; e < 8; ++e) lg[e] = wave_sum(lg[e]) + p.in[29][e];
    e1 = 0; float v1 = lg[0];
#pragma unroll
    for (int e = 1; e < 8; ++e) if (lg[e] > v1) { v1 = lg[e]; e1 = e; }
    e2 = -1; float v2 = -INFINITY;
#pragma unroll
    for (int e = 0; e < 8; ++e) if (e != e1 && lg[e] > v2) { v2 = lg[e]; e2 = e; }
    p1 = 1.f / (1.f + expf(v2 - v1)); p2 = 1.f - p1;
}
__device__ __forceinline__ void ph_router(const P& p, int wg, int nwg, int nw, unsigned char* lds, int tid) {
    unsigned* cnt = (unsigned*)(p.ws + WS_CTL) + CW_CNT;
    const int wave = tid >> 6, lane = tid & 63;
    int* sE = (int*)lds; float* sP = (float*)(lds + 1024); unsigned* sC = (unsigned*)(lds + 2048); int* sS = (int*)(lds + 3072);
    unsigned* rows = (unsigned*)(lds + 4096);
    const int per = 64 / nw;
    f32x4 wr[32];
#pragma unroll
    for (int j = 0; j < 4; ++j)
#pragma unroll
        for (int i = 0; i < 4; ++i) { const int k = 4 * lane + 256 * j + i; wr[(4 * j + i) * 2] = *(const f32x4*)(p.in[28] + (size_t)k * 8); wr[(4 * j + i) * 2 + 1] = *(const f32x4*)(p.in[28] + (size_t)k * 8 + 4); }
    for (int j0 = 0; (j0 * nwg + wg) * nw < M_LAT; j0 += per) {
        if (tid < 16) sC[tid] = 0u;
        if (tid < 128) sE[tid] = -1;
        __syncthreads();
        f32x4 xv[4], xn[4];
#define RLOAD(R, V) do { const bf16* xb_ = (const bf16*)(p.ws + WS_XB) + (size_t)(R) * D; _Pragma("unroll") for (int j = 0; j < 4; ++j) V[j] = ld_bf4(xb_ + 4 * lane + 256 * j); } while (0)
        { const int r0 = (j0 * nwg + wg) * nw + wave; if (r0 < M_LAT) RLOAD(r0, xv); }
        for (int jj = 0; jj < per; ++jj) { const int r = ((j0 + jj) * nwg + wg) * nw + wave, li = jj * nw + wave;
            { const int rnx = ((j0 + jj + 1) * nwg + wg) * nw + wave; if (jj + 1 < per && rnx < M_LAT) RLOAD(rnx, xn); }
            if (r < M_LAT) { int e1, e2; float p1, p2; router_row(p, r, lane, rows + li * 256, xv, wr, e1, e2, p1, p2);
                if (lane == 0) { sE[2 * li] = e1; sE[2 * li + 1] = e2; sP[2 * li] = p1; sP[2 * li + 1] = p2; atomicAdd(&sC[e1], 1u); atomicAdd(&sC[e2], 1u); } }
#pragma unroll
            for (int j = 0; j < 4; ++j) xv[j] = xn[j]; }
#undef RLOAD
        __syncthreads();
        if (tid < 8) sC[8 + tid] = sC[tid] ? atomicAdd(cnt + tid, sC[tid]) : 0u;
        __syncthreads();
        if (tid < 128) { const int e = sE[tid]; if (e >= 0) { int pre = 0; for (int q = 0; q < tid; ++q) pre += (sE[q] == e) ? 1 : 0;
                const int li = tid >> 1, jj = li / nw, w = li % nw, r = ((j0 + jj) * nwg + wg) * nw + w;
                const int slot = (int)sC[8 + e] + pre; sS[tid] = slot;
                ((int*)(p.ws + WS_TOKE))[2 * r + (tid & 1)] = e; ((int*)(p.ws + WS_TOKS))[2 * r + (tid & 1)] = slot; ((float*)(p.ws + WS_EXPP))[e * 16384 + slot] = sP[tid]; } }
        __syncthreads();
        for (int i = tid; i < 128 * 64; i += nw * 64) { const int pr = i >> 6, ck = i & 63, e = sE[pr]; if (e >= 0) { const u32x4 v = *(const u32x4*)(rows + (pr >> 1) * 256 + ck * 4);
                *(u32x4*)((unsigned char*)(p.ws + WS_H2PX) + ((size_t)e * 16384 + sS[pr]) * D + ck * 16) = v; } }
        __syncthreads();
    }
}
__device__ __forceinline__ void moe_bases(const P& p, int (&base)[9]) {
    const unsigned* cnt = (const unsigned*)(p.ws + WS_CTL) + CW_CNT; int b = 0;
#pragma unroll
    for (int e = 0; e < 8; ++e) { base[e] = b; b += (int)((cnt[e] + 255u) & ~255u); }
    base[8] = b;
}
__device__ __forceinline__ void ph_final(const P& p, int gw, int NGW, int lane) {
    int base[9]; moe_bases(p, base);
    const int* te = (const int*)(p.ws + WS_TOKE); const int* ts = (const int*)(p.ws + WS_TOKS);
#define FROWS(R, ROWS) do { _Pragma("unroll") for (int k = 0; k < 2; ++k) { const int e = te[2 * (R) + k]; int bs = 0; _Pragma("unroll") for (int q = 0; q < 8; ++q) bs = (q == e) ? base[q] : bs; ROWS[k] = bs + ts[2 * (R) + k]; } } while (0)
#define FLOAD(R, ROWS, XV, YA) do { const bf16* xb_ = (const bf16*)(p.ws + WS_XB) + (size_t)(R) * D; _Pragma("unroll") for (int j = 0; j < 4; ++j) { const int c = 4 * lane + 256 * j; XV[j] = *(const u32x2*)(xb_ + c); \
        _Pragma("unroll") for (int k = 0; k < 2; ++k) YA[k][j] = ROWS[k] < 32768 ? *(const u32x2*)((const bf16*)(p.ws + WS_H2P) + (size_t)ROWS[k] * D + c) : (u32x2){0u, 0u}; } } while (0)
    int r = gw; int rc[2] = {0, 0}, rn[2] = {0, 0}; u32x2 xc[4], ya[2][4], xn[4], yn[2][4];
    if (r < M_LAT) { FROWS(r, rc); FLOAD(r, rc, xc, ya); }
    for (; r < M_LAT; r += NGW) {
        const int rnx = r + NGW; if (rnx < M_LAT) { FROWS(rnx, rn); FLOAD(rnx, rn, xn, yn); }
        float* xr = p.out + (size_t)r * D; const float* g5 = modv(p, 1, bidx(r), 5);
        f32x4 v[4]; float s = 0.f;
#pragma unroll
        for (int j = 0; j < 4; ++j) { const int c = 4 * lane + 256 * j; const f32x4 g = *(const f32x4*)(g5 + c);
            const f32x4 x = (f32x4){__uint_as_float(xc[j].x << 16), __uint_as_float(xc[j].x & 0xffff0000u), __uint_as_float(xc[j].y << 16), __uint_as_float(xc[j].y & 0xffff0000u)};
            f32x4 y = (f32x4){0.f, 0.f, 0.f, 0.f};
#pragma unroll
            for (int k = 0; k < 2; ++k) { const u32x2 a = ya[k][j];
                y.x += __uint_as_float(a.x << 16); y.y += __uint_as_float(a.x & 0xffff0000u); y.z += __uint_as_float(a.y << 16); y.w += __uint_as_float(a.y & 0xffff0000u);
                if (rc[k] >= 32768) { for (int ks = 0; ks < 7; ++ks) { const u32x2 q = *(const u32x2*)((const bf16*)(p.ws + WS_YPT) + ((size_t)ks * 2048 + (rc[k] - 32768)) * D + c);
                    y.x += __uint_as_float(q.x << 16); y.y += __uint_as_float(q.x & 0xffff0000u); y.z += __uint_as_float(q.y << 16); y.w += __uint_as_float(q.y & 0xffff0000u); } } }
            v[j] = x + g * y; s += (v[j].x * v[j].x + v[j].y * v[j].y) + (v[j].z * v[j].z + v[j].w * v[j].w); }
        const float rinv = rsq_(wave_sum(s) * (1.f / D) + EPS);
#pragma unroll
        for (int j = 0; j < 4; ++j) { const int c = 4 * lane + 256 * j; *(f32x4*)(xr + c) = v[j] * rinv * *(const f32x4*)(p.in[33] + c); }
        rc[0] = rn[0]; rc[1] = rn[1];
#pragma unroll
        for (int j = 0; j < 4; ++j) { xc[j] = xn[j]; ya[0][j] = yn[0][j]; ya[1][j] = yn[1][j]; }
    }
#undef FROWS
#undef FLOAD
}
__device__ __forceinline__ void ph_occomb(const P& p, int l, int nrows, int gw, int NGW, int lane) {
    const float lam = ((const float*)(p.ws + WS_LAM))[l], li = ((const float*)(p.ws + WS_LAM))[2 + l];
    const int h = lane >> 4, dv = (lane & 15) * 8, half = dv >> 6, d = dv & 63;
    for (int r = gw; r < nrows; r += NGW) {
        const u32x4 a = *(const u32x4*)((const bf16*)(p.ws + WS_OCR) + (size_t)r * 1024 + ((h * 2 + 0) * 2 + half) * 64 + d);
        const u32x4 b = *(const u32x4*)((const bf16*)(p.ws + WS_OCR) + (size_t)r * 1024 + ((h * 2 + 1) * 2 + half) * 64 + d);
        float df[8]; float s = 0.f;
#pragma unroll
        for (int i = 0; i < 4; ++i) { df[2 * i] = __uint_as_float(a[i] << 16) - lam * __uint_as_float(b[i] << 16); df[2 * i + 1] = __uint_as_float(a[i] & 0xffff0000u) - lam * __uint_as_float(b[i] & 0xffff0000u); }
#pragma unroll
        for (int i = 0; i < 8; ++i) s += df[i] * df[i];
        s += __shfl_xor(s, 1); s += __shfl_xor(s, 2); s += __shfl_xor(s, 4); s += __shfl_xor(s, 8);
        const float rinv = (1.f - li) / sqrtf(s * (1.f / 128.f) + EPS);
        const float* sg = p.in[20] + l * 128 + dv;
        u32x4 o; o.x = pk2(df[0] * rinv * sg[0], df[1] * rinv * sg[1]); o.y = pk2(df[2] * rinv * sg[2], df[3] * rinv * sg[3]);
        o.z = pk2(df[4] * rinv * sg[4], df[5] * rinv * sg[5]); o.w = pk2(df[6] * rinv * sg[6], df[7] * rinv * sg[7]);
        *(u32x4*)((bf16*)(p.ws + WS_OABC) + (size_t)r * 1536 + 1024 + h * 128 + dv) = o;
    }
}
__device__ __forceinline__ void occomb_rows32(const P& p, int l, int row0, int h, int lane) {
    const float lam = ((const float*)(p.ws + WS_LAM))[l], li = ((const float*)(p.ws + WS_LAM))[2 + l];
    const int rsel = lane >> 4, dv = (lane & 15) * 8, half = dv >> 6, d = dv & 63;
    const float* sg = p.in[20] + l * 128 + dv;
    const f32x4 g0 = *(const f32x4*)sg, g1 = *(const f32x4*)(sg + 4);
#pragma unroll 2
    for (int it = 0; it < 8; ++it) { const int r = row0 + it * 4 + rsel;
        const u32x4 a = *(const u32x4*)((const bf16*)(p.ws + WS_OCR) + (size_t)r * 1024 + ((h * 2 + 0) * 2 + half) * 64 + d);
        const u32x4 b = *(const u32x4*)((const bf16*)(p.ws + WS_OCR) + (size_t)r * 1024 + ((h * 2 + 1) * 2 + half) * 64 + d);
        float df[8]; float s = 0.f;
#pragma unroll
        for (int i = 0; i < 4; ++i) { df[2 * i] = __uint_as_float(a[i] << 16) - lam * __uint_as_float(b[i] << 16); df[2 * i + 1] = __uint_as_float(a[i] & 0xffff0000u) - lam * __uint_as_float(b[i] & 0xffff0000u); }
#pragma unroll
        for (int i = 0; i < 8; ++i) s += df[i] * df[i];
        s += __shfl_xor(s, 1); s += __shfl_xor(s, 2); s += __shfl_xor(s, 4); s += __shfl_xor(s, 8);
        const float rinv = (1.f - li) / sqrtf(s * (1.f / 128.f) + EPS);
        u32x4 o; o.x = pk2(df[0] * rinv * g0.x, df[1] * rinv * g0.y); o.y = pk2(df[2] * rinv * g0.z, df[3] * rinv * g0.w);
        o.z = pk2(df[4] * rinv * g1.x, df[5] * rinv * g1.y); o.w = pk2(df[6] * rinv * g1.z, df[7] * rinv * g1.w);
        *(u32x4*)((bf16*)(p.ws + WS_OABC) + (size_t)r * 1536 + 1024 + h * 128 + dv) = o; }
}
constexpr int CONV_TILES_LAT = M_LAT / 64, CONV_TILES_ALL = CONV_TILES_LAT + M_CTX / 16;
constexpr int CONV_LDS_BYTES = 94 * 1024 + 16 * 512 * 4;
__device__ __forceinline__ void conv_tile(const P& p, int l, int tile, unsigned char* lds, int tid) {
    int s0, len, t0, nsub;
    if (tile < CONV_TILES_LAT) { s0 = (tile >> 6) * SEQ; len = SEQ; t0 = (tile & 63) * 64; nsub = 4; } else { const int q = tile - CONV_TILES_LAT; s0 = M_LAT + (q >> 4) * CTXL; len = CTXL; t0 = (q & 15) * 16; nsub = 1; }
    bf16* yin = (bf16*)lds;
    float* outs = (float*)(lds + 94 * 1024);
    const bf16* Y = (const bf16*)(p.ws + WS_Y);
    const int nin = 16 * nsub + 30;
    {
        u32x4 v[12];
#pragma unroll
        for (int q = 0; q < 12; ++q) { const int i = tid + q * 512, rr = i >> 6, ck = i & 63, tt = t0 - 15 + rr;
            v[q] = (u32x4){0u, 0u, 0u, 0u}; if (i < nin * 64 && tt >= 0 && tt < len) v[q] = *(const u32x4*)(Y + (size_t)(s0 + tt) * 512 + ck * 8); }
#pragma unroll
        for (int q = 0; q < 12; ++q) { const int i = tid + q * 512, rr = i >> 6, ck = i & 63; if (i < nin * 64) *(u32x4*)(yin + rr * 512 + ck * 8) = v[q]; } }
    const int ch = tid, wave = tid >> 6, lane = tid & 63;
    float w[31];
    const float* wp = p.in[12] + (size_t)l * 31 * 512 + ch;
#pragma unroll
    for (int j = 0; j < 31; ++j) w[j] = wp[j * 512];
    const float bias = p.in[13][l * 512 + ch];
    const f32x4 lg0 = *(const f32x4*)(p.in[14] + l * 512 + lane * 8), lg1 = *(const f32x4*)(p.in[14] + l * 512 + lane * 8 + 4);
    const f32x4 lb0 = *(const f32x4*)(p.in[15] + l * 512 + lane * 8), lb1 = *(const f32x4*)(p.in[15] + l * 512 + lane * 8 + 4);
    __syncthreads();
#pragma unroll 1
    for (int sb = 0; sb < nsub; ++sb) {
        float a[16];
#pragma unroll
        for (int o = 0; o < 16; ++o) a[o] = bias;
#pragma unroll
        for (int i = 0; i < 46; ++i) { const float x = bf2f(yin[(sb * 16 + i) * 512 + ch]);
#pragma unroll
            for (int o = 0; o < 16; ++o) { const int j = i - o; if (j >= 0 && j < 31) a[o] += x * w[j]; } }
#pragma unroll
        for (int o = 0; o < 16; ++o) outs[o * 512 + ch] = a[o];
        __syncthreads();
#pragma unroll
        for (int rr = 0; rr < 2; ++rr) { const int o = 2 * wave + rr;
            f32x4 v0 = *(const f32x4*)(outs + o * 512 + lane * 8), v1 = *(const f32x4*)(outs + o * 512 + lane * 8 + 4);
            const float mean = wave_sum((v0.x + v0.y) + (v0.z + v0.w) + (v1.x + v1.y) + (v1.z + v1.w)) * (1.f / 512.f);
            v0 = v0 - mean; v1 = v1 - mean;
            const float var = wave_sum((v0.x * v0.x + v0.y * v0.y) + (v0.z * v0.z + v0.w * v0.w) + (v1.x * v1.x + v1.y * v1.y) + (v1.z * v1.z + v1.w * v1.w)) * (1.f / 512.f);
            const float rstd = rsq_(var + EPS);
            v0 = v0 * rstd * lg0 + lb0; v1 = v1 * rstd * lg1 + lb1;
            u32x4 ov; ov.x = pk2(siluf_(v0.x), siluf_(v0.y)); ov.y = pk2(siluf_(v0.z), siluf_(v0.w)); ov.z = pk2(siluf_(v1.x), siluf_(v1.y)); ov.w = pk2(siluf_(v1.z), siluf_(v1.w));
            *(u32x4*)((bf16*)(p.ws + WS_OABC) + (size_t)(s0 + t0 + sb * 16 + o) * 1536 + 512 + lane * 8) = ov; }
        __syncthreads();
    }
}


namespace pg8 {
#define PG8_LAS __attribute__((address_space(3)))
typedef unsigned short bf16_t;
typedef short bf16x8 __attribute__((ext_vector_type(8)));
typedef float f32x4 __attribute__((ext_vector_type(4)));
typedef unsigned u32x4 __attribute__((ext_vector_type(4)));
constexpr int BM = 256, BK = 64, HALF = 128, HTB = HALF * BK * 2  , STAGE_BYTES = 8 * HTB, NXCD = 8, WGM = 8;

__host__ __device__ __forceinline__ int lds_byte(int r, int c) { const int st = (r >> 4) * 2 + (c >> 5), rr = r & 15, cc = c & 31, ob = rr * 64 + cc * 2; return st * 1024 + (ob ^ (((ob >> 9) & 1) << 5)); }
__host__ __device__ __forceinline__ void stage_rc(int b, int& R, int& C) { const int st = b / 1024, sb = b % 1024, swz = sb ^ (((sb >> 9) & 1) << 5); R = (st >> 1) * 16 + swz / 64; C = (st & 1) * 32 + (swz % 64) / 2; }
__host__ __device__ __forceinline__ int perm32(int rho) { const int n = rho >> 4, i = rho & 15; return 8 * (i >> 2) + 4 * n + (i & 3); }

typedef int v4i_t __attribute__((ext_vector_type(4))); typedef int v8i_t __attribute__((ext_vector_type(8)));
__device__ __forceinline__ v8i_t pg8_cat(bf16x8 a, bf16x8 b) { const v4i_t x = __builtin_bit_cast(v4i_t, a), y = __builtin_bit_cast(v4i_t, b); return __builtin_shufflevector(x, y, 0, 1, 2, 3, 4, 5, 6, 7); }
struct Unit { int pm, pn, ko, pa; };
struct Gemm { const bf16_t* A; const bf16_t* Bt; int M, N, K, ld; int sc_w, sc_a; int a_pa; };

struct StaticOrder {
    int nM, nN, nwg, G, c;
    __host__ __device__ void init(int M, int N, int G_, int c_) { nM = M / BM; nN = N / BM; nwg = nM * nN; G = G_; c = c_; }
    __host__ __device__ bool next(int i, Unit& u) const {
        const long L = (long)i * G + c; if (L >= nwg) return false;
        int wgid = (int)L; { const int q = nwg / NXCD, r = nwg % NXCD, xcd = wgid % NXCD, off = wgid / NXCD; wgid = (xcd < r ? xcd * (q + 1) : r * (q + 1) + (xcd - r) * q) + off; }
        const int nig = WGM * nN, gid = wgid / nig, fm = gid * WGM, gsz = (nM - fm) < WGM ? (nM - fm) : WGM;
        u.pm = fm + ((wgid % nig) % gsz); u.pn = (wgid % nig) / gsz; u.ko = 0; u.pa = u.pm; return true;
    }
    __device__ __forceinline__ void a_ready(const Unit&) const {}
    __device__ __forceinline__ void done(const Unit&) const {}
};


typedef float f32x2_cv __attribute__((ext_vector_type(2))); typedef __bf16 bf16x2_cv __attribute__((ext_vector_type(2)));
__device__ __forceinline__ unsigned cvt_pk_bf16(float lo, float hi) { f32x2_cv v = {lo, hi}; bf16x2_cv b = __builtin_convertvector(v, bf16x2_cv); return __builtin_bit_cast(unsigned, b); }
typedef float f32x2 __attribute__((ext_vector_type(2)));

struct InprojL1Order {
    StaticOrder so; int G, c;
    __device__ void init(int G_, int c_) { so.init(16384, 6400, G_, c_); G = G_; c = c_; }
    __device__ bool next(int i, Unit& u) const {
        const int L = i * G + c;
        if (L < 1600) return so.next(i, u);
        const int q = L - 1600; if (q >= 20) return false;
        const int k = q % 5; u.pm = 64 + q / 5; u.pn = k == 0 ? 2 : 8 + k; u.ko = 0; u.pa = u.pm; return true;
    }
    __device__ __forceinline__ void a_ready(const Unit&) const {}
    __device__ __forceinline__ void done(const Unit&) const {}
};
struct MoeOrder {
    StaticOrder so; int nper; int t1, t2, t3, t4, t5, t6, t7;
    __device__ void init(const int (&base)[9], int nper_, int G_, int c_, int max_tiles = 1 << 20) { const int nt_ = (base[8] >> 8) < max_tiles ? (base[8] >> 8) : max_tiles; so.init(nt_ * BM, nper_ * BM, G_, c_); nper = nper_;
        t1 = base[1] >> 8; t2 = base[2] >> 8; t3 = base[3] >> 8; t4 = base[4] >> 8; t5 = base[5] >> 8; t6 = base[6] >> 8; t7 = base[7] >> 8; }
    __device__ bool next(int i, Unit& u) const {
        if (!so.next(i, u)) return false;
        const int e = (u.pm >= t1) + (u.pm >= t2) + (u.pm >= t3) + (u.pm >= t4) + (u.pm >= t5) + (u.pm >= t6) + (u.pm >= t7);
        const int te = e == 0 ? 0 : e == 1 ? t1 : e == 2 ? t2 : e == 3 ? t3 : e == 4 ? t4 : e == 5 ? t5 : e == 6 ? t6 : t7;
        u.pn += e * nper; u.pa = e * 64 + (u.pm - te); return true;
    }
    __device__ __forceinline__ void a_ready(const Unit&) const {}
    __device__ __forceinline__ void done(const Unit&) const {}
};

struct CtxSliceOrder {
    int nks, G, c;
    __device__ void init(int nks_, int G_, int c_) { nks = nks_; G = G_; c = c_; }
    __device__ bool next(int i, Unit& u) const {
        const int s = i * G + c; if (s >= 16 * nks) return false;
        const int q = s / nks, r = s % nks; u.pm = 64 + (q >> 2); u.pn = q & 3; u.ko = r * 256; u.pa = u.pm; return true;
    }
    __device__ __forceinline__ void a_ready(const Unit&) const {}
    __device__ __forceinline__ void done(const Unit&) const {}
};
struct MoeTailOrder {
    int ntail, G, c; int t1, t2, t3, t4, t5, t6, t7;
    __device__ void init(const int (&base)[9], int G_, int c_) { ntail = (base[8] >> 8) - 128; G = G_; c = c_;
        t1 = base[1] >> 8; t2 = base[2] >> 8; t3 = base[3] >> 8; t4 = base[4] >> 8; t5 = base[5] >> 8; t6 = base[6] >> 8; t7 = base[7] >> 8; }
    __device__ bool next(int i, Unit& u) const {
        const int s = i * G + c; if (s >= ntail * 28) return false;
        const int tile = s / 28, r = s % 28; u.pm = 128 + tile;
        const int e = (u.pm >= t1) + (u.pm >= t2) + (u.pm >= t3) + (u.pm >= t4) + (u.pm >= t5) + (u.pm >= t6) + (u.pm >= t7);
        const int te = e == 0 ? 0 : e == 1 ? t1 : e == 2 ? t2 : e == 3 ? t3 : e == 4 ? t4 : e == 5 ? t5 : e == 6 ? t6 : t7;
        u.pn = e * 4 + r / 7; u.ko = (r % 7) * 256; u.pa = e * 64 + (u.pm - te); return true;
    }
    __device__ __forceinline__ void a_ready(const Unit&) const {}
    __device__ __forceinline__ void done(const Unit&) const {}
};

__device__ __forceinline__ u32x4 pack8(f32x4 a, f32x4 b) { u32x4 w; w.x = cvt_pk_bf16(a[0], a[1]); w.y = cvt_pk_bf16(a[2], a[3]); w.z = cvt_pk_bf16(b[0], b[1]); w.w = cvt_pk_bf16(b[2], b[3]); return w; }
__device__ __forceinline__ float sigm(float x) { return __builtin_amdgcn_rcpf(1.f + __expf(-x)); }
__device__ __forceinline__ f32x4 sigm4(f32x4 v) { f32x4 r; r[0] = sigm(v[0]); r[1] = sigm(v[1]); r[2] = sigm(v[2]); r[3] = sigm(v[3]); return r; }
__device__ __forceinline__ f32x4 lo4(u32x4 g) { f32x4 r; r[0] = __uint_as_float(g.x << 16); r[1] = __uint_as_float(g.x & 0xffff0000u); r[2] = __uint_as_float(g.y << 16); r[3] = __uint_as_float(g.y & 0xffff0000u); return r; }
__device__ __forceinline__ f32x4 hi4(u32x4 g) { f32x4 r; r[0] = __uint_as_float(g.z << 16); r[1] = __uint_as_float(g.z & 0xffff0000u); r[2] = __uint_as_float(g.w << 16); r[3] = __uint_as_float(g.w & 0xffff0000u); return r; }
typedef unsigned u32x2 __attribute__((ext_vector_type(2)));

struct EpiInproj {
    static constexpr bool PERM = false, AFTER_DRAIN = false, MIDK = false, DUPABLE = true;
    unsigned char* ws; const float* qn_g; const float* kn_g; const float* b_gate;
    __device__ __forceinline__ void operator()(const f32x4 (&acc)[2][2][4][2], const Unit& u, int wr, int wc, int fr, int fq) const {
        const int pn = u.pn, pm = u.pm, row0 = pm * BM + wr * 64 + fr;
        const int kroff = pm < 64 ? (pm >> 4) * 256 : (pm - 64) * 4096 - 12288;
#ifndef DBG_INPROJ
#define DBG_INPROJ 15
#endif
        if (pn >= 13) { if (!(DBG_INPROJ & 1)) return;
            const int gc0 = (pn - 13) * 256 + wc * 32 + 8 * fq; f32x4 bv[2][2];
#pragma unroll
            for (int bj = 0; bj < 2; ++bj)
#pragma unroll
                for (int n = 0; n < 2; ++n) bv[bj][n] = *(const f32x4*)(b_gate + gc0 + 128 * bj + 4 * n);
            unsigned char* gb = ws + WS_G + (size_t)row0 * 3072 + (pn - 13) * 256 + (4 * wc + fq) * 16;
#pragma unroll
            for (int ai = 0; ai < 2; ++ai)
#pragma unroll
                for (int m = 0; m < 4; ++m) { u32x4 w;
#pragma unroll
                    for (int bj = 0; bj < 2; ++bj)
#pragma unroll
                        for (int n = 0; n < 2; ++n) { const f32x4 x = acc[ai][bj][m][n] + bv[bj][n]; unsigned d = 0u;
#pragma unroll
                            for (int e = 0; e < 4; ++e) { const float g255 = __builtin_amdgcn_rcpf(__builtin_fmaf(__expf(-x[e]), 1.f / 255.f, 1.f / 255.f));
                                d = __builtin_amdgcn_cvt_pk_u8_f32(__builtin_fmaxf(g255, 1.f), e, d); }
                            w[2 * bj + n] = d; }
                    *(u32x4*)(gb + (size_t)(ai * HALF + m * 16) * 3072) = w; }
        } else if (pn >= 11) { if (!(DBG_INPROJ & 2)) return;
            const int c0 = (pn - 11) * 256 + wc * 32 + 8 * fq;
#pragma unroll
            for (int ai = 0; ai < 2; ++ai)
#pragma unroll
                for (int m = 0; m < 4; ++m) { bf16_t* dst = (bf16_t*)(ws + WS_VC) + (size_t)(row0 + ai * HALF + m * 16 + kroff) * 512 + c0;
#pragma unroll
                    for (int bj = 0; bj < 2; ++bj) *(u32x4*)(dst + 128 * bj) = pack8(acc[ai][bj][m][0], acc[ai][bj][m][1]); }
        } else if (pn >= 3 && pn < 7) { if (!(DBG_INPROJ & 4)) return;
            const int c0 = (pn - 3) * 128 + wc * 32 + 8 * fq;
#pragma unroll
            for (int ai = 0; ai < 2; ++ai)
#pragma unroll
                for (int m = 0; m < 4; ++m) { bf16_t* dst = (bf16_t*)(ws + WS_Y) + (size_t)(row0 + ai * HALF + m * 16) * 512 + c0;
                    *(u32x4*)dst = pack8(acc[ai][0][m][0] * sigm4(acc[ai][1][m][0]), acc[ai][0][m][1] * sigm4(acc[ai][1][m][1])); }
        } else { if (!(DBG_INPROJ & 8)) return;
            const bool isv = (pn == 2 && wc >= 2), isq = pn < 2 || pn == 7 || pn == 8, normed = pn < 3 && !isv, roped = !isv && pm < 64;
            bf16_t* dst; int pitch, roff;
            if (pn < 2) { dst = (bf16_t*)(ws + WS_QA) + (4 * pn + wc) * 64; pitch = 512; roff = 0; }
            else if (pn == 2) { dst = (bf16_t*)(ws + (wc < 2 ? WS_KA : WS_VA)) + (wc & 1) * 64; pitch = 128; roff = kroff; }
            else if (pn < 9) { dst = (bf16_t*)(ws + WS_QC) + (4 * (pn - 7) + wc) * 64; pitch = 512; roff = 0; }
            else { dst = (bf16_t*)(ws + WS_KC) + (4 * (pn - 9) + wc) * 64; pitch = 512; roff = kroff; }
            dst += isv ? 4 * fq : 8 * fq;
            f32x4 gv[2][2];
            const float* g = isq ? qn_g : kn_g;
#pragma unroll
            for (int bj = 0; bj < 2; ++bj)
#pragma unroll
                for (int n = 0; n < 2; ++n) gv[bj][n] = normed ? *(const f32x4*)(g + 32 * bj + 16 * n + 4 * fq) : (f32x4){1.f, 1.f, 1.f, 1.f};
            const float qs = isq ? C2 : 1.f;
            const float* cosT = (const float*)(ws + WS_ROPE) + 4 * fq; const float* sinT = cosT + 1024;
#pragma unroll
            for (int ai = 0; ai < 2; ++ai)
#pragma unroll
                for (int m = 0; m < 4; ++m) { const int row = row0 + ai * HALF + m * 16;
                    f32x4 v[2][2];
#pragma unroll
                    for (int bj = 0; bj < 2; ++bj)
#pragma unroll
                        for (int n = 0; n < 2; ++n) v[bj][n] = acc[ai][bj][m][n];
                    if (normed) { float ss = 0.f;
#pragma unroll
                        for (int bj = 0; bj < 2; ++bj)
#pragma unroll
                            for (int n = 0; n < 2; ++n) ss += (v[bj][n][0] * v[bj][n][0] + v[bj][n][1] * v[bj][n][1]) + (v[bj][n][2] * v[bj][n][2] + v[bj][n][3] * v[bj][n][3]);
                        ss = ::xsum_x32(::xsum_x16(ss));
                        const float rinv = ::rsq_(ss * (1.f / 64.f) + EPS);
#pragma unroll
                        for (int bj = 0; bj < 2; ++bj)
#pragma unroll
                            for (int n = 0; n < 2; ++n) v[bj][n] = v[bj][n] * rinv * gv[bj][n]; }
                    if (roped) { const int t = row & 4095;
#pragma unroll
                        for (int bj = 0; bj < 2; ++bj) { const int pos = bj ? (t & 63) : (t >> 6); const f32x4 cs = *(const f32x4*)(cosT + pos * 16), sn = *(const f32x4*)(sinT + pos * 16);
                            const f32x4 x1 = v[bj][0], x2 = v[bj][1]; v[bj][0] = x1 * cs - x2 * sn; v[bj][1] = x2 * cs + x1 * sn; } }
                    bf16_t* rp = dst + (size_t)(row + roff) * pitch;
                    if (isv) {
#pragma unroll
                        for (int bj = 0; bj < 2; ++bj)
#pragma unroll
                            for (int n = 0; n < 2; ++n) { const f32x4 o = v[bj][n]; u32x2 w; w.x = cvt_pk_bf16(o[0], o[1]); w.y = cvt_pk_bf16(o[2], o[3]); *(u32x2*)(rp + 32 * bj + 16 * n) = w; } }
                    else {
#pragma unroll
                        for (int bj = 0; bj < 2; ++bj) *(u32x4*)(rp + 32 * bj) = pack8(v[bj][0] * qs, v[bj][1] * qs); }
                }
        }
    }
};
struct EpiMerge {
    static constexpr bool PERM = false, AFTER_DRAIN = false, MIDK = true, DUPABLE = false;
    const unsigned char* G; bf16_t* MB;
    static __device__ __forceinline__ float ub(unsigned w, int k) { return (float)((w >> (8 * k)) & 0xffu); }
    __device__ __forceinline__ void mid(f32x4 (&acc)[2][2][4][2], const Unit& u, int wr, int wc, int fr, int fq, int seg) const {
        const unsigned rowb = (unsigned)(u.pm * BM + wr * 64 + fr) * 3072u + (unsigned)((seg - 1) * 1024 + u.pn * 256 + (4 * wc + fq) * 16);
        const unsigned char* Gb = G;
#pragma unroll
        for (int ai = 0; ai < 2; ++ai) { u32x4 ga[4], gb[4];
#pragma unroll
            for (int m = 0; m < 4; ++m) { const unsigned o = rowb + (unsigned)(ai * HALF + m * 16) * 3072u; ga[m] = *(const u32x4*)(Gb + o); gb[m] = *(const u32x4*)(Gb + (o + 1024u)); }
#pragma unroll
            for (int m = 0; m < 4; ++m)
#pragma unroll
                for (int bj = 0; bj < 2; ++bj)
#pragma unroll
                    for (int n = 0; n < 2; ++n) { const unsigned a = ga[m][2 * bj + n], b = gb[m][2 * bj + n]; f32x4 r;
#pragma unroll
                        for (int e = 0; e < 4; ++e) r[e] = ub(a, e) * __builtin_amdgcn_rcpf(ub(b, e));
                        acc[ai][bj][m][n] *= r; }
            asm volatile("" ::: "memory"); }
    }
    __device__ __forceinline__ void operator()(const f32x4 (&acc)[2][2][4][2], const Unit& u, int wr, int wc, int fr, int fq) const {
        const int row0 = u.pm * BM + wr * 64 + fr, c0 = u.pn * 256 + wc * 32 + 8 * fq;
#pragma unroll
        for (int ai = 0; ai < 2; ++ai)
#pragma unroll
            for (int m = 0; m < 4; ++m) { const int row = row0 + ai * HALF + m * 16; const u32x4 g = *(const u32x4*)(G + (size_t)row * 3072 + 2048 + u.pn * 256 + (4 * wc + fq) * 16);
#pragma unroll
                for (int bj = 0; bj < 2; ++bj) { f32x4 g0, g1;
#pragma unroll
                    for (int e = 0; e < 4; ++e) { g0[e] = ub(g[2 * bj], e) * (1.f / 255.f); g1[e] = ub(g[2 * bj + 1], e) * (1.f / 255.f); }
                    *(u32x4*)(MB + (size_t)row * 1024 + c0 + 128 * bj) = pack8(acc[ai][bj][m][0] * g0, acc[ai][bj][m][1] * g1); } }
    }
};
struct EpiResid {
    static constexpr bool PERM = false, AFTER_DRAIN = false, MIDK = false, DUPABLE = false;
    __device__ __forceinline__ int nst(const Unit&) const { return 0; }
    const float* base_f32; bf16_t* xb; const float* gate;
    __device__ __forceinline__ void operator()(const f32x4 (&acc)[2][2][4][2], const Unit& u, int wr, int wc, int fr, int fq) const {
        const int pm = u.pm, c0 = u.pn * 256 + wc * 32 + 4 * fq, bi = pm >> 4, row0 = pm * BM + wr * 64 + fr;
        f32x4 gv[2][2];
#pragma unroll
        for (int bj = 0; bj < 2; ++bj)
#pragma unroll
            for (int n = 0; n < 2; ++n) gv[bj][n] = *(const f32x4*)(gate + (size_t)bi * 6 * 1024 + c0 + 128 * bj + 16 * n);
#pragma unroll
        for (int ai = 0; ai < 2; ++ai)
#pragma unroll
            for (int m = 0; m < 4; ++m) { const size_t off = (size_t)(row0 + ai * HALF + m * 16) * 1024 + c0;
#pragma unroll
                for (int bj = 0; bj < 2; ++bj)
#pragma unroll
                    for (int n = 0; n < 2; ++n) { const size_t o = off + 128 * bj + 16 * n; f32x4 b;
                        if (base_f32) b = *(const f32x4*)(base_f32 + o);
                        else { const u32x2 q = *(const u32x2*)(xb + o); b[0] = __uint_as_float(q.x << 16); b[1] = __uint_as_float(q.x & 0xffff0000u); b[2] = __uint_as_float(q.y << 16); b[3] = __uint_as_float(q.y & 0xffff0000u); }
                        const f32x4 r = b + gv[bj][n] * acc[ai][bj][m][n]; u32x2 w; w.x = cvt_pk_bf16(r[0], r[1]); w.y = cvt_pk_bf16(r[2], r[3]); *(u32x2*)(xb + o) = w; } }
    }
};
struct EpiSwiglu {
    static constexpr bool PERM = false, AFTER_DRAIN = false, MIDK = false, DUPABLE = false;
    bf16_t* O; int ld, nper;
    __device__ __forceinline__ void operator()(const f32x4 (&acc)[2][2][4][2], const Unit& u, int wr, int wc, int fr, int fq) const {
        const int row0 = u.pm * BM + wr * 64 + fr, c0 = (u.pn % nper) * 128 + wc * 32 + 8 * fq;
#pragma unroll
        for (int ai = 0; ai < 2; ++ai)
#pragma unroll
            for (int m = 0; m < 4; ++m) { const f32x4 a0 = acc[ai][0][m][0], a1 = acc[ai][0][m][1];
                *(u32x4*)(O + (size_t)(row0 + ai * HALF + m * 16) * ld + c0) = pack8(a0 * sigm4(a0) * acc[ai][1][m][0], a1 * sigm4(a1) * acc[ai][1][m][1]); }
    }
};
struct EpiSwigluF8 {
    static constexpr bool PERM = false, AFTER_DRAIN = false, MIDK = false, DUPABLE = false;
    unsigned char* O; int ld, nper;
    __device__ __forceinline__ void operator()(const f32x4 (&acc)[2][2][4][2], const Unit& u, int wr, int wc, int fr, int fq) const {
        const int row0 = u.pm * BM + wr * 64 + fr, c0 = (u.pn % nper) * 128 + wc * 32 + 8 * fq;
#pragma unroll
        for (int ai = 0; ai < 2; ++ai)
#pragma unroll
            for (int m = 0; m < 4; ++m) { const f32x4 a0 = acc[ai][0][m][0], a1 = acc[ai][0][m][1];
                const f32x4 y0 = a0 * sigm4(a0) * acc[ai][1][m][0] * 4.f, y1 = a1 * sigm4(a1) * acc[ai][1][m][1] * 4.f;
                u32x2 w; w.x = __builtin_amdgcn_cvt_pk_fp8_f32(y0[2], y0[3], __builtin_amdgcn_cvt_pk_fp8_f32(y0[0], y0[1], 0u, false), true);
                w.y = __builtin_amdgcn_cvt_pk_fp8_f32(y1[2], y1[3], __builtin_amdgcn_cvt_pk_fp8_f32(y1[0], y1[1], 0u, false), true);
                *(u32x2*)(O + (size_t)(row0 + ai * HALF + m * 16) * ld + c0) = w; }
    }
};
struct EpiCtxPartial {
    static constexpr bool PERM = false, AFTER_DRAIN = false, MIDK = false, DUPABLE = false;
    bf16_t* P;
    __device__ __forceinline__ void operator()(const f32x4 (&acc)[2][2][4][2], const Unit& u, int wr, int wc, int fr, int fq) const {
        const int row0 = (u.pm - 64) * BM + wr * 64 + fr, c0 = u.pn * 256 + wc * 32 + 4 * fq; bf16_t* Y = P + (size_t)(u.ko >> 8) * 1024 * 1024;
#pragma unroll
        for (int ai = 0; ai < 2; ++ai)
#pragma unroll
            for (int m = 0; m < 4; ++m) { const int row = row0 + ai * HALF + m * 16;
#pragma unroll
                for (int bj = 0; bj < 2; ++bj)
#pragma unroll
                    for (int n = 0; n < 2; ++n) { const f32x4 a = acc[ai][bj][m][n]; u32x2 w; w.x = cvt_pk_bf16(a[0], a[1]); w.y = cvt_pk_bf16(a[2], a[3]); *(u32x2*)(Y + (size_t)row * 1024 + c0 + 128 * bj + 16 * n) = w; } }
    }
};
struct EpiMoeDownTail {
    static constexpr bool PERM = false, AFTER_DRAIN = false, MIDK = false, DUPABLE = false;
    bf16_t* YPT; const float* rowp;
    __device__ __forceinline__ void operator()(const f32x4 (&acc)[2][2][4][2], const Unit& u, int wr, int wc, int fr, int fq) const {
        const int row0 = u.pm * BM + wr * 64 + fr, c0 = (u.pn & 3) * 256 + wc * 32 + 8 * fq; bf16_t* Y = YPT + (size_t)(u.ko >> 8) * 2048 * 1024 - (size_t)32768 * 1024;
#pragma unroll
        for (int ai = 0; ai < 2; ++ai)
#pragma unroll
            for (int m = 0; m < 4; ++m) { const int row = row0 + ai * HALF + m * 16; const float rp = rowp[u.pa * BM + wr * 64 + fr + ai * HALF + m * 16];
#pragma unroll
                for (int bj = 0; bj < 2; ++bj) *(u32x4*)(Y + (size_t)row * 1024 + c0 + 128 * bj) = pack8(acc[ai][bj][m][0] * rp, acc[ai][bj][m][1] * rp); }
    }
};
struct EpiMoeDown {
    static constexpr bool PERM = false, AFTER_DRAIN = false, MIDK = false, DUPABLE = false;
    bf16_t* YP; const float* rowp;
    __device__ __forceinline__ void operator()(const f32x4 (&acc)[2][2][4][2], const Unit& u, int wr, int wc, int fr, int fq) const {
        const int row0 = u.pm * BM + wr * 64 + fr, c0 = (u.pn & 3) * 256 + wc * 32 + 8 * fq;
#pragma unroll
        for (int ai = 0; ai < 2; ++ai)
#pragma unroll
            for (int m = 0; m < 4; ++m) { const int row = row0 + ai * HALF + m * 16; const float rp = rowp[u.pa * BM + wr * 64 + fr + ai * HALF + m * 16];
#pragma unroll
                for (int bj = 0; bj < 2; ++bj) *(u32x4*)(YP + (size_t)row * 1024 + c0 + 128 * bj) = pack8(acc[ai][bj][m][0] * rp, acc[ai][bj][m][1] * rp); }
    }
};

template <class Epi, class Sched, bool ALIGN_EPI = false, bool SP2 = false, bool F8 = false>
__device__ __forceinline__ void gemm_phase(PG8_LAS unsigned char* lds, const Gemm g, const Sched& S, const Epi& E) {
    int tid_o = threadIdx.x; asm volatile("" : "+v"(tid_o));
    const int tid = tid_o, wid = __builtin_amdgcn_readfirstlane(tid >> 6), lane = tid & 63, wr = wid >> 2, wc = wid & 3, fr = lane & 15, fq = lane >> 4;
    const int K = g.K, nt = K / BK;
    unsigned voffA[2], voffB[2];
#pragma unroll
    for (int i = 0; i < 2; ++i) { int R, C; stage_rc(tid * 16 + i * 8192, R, C); const int Rb = Epi::PERM ? ((R & ~31) + perm32(R & 31)) : R;
        voffA[i] = (unsigned)(R * g.ld + C) * 2u; voffB[i] = (unsigned)(Rb * g.ld + C) * 2u; }
    const size_t kstep = (size_t)(BK * 2);
    const size_t hstep = (size_t)HALF * g.ld * 2;
    const size_t tstep = 2 * hstep;
    const unsigned ldsw = (unsigned)wid * 1024u;
    const int aoff = lds_byte(wr * 64 + fr, fq * 8), boff = lds_byte(wc * 32 + fr, fq * 8);
#define PG8_SA(b, h) (((b) * 2 + (h)) * HTB)
#define PG8_SB(b, h) ((4 + (b) * 2 + (h)) * HTB)
#define PG8_STAGE(bufoff, gbase, voff) do { _Pragma("unroll") for (int _i = 0; _i < 2; ++_i) \
        __builtin_amdgcn_global_load_lds((const unsigned*)((const char*)(gbase) + (voff)[_i]), (PG8_LAS unsigned*)(lds + (bufoff) + ldsw + _i * 8192), 16, 0, 0); } while (0)
#define PG8_LDA(dst, b, h) do { if constexpr (F8) { _Pragma("unroll") for (int m = 0; m < 4; ++m) { const v4i_t x_ = *(const PG8_LAS v4i_t*)(lds + PG8_SA(b, h) + aoff + m * 2048), y_ = *(const PG8_LAS v4i_t*)(lds + PG8_SA(b, h) + aoff + m * 2048 + 1024); dst##8[m] = __builtin_shufflevector(x_, y_, 0, 1, 2, 3, 4, 5, 6, 7); } } \
        else { _Pragma("unroll") for (int m = 0; m < 4; ++m) _Pragma("unroll") for (int k = 0; k < 2; ++k) dst[m][k] = *(const PG8_LAS bf16x8*)(lds + PG8_SA(b, h) + aoff + m * 2048 + k * 1024); } } while (0)
#define PG8_LDB(dst, b, h) do { if constexpr (F8) { _Pragma("unroll") for (int n = 0; n < 2; ++n) { const v4i_t x_ = *(const PG8_LAS v4i_t*)(lds + PG8_SB(b, h) + boff + n * 2048), y_ = *(const PG8_LAS v4i_t*)(lds + PG8_SB(b, h) + boff + n * 2048 + 1024); dst##8[n] = __builtin_shufflevector(x_, y_, 0, 1, 2, 3, 4, 5, 6, 7); } } \
        else { _Pragma("unroll") for (int n = 0; n < 2; ++n) _Pragma("unroll") for (int k = 0; k < 2; ++k) dst[n][k] = *(const PG8_LAS bf16x8*)(lds + PG8_SB(b, h) + boff + n * 2048 + k * 1024); } } while (0)
#define PG8_MMA(ai, bj, At, Bt) do { if constexpr (F8) { __builtin_amdgcn_s_setprio(1); _Pragma("unroll") for (int m = 0; m < 4; ++m) _Pragma("unroll") for (int n = 0; n < 2; ++n) \
        asm volatile("v_mfma_scale_f32_16x16x128_f8f6f4 %0, %1, %2, %0, %3, %4 op_sel_hi:[0,0,0]" : "+v"(acc[ai][bj][m][n]) : "v"(Bt##8[n]), "v"(At##8[m]), "v"(scw_), "v"(sca_));     __builtin_amdgcn_s_setprio(0); } else { __builtin_amdgcn_s_setprio(1); _Pragma("unroll") for (int m = 0; m < 4; ++m) _Pragma("unroll") for (int n = 0; n < 2; ++n) _Pragma("unroll") for (int k = 0; k < 2; ++k) \
        acc[ai][bj][m][n] = __builtin_amdgcn_mfma_f32_16x16x32_bf16(Bt[n][k], At[m][k], acc[ai][bj][m][n], 0, 0, 0); __builtin_amdgcn_s_setprio(0); } } while (0)
#define PG8_WAIT_V(n) asm volatile("s_waitcnt vmcnt(" #n ")" ::: "memory")
#define PG8_WAIT_L(n) asm volatile("s_waitcnt lgkmcnt(" #n ")" ::: "memory")
#define PG8_BAR __builtin_amdgcn_s_barrier()
#define PG8_SCHED __builtin_amdgcn_sched_barrier(0)
    Unit cur, nxt; int ui = 0;
    if (!S.next(0, cur)) return;
    f32x4 acc[2][2][4][2];
#pragma unroll
    for (int a = 0; a < 2; ++a)
#pragma unroll
        for (int b = 0; b < 2; ++b)
#pragma unroll
            for (int m = 0; m < 4; ++m)
#pragma unroll
                for (int n = 0; n < 2; ++n) acc[a][b][m][n] = (f32x4){0.f, 0.f, 0.f, 0.f};
    int scw_ = g.sc_w, sca_ = g.sc_a; asm volatile("" : "+v"(scw_), "+v"(sca_));
    bf16x8 At[4][2], B0[2][2], B1[2][2]; v8i_t At8[4], B08[2], B18[2];
    const char* cA = (const char*)g.A + (size_t)(g.a_pa ? cur.pa : cur.pm) * tstep + (size_t)cur.ko * 2; const char* cB = (const char*)g.Bt + (size_t)cur.pn * tstep + (size_t)cur.ko * 2;
    S.a_ready(cur);
    if constexpr (SP2) {
        PG8_STAGE(PG8_SB(0, 0), cB, voffB); PG8_STAGE(PG8_SB(0, 1), cB + hstep, voffB); PG8_STAGE(PG8_SA(0, 0), cA, voffA); PG8_STAGE(PG8_SA(0, 1), cA + hstep, voffA);
        if (wr == 1) PG8_BAR;
        PG8_WAIT_V(2); PG8_BAR;
        PG8_STAGE(PG8_SB(1, 0), cB + kstep, voffB); PG8_STAGE(PG8_SA(1, 0), cA + kstep, voffA); PG8_STAGE(PG8_SB(1, 1), cB + hstep + kstep, voffB);
        PG8_WAIT_V(6); PG8_BAR;
    } else {
        PG8_STAGE(PG8_SB(0, 0), cB, voffB); PG8_STAGE(PG8_SA(0, 0), cA, voffA); PG8_STAGE(PG8_SB(0, 1), cB + hstep, voffB); PG8_STAGE(PG8_SA(0, 1), cA + hstep, voffA);
        if (wr == 1) PG8_BAR;
        PG8_WAIT_V(4); PG8_BAR;
        PG8_STAGE(PG8_SB(1, 0), cB + kstep, voffB); PG8_STAGE(PG8_SA(1, 0), cA + kstep, voffA); PG8_STAGE(PG8_SB(1, 1), cB + hstep + kstep, voffB);
        PG8_WAIT_V(6); PG8_BAR;
    }
    for (;;) {
        const bool has_next = S.next(ui + 1, nxt);
        const char* nA = has_next ? (const char*)g.A + (size_t)(g.a_pa ? nxt.pa : nxt.pm) * tstep + (size_t)nxt.ko * 2 : cA; const char* nB = has_next ? (const char*)g.Bt + (size_t)nxt.pn * tstep + (size_t)nxt.ko * 2 : cB;
#pragma unroll 1
        for (int t = 0; t < nt; t += 2) {
            const bool last = (t == nt - 2);
            const char* a1 = cA + (size_t)(t + 1) * kstep;
            const char* a2 = last ? nA : cA + (size_t)(t + 2) * kstep; const char* b2 = last ? nB : cB + (size_t)(t + 2) * kstep;
            const char* a3 = a2 + kstep; const char* b3 = b2 + kstep;
            if (last && has_next) S.a_ready(nxt);
            if constexpr (Epi::MIDK) { if (t == 8 || t == 16) E.mid(acc, cur, wr, wc, fr, fq, t >> 3); }
            if constexpr (SP2) {
            PG8_LDB(B0, 0, 0); PG8_LDB(B1, 0, 1); PG8_SCHED; PG8_LDA(At, 0, 0); PG8_STAGE(PG8_SA(1, 1), a1 + hstep, voffA);
            PG8_WAIT_V(8); PG8_WAIT_L(0); PG8_BAR; PG8_MMA(0, 0, At, B0); PG8_MMA(0, 1, At, B1); PG8_BAR; PG8_SCHED;
            PG8_LDA(At, 0, 1); PG8_STAGE(PG8_SB(0, 0), b2, voffB); PG8_STAGE(PG8_SB(0, 1), b2 + hstep, voffB); PG8_STAGE(PG8_SA(0, 0), a2, voffA);
            PG8_WAIT_V(8); PG8_WAIT_L(0); PG8_BAR; PG8_MMA(1, 0, At, B0); PG8_MMA(1, 1, At, B1); PG8_BAR; PG8_SCHED;
            PG8_LDB(B0, 1, 0); PG8_LDB(B1, 1, 1); PG8_SCHED; PG8_LDA(At, 1, 0); PG8_STAGE(PG8_SA(0, 1), a2 + hstep, voffA);
            PG8_WAIT_V(8); PG8_WAIT_L(0); PG8_BAR; PG8_MMA(0, 0, At, B0); PG8_MMA(0, 1, At, B1); PG8_BAR; PG8_SCHED;
            PG8_LDA(At, 1, 1); PG8_STAGE(PG8_SB(1, 0), b3, voffB); PG8_STAGE(PG8_SB(1, 1), b3 + hstep, voffB); PG8_STAGE(PG8_SA(1, 0), a3, voffA);
            PG8_WAIT_V(8); PG8_WAIT_L(0); PG8_BAR; PG8_MMA(1, 0, At, B0); PG8_MMA(1, 1, At, B1); PG8_BAR; PG8_SCHED;
            } else {
            PG8_LDB(B0, 0, 0); PG8_SCHED; PG8_LDA(At, 0, 0); PG8_STAGE(PG8_SA(1, 1), a1 + hstep, voffA);
            PG8_WAIT_L(8); PG8_BAR; PG8_WAIT_L(0); PG8_MMA(0, 0, At, B0); PG8_BAR; PG8_SCHED;
            PG8_LDB(B1, 0, 1); PG8_STAGE(PG8_SB(0, 0), b2, voffB);
            PG8_BAR; PG8_WAIT_L(0); PG8_MMA(0, 1, At, B1); PG8_BAR;
            PG8_LDA(At, 0, 1); PG8_STAGE(PG8_SA(0, 0), a2, voffA);
            PG8_BAR; PG8_WAIT_L(0); PG8_MMA(1, 0, At, B0); PG8_BAR; PG8_SCHED;
            PG8_STAGE(PG8_SB(0, 1), b2 + hstep, voffB);
            PG8_WAIT_V(6); PG8_BAR; PG8_MMA(1, 1, At, B1); PG8_BAR;
            PG8_LDB(B0, 1, 0); PG8_SCHED; PG8_LDA(At, 1, 0); PG8_STAGE(PG8_SA(0, 1), a2 + hstep, voffA);
            PG8_WAIT_L(8); PG8_BAR; PG8_WAIT_L(0); PG8_MMA(0, 0, At, B0); PG8_BAR; PG8_SCHED;
            PG8_LDB(B1, 1, 1); PG8_STAGE(PG8_SB(1, 0), b3, voffB);
            PG8_BAR; PG8_WAIT_L(0); PG8_MMA(0, 1, At, B1); PG8_BAR;
            PG8_LDA(At, 1, 1); PG8_STAGE(PG8_SA(1, 0), a3, voffA);
            PG8_BAR; PG8_WAIT_L(0); PG8_MMA(1, 0, At, B0); PG8_BAR; PG8_SCHED;
            PG8_STAGE(PG8_SB(1, 1), b3 + hstep, voffB);
            PG8_WAIT_V(6); PG8_BAR; PG8_MMA(1, 1, At, B1); PG8_BAR;
            }
        }
        if constexpr (F8) asm volatile("s_nop 15\n\ts_nop 7" ::: "memory");
        if constexpr (ALIGN_EPI) { if (wr == 0) PG8_BAR; }
        if constexpr (!Epi::AFTER_DRAIN) { E(acc, cur, wr, wc, fr, fq);
#ifdef DUP_EPI
            if constexpr (Epi::DUPABLE) { asm volatile("" ::: "memory"); E(acc, cur, wr, wc, fr, fq); }
#endif
            S.done(cur); }
        if (!has_next) break;
#pragma unroll
        for (int a = 0; a < 2; ++a)
#pragma unroll
            for (int b = 0; b < 2; ++b)
#pragma unroll
                for (int m = 0; m < 4; ++m)
#pragma unroll
                    for (int n = 0; n < 2; ++n) acc[a][b][m][n] = (f32x4){0.f, 0.f, 0.f, 0.f};
        cur = nxt; cA = nA; cB = nB; ++ui;
        if constexpr (ALIGN_EPI) { if (wr == 1) PG8_BAR; }
    }
    PG8_WAIT_V(0);
    if constexpr (!ALIGN_EPI) { if (wr == 0) PG8_BAR; }
    PG8_BAR;
    if constexpr (Epi::AFTER_DRAIN) { E.fused(acc, cur, wr, wc, fr, fq, lds, wid, lane); S.done(cur); }
#undef PG8_SA
#undef PG8_SB
#undef PG8_STAGE
#undef PG8_LDA
#undef PG8_LDB
#undef PG8_MMA
#undef PG8_WAIT_V
#undef PG8_WAIT_L
#undef PG8_BAR
#undef PG8_SCHED
}
}


#include <hip/hip_bf16.h>
#include <cmath>

namespace attn_body {
using bf16=__hip_bfloat16;
using bf16x8=__attribute__((ext_vector_type(8)))short;
using s16x4=__attribute__((ext_vector_type(4)))short;
using f32x16=__attribute__((ext_vector_type(16)))float;
using u32x4=__attribute__((ext_vector_type(4)))unsigned;
constexpr int D=64;
constexpr int NW=8,QBLK=32,QB=QBLK*NW,KVBLK=64;
constexpr int ATTN_UNIT_ROWS=QB;
__device__ __forceinline__ int crow(int r,int hi){return (r&3)+8*(r>>2)+4*hi;}
#define SBAR() __builtin_amdgcn_sched_barrier(0)
__device__ __forceinline__ void cmask(f32x16&p0,f32x16&p1,int jb,int qrel,int hi){
  const float NEG=-INFINITY; int kb=64*jb+4*hi;
  #pragma unroll
  for(int r=0;r<16;++r){int kv=kb+(r&3)+8*(r>>2); if(kv>qrel)p0[r]=NEG; if(kv+32>qrel)p1[r]=NEG;}
}

constexpr int NSLOT=3, SLOTB=8192;
constexpr int LDS_K=0, LDS_V=NSLOT*SLOTB, LDS_WS=2*NSLOT*SLOTB, LDS_OST=LDS_WS+NW*64*4, LDS_BYTES=LDS_OST+NW*4096;
constexpr float C2=0.125f*1.4426950408889634f;
__device__ __forceinline__ void glds16(const void*gsrc,unsigned lds_dst){unsigned keep;
  asm volatile("s_mov_b32 %0, m0\n\ts_mov_b32 m0, %2\n\ts_nop 0\n\tglobal_load_lds_dwordx4 %1, off\n\ts_mov_b32 m0, %0":"=&s"(keep):"v"(gsrc),"s"(lds_dst):"memory");}
__device__ __forceinline__ float max3f(float a,float b,float c){float r;asm("v_max3_f32 %0, %1, %2, %3":"=v"(r):"v"(a),"v"(b),"v"(c));return r;}
__device__ __forceinline__ float max2f(float a,float b){float r;asm("v_max_f32_e32 %0, %1, %2":"=v"(r):"v"(a),"v"(b));return r;}
__device__ __forceinline__ float fadd_s(float a,float b){float r;asm("v_add_f32_e32 %0, %1, %2":"=v"(r):"v"(a),"v"(b));return r;}
__device__ __forceinline__ float fsub_s(float a,float b){float r;asm("v_sub_f32_e32 %0, %1, %2":"=v"(r):"v"(a),"v"(b));return r;}
typedef float f32x2_t __attribute__((ext_vector_type(2))); typedef __bf16 bf16x2_t __attribute__((ext_vector_type(2)));
__device__ __forceinline__ unsigned cvtpk_s(float lo,float hi){f32x2_t v={lo,hi};bf16x2_t b=__builtin_convertvector(v,bf16x2_t);return __builtin_bit_cast(unsigned,b);}
#define WAIT_BAR(N) asm volatile("s_waitcnt vmcnt(" #N ") lgkmcnt(0)\n\ts_barrier":::"memory")

__device__ __forceinline__ void qkt(f32x16&p0,f32x16&p1,const char*Kslot,const bf16x8*qr,const f32x16&negm,int r32,int hi){
  const char*kb=Kslot+hi*1024+r32*16;
  #pragma unroll
  for(int d0=0;d0<4;++d0){
    const bf16x8 b0=*reinterpret_cast<const bf16x8*>(kb+d0*2048);
    const bf16x8 b1=*reinterpret_cast<const bf16x8*>(kb+d0*2048+512);
    if(d0==0){p0=__builtin_amdgcn_mfma_f32_32x32x16_bf16(b0,qr[0],negm,0,0,0);p1=__builtin_amdgcn_mfma_f32_32x32x16_bf16(b1,qr[0],negm,0,0,0);}
    else{p0=__builtin_amdgcn_mfma_f32_32x32x16_bf16(b0,qr[d0],p0,0,0,0);p1=__builtin_amdgcn_mfma_f32_32x32x16_bf16(b1,qr[d0],p1,0,0,0);}}
}
typedef __attribute__((address_space(3))) const char* lds_cptr;
typedef short v4i16_t __attribute__((ext_vector_type(4)));
__device__ __forceinline__ void kload8(bf16x8*kf,lds_cptr kp){
  kf[0]=*(const __attribute__((address_space(3))) bf16x8*)(kp);      kf[1]=*(const __attribute__((address_space(3))) bf16x8*)(kp+512);
  kf[2]=*(const __attribute__((address_space(3))) bf16x8*)(kp+2048); kf[3]=*(const __attribute__((address_space(3))) bf16x8*)(kp+2560);
  kf[4]=*(const __attribute__((address_space(3))) bf16x8*)(kp+4096); kf[5]=*(const __attribute__((address_space(3))) bf16x8*)(kp+4608);
  kf[6]=*(const __attribute__((address_space(3))) bf16x8*)(kp+6144); kf[7]=*(const __attribute__((address_space(3))) bf16x8*)(kp+6656);
}
__device__ __forceinline__ void kload2(bf16x8*kf,lds_cptr kp,int j){ kf[2*j]=*(const __attribute__((address_space(3))) bf16x8*)(kp+j*2048); kf[2*j+1]=*(const __attribute__((address_space(3))) bf16x8*)(kp+j*2048+512); }
__device__ __forceinline__ s16x4 vtr(lds_cptr p){ return __builtin_bit_cast(s16x4,__builtin_amdgcn_ds_read_tr16_b64_v4i16((__attribute__((address_space(3))) v4i16_t*)p)); }
__device__ __forceinline__ float rowmax(const f32x16&p0,const f32x16&p1){
  float a=max3f(p0[0],p0[1],p1[0]),b=max3f(p0[2],p0[3],p1[1]);a=max3f(a,p1[2],p1[3]);
  #pragma unroll
  for(int r=4;r<16;r+=4){a=max3f(a,p0[r],p0[r+1]);b=max3f(b,p0[r+2],p0[r+3]);a=max3f(a,p1[r],p1[r+1]);b=max3f(b,p1[r+2],p1[r+3]);}
  const float m=max2f(a,b);
  auto rr=__builtin_amdgcn_permlane32_swap(__float_as_uint(m),__float_as_uint(m),false,false);
  return max2f(__uint_as_float(rr[0]),__uint_as_float(rr[1]));
}
__device__ __forceinline__ void pv(f32x16*o,int vb,bf16x8 pa0,bf16x8 pa1,bf16x8 pa2,bf16x8 pa3){
  #pragma unroll
  for(int d0=0;d0<2;++d0){s16x4 lo[4],hi[4];
    #pragma unroll
    for(int ks=0;ks<4;++ks){
      asm volatile("ds_read_b64_tr_b16 %0,%1 offset:%c2":"=&v"(lo[ks]):"v"(vb),"i"(d0*4096+ks*1024):"memory");
      asm volatile("ds_read_b64_tr_b16 %0,%1 offset:%c2":"=&v"(hi[ks]):"v"(vb),"i"(d0*4096+ks*1024+512):"memory");}
    asm volatile("s_waitcnt lgkmcnt(0)":::"memory");SBAR();
    #define PK(k) (bf16x8){lo[k][0],lo[k][1],lo[k][2],lo[k][3],hi[k][0],hi[k][1],hi[k][2],hi[k][3]}
    o[d0]=__builtin_amdgcn_mfma_f32_32x32x16_bf16(pa0,PK(0),o[d0],0,0,0);
    o[d0]=__builtin_amdgcn_mfma_f32_32x32x16_bf16(pa1,PK(1),o[d0],0,0,0);
    o[d0]=__builtin_amdgcn_mfma_f32_32x32x16_bf16(pa2,PK(2),o[d0],0,0,0);
    o[d0]=__builtin_amdgcn_mfma_f32_32x32x16_bf16(pa3,PK(3),o[d0],0,0,0);
    #undef PK
  }
}

#ifndef ATTN_STORE16
#define ATTN_STORE16(p,v) (*(u32x4*)(p)=(v))
#endif
template<int THRL,bool FIXREF=false> __device__ __forceinline__ void attn_unit(const bf16*Qu,int qp,const bf16*__restrict__ Kh,const bf16*__restrict__ Vh,int kvp,bf16*Ou,int op,int NT,char*shm,float cref=0.f){
  int tid_o=threadIdx.x; asm volatile("":"+v"(tid_o)); const int tid=tid_o,lane=tid&63,r32=lane&31,hi=lane>>5; const int wid=__builtin_amdgcn_readfirstlane(tid>>6);
  const bf16*Qw=Qu+(long)(wid*QBLK)*qp;
  const unsigned lds0=(unsigned)(uintptr_t)shm;
  float*wsf=(float*)(shm+LDS_WS)+wid*64;
  const bf16*ksrc=Kh+(long)lane*kvp+wid*8;
  const bf16*vsrc=Vh+(long)(16*(wid&3)+(lane>>2))*kvp+(wid>>2)*32+(lane&3)*8;
  const unsigned kdst=lds0+LDS_K+wid*1024, vdst=lds0+LDS_V+wid*1024;
  #define DMA_K(t,slot) glds16(ksrc+(long)(t)*KVBLK*kvp,(unsigned)__builtin_amdgcn_readfirstlane(kdst+(slot)))
  #define DMA_V(t,slot) glds16(vsrc+(long)(t)*KVBLK*kvp,(unsigned)__builtin_amdgcn_readfirstlane(vdst+(slot)))
  const int vb0=(int)(lds0+LDS_V)+((lane>>4)&1)*32+(lane&3)*8+(4*hi+((lane&15)>>2))*64;
  const char*Kbase=shm+LDS_K; bf16x8 kf[8];
  const lds_cptr shm3=(lds_cptr)shm; const lds_cptr kp0=shm3+LDS_K+hi*1024+r32*16; const lds_cptr vp0=shm3+LDS_V+((lane>>4)&1)*32+(lane&3)*8+(4*hi+((lane&15)>>2))*64;
  DMA_K(0,0);DMA_V(0,0);DMA_K(1,SLOTB);
  bf16x8 qr[4];
  #pragma unroll
  for(int d0=0;d0<4;++d0)qr[d0]=*reinterpret_cast<const bf16x8*>(&Qw[(long)r32*qp+d0*16+hi*8]);
  float mhat=0.f,l_reg=0.f;f32x16 o[2];o[0]=f32x16{};o[1]=f32x16{};f32x16 negm=f32x16{}; if constexpr(FIXREF){ _Pragma("unroll") for(int r=0;r<16;++r)negm[r]=-cref; } asm volatile("":"+v"(negm));
  #define CMASK(P0,P1,t) do{}while(0)
  bool resc=false;
  #define START(P0,P1) do{ resc=false; if constexpr(!FIXREF){ const float rm=rowmax(P0,P1); \
    { const float dl=rm; mhat=fadd_s(mhat,dl); \
      _Pragma("unroll") for(int r=0;r<16;++r){P0[r]=fsub_s(P0[r],dl);P1[r]=fsub_s(P1[r],dl);} \
      _Pragma("unroll") for(int r=0;r<16;++r)negm[r]=-mhat; asm volatile("":"+v"(negm)); } } \
    _Pragma("unroll") for(int r=0;r<16;++r)P0[r]=__builtin_amdgcn_exp2f(P0[r]); }while(0)
  #define RESC() do{ if constexpr(!FIXREF){ if(resc){ asm volatile("s_waitcnt lgkmcnt(0)":::"memory"); \
      _Pragma("unroll") for(int d_=0;d_<2;++d_) _Pragma("unroll") for(int r=0;r<16;++r)o[d_][r]*=wsf[crow(r,hi)]; } } }while(0)
  f32x16 pA0,pA1,pB0,pB1;
  int sl_prev=0,sl_cur=0,sl_next=SLOTB;
  #define ROT() do{sl_prev=sl_cur;sl_cur=sl_next;sl_next=(sl_next==(NSLOT-1)*SLOTB)?0:sl_next+SLOTB;}while(0)
  DMA_K(2,2*SLOTB);
  WAIT_BAR(3);
  qkt(pA0,pA1,Kbase,qr,negm,r32,hi);asm volatile("s_nop 15\n\ts_nop 7":"+v"(pA0),"+v"(pA1));CMASK(pA0,pA1,0);
  START(pA0,pA1);
  _Pragma("unroll") for(int r=0;r<16;++r)pA1[r]=__builtin_amdgcn_exp2f(pA1[r]);
  WAIT_BAR(0);
  DMA_K(3,0);DMA_V(1,SLOTB);
  ROT();
  kload8(kf,kp0+sl_cur);
  WAIT_BAR(2);
  s16x4 vlo[8],vhi[8]; u32x4 pw0,pw1,pw2,pw3;
  #define PKW(P,B) cvtpk_s(P[B],P[B+1])
  #define PAF(k) __builtin_bit_cast(bf16x8,pw##k)
  #define VFR(i) (bf16x8){vlo[i][0],vlo[i][1],vlo[i][2],vlo[i][3],vhi[i][0],vhi[i][1],vhi[i][2],vhi[i][3]}
  #define PIN(x) asm volatile("":"+v"(x))
  #define MX3(a,b,c) __builtin_fmaxf(__builtin_fmaxf((a),(b)),(c))
  #define GAPA(MF,A0,A1,A2,A3,W0,W1,PW) do{ MF; sacc+=A0; sacc+=A1; sacc+=A2; sacc+=A3; PIN(sacc); W0; W1; PIN(PW); SBAR(); }while(0)
  #define EX(v) __builtin_amdgcn_exp2f(v)
  #define GAPB(MF,X,B) do{ MF; X[B]=EX(X[B]); X[B+1]=EX(X[B+1]); X[B+2]=EX(X[B+2]); X[B+3]=EX(X[B+3]); PIN(X); SBAR(); }while(0)
  #define VRD(i) do{ vlo[i]=vtr(vp_+(((i)>>2)*4096+((i)&3)*1024)); vhi[i]=vtr(vp_+(((i)>>2)*4096+((i)&3)*1024+512)); }while(0)
  #define KRD(G,j) do{ if(G){ kload2(kf,kp0+sl_next,j); SBAR(); } }while(0)
  #define STEP(C0,C1,P0,P1,t,GK,GV,GL) do{ SBAR(); \
    const lds_cptr vp_=vp0+sl_prev; \
    VRD(0); SBAR(); float sacc=(P0[0]+P0[1]); \
    GAPA(C0=__builtin_amdgcn_mfma_f32_32x32x16_bf16(kf[0],qr[0],negm,0,0,0), P0[2],P0[3],P0[4],P0[5],     pw0[0]=PKW(P0,0), pw0[1]=PKW(P0,2), pw0); \
    VRD(4); SBAR(); GAPA(C1=__builtin_amdgcn_mfma_f32_32x32x16_bf16(kf[1],qr[0],negm,0,0,0), P0[6],P0[7],P0[8],P0[9],     pw0[2]=PKW(P0,4), pw0[3]=PKW(P0,6), pw0); \
    VRD(1); SBAR(); GAPA(C0=__builtin_amdgcn_mfma_f32_32x32x16_bf16(kf[2],qr[1],C0,0,0,0),   P0[10],P0[11],P0[12],P0[13], pw1[0]=PKW(P0,8), pw1[1]=PKW(P0,10), pw1); \
    VRD(5); SBAR(); GAPA(C1=__builtin_amdgcn_mfma_f32_32x32x16_bf16(kf[3],qr[1],C1,0,0,0),   P0[14],P0[15],P1[0],P1[1],   pw1[2]=PKW(P0,12),pw1[3]=PKW(P0,14), pw1); \
    VRD(2); SBAR(); GAPA(C0=__builtin_amdgcn_mfma_f32_32x32x16_bf16(kf[4],qr[2],C0,0,0,0),   P1[2],P1[3],P1[4],P1[5],     pw2[0]=PKW(P1,0), pw2[1]=PKW(P1,2), pw2); \
    VRD(6); SBAR(); GAPA(C1=__builtin_amdgcn_mfma_f32_32x32x16_bf16(kf[5],qr[2],C1,0,0,0),   P1[6],P1[7],P1[8],P1[9],     pw2[2]=PKW(P1,4), pw2[3]=PKW(P1,6), pw2); \
    VRD(3); SBAR(); GAPA(C0=__builtin_amdgcn_mfma_f32_32x32x16_bf16(kf[6],qr[3],C0,0,0,0),   P1[10],P1[11],P1[12],P1[13], pw3[0]=PKW(P1,8), pw3[1]=PKW(P1,10), pw3); \
    VRD(7); SBAR(); GAPA(C1=__builtin_amdgcn_mfma_f32_32x32x16_bf16(kf[7],qr[3],C1,0,0,0),   P1[14],P1[15],0.f,0.f,       pw3[2]=PKW(P1,12),pw3[3]=PKW(P1,14), pw3); \
    l_reg+=sacc; \
    if(GK){DMA_K((t)+3,sl_cur);} if(GV){DMA_V((t)+1,sl_next);} \
    CMASK(C0,C1,t); \
    if constexpr(!FIXREF){ float a=MX3(C0[0],C0[1],C1[0]),b=MX3(C0[2],C0[3],C1[1]); a=MX3(a,C1[2],C1[3]); \
      _Pragma("unroll") for(int r=4;r<16;r+=4){a=MX3(a,C0[r],C0[r+1]);b=MX3(b,C0[r+2],C0[r+3]);a=MX3(a,C1[r],C1[r+1]);b=MX3(b,C1[r+2],C1[r+3]);} \
      float rm=__builtin_fmaxf(a,b); { auto rr=__builtin_amdgcn_permlane32_swap(__float_as_uint(rm),__float_as_uint(rm),false,false); rm=__builtin_fmaxf(__uint_as_float(rr[0]),__uint_as_float(rr[1])); } \
      resc=false; \
      if(__builtin_expect(__any(rm>(float)THRL),0)){ const float dl=__builtin_fmaxf(rm,0.f); mhat+=dl; \
        _Pragma("unroll") for(int r=0;r<16;++r){C0[r]-=dl;C1[r]-=dl;} \
        _Pragma("unroll") for(int r=0;r<16;++r)negm[r]=-mhat; asm volatile("":"+v"(negm)); \
        const float f=__builtin_amdgcn_exp2f(-dl); l_reg*=f; if(hi==0)wsf[r32]=f; resc=true; } } \
    SBAR(); \
    GAPB(o[0]=__builtin_amdgcn_mfma_f32_32x32x16_bf16(PAF(0),VFR(0),o[0],0,0,0), C0,0); \
    GAPB(o[1]=__builtin_amdgcn_mfma_f32_32x32x16_bf16(PAF(0),VFR(4),o[1],0,0,0), C0,4); \
    KRD(GL,0); GAPB(o[0]=__builtin_amdgcn_mfma_f32_32x32x16_bf16(PAF(1),VFR(1),o[0],0,0,0), C0,8); \
    KRD(GL,1); GAPB(o[1]=__builtin_amdgcn_mfma_f32_32x32x16_bf16(PAF(1),VFR(5),o[1],0,0,0), C0,12); \
    KRD(GL,2); GAPB(o[0]=__builtin_amdgcn_mfma_f32_32x32x16_bf16(PAF(2),VFR(2),o[0],0,0,0), C1,0); \
    KRD(GL,3); GAPB(o[1]=__builtin_amdgcn_mfma_f32_32x32x16_bf16(PAF(2),VFR(6),o[1],0,0,0), C1,4); \
    GAPB(o[0]=__builtin_amdgcn_mfma_f32_32x32x16_bf16(PAF(3),VFR(3),o[0],0,0,0), C1,8); \
    GAPB(o[1]=__builtin_amdgcn_mfma_f32_32x32x16_bf16(PAF(3),VFR(7),o[1],0,0,0), C1,12); \
    }while(0)
  int t=1;
  #undef CMASK
  #define CMASK(P0,P1,t) do{}while(0)
  for(;t+5<NT;t+=2){
    STEP(pB0,pB1,pA0,pA1,t,true,true,true);     WAIT_BAR(2); RESC(); ROT();
    STEP(pA0,pA1,pB0,pB1,t+1,true,true,true);   WAIT_BAR(2); RESC(); ROT();
  }
  #undef CMASK
  #define CMASK(P0,P1,t) do{}while(0)
  #define ENDW(tt) do{ if((tt)+3<NT){WAIT_BAR(2);} else if((tt)+2<NT){WAIT_BAR(1);} else {WAIT_BAR(0);} }while(0)
  for(;t+1<NT;t+=2){
    STEP(pB0,pB1,pA0,pA1,t,(t+3<NT),(t+1<NT),(t+1<NT));       ENDW(t);   RESC(); ROT();
    STEP(pA0,pA1,pB0,pB1,t+1,(t+4<NT),(t+2<NT),(t+2<NT));     ENDW(t+1); RESC(); ROT();
  }
  STEP(pB0,pB1,pA0,pA1,NT-1,false,false,false); RESC();
  { float sacc=pB0[0]+pB0[1]; _Pragma("unroll") for(int r=2;r<16;++r)sacc+=pB0[r]; _Pragma("unroll") for(int r=0;r<16;++r)sacc+=pB1[r]; l_reg+=sacc;
    pw0=(u32x4){PKW(pB0,0),PKW(pB0,2),PKW(pB0,4),PKW(pB0,6)};pw1=(u32x4){PKW(pB0,8),PKW(pB0,10),PKW(pB0,12),PKW(pB0,14)};pw2=(u32x4){PKW(pB1,0),PKW(pB1,2),PKW(pB1,4),PKW(pB1,6)};pw3=(u32x4){PKW(pB1,8),PKW(pB1,10),PKW(pB1,12),PKW(pB1,14)};
    SBAR(); pv(o,vb0+sl_cur,PAF(0),PAF(1),PAF(2),PAF(3)); }
  #undef PKW
  #undef PAF
  #undef VFR
  #undef PIN
  #undef MX3
  #undef GAPA
  #undef GAPB
  #undef EX
  #undef VRD
  #undef KRD
  #undef STEP
  #undef ENDW
  {auto rr=__builtin_amdgcn_permlane32_swap(__float_as_uint(l_reg),__float_as_uint(l_reg),false,false);l_reg=__uint_as_float(rr[0])+__uint_as_float(rr[1]);}
  if(hi==0)wsf[32+r32]=l_reg;asm volatile("s_waitcnt lgkmcnt(0)":::"memory");
  float rli[16];
  #pragma unroll
  for(int r=0;r<16;++r)rli[r]=__builtin_amdgcn_rcpf(wsf[32+crow(r,hi)]);
  bf16*Ow=Ou+(long)(wid*QBLK)*op;
  { bf16*stg=(bf16*)(shm+LDS_OST)+wid*2048;
    #pragma unroll
    for(int r=0;r<16;++r){const int orow=crow(r,hi);
      #pragma unroll
      for(int d0=0;d0<2;++d0)stg[orow*64+d0*32+r32]=__float2bfloat16(o[d0][r]*rli[r]);}
    asm volatile("s_waitcnt lgkmcnt(0)":::"memory");
    #pragma unroll
    for(int i=0;i<4;++i){const int row=i*8+(lane>>3),ch=lane&7; const u32x4 v=*(const u32x4*)(stg+row*64+ch*8); ATTN_STORE16(Ow+(long)row*op+ch*8,v);} }
  asm volatile("s_waitcnt lgkmcnt(0)\n\ts_barrier":::"memory");
  #undef DMA_K
  #undef DMA_V
  #undef CMASK
  #undef START
  #undef RESC
  #undef ROT
}
constexpr int ATTN_LDS_BYTES=LDS_BYTES;
constexpr int C2_KSL=8192, C2_VSL=16384, C2_LK=0, C2_LV=3*C2_KSL, C2_LWS=C2_LV+2*C2_VSL, C2_END=C2_LWS+NW*64*4, C2_STASH=65536;
static_assert(C2_END<=C2_STASH,"c2 lds");
template<int MODE,int THRL> __device__ __forceinline__ void attn_unit_v128(const bf16*Qu,int qp,const bf16*__restrict__ Kh,const bf16*__restrict__ Vh,int kvp,bf16*Ou,int op,int NT,char*shm,float lam,float oscale,const float*__restrict__ sg){
  int tid_o=threadIdx.x; asm volatile("":"+v"(tid_o)); const int tid=tid_o,lane=tid&63,r32=lane&31,hi=lane>>5; const int wid=__builtin_amdgcn_readfirstlane(tid>>6);
  const bf16*Qw=Qu+(long)(wid*QBLK)*qp;
  const unsigned lds0=(unsigned)(uintptr_t)shm;
  float*wsf=(float*)(shm+C2_LWS)+wid*64;
  const bf16*ksrc=Kh+(long)lane*kvp+wid*8;
  const bf16*vsrc=Vh+(long)(16*(wid&3)+(lane>>2))*kvp+(wid>>2)*32+(lane&3)*8;
  const unsigned kdst=lds0+C2_LK+wid*1024, vdst=lds0+C2_LV+wid*1024;
  #define XK(t,slot) glds16(ksrc+(long)(t)*KVBLK*kvp,(unsigned)__builtin_amdgcn_readfirstlane(kdst+(slot)))
  #define XV(t,slot) do{ glds16(vsrc+(long)(t)*KVBLK*kvp,(unsigned)__builtin_amdgcn_readfirstlane(vdst+(slot))); glds16(vsrc+64+(long)(t)*KVBLK*kvp,(unsigned)__builtin_amdgcn_readfirstlane(vdst+8192+(slot))); }while(0)
  const char*Kbase=shm+C2_LK; bf16x8 kf[8];
  const lds_cptr shm3=(lds_cptr)shm; const lds_cptr kp0=shm3+C2_LK+hi*1024+r32*16; const lds_cptr vp0=shm3+C2_LV+((lane>>4)&1)*32+(lane&3)*8+(4*hi+((lane&15)>>2))*64;
  const int vb0=(int)(lds0+C2_LV)+((lane>>4)&1)*32+(lane&3)*8+(4*hi+((lane&15)>>2))*64;
  XK(0,0);XV(0,0);XK(1,C2_KSL);
  bf16x8 qr[4];
  #pragma unroll
  for(int d0=0;d0<4;++d0)qr[d0]=*reinterpret_cast<const bf16x8*>(&Qw[(long)r32*qp+d0*16+hi*8]);
  float mhat=0.f,l_reg=0.f;f32x16 o[4];o[0]=f32x16{};o[1]=f32x16{};o[2]=f32x16{};o[3]=f32x16{};f32x16 negm=f32x16{};asm volatile("":"+v"(negm));
  bool resc=false;
  #define XRESC() do{ if(resc){ asm volatile("s_waitcnt lgkmcnt(0)":::"memory"); \
      _Pragma("unroll") for(int d_=0;d_<4;++d_) _Pragma("unroll") for(int r=0;r<16;++r)o[d_][r]*=wsf[crow(r,hi)]; } }while(0)
  f32x16 C0,C1; s16x4 vlo[8],vhi[8]; u32x4 pw0,pw1,pw2,pw3;
  int k_t=C2_KSL,k_t1=2*C2_KSL;
  int v_tm1=0,v_t=C2_VSL;
  #define XROT() do{ k_t=k_t1; k_t1=(k_t1==2*C2_KSL)?0:k_t1+C2_KSL; const int s_=v_tm1; v_tm1=v_t; v_t=s_; }while(0)
  XK(2,2*C2_KSL);
  WAIT_BAR(3);
  qkt(C0,C1,Kbase,qr,negm,r32,hi);asm volatile("s_nop 15\n\ts_nop 7":"+v"(C0),"+v"(C1));
  { const float rm=rowmax(C0,C1); mhat=fadd_s(mhat,rm);
    _Pragma("unroll") for(int r=0;r<16;++r){C0[r]=fsub_s(C0[r],rm);C1[r]=fsub_s(C1[r],rm);}
    _Pragma("unroll") for(int r=0;r<16;++r)negm[r]=-mhat; asm volatile("":"+v"(negm));
    _Pragma("unroll") for(int r=0;r<16;++r){C0[r]=__builtin_amdgcn_exp2f(C0[r]);C1[r]=__builtin_amdgcn_exp2f(C1[r]);}
    float sacc=0.f; _Pragma("unroll") for(int r=0;r<16;++r)sacc+=C0[r]; _Pragma("unroll") for(int r=0;r<16;++r)sacc+=C1[r]; l_reg=sacc;
    pw0=(u32x4){cvtpk_s(C0[0],C0[1]),cvtpk_s(C0[2],C0[3]),cvtpk_s(C0[4],C0[5]),cvtpk_s(C0[6],C0[7])}; pw1=(u32x4){cvtpk_s(C0[8],C0[9]),cvtpk_s(C0[10],C0[11]),cvtpk_s(C0[12],C0[13]),cvtpk_s(C0[14],C0[15])};
    pw2=(u32x4){cvtpk_s(C1[0],C1[1]),cvtpk_s(C1[2],C1[3]),cvtpk_s(C1[4],C1[5]),cvtpk_s(C1[6],C1[7])}; pw3=(u32x4){cvtpk_s(C1[8],C1[9]),cvtpk_s(C1[10],C1[11]),cvtpk_s(C1[12],C1[13]),cvtpk_s(C1[14],C1[15])};
    asm volatile("":"+v"(pw0),"+v"(pw1),"+v"(pw2),"+v"(pw3)); }
  WAIT_BAR(0);
  if(3<NT){XK(3,0);} XV(1,C2_VSL);
  kload8(kf,kp0+k_t);
  if(3<NT){WAIT_BAR(3);}else{WAIT_BAR(2);}
  #define PAF(k) __builtin_bit_cast(bf16x8,pw##k)
  #define VFR(i) (bf16x8){vlo[i][0],vlo[i][1],vlo[i][2],vlo[i][3],vhi[i][0],vhi[i][1],vhi[i][2],vhi[i][3]}
  #define PIN(x) asm volatile("":"+v"(x))
  #define MX3(a,b,c) __builtin_fmaxf(__builtin_fmaxf((a),(b)),(c))
  #define EX(v) __builtin_amdgcn_exp2f(v)
  #define VRD(s,f) do{ vlo[s]=vtr(vp_+((((f)&3))*4096+((f)>>2)*1024)); vhi[s]=vtr(vp_+((((f)&3))*4096+((f)>>2)*1024+512)); }while(0)
  #define KRD(G,j) do{ if(G){ kload2(kf,kp0+k_t1,j); SBAR(); } }while(0)
  #define QKG(MF,i) do{ VRD(i,i); SBAR(); MF; SBAR(); }while(0)
  #define PVG(f,RD,X0,X1,A0,A1,PK) do{ o[(f)&3]=__builtin_amdgcn_mfma_f32_32x32x16_bf16(PAFK(f),VFR((f)&7),o[(f)&3],0,0,0); RD; X0=EX(X0); X1=EX(X1); sacc+=A0; sacc+=A1; PIN(sacc); PK; PIN(C0); PIN(C1); SBAR(); }while(0)
  #define PAFK(f) (((f)>>2)==0?PAF(0):((f)>>2)==1?PAF(1):((f)>>2)==2?PAF(2):PAF(3))
  #define PKW(P,B) cvtpk_s(P[B],P[B+1])
  #define XSTEP(t,GK,GV,GL) do{ SBAR(); \
    if(GV){XV((t),v_t);} \
    const lds_cptr vp_=vp0+v_tm1; \
    QKG(C0=__builtin_amdgcn_mfma_f32_32x32x16_bf16(kf[0],qr[0],negm,0,0,0),0); \
    QKG(C1=__builtin_amdgcn_mfma_f32_32x32x16_bf16(kf[1],qr[0],negm,0,0,0),1); \
    QKG(C0=__builtin_amdgcn_mfma_f32_32x32x16_bf16(kf[2],qr[1],C0,0,0,0),2); \
    QKG(C1=__builtin_amdgcn_mfma_f32_32x32x16_bf16(kf[3],qr[1],C1,0,0,0),3); \
    QKG(C0=__builtin_amdgcn_mfma_f32_32x32x16_bf16(kf[4],qr[2],C0,0,0,0),4); \
    QKG(C1=__builtin_amdgcn_mfma_f32_32x32x16_bf16(kf[5],qr[2],C1,0,0,0),5); \
    QKG(C0=__builtin_amdgcn_mfma_f32_32x32x16_bf16(kf[6],qr[3],C0,0,0,0),6); \
    QKG(C1=__builtin_amdgcn_mfma_f32_32x32x16_bf16(kf[7],qr[3],C1,0,0,0),7); \
    if(GK){XK((t)+3,k_t);} \
    { float a=MX3(C0[0],C0[1],C1[0]),b=MX3(C0[2],C0[3],C1[1]); a=MX3(a,C1[2],C1[3]); \
      _Pragma("unroll") for(int r=4;r<16;r+=4){a=MX3(a,C0[r],C0[r+1]);b=MX3(b,C0[r+2],C0[r+3]);a=MX3(a,C1[r],C1[r+1]);b=MX3(b,C1[r+2],C1[r+3]);} \
      float rm=__builtin_fmaxf(a,b); { auto rr=__builtin_amdgcn_permlane32_swap(__float_as_uint(rm),__float_as_uint(rm),false,false); rm=__builtin_fmaxf(__uint_as_float(rr[0]),__uint_as_float(rr[1])); } \
      resc=false; \
      if(__builtin_expect(__any(rm>(float)THRL),0)){ const float dl=__builtin_fmaxf(rm,0.f); mhat+=dl; \
        _Pragma("unroll") for(int r=0;r<16;++r){C0[r]-=dl;C1[r]-=dl;} \
        _Pragma("unroll") for(int r=0;r<16;++r)negm[r]=-mhat; asm volatile("":"+v"(negm)); \
        const float f=__builtin_amdgcn_exp2f(-dl); l_reg*=f; if(hi==0)wsf[r32]=f; resc=true; } } \
    SBAR(); \
    float sacc=0.f; \
    PVG(0, VRD(0,8),  C0[0],C0[1],  0.f,0.f,      ;); \
    PVG(1, VRD(1,9),  C0[2],C0[3],  C0[0],C0[1],  ;); \
    PVG(2, VRD(2,10), C0[4],C0[5],  C0[2],C0[3],  ;); \
    KRD(GL,0); PVG(3, VRD(3,11), C0[6],C0[7],  C0[4],C0[5],  ;); \
    KRD(GL,1); PVG(4, VRD(4,12), C0[8],C0[9],  C0[6],C0[7],  pw0[0]=PKW(C0,0);pw0[1]=PKW(C0,2);PIN(pw0)); \
    KRD(GL,2); PVG(5, VRD(5,13), C0[10],C0[11],C0[8],C0[9],  pw0[2]=PKW(C0,4);pw0[3]=PKW(C0,6);PIN(pw0)); \
    KRD(GL,3); PVG(6, VRD(6,14), C0[12],C0[13],C0[10],C0[11],;); \
    PVG(7, VRD(7,15), C0[14],C0[15],C0[12],C0[13],;); \
    PVG(8, ;,         C1[0],C1[1],  C0[14],C0[15],pw1[0]=PKW(C0,8);pw1[1]=PKW(C0,10);PIN(pw1)); \
    PVG(9, ;,         C1[2],C1[3],  C1[0],C1[1],  pw1[2]=PKW(C0,12);pw1[3]=PKW(C0,14);PIN(pw1)); \
    PVG(10,;,         C1[4],C1[5],  C1[2],C1[3],  ;); \
    PVG(11,;,         C1[6],C1[7],  C1[4],C1[5],  ;); \
    PVG(12,;,         C1[8],C1[9],  C1[6],C1[7],  pw2[0]=PKW(C1,0);pw2[1]=PKW(C1,2);PIN(pw2)); \
    PVG(13,;,         C1[10],C1[11],C1[8],C1[9],  pw2[2]=PKW(C1,4);pw2[3]=PKW(C1,6);PIN(pw2)); \
    PVG(14,;,         C1[12],C1[13],C1[10],C1[11],;); \
    PVG(15,;,         C1[14],C1[15],C1[12],C1[13],;); \
    sacc+=C1[14]; sacc+=C1[15]; l_reg+=sacc; \
    pw3[0]=PKW(C1,8);pw3[1]=PKW(C1,10);pw3[2]=PKW(C1,12);pw3[3]=PKW(C1,14);PIN(pw3); SBAR(); \
    }while(0)
  int t=1;
  XSTEP(1,(4<NT),false,(2<NT)); if(4<NT){WAIT_BAR(1);}else{WAIT_BAR(0);} XRESC(); XROT(); t=2;
  for(;t+3<NT;++t){ XSTEP(t,true,true,true); WAIT_BAR(1); XRESC(); XROT(); }
  for(;t+1<NT;++t){ XSTEP(t,false,true,true); WAIT_BAR(0); XRESC(); XROT(); }
  XSTEP(NT-1,false,true,false); WAIT_BAR(0); XRESC();
  { const int vb=vb0+v_t;
    #pragma unroll
    for(int d0=0;d0<4;++d0){s16x4 lo[4],hh[4];
      #pragma unroll
      for(int ks=0;ks<4;++ks){
        asm volatile("ds_read_b64_tr_b16 %0,%1 offset:%c2":"=&v"(lo[ks]):"v"(vb),"i"(d0*4096+ks*1024):"memory");
        asm volatile("ds_read_b64_tr_b16 %0,%1 offset:%c2":"=&v"(hh[ks]):"v"(vb),"i"(d0*4096+ks*1024+512):"memory");}
      asm volatile("s_waitcnt lgkmcnt(0)":::"memory");SBAR();
      #define PKD(k) (bf16x8){lo[k][0],lo[k][1],lo[k][2],lo[k][3],hh[k][0],hh[k][1],hh[k][2],hh[k][3]}
      o[d0]=__builtin_amdgcn_mfma_f32_32x32x16_bf16(PAF(0),PKD(0),o[d0],0,0,0);
      o[d0]=__builtin_amdgcn_mfma_f32_32x32x16_bf16(PAF(1),PKD(1),o[d0],0,0,0);
      o[d0]=__builtin_amdgcn_mfma_f32_32x32x16_bf16(PAF(2),PKD(2),o[d0],0,0,0);
      o[d0]=__builtin_amdgcn_mfma_f32_32x32x16_bf16(PAF(3),PKD(3),o[d0],0,0,0);
      #undef PKD
    } }
  #undef PKW
  #undef PAFK
  #undef PVG
  #undef QKG
  #undef KRD
  #undef VRD
  #undef EX
  #undef MX3
  #undef PIN
  #undef VFR
  #undef PAF
  #undef XSTEP
  {auto rr=__builtin_amdgcn_permlane32_swap(__float_as_uint(l_reg),__float_as_uint(l_reg),false,false);l_reg=__uint_as_float(rr[0])+__uint_as_float(rr[1]);}
  if(hi==0)wsf[32+r32]=l_reg;asm volatile("s_waitcnt lgkmcnt(0)":::"memory");
  float rli[16];
  #pragma unroll
  for(int r=0;r<16;++r)rli[r]=__builtin_amdgcn_rcpf(wsf[32+crow(r,hi)]);
  unsigned*stash=(unsigned*)(shm+C2_STASH)+wid*2048;
  if constexpr(MODE==0){
    #pragma unroll
    for(int d0=0;d0<4;++d0)
      #pragma unroll
      for(int r=0;r<16;r+=2)stash[(d0*8+(r>>1))*64+lane]=cvtpk_s(o[d0][r]*rli[r],o[d0][r+1]*rli[r+1]);
  }else{
    float ss[16];
    #pragma unroll
    for(int r=0;r<16;++r)ss[r]=0.f;
    #pragma unroll
    for(int d0=0;d0<4;++d0)
      #pragma unroll
      for(int r=0;r<16;r+=2){const unsigned w=stash[(d0*8+(r>>1))*64+lane];
        const float da=__uint_as_float(w<<16)-lam*(o[d0][r]*rli[r]),db=__uint_as_float(w&0xffff0000u)-lam*(o[d0][r+1]*rli[r+1]);
        o[d0][r]=da;o[d0][r+1]=db;ss[r]+=da*da;ss[r+1]+=db*db;}
    #pragma unroll
    for(int r=0;r<16;++r){float v=::xsum_x16(::xsum_row16(ss[r]));
      ss[r]=oscale*::rsq_(v*(1.f/128.f)+1e-6f);}
    bf16*stg=(bf16*)stash;
    #pragma unroll
    for(int d0=0;d0<4;++d0){const float g=sg[d0*32+r32];
      #pragma unroll
      for(int r=0;r<16;++r)stg[crow(r,hi)*128+d0*32+r32]=__float2bfloat16(o[d0][r]*ss[r]*g);}
    asm volatile("s_waitcnt lgkmcnt(0)":::"memory");
    bf16*Ow=Ou+(long)(wid*QBLK)*op;
    #pragma unroll
    for(int i=0;i<8;++i){const int row=i*4+(lane>>4),ch=lane&15;const u32x4 v=*(const u32x4*)(stg+row*128+ch*8);*(u32x4*)(Ow+(long)row*op+ch*8)=v;}
  }
  asm volatile("s_waitcnt lgkmcnt(0)\n\ts_barrier":::"memory");
  #undef XK
  #undef XV
  #undef XRESC
  #undef XROT
}
#undef SBAR
#undef WAIT_BAR
}

namespace attn_c {
using bf16 = __hip_bfloat16;
constexpr int D = 128, DQK = 64, NW = 8, QBLK = 32, KVBLK = 64, SDEPTH = 2;
constexpr size_t SHM_V = KVBLK * D * 2, SHM_K = KVBLK * DQK * 2, SHM_ATTN = 2 * SHM_V + 2 * SHM_K + NW * 64 * 4;
constexpr float THR_L2 = 8.f * 1.4426950408889634f;
using bf16x8 = __attribute__((ext_vector_type(8))) short;
using s16x4  = __attribute__((ext_vector_type(4))) short;
using f32x16 = __attribute__((ext_vector_type(16))) float;
using f32x8  = __attribute__((ext_vector_type(8))) float;
using u32x4  = __attribute__((ext_vector_type(4))) unsigned;
#define KSWZ(row, colB) ((row) * 128 + ((colB) ^ ((((row) >> 1) & 7) << 4)))
#define SBAR_C() __builtin_amdgcn_sched_barrier(0)
__device__ __forceinline__ int crow(int r, int hi) { return (r & 3) + 8 * (r >> 2) + 4 * hi; }
__device__ __forceinline__ unsigned cvtpk(float lo, float hi) {
  typedef float f2_ __attribute__((ext_vector_type(2))); typedef __bf16 b2_ __attribute__((ext_vector_type(2))); f2_ v = {lo, hi}; b2_ b = __builtin_convertvector(v, b2_); return __builtin_bit_cast(unsigned, b);
}
template <typename TIn> struct Stage;
template <> struct Stage<bf16>  { using T = bf16x8;
  __device__ static __forceinline__ T ld8(const bf16* p) { return *reinterpret_cast<const bf16x8*>(p); }
  __device__ static __forceinline__ bf16x8 tobf(T x) { return x; } };
template <> struct Stage<float> { using T = f32x8;
  __device__ static __forceinline__ T ld8(const float* p) { return *reinterpret_cast<const f32x8*>(p); }
  __device__ static __forceinline__ bf16x8 tobf(T x) {
    u32x4 w = {cvtpk(x[0], x[1]), cvtpk(x[2], x[3]), cvtpk(x[4], x[5]), cvtpk(x[6], x[7])}; return *reinterpret_cast<bf16x8*>(&w); } };

__device__ __forceinline__ void partialSM(f32x16& p0, f32x16& p1, float& m_reg, float& mn, float& alpha) {
  constexpr float C = 1.f;
  float pmax = p0[0]; for (int r = 1; r < 16; ++r) pmax = fmaxf(pmax, p0[r]); for (int r = 0; r < 16; ++r) pmax = fmaxf(pmax, p1[r]);
  { auto rr = __builtin_amdgcn_permlane32_swap(__float_as_uint(pmax), __float_as_uint(pmax), false, false);
    pmax = fmaxf(__uint_as_float(rr[0]), __uint_as_float(rr[1])); }
  if (__builtin_expect(__all(pmax - m_reg <= THR_L2), 1)) { mn = m_reg; alpha = 1.f; }
  else { mn = fmaxf(m_reg, pmax); alpha = __builtin_amdgcn_exp2f((m_reg - mn) * C); m_reg = mn; }
  float mnC = -mn * C;
  for (int r = 0; r < 16; ++r) p0[r] = fmaf(p0[r], C, mnC); for (int r = 0; r < 16; ++r) p1[r] = fmaf(p1[r], C, mnC);
  for (int r = 0; r < 16; ++r) p0[r] = __builtin_amdgcn_exp2f(p0[r]);
}
__device__ __forceinline__ void finishSM(f32x16& p0, f32x16& p1, float alpha, float& l_reg, bf16x8& pa0, bf16x8& pa1, bf16x8& pa2, bf16x8& pa3) {
  for (int r = 0; r < 16; ++r) p1[r] = __builtin_amdgcn_exp2f(p1[r]);
  float ps = 0; for (int r = 0; r < 16; ++r) ps += p0[r]; for (int r = 0; r < 16; ++r) ps += p1[r];
  { auto rr = __builtin_amdgcn_permlane32_swap(__float_as_uint(ps), __float_as_uint(ps), false, false);
    ps = __uint_as_float(rr[0]) + __uint_as_float(rr[1]); }
  l_reg = l_reg * alpha + ps;
#define PK4(P, BASE, OUT) do { unsigned a0 = cvtpk(P[BASE + 0], P[BASE + 1]), a1 = cvtpk(P[BASE + 2], P[BASE + 3]);   \
    unsigned b0 = cvtpk(P[BASE + 4], P[BASE + 5]), b1 = cvtpk(P[BASE + 6], P[BASE + 7]);                              \
    auto r0 = __builtin_amdgcn_permlane32_swap(a0, b0, false, false); auto r1 = __builtin_amdgcn_permlane32_swap(a1, b1, false, false); \
    u32x4 w = {r0[0], r1[0], r0[1], r1[1]}; OUT = *reinterpret_cast<bf16x8*>(&w); } while (0)
  PK4(p0, 0, pa0); PK4(p0, 8, pa1); PK4(p1, 0, pa2); PK4(p1, 8, pa3);
#undef PK4
}
__device__ __forceinline__ void qkt(f32x16& p0, f32x16& p1, const bf16* Ks, const bf16x8* qr, int r32, int hi) {
  p0 = f32x16{}; p1 = f32x16{};
  for (int d0 = 0; d0 < 4; ++d0) { int cb = (d0 * 16 + hi * 8) * 2;
    bf16x8 b0 = *reinterpret_cast<const bf16x8*>((const char*)Ks + KSWZ(r32, cb));
    bf16x8 b1 = *reinterpret_cast<const bf16x8*>((const char*)Ks + KSWZ(32 + r32, cb));
    p0 = __builtin_amdgcn_mfma_f32_32x32x16_bf16(b0, qr[d0], p0, 0, 0, 0);
    p1 = __builtin_amdgcn_mfma_f32_32x32x16_bf16(b1, qr[d0], p1, 0, 0, 0); }
}
__device__ __forceinline__ int v_st(int k, int c) { const int kk = (k & ~0xC) | ((k & 4) << 1) | ((k & 8) >> 1); return ((kk >> 3) * 4 + (c >> 5)) * 512 + ((kk & 7) * 32 + (c & 31)) * 2; }
__device__ __forceinline__ int v_rd_base(int lane) { return ((lane & 3) << 3) | (((lane >> 2) & 3) << 6) | (((lane >> 4) & 1) << 5) | (((lane >> 5) & 1) << 8); }
constexpr int v_rd_off(int d0, int ks, int half) { return d0 * 512 + ks * 4096 + half * 2048; }
template <int OFF> __device__ __forceinline__ s16x4 tr_read(int vb) {
  s16x4 r; asm volatile("ds_read_b64_tr_b16 %0, %1 offset:%2" : "=&v"(r) : "v"(vb), "i"(OFF) : "memory"); return r;
}
template <int D0> __device__ __forceinline__ void pv_one(f32x16& od, int vb, bf16x8 pa0, bf16x8 pa1, bf16x8 pa2, bf16x8 pa3) {
  const s16x4 l0 = tr_read<v_rd_off(D0, 0, 0)>(vb), h0 = tr_read<v_rd_off(D0, 0, 1)>(vb), l1 = tr_read<v_rd_off(D0, 1, 0)>(vb), h1 = tr_read<v_rd_off(D0, 1, 1)>(vb);
  const s16x4 l2 = tr_read<v_rd_off(D0, 2, 0)>(vb), h2 = tr_read<v_rd_off(D0, 2, 1)>(vb), l3 = tr_read<v_rd_off(D0, 3, 0)>(vb), h3 = tr_read<v_rd_off(D0, 3, 1)>(vb);
  asm volatile("s_waitcnt lgkmcnt(0)" ::: "memory"); SBAR_C();
#define PK(L, H) (bf16x8){L[0], L[1], L[2], L[3], H[0], H[1], H[2], H[3]}
  od = __builtin_amdgcn_mfma_f32_32x32x16_bf16(pa0, PK(l0, h0), od, 0, 0, 0);
  od = __builtin_amdgcn_mfma_f32_32x32x16_bf16(pa1, PK(l1, h1), od, 0, 0, 0);
  od = __builtin_amdgcn_mfma_f32_32x32x16_bf16(pa2, PK(l2, h2), od, 0, 0, 0);
  od = __builtin_amdgcn_mfma_f32_32x32x16_bf16(pa3, PK(l3, h3), od, 0, 0, 0);
#undef PK
}
__device__ __forceinline__ void pv_d0(f32x16* o, int vb, bf16x8 pa0, bf16x8 pa1, bf16x8 pa2, bf16x8 pa3) {
  pv_one<0>(o[0], vb, pa0, pa1, pa2, pa3); pv_one<1>(o[1], vb, pa0, pa1, pa2, pa3); pv_one<2>(o[2], vb, pa0, pa1, pa2, pa3); pv_one<3>(o[3], vb, pa0, pa1, pa2, pa3);
}

template <int MODE> __device__ __forceinline__ void attn_c_unit(const bf16* __restrict__ Qb, int ldq, const bf16* __restrict__ Kh, const bf16* __restrict__ Vh, int ldk,
                                            bf16* __restrict__ Ob, int ldo, int seq, char* lds, float lam, float oscale, const float* __restrict__ sg) {
  typedef bf16 TQ; const int LDQ = ldq, LDK = ldk, LDO = ldo;
  using St = Stage<bf16>; using SQ = Stage<bf16>;
  int tid_o = threadIdx.x; asm volatile("" : "+v"(tid_o)); const int tid = tid_o, wid = tid >> 6, lane = tid & 63, r32 = lane & 31, hi = lane >> 5;
  bf16* V_lds = (bf16*)lds; bf16* K_lds = (bf16*)(lds + 2 * SHM_V);
  float* ws = (float*)(lds + 2 * SHM_V + 2 * SHM_K) + wid * 64; float* li_l = ws; float* al_l = ws + 32;
  float m_reg = -1e30f, l_reg = 0; f32x16 o[4] = {}; bf16x8 qr[4];
  const TQ* Qw = Qb + (long)(wid * QBLK + r32) * LDQ + hi * 8;
#pragma unroll
  for (int d0 = 0; d0 < 4; ++d0) qr[d0] = SQ::tobf(SQ::ld8(Qw + d0 * 16));
  const int sr = tid >> 4, sc = (tid & 15) * 8, vst0 = v_st(sr, sc), vst1 = v_st(32 + sr, sc), kr = tid >> 3, kcb = (tid & 7) * 16;
  const int vb0 = (int)(uintptr_t)V_lds + v_rd_base(lane);
  struct { typename St::T vs0, vs1, ks0; } sr_[SDEPTH];
#define SLOAD(i, k0) do { sr_[i].vs0 = St::ld8(&Vh[(long)((k0) + sr) * LDK + sc]); sr_[i].vs1 = St::ld8(&Vh[(long)((k0) + 32 + sr) * LDK + sc]); \
    sr_[i].ks0 = St::ld8(&Kh[(long)((k0) + kr) * LDK + (kcb >> 1)]); } while (0)
#define SWRITE(b, i) do { *(bf16x8*)((char*)V_lds + (b) * SHM_V + vst0) = St::tobf(sr_[i].vs0);          \
    *(bf16x8*)((char*)V_lds + (b) * SHM_V + vst1) = St::tobf(sr_[i].vs1);                               \
    *(bf16x8*)((char*)K_lds + (b) * SHM_K + KSWZ(kr, kcb)) = St::tobf(sr_[i].ks0); } while (0)
#define SWAIT() do { if constexpr (SDEPTH == 2) asm volatile("s_waitcnt vmcnt(3)" ::: "memory"); else asm volatile("s_waitcnt vmcnt(0)" ::: "memory"); } while (0)
#define RESC(a) do { if (__any((a) < 1.f)) { if (hi == 0) al_l[r32] = (a); asm volatile("s_waitcnt lgkmcnt(0)" ::: "memory"); \
    for (int d = 0; d < 4; ++d) for (int r = 0; r < 16; ++r) o[d][r] *= al_l[crow(r, hi)]; } } while (0)
  f32x16 pA0, pA1, pB0, pB1; float mnA, mnB, alA, alB; bf16x8 pa0, pa1, pa2, pa3; const int NT = seq / KVBLK;
  constexpr int SE = 0, SO = SDEPTH - 1;
  SLOAD(SE, 0); asm volatile("s_waitcnt vmcnt(0)" ::: "memory"); SWRITE(0, SE); __syncthreads();
  qkt(pA0, pA1, K_lds, qr, r32, hi); partialSM(pA0, pA1, m_reg, mnA, alA);
  SLOAD(SO, KVBLK); if constexpr (SDEPTH == 2) { if (2 < NT) SLOAD(SE, 2 * KVBLK); }
  SWAIT(); SWRITE(1, SO); __syncthreads();
  for (int j = 1; j + 1 < NT; j += 2) {
    SBAR_C(); qkt(pB0, pB1, (bf16*)((char*)K_lds + SHM_K), qr, r32, hi);
    finishSM(pA0, pA1, alA, l_reg, pa0, pa1, pa2, pa3); SBAR_C();
    SLOAD(SO, (j + SDEPTH) * KVBLK); SBAR_C();
    pv_d0(o, vb0, pa0, pa1, pa2, pa3); partialSM(pB0, pB1, m_reg, mnB, alB);
    __syncthreads(); SWAIT(); SWRITE(0, SE);
    RESC(alB); __syncthreads();
    SBAR_C(); qkt(pA0, pA1, K_lds, qr, r32, hi);
    finishSM(pB0, pB1, alB, l_reg, pa0, pa1, pa2, pa3); SBAR_C();
    if (SDEPTH == 1 || j + 3 < NT) SLOAD(SE, (j + 1 + SDEPTH) * KVBLK); SBAR_C();
    pv_d0(o, vb0 + (int)SHM_V, pa0, pa1, pa2, pa3); partialSM(pA0, pA1, m_reg, mnA, alA);
    __syncthreads(); SWAIT(); SWRITE(1, SO);
    RESC(alA); __syncthreads();
  }
  SBAR_C(); qkt(pB0, pB1, (bf16*)((char*)K_lds + SHM_K), qr, r32, hi);
  finishSM(pA0, pA1, alA, l_reg, pa0, pa1, pa2, pa3); SBAR_C();
  pv_d0(o, vb0, pa0, pa1, pa2, pa3); partialSM(pB0, pB1, m_reg, mnB, alB);
  __syncthreads(); RESC(alB);
  finishSM(pB0, pB1, alB, l_reg, pa0, pa1, pa2, pa3); SBAR_C();
  pv_d0(o, vb0 + (int)SHM_V, pa0, pa1, pa2, pa3);
  if (hi == 0) li_l[r32] = l_reg; asm volatile("s_waitcnt lgkmcnt(0)" ::: "memory");
  float rli[16];
#pragma unroll
  for (int r = 0; r < 16; ++r) rli[r] = __builtin_amdgcn_rcpf(li_l[crow(r, hi)]);
  unsigned* stash = (unsigned*)(lds + 65536) + wid * 2048;
  if constexpr (MODE == 0) {
#pragma unroll
    for (int d0 = 0; d0 < 4; ++d0)
#pragma unroll
      for (int r = 0; r < 16; r += 2) stash[(d0 * 8 + (r >> 1)) * 64 + lane] = cvtpk(o[d0][r] * rli[r], o[d0][r + 1] * rli[r + 1]);
  } else {
    float ss[16];
#pragma unroll
    for (int r = 0; r < 16; ++r) ss[r] = 0.f;
#pragma unroll
    for (int d0 = 0; d0 < 4; ++d0)
#pragma unroll
      for (int r = 0; r < 16; r += 2) { const unsigned w = stash[(d0 * 8 + (r >> 1)) * 64 + lane];
        const float da = __uint_as_float(w << 16) - lam * (o[d0][r] * rli[r]), db = __uint_as_float(w & 0xffff0000u) - lam * (o[d0][r + 1] * rli[r + 1]);
        o[d0][r] = da; o[d0][r + 1] = db; ss[r] += da * da; ss[r + 1] += db * db; }
#pragma unroll
    for (int r = 0; r < 16; ++r) { float v = ss[r]; v += __shfl_xor(v, 1); v += __shfl_xor(v, 2); v += __shfl_xor(v, 4); v += __shfl_xor(v, 8); v += __shfl_xor(v, 16);
      ss[r] = oscale / sqrtf(v * (1.f / 128.f) + 1e-6f); }
    bf16* stg = (bf16*)stash;
#pragma unroll
    for (int d0 = 0; d0 < 4; ++d0) { const float g = sg[d0 * 32 + r32];
#pragma unroll
      for (int r = 0; r < 16; ++r) stg[crow(r, hi) * 128 + d0 * 32 + r32] = __float2bfloat16(o[d0][r] * ss[r] * g); }
    asm volatile("s_waitcnt lgkmcnt(0)" ::: "memory");
    bf16* Ow = Ob + (long)(wid * QBLK) * LDO;
#pragma unroll
    for (int i = 0; i < 8; ++i) { const int row = i * 4 + (lane >> 4), ch = lane & 15; const u32x4 v = *(const u32x4*)(stg + row * 128 + ch * 8); *(u32x4*)(Ow + (long)row * LDO + ch * 8) = v; }
  }
  __syncthreads();
#undef SLOAD
#undef SWRITE
#undef SWAIT
#undef RESC
}


#undef KSWZ
}


#define LAS __attribute__((address_space(3)))

#define XB_TMO      128
#define XB_XCNT(j)  (256  + 64 * (j))
#define XB_XSUB(j)  (1280 + 64 * (j))
#define XB_XGEN(j)  (2304 + 64 * (j))
#define XB_TOP      3328
#define XB_TOPGEN   3392
#define XCD_BAR_WORDS 3456
#define XB_SPIN_CAP (1u << 18)

__device__ __forceinline__ unsigned xb_ld(unsigned* p)              { return __hip_atomic_load(p, __ATOMIC_RELAXED, __HIP_MEMORY_SCOPE_AGENT); }
__device__ __forceinline__ unsigned xb_add(unsigned* p, unsigned v) { return __hip_atomic_fetch_add(p, v, __ATOMIC_RELAXED, __HIP_MEMORY_SCOPE_AGENT); }
__device__ __forceinline__ unsigned xb_xcc_id() { return (unsigned)__builtin_amdgcn_s_getreg((3 << 11) | 20) & 0xFu; }
#define XB_SPIN(cond, bar) do { unsigned _sp = 0; while (cond) { __builtin_amdgcn_s_sleep(1); \
    if ((++_sp & 255u) == 0u) { if (xb_ld(&(bar)[XB_TMO])) break; if (_sp > XB_SPIN_CAP) { atomicAdd(&(bar)[XB_TMO], 1u); break; } } } } while (0)

struct XcdBarrier {
    unsigned* bar; unsigned x;
    volatile LAS unsigned* st;
};

__device__ __forceinline__ XcdBarrier xcd_barrier_post(unsigned* bar, volatile LAS unsigned* st) {
    XcdBarrier b; b.bar = bar; b.x = xb_xcc_id(); b.st = st;
    if (threadIdx.x == 0) (void)xb_add(&bar[XB_XCNT(b.x)], 1u);
    return b;
}
__device__ __forceinline__ void xcd_barrier_complete(unsigned* bar, unsigned x, unsigned& nloc, unsigned& nx) {
    const unsigned G = gridDim.x * gridDim.y * gridDim.z;
    unsigned sum, cnt, mine, sp = 0u;
    for (;;) {
        sum = 0u; cnt = 0u; mine = 0u;
#pragma unroll
        for (unsigned j = 0; j < 16; ++j) { const unsigned c = xb_ld(&bar[XB_XCNT(j)]); sum += c; cnt += (c > 0u) ? 1u : 0u; mine = (j == x) ? c : mine; }
        if (sum == G) break;
        __builtin_amdgcn_s_sleep(1);
        if ((++sp & 255u) == 0u) { if (xb_ld(&bar[XB_TMO])) break; if (sp > XB_SPIN_CAP) { atomicAdd(&bar[XB_TMO], 1u); break; } }
    }
    nloc = mine > 0u ? mine : 1u; nx = cnt > 0u ? cnt : 1u;
}

__device__ __forceinline__ void xcd_barrier(const XcdBarrier& b) {
    asm volatile("s_waitcnt vmcnt(0)" ::: "memory");
    __syncthreads();
    if (threadIdx.x == 0) {
        unsigned* bar = b.bar;
        __builtin_amdgcn_s_waitcnt(0);
        unsigned nloc = b.st[0], nx = b.st[1];
        if (nloc == 0u) { xcd_barrier_complete(bar, b.x, nloc, nx); b.st[0] = nloc; b.st[1] = nx; }
        const unsigned old = xb_add(&bar[XB_XSUB(b.x)], 1u);
        const unsigned gen = old / nloc;
        if (old + 1u == (gen + 1u) * nloc) {
            __builtin_amdgcn_fence(__ATOMIC_RELEASE, "agent");
            asm volatile("s_waitcnt vmcnt(0)" ::: "memory");
            const unsigned og = xb_add(&bar[XB_TOP], 1u);
            const unsigned tg = og / nx;
            if (og + 1u == (tg + 1u) * nx) xb_add(&bar[XB_TOPGEN], 1u);
            else XB_SPIN(xb_ld(&bar[XB_TOPGEN]) == tg, bar);
            __builtin_amdgcn_fence(__ATOMIC_ACQUIRE, "agent");
            xb_add(&bar[XB_XGEN(b.x)], 1u);
            asm volatile("s_waitcnt vmcnt(0)" ::: "memory");
        } else {
            XB_SPIN(xb_ld(&bar[XB_XGEN(b.x)]) == gen, bar);
            __builtin_amdgcn_fence(__ATOMIC_ACQUIRE, "agent");
            asm volatile("s_waitcnt vmcnt(0)" ::: "memory");
        }
    }
    __syncthreads();
}

constexpr int NWAVES = 8, RING_BYTES = 131072, LDSCTL_OFF = RING_BYTES, MISC_OFF = LDSCTL_OFF + 320, LDS_BYTES = 147456;
constexpr int CW_BAR = 4096;
#ifndef KMASK
#define KMASK 0xFFFF
#endif
#define KEN(k) (((KMASK) >> (k)) & 1)
#ifndef DUPMASK
#define DUPMASK 0
#endif
#define NREP(k) ((((DUPMASK) >> (k)) & 1) ? 2 : 1)
struct Args { P p; int ph_lo, ph_hi, li, pad; };

struct InprojOrder {
    pg8::StaticOrder so; int G, c, nmain, nextra;
    __device__ void init(int l, int G_, int c_) { so.init(l == 0 ? MT : M_LAT, IN_W, G_, c_); G = G_; c = c_; nmain = so.nwg; nextra = l == 0 ? 0 : 20; }
    __device__ bool next(int i, pg8::Unit& u) const {
        const int L = i * G + c;
        if (L < nmain) return so.next(i, u);
        const int q = L - nmain; if (q >= nextra) return false;
        const int k = q % 5; u.pm = 64 + q / 5; u.pn = k == 0 ? 2 : 8 + k; u.ko = 0; u.pa = u.pm; return true;
    }
    __device__ __forceinline__ void a_ready(const pg8::Unit&) const {}
    __device__ __forceinline__ void done(const pg8::Unit&) const {}
};

__device__ __forceinline__ P load_p() {
    const __attribute__((address_space(4))) P* k = (const __attribute__((address_space(4))) P*)__builtin_amdgcn_kernarg_segment_ptr();
    asm volatile("" : "+s"(k));
    P r;
#pragma unroll
    for (int i = 0; i < 34; ++i) r.in[i] = k->in[i];
    r.out = k->out; r.ws = k->ws; return r;
}
__global__ void __launch_bounds__(NWAVES * 64, 2) mega(Args args) {
    extern __shared__ __attribute__((aligned(16))) unsigned char lds[];
    LAS unsigned char* ldsl = (LAS unsigned char*)lds;
    const int tid = threadIdx.x, lane = tid & 63, wave = __builtin_amdgcn_readfirstlane(tid >> 6);
    const int G = gridDim.x, bx = blockIdx.x, vcu = (G % 8 == 0) ? (bx % 8) * (G / 8) + bx / 8 : bx;
    const int gw = vcu * NWAVES + wave, NGW = G * NWAVES;
    for (int u = tid; u < (LDS_BYTES - LDSCTL_OFF) / 4; u += NWAVES * 64) ((LAS unsigned*)(ldsl + LDSCTL_OFF))[u] = 0u;
    __syncthreads();
    XcdBarrier bar = xcd_barrier_post((unsigned*)(args.p.ws + WS_CTL) + CW_BAR + args.li * XCD_BAR_WORDS, (volatile LAS unsigned*)(ldsl + MISC_OFF) + 8);
    const int lo = args.ph_lo, hi = args.ph_hi;
#define IN(k) (lo <= (k) && (k) < hi)
#define OPQ(x) ({ int t_ = (x); asm volatile("" : "+v"(t_)); t_; })
#define SEAM(k) do { if (IN(k) && IN((k) + 1)) { xcd_barrier(bar); if (NREP(16) == 2) xcd_barrier(bar); } } while (0)

    if (KEN(0) && IN(0)) { const P& p = args.p;
        for (int rep_ = 0; rep_ < NREP(0); ++rep_) {
        for (int it = vcu; it < 192; it += G) ph_mod_item(p, it, (float*)lds, OPQ(tid));
        if (vcu == G - 1) ph_misc(p, tid, NWAVES * 64);
        float* scr = (float*)(lds + wave * 16384);
        if (ALL_MEGA) { for (int j = gw; j < N_PRO; j += NGW) prep_item(p, pro_item(j), scr, OPQ(lane)); }
        else for (int it = gw; it < IT_TOTAL; it += NGW) prep_item(p, it, scr, OPQ(lane));
        __syncthreads(); }
    }
    SEAM(0);

    for (int l = 0; l < 2; ++l) {
        const int pb = l == 0 ? 1 : 10;
        const int nrows = l == 0 ? MT : M_LAT;
        if (KEN(1) && IN(pb)) { const P p = load_p(); for (int rep_ = 0; rep_ < NREP(1); ++rep_) ph_norm(p, l, 0, MT, OPQ(gw), NGW, OPQ(lane)); }
        SEAM(pb);
        if (KEN(2) && IN(pb + 1)) { const P p = load_p(); unsigned char* ws = p.ws;
            pg8::Gemm g{(const bf16*)(ws + WS_H), (const bf16*)(ws + WS_WIN) + (size_t)l * IN_W * D, MT, IN_W, D, D};
            InprojOrder S; S.init(l, G, bx);
            pg8::EpiInproj E{ws, p.in[10] + l * 64, p.in[11] + l * 64, p.in[9] + l * 3072};
            for (int rep_ = 0; rep_ < NREP(2); ++rep_) pg8::gemm_phase<pg8::EpiInproj, InprojOrder, true, true>(ldsl, g, S, E);
            if (ALL_MEGA && l == 0) {
                const int nfull = (MT / 256 * 25) % G; const P& pa = args.p; float* scr = (float*)(lds + wave * 16384);
                const int rank = nfull != 0 ? (int)bx - nfull : (int)bx, nid = nfull != 0 ? G - nfull : G;
                if (rank >= 0) for (int j = rank * NWAVES + wave; j < N_L1; j += nid * NWAVES) prep_item(pa, l1_item(j), scr, OPQ(lane)); }
            if (ALL_MEGA && l == 1) {
                const int nfull = (M_LAT / 256 * 25 + 20) % G;
                if (nfull != 0 && (int)bx >= nfull) { const P& pa = args.p; const int rank = (int)bx - nfull, nid = G - nfull; float* scr = (float*)(lds + wave * 16384);
                    for (int it = IT_DEF1 + rank * NWAVES + wave; it < IT_TOTAL; it += nid * NWAVES) prep_item(pa, it, scr, OPQ(lane)); }
                else if (nfull == 0) { const P& pa = args.p; float* scr = (float*)(lds + wave * 16384);
                    for (int it = IT_DEF1 + (int)bx * NWAVES + wave; it < IT_TOTAL; it += G * NWAVES) prep_item(pa, it, scr, OPQ(lane)); } }
        }
        SEAM(pb + 1);
        if (IN(pb + 2)) { const P p = load_p(); unsigned char* ws = p.ws;
            if (KEN(3)) for (int rep_ = 0; rep_ < NREP(3); ++rep_) for (int t = vcu; t < (l == 0 ? CONV_TILES_ALL : CONV_TILES_LAT); t += G) conv_tile(p, l, t, lds, OPQ(tid));
            __syncthreads();
            if (KEN(4)) for (int rep_ = 0; rep_ < NREP(4); ++rep_) for (int k = 0;; ++k) {
                const int nl = vcu < 512 ? (512 - vcu + G - 1) / G : 0; int u;
                if (k < nl) u = vcu + k * G; else { const int q = (vcu + G - 32 % G) % G + (k - nl) * G; if (l != 0 || q >= 32) break; u = 512 + q; }
                int b, vh, qrow0, krow0, NT;
                if (u < 512) { b = u >> 7; vh = (u >> 4) & 7; qrow0 = b * SEQ + (u & 15) * 256; krow0 = b * NKEY; NT = NKEY / 64; }
                else { const int q = u - 512; b = q >> 3; vh = q & 7; qrow0 = M_LAT + b * CTXL; krow0 = b * NKEY + SEQ; NT = CTXL / 64; }
                const attn_body::bf16* qa_ = (const attn_body::bf16*)(ws + WS_QA) + (size_t)qrow0 * 512 + vh * 64; const attn_body::bf16* ka_ = (const attn_body::bf16*)(ws + WS_KA) + (size_t)krow0 * 128 + (vh >> 2) * 64;
                const attn_body::bf16* va_ = (const attn_body::bf16*)(ws + WS_VA) + (size_t)krow0 * 128 + (vh >> 2) * 64; attn_body::bf16* oa_ = (attn_body::bf16*)(ws + WS_OABC) + (size_t)qrow0 * 1536 + vh * 64;
                const float cref = ((const float*)(ws + WS_LAM))[4 + l];
                if (cref > 0.f) attn_body::attn_unit<8, true>(qa_, 512, ka_, va_, 128, oa_, 1536, NT, (char*)lds, cref);
                else attn_body::attn_unit<8, false>(qa_, 512, ka_, va_, 128, oa_, 1536, NT, (char*)lds);
            }
            if (KEN(4)) for (int rep_ = 0; rep_ < NREP(4); ++rep_) for (int k = 0;; ++k) {
                const int nl = vcu < 256 ? (256 - vcu + G - 1) / G : 0; int su;
                if (k < nl) su = vcu + k * G; else { const int q = (vcu + G - 64 % G) % G + (k - nl) * G; if (l != 0 || q >= 16) break; su = 256 + q; }
                int b, h, qrow0, krow0, NT;
                if (su < 256) { b = su >> 6; h = (su >> 4) & 3; qrow0 = b * SEQ + (su & 15) * 256; krow0 = b * NKEY; NT = NKEY / 64; }
                else { const int q = su - 256; b = q >> 2; h = q & 3; qrow0 = M_LAT + b * CTXL; krow0 = b * NKEY + SEQ; NT = CTXL / 64; }
                {
                    const float lam = ((const float*)(ws + WS_LAM))[l], li = ((const float*)(ws + WS_LAM))[2 + l];
                    const attn_c::bf16* q_ = (const attn_c::bf16*)(ws + WS_QC) + (size_t)qrow0 * 512 + (2 * h) * 64; const attn_c::bf16* k_ = (const attn_c::bf16*)(ws + WS_KC) + (size_t)krow0 * 512 + (2 * h) * 64;
                    const attn_c::bf16* v_ = (const attn_c::bf16*)(ws + WS_VC) + (size_t)krow0 * 512 + h * 128;
                    attn_body::attn_unit_v128<0, 8>(q_, 512, k_, v_, 512, (attn_c::bf16*)nullptr, 0, NT, (char*)lds, 0.f, 0.f, (const float*)nullptr);
                    attn_body::attn_unit_v128<1, 8>(q_ + 64, 512, k_ + 64, v_, 512, (attn_c::bf16*)(ws + WS_OABC) + (size_t)qrow0 * 1536 + 1024 + h * 128, 1536, NT, (char*)lds, lam, 1.f - li, p.in[20] + l * 128); }
            }
        }
        if (IN(pb + 2) && IN(pb + 4)) xcd_barrier(bar);
        if (KEN(6) && IN(pb + 4)) { const P p = load_p(); unsigned char* ws = p.ws;
            pg8::Gemm g{(const bf16*)(ws + WS_OABC), (const bf16*)(ws + WS_WP) + (size_t)l * D * 1536, nrows, D, 1536, 1536};
            pg8::StaticOrder S; S.init(nrows, D, G, bx);
            pg8::EpiMerge E{(const unsigned char*)(ws + WS_G), (bf16*)(ws + WS_MB)};
            for (int rep_ = 0; rep_ < NREP(6); ++rep_) pg8::gemm_phase<pg8::EpiMerge, pg8::StaticOrder, true, true>(ldsl, g, S, E);
            if (ALL_MEGA && l == 0 && (int)bx >= MT / 256 * 4 - G) {
                const P& pa = args.p; const int n2 = MT / 256 * 4 - G, rank = (int)bx - n2, nid = G - n2; float* scr = (float*)(lds + wave * 16384);
                for (int it = IT_EARLY + rank * NWAVES + wave; it < IT_DEF1; it += nid * NWAVES) prep_item(pa, it, scr, OPQ(lane)); }
        }
        SEAM(pb + 4);
        if (KEN(7) && IN(pb + 5)) { const P p = load_p(); unsigned char* ws = p.ws;
            pg8::Gemm g{(const bf16*)(ws + WS_MB), (const bf16*)(ws + WS_WOUT) + (size_t)l * D * D, M_LAT, D, D, D};
            pg8::StaticOrder S; S.init(M_LAT, D, G, bx);
            pg8::EpiResid E{l == 0 ? p.in[0] : (const float*)nullptr, (bf16*)(ws + WS_XB), modv(p, l, 0, 2)};
            pg8::gemm_phase<pg8::EpiResid, pg8::StaticOrder, true, true>(ldsl, g, S, E);
            if (l == 0) {
                pg8::Gemm gt{(const bf16*)(ws + WS_MB), (const bf16*)(ws + WS_WOUT), MT, D, 256, D};
                pg8::CtxSliceOrder St; St.init(4, G, bx);
                pg8::EpiCtxPartial Et{(bf16*)(ws + WS_CPO)};
                pg8::gemm_phase<pg8::EpiCtxPartial, pg8::CtxSliceOrder, true, true>(ldsl, gt, St, Et);
                }
        }
        SEAM(pb + 5);
        if (l == 0) {
            if (KEN(8) && IN(pb + 6)) { const P p = load_p(); for (int rep_ = 0; rep_ < NREP(8); ++rep_) ph_norm(p, l, 1, MT, OPQ(gw), NGW, OPQ(lane)); }
            SEAM(pb + 6);
            if (KEN(9) && IN(pb + 7)) { const P p = load_p(); unsigned char* ws = p.ws;
                pg8::Gemm g{(const bf16*)(ws + WS_H8), (const bf16*)(ws + WS_FFN13), MT, 2 * DFF, D / 2, D / 2, SC_W13, SC_ONE};
                pg8::StaticOrder S; S.init(MT, 2 * DFF, G, bx);
                pg8::EpiSwiglu E{(bf16*)(ws + WS_HMID), DFF, 1 << 20};
                for (int rep_ = 0; rep_ < NREP(9); ++rep_) pg8::gemm_phase<pg8::EpiSwiglu, pg8::StaticOrder, true, true, true>(ldsl, g, S, E);
            }
            SEAM(pb + 7);
            if (KEN(10) && IN(pb + 8)) { const P p = load_p(); unsigned char* ws = p.ws;
                pg8::Gemm g{(const bf16*)(ws + WS_HMID), (const bf16*)(ws + WS_FFN2), M_LAT, D, DFF, DFF};
                pg8::StaticOrder S; S.init(M_LAT, D, G, bx);
                pg8::EpiResid E{(const float*)nullptr, (bf16*)(ws + WS_XB), modv(p, 0, 0, 5)};
                pg8::gemm_phase<pg8::EpiResid, pg8::StaticOrder, true, true>(ldsl, g, S, E);
                {
                    pg8::Gemm gt{(const bf16*)(ws + WS_HMID), (const bf16*)(ws + WS_FFN2), MT, D, 256, DFF};
                    pg8::CtxSliceOrder St; St.init(11, G, bx);
                    pg8::EpiCtxPartial Et{(bf16*)(ws + WS_CPF)};
                    pg8::gemm_phase<pg8::EpiCtxPartial, pg8::CtxSliceOrder, true, true>(ldsl, gt, St, Et);
                    }
            }
            SEAM(pb + 8);
        } else {
            if (KEN(11) && IN(pb + 6)) { const P p = load_p(); ph_router(p, vcu, G, NWAVES, lds, OPQ(tid)); }
            if (IN(pb + 6) && IN(pb + 8)) xcd_barrier(bar);
            if (KEN(13) && IN(pb + 8)) { const P p = load_p(); unsigned char* ws = p.ws;
                int base[9]; moe_bases(p, base);
                pg8::Gemm g{(const bf16*)(ws + WS_H2PX), (const bf16*)(ws + WS_MOE13), base[8], 8 * 2 * DFFX, D / 2, D / 2, SC_W13, SC_ONE, 1};
                pg8::MoeOrder S; S.init(base, 28, G, bx);
                pg8::EpiSwigluF8 E{(unsigned char*)(ws + WS_HMX), DFFX, 28};
                for (int rep_ = 0; rep_ < NREP(13); ++rep_) pg8::gemm_phase<pg8::EpiSwigluF8, pg8::MoeOrder, true, true, true>(ldsl, g, S, E);
            }
            SEAM(pb + 8);
            if (KEN(14) && IN(pb + 9)) { const P p = load_p(); unsigned char* ws = p.ws;
                int base[9]; moe_bases(p, base);
                pg8::Gemm g{(const bf16*)(ws + WS_HMX), (const bf16*)(ws + WS_MOE2), base[8], 8 * D, DFFX / 2, DFFX / 2, SC_W2, SC_HM};
                pg8::MoeOrder S; S.init(base, 4, G, bx, 128);
                pg8::EpiMoeDown E{(bf16*)(ws + WS_H2P), (const float*)(ws + WS_EXPP)};
                for (int rep_ = 0; rep_ < NREP(14); ++rep_) pg8::gemm_phase<pg8::EpiMoeDown, pg8::MoeOrder, true, true, true>(ldsl, g, S, E);
                {
                    pg8::Gemm gt{(const bf16*)(ws + WS_HMX), (const bf16*)(ws + WS_MOE2), base[8], 8 * D, 256, DFFX / 2, SC_W2, SC_HM};
                    pg8::MoeTailOrder St; St.init(base, G, bx);
                    pg8::EpiMoeDownTail Et{(bf16*)(ws + WS_YPT), (const float*)(ws + WS_EXPP)};
                    pg8::gemm_phase<pg8::EpiMoeDownTail, pg8::MoeTailOrder, true, true, true>(ldsl, gt, St, Et); }
            }
            SEAM(pb + 9);
            if (KEN(15) && IN(pb + 10)) { const P p = load_p(); ph_final(p, OPQ(gw), NGW, OPQ(lane)); }
        }
    }
#undef IN
#undef SEAM
}
constexpr int N_PHASES = 21;

#if !ALL_MEGA
__global__ void __launch_bounds__(256) k_prep(P p) {
    __shared__ float scr[4][64 * 33];
    const int wave = threadIdx.x >> 6, lane = threadIdx.x & 63;
    for (int it = blockIdx.x * 4 + wave; it < IT_TOTAL; it += gridDim.x * 4) prep_item(p, it, scr[wave], lane);
}
__global__ void __launch_bounds__(512) k_mod(P p) { __shared__ float sm[8 * 5 * 64 + 5 * 1024]; for (int it = blockIdx.x; it < 192; it += gridDim.x) ph_mod_item(p, it, sm, threadIdx.x); if (blockIdx.x == 0) ph_misc(p, threadIdx.x, 512); }
__global__ void __launch_bounds__(256) k_norm(P p, int l, int which, int nrows) { ph_norm(p, l, which, nrows, blockIdx.x * 4 + (threadIdx.x >> 6), gridDim.x * 4, threadIdx.x & 63); }
__global__ void __launch_bounds__(256) k_router(P p) { __shared__ __attribute__((aligned(16))) unsigned char sm[4096 + 65536 - 4096]; ph_router(p, blockIdx.x, gridDim.x, 4, sm, threadIdx.x); }
__global__ void __launch_bounds__(256) k_final(P p) { ph_final(p, blockIdx.x * 4 + (threadIdx.x >> 6), gridDim.x * 4, threadIdx.x & 63); }
__global__ void __launch_bounds__(256) k_occomb(P p, int l, int nrows) { ph_occomb(p, l, nrows, blockIdx.x * 4 + (threadIdx.x >> 6), gridDim.x * 4, threadIdx.x & 63); }
__global__ void __launch_bounds__(512, 2) k_conv(P p, int l, int ntiles) { extern __shared__ __attribute__((aligned(16))) unsigned char sm[]; for (int t = blockIdx.x; t < ntiles; t += gridDim.x) { int tid = threadIdx.x; asm volatile("" : "+v"(tid)); conv_tile(p, l, t, sm, tid); } }
__global__ void __launch_bounds__(256) k_attn(P p, int typeC) {
    __shared__ float Ks[32][64], Vs[32][64];
    const int qb = blockIdx.x, vh = blockIdx.y, tid = threadIdx.x;
    const bf16 *Q, *K, *V; bf16* O; int qp, kp, op;
    if (!typeC) { Q = (const bf16*)(p.ws + WS_QA) + vh * 64; qp = 512; K = (const bf16*)(p.ws + WS_KA) + (vh / 4) * 64; V = (const bf16*)(p.ws + WS_VA) + (vh / 4) * 64; kp = 128; O = (bf16*)(p.ws + WS_OABC) + vh * 64; op = 1536; }
    else { Q = (const bf16*)(p.ws + WS_QC) + (vh >> 1) * 64; qp = 512; K = (const bf16*)(p.ws + WS_KC) + (vh >> 1) * 64; V = (const bf16*)(p.ws + WS_VC) + (vh >> 2) * 128 + (vh & 1) * 64; kp = 512; O = (bf16*)(p.ws + WS_OCR) + vh * 64; op = 1024; }
    int k0, nk; if (qb < 64) { k0 = (qb / 16) * NKEY; nk = NKEY; } else { k0 = (qb - 64) * NKEY + SEQ; nk = CTXL; }
    const int row = qb * 256 + tid;
    float q[64], o[64];
#pragma unroll
    for (int d = 0; d < 64; ++d) { q[d] = bf2f(Q[(size_t)row * qp + d]); o[d] = 0.f; }
    float m = -INFINITY, lsum = 0.f;
    for (int kt = 0; kt < nk; kt += 32) {
        __syncthreads();
        for (int i = tid; i < 32 * 64; i += 256) { const int kk = i >> 6, d = i & 63; Ks[kk][d] = bf2f(K[(size_t)(k0 + kt + kk) * kp + d]); Vs[kk][d] = bf2f(V[(size_t)(k0 + kt + kk) * kp + d]); }
        __syncthreads();
        float s[32]; float mx = m;
#pragma unroll
        for (int j = 0; j < 32; ++j) { float a = 0.f;
#pragma unroll
            for (int d = 0; d < 64; ++d) a += q[d] * Ks[j][d];
            s[j] = a; mx = fmaxf(mx, a); }
        const float alpha = exp2f(m - mx); m = mx; lsum *= alpha;
#pragma unroll
        for (int d = 0; d < 64; ++d) o[d] *= alpha;
#pragma unroll
        for (int j = 0; j < 32; ++j) { const float pj = exp2f(s[j] - m); lsum += pj;
#pragma unroll
            for (int d = 0; d < 64; ++d) o[d] += pj * Vs[j][d]; }
    }
    const float rl = 1.f / lsum;
#pragma unroll
    for (int d = 0; d < 64; d += 2) *(unsigned*)(O + (size_t)row * op + d) = pk2(o[d] * rl, o[d + 1] * rl);
}

struct TileCtx { float (*C)[257]; int rt64, pn, tid; };
template <class Epi> __global__ void __launch_bounds__(256) k_gemm(P p, Epi E, const bf16* A, int lda, const bf16* Bt, int ldb, int K) {
    extern __shared__ __attribute__((aligned(16))) float smem_g[];
    float (*As)[64] = (float (*)[64])smem_g;
    float (*Bs)[256] = (float (*)[256])(smem_g + 32 * 64);
    float (*Ct)[257] = (float (*)[257])(smem_g + 32 * 64 + 32 * 256);
    const int tid = threadIdx.x, tx = tid & 31, ty = tid >> 5, rt64 = blockIdx.x, pn = blockIdx.y;
    int bt; if (!E.map(p, rt64, pn, bt)) return;
    const bf16* Ab = A + (size_t)rt64 * 64 * lda; const bf16* Bb = Bt + (size_t)bt * 256 * ldb;
    float acc[8][8];
#pragma unroll
    for (int i = 0; i < 8; ++i)
#pragma unroll
        for (int j = 0; j < 8; ++j) acc[i][j] = 0.f;
    for (int k0 = 0; k0 < K; k0 += 32) {
        if (Epi::MIDK && (k0 == 512 || k0 == 1024)) E.mid(p, acc, rt64 * 64 + ty * 8, pn, tx, k0 / 512);
        __syncthreads();
        { const int r = tid >> 2, kq = (tid & 3) * 8; const u32x4 v = *(const u32x4*)(Ab + (size_t)r * lda + k0 + kq);
            As[kq + 0][r] = __uint_as_float(v.x << 16); As[kq + 1][r] = __uint_as_float(v.x & 0xffff0000u); As[kq + 2][r] = __uint_as_float(v.y << 16); As[kq + 3][r] = __uint_as_float(v.y & 0xffff0000u);
            As[kq + 4][r] = __uint_as_float(v.z << 16); As[kq + 5][r] = __uint_as_float(v.z & 0xffff0000u); As[kq + 6][r] = __uint_as_float(v.w << 16); As[kq + 7][r] = __uint_as_float(v.w & 0xffff0000u); }
#pragma unroll
        for (int q4 = 0; q4 < 4; ++q4) { const u32x4 v = *(const u32x4*)(Bb + (size_t)tid * ldb + k0 + q4 * 8); const int kq = q4 * 8;
            Bs[kq + 0][tid] = __uint_as_float(v.x << 16); Bs[kq + 1][tid] = __uint_as_float(v.x & 0xffff0000u); Bs[kq + 2][tid] = __uint_as_float(v.y << 16); Bs[kq + 3][tid] = __uint_as_float(v.y & 0xffff0000u);
            Bs[kq + 4][tid] = __uint_as_float(v.z << 16); Bs[kq + 5][tid] = __uint_as_float(v.z & 0xffff0000u); Bs[kq + 6][tid] = __uint_as_float(v.w << 16); Bs[kq + 7][tid] = __uint_as_float(v.w & 0xffff0000u); }
        __syncthreads();
#pragma unroll 4
        for (int k = 0; k < 32; ++k) { float a[8], b[8];
#pragma unroll
            for (int i = 0; i < 8; ++i) a[i] = As[k][ty * 8 + i];
#pragma unroll
            for (int j = 0; j < 8; ++j) b[j] = Bs[k][tx + 32 * j];
#pragma unroll
            for (int i = 0; i < 8; ++i)
#pragma unroll
                for (int j = 0; j < 8; ++j) acc[i][j] += a[i] * b[j]; }
    }
    if (Epi::MIDK) E.mid(p, acc, rt64 * 64 + ty * 8, pn, tx, 3);
#pragma unroll
    for (int i = 0; i < 8; ++i)
#pragma unroll
        for (int j = 0; j < 8; ++j) Ct[ty * 8 + i][tx + 32 * j] = acc[i][j];
    __syncthreads();
    TileCtx c{Ct, rt64, pn, tid};
    E.tile(p, c);
}
struct NInproj {
    static constexpr bool MIDK = false; int l;
    __device__ bool map(const P&, int, int pn, int& bt) const { bt = pn; return true; }
    __device__ void mid(const P&, float (&)[8][8], int, int, int, int) const {}
    __device__ void tile(const P& p, const TileCtx& t) const {
        const int c = t.tid, pn = t.pn, bj = c >> 7, hh = (c >> 5) & 3, j32 = c & 31, d = 32 * bj + j32, f = j32 & 15, nh = (j32 >> 4) & 1;
        const float* cosT = (const float*)(p.ws + WS_ROPE); const float* sinT = cosT + 1024;
        for (int r = 0; r < 64; ++r) {
            const int row = t.rt64 * 64 + r; const float v = t.C[r][c];
            if (pn < 3 || (pn >= 7 && pn < 11)) {
                const bool isq = pn < 2 || (pn >= 7 && pn < 9), isA = pn < 3, isv = (pn == 2 && hh >= 2);
                float x = v, xp = t.C[r][c ^ 16];
                if (isA && !isv) { float ss = 0.f;
                    for (int dd = 0; dd < 64; ++dd) { const float u = t.C[r][128 * (dd >> 5) + 32 * hh + (dd & 31)]; ss += u * u; }
                    const float rinv = 1.f / sqrtf(ss * (1.f / 64.f) + EPS); const float* g = p.in[isq ? 10 : 11] + l * 64;
                    x = x * rinv * g[d]; xp = xp * rinv * g[d ^ 16]; }
                float o = x;
                if (!isv && row < M_LAT) { const int tpos = row % SEQ, pos = bj ? (tpos % 64) : (tpos / 64); const float cs = cosT[pos * 16 + f], sn = sinT[pos * 16 + f];
                    o = nh ? (x * cs + xp * sn) : (x * cs - xp * sn); }
                if (isq) o *= C2;
                bf16* dst;
                if (pn < 2) dst = (bf16*)(p.ws + WS_QA) + (size_t)row * 512 + (4 * pn + hh) * 64 + d;
                else if (pn == 2) dst = (bf16*)(p.ws + (hh < 2 ? WS_KA : WS_VA)) + (size_t)keyrow(row) * 128 + (hh & 1) * 64 + d;
                else if (pn < 9) dst = (bf16*)(p.ws + WS_QC) + (size_t)row * 512 + (4 * (pn - 7) + hh) * 64 + d;
                else dst = (bf16*)(p.ws + WS_KC) + (size_t)keyrow(row) * 512 + (4 * (pn - 9) + hh) * 64 + d;
                *dst = (bf16)f2bf(o);
            } else if (pn < 7) {
                if (c < 128) { const float gt = t.C[r][c + 128]; ((bf16*)(p.ws + WS_Y))[(size_t)row * 512 + (pn - 3) * 128 + pcol(c)] = (bf16)f2bf(v * sigmoidf_(gt)); }
            } else if (pn < 13) {
                ((bf16*)(p.ws + WS_VC))[(size_t)keyrow(row) * 512 + (pn - 11) * 256 + pcol(c)] = (bf16)f2bf(v);
            } else {
                const int gc = (pn - 13) * 256 + pcol(c);
                ((bf16*)(p.ws + WS_G))[(size_t)row * 3072 + gc] = (bf16)f2bf(sigmoidf_(v + p.in[9][l * 3072 + gc]));
            }
        }
    }
};
struct NMerge {
    static constexpr bool MIDK = true; int pad_;
    __device__ bool map(const P&, int, int pn, int& bt) const { bt = pn; return true; }
    __device__ void mid(const P& p, float (&acc)[8][8], int row0, int pn, int tx, int seg  ) const {
        const bf16* G = (const bf16*)(p.ws + WS_G);
#pragma unroll
        for (int i = 0; i < 8; ++i)
#pragma unroll
            for (int j = 0; j < 8; ++j) { const int col = pn * 256 + pcol(tx + 32 * j); const size_t o = (size_t)(row0 + i) * 3072 + col;
                const float f = seg == 3 ? bf2f(G[o + 2048]) : bf2f(G[o + (seg - 1) * 1024]) / bf2f(G[o + seg * 1024]); acc[i][j] *= f; }
    }
    __device__ void tile(const P& p, const TileCtx& t) const {
        for (int r = 0; r < 64; ++r) ((bf16*)(p.ws + WS_MB))[(size_t)(t.rt64 * 64 + r) * D + t.pn * 256 + pcol(t.tid)] = (bf16)f2bf(t.C[r][t.tid]);
    }
};
struct NResid {
    static constexpr bool MIDK = false; int l, gj  , first  ;
    __device__ bool map(const P&, int, int pn, int& bt) const { bt = pn; return true; }
    __device__ void mid(const P&, float (&)[8][8], int, int, int, int) const {}
    __device__ void tile(const P& p, const TileCtx& t) const {
        for (int r = 0; r < 64; ++r) { const int row = t.rt64 * 64 + r, col = t.pn * 256 + t.tid;
            const float b = first ? x0_row(p, row)[col] : xs_row(p, row)[col];
            xs_row(p, row)[col] = b + modv(p, l, bidx(row), gj)[col] * t.C[r][t.tid]; }
    }
};
struct NSwiglu {
    static constexpr bool MIDK = false; int moe;
    __device__ bool map(const P& p, int rt64, int pn, int& bt) const {
        if (!moe) { bt = pn; return true; }
        int base[9]; moe_bases(p, base); if (rt64 * 64 >= base[8]) return false;
        int e = 0;
#pragma unroll
        for (int q = 1; q < 8; ++q) if (rt64 * 64 >= base[q]) e = q;
        bt = e * 28 + pn; return true;
    }
    __device__ void mid(const P&, float (&)[8][8], int, int, int, int) const {}
    __device__ void tile(const P& p, const TileCtx& t) const {
        if (t.tid >= 128) return;
        bf16* O = (bf16*)(p.ws + (moe ? WS_HMX : WS_HMID)); const int ld = moe ? DFFX : DFF;
        for (int r = 0; r < 64; ++r) O[(size_t)(t.rt64 * 64 + r) * ld + t.pn * 128 + pcol(t.tid)] = (bf16)f2bf(siluf_(t.C[r][t.tid]) * t.C[r][t.tid + 128]);
    }
};
struct NMoeDown {
    static constexpr bool MIDK = false; int pad_;
    __device__ bool map(const P& p, int rt64, int pn, int& bt) const {
        int base[9]; moe_bases(p, base); if (rt64 * 64 >= base[8]) return false;
        int e = 0;
#pragma unroll
        for (int q = 1; q < 8; ++q) if (rt64 * 64 >= base[q]) e = q;
        bt = e * 4 + pn; return true;
    }
    __device__ void mid(const P&, float (&)[8][8], int, int, int, int) const {}
    __device__ void tile(const P& p, const TileCtx& t) const {
        for (int r = 0; r < 64; ++r) { const int row = t.rt64 * 64 + r;
            ((bf16*)(p.ws + WS_H2P))[(size_t)row * D + t.pn * 256 + pcol(t.tid)] = (bf16)f2bf(((const float*)(p.ws + WS_ROWP))[row] * t.C[r][t.tid]); }
    }
};


#endif

constexpr int GEMM_LDS = (32 * 64 + 32 * 256 + 64 * 257) * 4;
constexpr int CONV_LDS = CONV_LDS_BYTES;
#if !ALL_MEGA
static void launch_naive_phase(const P& p, int ph, hipStream_t stream) {
    unsigned char* ws = p.ws;
    if (ph == 0) { k_prep<<<1024, 256, 0, stream>>>(p); k_mod<<<192, 512, 0, stream>>>(p); return; }
    const int l = ph >= 10 ? 1 : 0, k = ph - (l ? 10 : 1), nrows = l == 0 ? MT : M_LAT;
    switch (k) {
    case 0: k_norm<<<1024, 256, 0, stream>>>(p, l, 0, MT); break;
    case 1: k_gemm<NInproj><<<dim3(MT / 64, 25), 256, GEMM_LDS, stream>>>(p, NInproj{l}, (const bf16*)(ws + WS_H), D, (const bf16*)(ws + WS_WIN) + (size_t)l * IN_W * D, D, D); break;
    case 2: k_conv<<<320, 512, CONV_LDS, stream>>>(p, l, l == 0 ? CONV_TILES_ALL : CONV_TILES_LAT);
            k_attn<<<dim3(nrows / 256, 8), 256, 0, stream>>>(p, 0); k_attn<<<dim3(nrows / 256, 16), 256, 0, stream>>>(p, 1); break;
    case 3: k_occomb<<<1024, 256, 0, stream>>>(p, l, nrows); break;
    case 4: k_gemm<NMerge><<<dim3(nrows / 64, 4), 256, GEMM_LDS, stream>>>(p, NMerge{0}, (const bf16*)(ws + WS_OABC), 1536, (const bf16*)(ws + WS_WP) + (size_t)l * D * 1536, 1536, 1536); break;
    case 5: k_gemm<NResid><<<dim3(nrows / 64, 4), 256, GEMM_LDS, stream>>>(p, NResid{l, 2, l == 0}, (const bf16*)(ws + WS_MB), D, (const bf16*)(ws + WS_WOUT) + (size_t)l * D * D, D, D); break;
    case 6: if (l == 0) k_norm<<<1024, 256, 0, stream>>>(p, l, 1, MT); else k_router<<<1024, 256, 0, stream>>>(p); break;
    case 7: if (l == 0) k_gemm<NSwiglu><<<dim3(MT / 64, 22), 256, GEMM_LDS, stream>>>(p, NSwiglu{0}, (const bf16*)(ws + WS_H), D, (const bf16*)(ws + WS_FFN13), D, D);
            break;
    case 8: if (l == 0) k_gemm<NResid><<<dim3(MT / 64, 4), 256, GEMM_LDS, stream>>>(p, NResid{l, 5, 0}, (const bf16*)(ws + WS_HMID), DFF, (const bf16*)(ws + WS_FFN2), DFF, DFF);
            else k_gemm<NSwiglu><<<dim3(RMAX / 64, 28), 256, GEMM_LDS, stream>>>(p, NSwiglu{1}, (const bf16*)(ws + WS_H2P), D, (const bf16*)(ws + WS_MOE13), D, D); break;
    case 9: k_gemm<NMoeDown><<<dim3(RMAX / 64, 4), 256, GEMM_LDS, stream>>>(p, NMoeDown{0}, (const bf16*)(ws + WS_HMX), DFFX, (const bf16*)(ws + WS_MOE2), DFFX, DFFX); break;
    case 10: k_final<<<1024, 256, 0, stream>>>(p); break;
    }
}
#endif
extern "C" void kernel_launch(void* const* d_in, const int* in_sizes, int n_in, void* d_out, int out_size, void* d_ws, size_t ws_size, hipStream_t stream) {
    static int grid = 0;
    if (grid == 0) {
        if (n_in != 34 || out_size != M_LAT * D || ws_size < WS_END2) { fprintf(stderr, "kernel_launch: unexpected shapes (n_in %d out %d ws %zu need %zu)\n", n_in, out_size, ws_size, (size_t)WS_END2); grid = -1; return; }
        int dev = 0, cus = 0, per_cu = 0;
        if (hipGetDevice(&dev) != hipSuccess || hipDeviceGetAttribute(&cus, hipDeviceAttributeMultiprocessorCount, dev) != hipSuccess) { grid = -1; return; }
        if (hipFuncSetAttribute((const void*)mega, hipFuncAttributeMaxDynamicSharedMemorySize, LDS_BYTES) != hipSuccess) { fprintf(stderr, "kernel_launch: hipFuncSetAttribute failed\n"); grid = -1; return; }
#if !ALL_MEGA
        (void)hipFuncSetAttribute((const void*)k_gemm<NInproj>, hipFuncAttributeMaxDynamicSharedMemorySize, GEMM_LDS);
        (void)hipFuncSetAttribute((const void*)k_gemm<NMerge>, hipFuncAttributeMaxDynamicSharedMemorySize, GEMM_LDS);
        (void)hipFuncSetAttribute((const void*)k_gemm<NResid>, hipFuncAttributeMaxDynamicSharedMemorySize, GEMM_LDS);
        (void)hipFuncSetAttribute((const void*)k_gemm<NSwiglu>, hipFuncAttributeMaxDynamicSharedMemorySize, GEMM_LDS);
        (void)hipFuncSetAttribute((const void*)k_gemm<NMoeDown>, hipFuncAttributeMaxDynamicSharedMemorySize, GEMM_LDS);
        (void)hipFuncSetAttribute((const void*)k_conv, hipFuncAttributeMaxDynamicSharedMemorySize, CONV_LDS);
#endif
        if (hipOccupancyMaxActiveBlocksPerMultiprocessor(&per_cu, (const void*)mega, NWAVES * 64, LDS_BYTES) != hipSuccess || per_cu < 1) fprintf(stderr, "kernel_launch: occupancy query says %d\n", per_cu);
        (void)hipGetLastError();
        grid = cus;
    }
    if (grid < 0) return;
    P p{};
    for (int i = 0; i < 34; ++i) p.in[i] = (const float*)d_in[i];
    p.out = (float*)d_out; p.ws = (unsigned char*)d_ws;
    (void)hipMemsetAsync((char*)d_ws + WS_CTL, 0, CTL_ZERO_BYTES, stream);
    const unsigned mask = MEGA_MASK;
    int li = 0;
    for (int ph = 0; ph < N_PHASES;) {
        if ((mask >> ph) & 1u) { int hi = ph; while (hi < N_PHASES && ((mask >> hi) & 1u)) ++hi;
#if !ALL_MEGA && defined(DBG_INPROJ)
            if (ph == 2) launch_naive_phase(p, 2, stream);
#endif
            Args a{}; a.p = p; a.ph_lo = ph; a.ph_hi = hi; a.li = li++; a.pad = 0;
            hipLaunchKernelGGL(mega, dim3(grid), dim3(NWAVES * 64), LDS_BYTES, stream, a);
            ph = hi; }
#if !ALL_MEGA
        else { launch_naive_phase(p, ph, stream); ++ph; }
#else
        else ++ph;
#endif
    }
}
```

```cpp
#include <hip/hip_runtime.h>
#include <cstdint>
#include <cstdio>


#ifndef MEGA_MASK
#define MEGA_MASK 0x1FFFFF
#endif
#define ALL_MEGA ((MEGA_MASK) == 0x1FFFFF)
typedef unsigned short bf16;
typedef float f32x4 __attribute__((ext_vector_type(4)));
typedef unsigned u32x4 __attribute__((ext_vector_type(4)));
typedef unsigned u32x2 __attribute__((ext_vector_type(2)));

constexpr int D = 1024, NB = 4, SEQ = 4096, CTXL = 256;
constexpr int M_LAT = NB * SEQ, M_CTX = NB * CTXL, MT = M_LAT + M_CTX;
constexpr int NKEY = SEQ + CTXL;
constexpr int IN_W = 6400;
constexpr int DFF = 2816, DFFX = 3584, NEXP = 8;
constexpr int RMAX = 34816;
constexpr float EPS = 1e-6f;
constexpr float C2 = 0.125f * 1.4426950408889634f;

constexpr size_t MiB = 1u << 20;
constexpr size_t WS_CTL = 0, CTL_ZERO_BYTES = 1 * MiB;
constexpr size_t WS_MODV = 1 * MiB;
constexpr size_t WS_ROPE = WS_MODV + 256 * 1024;
constexpr size_t WS_LAM = WS_ROPE + 16 * 1024;
constexpr size_t WS_TOKE = 2 * MiB;
constexpr size_t WS_TOKS = WS_TOKE + 128 * 1024;
constexpr size_t WS_TOKP = WS_TOKS + 128 * 1024;
constexpr size_t WS_EXPP = 3 * MiB;
constexpr size_t WS_XSC = 4 * MiB;
constexpr size_t WS_MOE13 = 8 * MiB;
constexpr size_t WS_XB = 64 * MiB;
constexpr size_t WS_CPF = 96 * MiB;
constexpr size_t WS_CPO = 148 * MiB;
constexpr size_t WS_WIN8 = 156 * MiB;
constexpr size_t WS_MOE2 = 120 * MiB;
constexpr size_t WS_A2 = 176 * MiB;
constexpr size_t WS_WIN = WS_A2;
constexpr size_t WS_WP = WS_WIN + 2 * (size_t)IN_W * D * 2;
constexpr size_t WS_WOUT = WS_WP + 2 * (size_t)D * 1536 * 2;
constexpr size_t WS_FFN13 = WS_WOUT + 2 * (size_t)D * D * 2;
constexpr size_t WS_FFN2 = WS_FFN13 + (size_t)2 * DFF * D * 2;
constexpr size_t WS_U = 228 * MiB;
static_assert(WS_FFN2 + (size_t)D * DFF * 2 <= WS_U, "A2");
static_assert(WS_WIN8 + (size_t)2 * 3072 * 1024 <= WS_A2, "WIN8");
static_assert(WS_MOE13 + (size_t)8 * 7168 * 1024 <= WS_XB && WS_XB + (size_t)M_LAT * D * 2 <= WS_CPF && WS_CPF + (size_t)11 * 1024 * 1024 * 2 <= WS_MOE2 && WS_MOE2 + (size_t)8 * 1024 * 3584 <= WS_CPO && WS_CPO + (size_t)4 * 1024 * 1024 * 2 <= WS_A2, "XB / ctx partials");
constexpr size_t WS_QA = WS_U;
constexpr size_t WS_KA = WS_QA + (size_t)MT * 512 * 2;
constexpr size_t WS_VA = WS_KA + (size_t)MT * 128 * 2;
constexpr size_t WS_Y = WS_VA + (size_t)MT * 128 * 2;
constexpr size_t WS_QC = WS_Y + (size_t)MT * 512 * 2;
constexpr size_t WS_KC = WS_QC + (size_t)MT * 512 * 2;
constexpr size_t WS_VC = WS_KC + (size_t)MT * 512 * 2;
constexpr size_t WS_G = WS_VC + (size_t)MT * 512 * 2;
constexpr size_t WS_OABC = WS_G + (size_t)MT * 3072 * 2;
constexpr size_t WS_H = WS_OABC;
constexpr size_t WS_H8 = WS_H + (size_t)MT * D * 2;
constexpr size_t WS_OCR = WS_OABC + (size_t)MT * 1536 * 2;
constexpr size_t WS_MB = WS_OCR;
constexpr size_t WS_END = WS_OCR + (size_t)MT * 1024 * 2;
constexpr size_t WS_HMID = WS_U;
static_assert(WS_HMID + (size_t)MT * DFF * 2 <= WS_G, "HMID overlay");
constexpr size_t WS_H2P = WS_A2;
constexpr size_t WS_HMX = WS_H2P + (size_t)RMAX * D * 2;
constexpr size_t WS_H2PX = WS_HMX + (size_t)RMAX * DFFX;
constexpr size_t WS_YPT = WS_H2PX + (size_t)8 * 16384 * D;
constexpr size_t WS_END2 = WS_YPT + (size_t)7 * 2048 * 1024 * 2;
static_assert(WS_HMX + (size_t)RMAX * DFFX * 2 <= WS_END2 && WS_END2 <= 582000000, "HMX overlay");
static_assert(WS_H2P + (size_t)RMAX * D * 2 <= WS_H, "H2P must not overlap H");

constexpr int CW_CNT = 64;

__device__ __forceinline__ float bf2f(bf16 v) { return __uint_as_float(((unsigned)v) << 16); }
__device__ __forceinline__ unsigned f2bf(float f) { unsigned u = __float_as_uint(f); return (u + 0x7fffu + ((u >> 16) & 1u)) >> 16; }
typedef float f32x2_pk __attribute__((ext_vector_type(2))); typedef __bf16 bf16x2_pk __attribute__((ext_vector_type(2)));
__device__ __forceinline__ unsigned pk2(float lo, float hi) { f32x2_pk v = {lo, hi}; bf16x2_pk b = __builtin_convertvector(v, bf16x2_pk); return __builtin_bit_cast(unsigned, b); }
__device__ __forceinline__ float sigmoidf_(float x) { return 1.f / (1.f + __expf(-x)); }
__device__ __forceinline__ float siluf_(float x) { return x * __builtin_amdgcn_rcpf(1.f + __expf(-x)); }
__device__ __forceinline__ float rsq_(float x) { return __builtin_amdgcn_rsqf(x); }
template <int CTRL> __device__ __forceinline__ float dpp_mov(float v) { return __builtin_bit_cast(float, __builtin_amdgcn_update_dpp(0, __builtin_bit_cast(int, v), CTRL, 0xf, 0xf, true)); }
__device__ __forceinline__ float xsum_row16(float v) {
    v += dpp_mov<0xB1>(v); v += dpp_mov<0x4E>(v); v += dpp_mov<0x141>(v); v += dpp_mov<0x140>(v); return v; }
__device__ __forceinline__ float xsum_x16(float v) { const auto rr = __builtin_amdgcn_permlane16_swap(__float_as_uint(v), __float_as_uint(v), false, false); return __uint_as_float(rr[0]) + __uint_as_float(rr[1]); }
__device__ __forceinline__ float xsum_x32(float v) { const auto rr = __builtin_amdgcn_permlane32_swap(__float_as_uint(v), __float_as_uint(v), false, false); return __uint_as_float(rr[0]) + __uint_as_float(rr[1]); }
__device__ __forceinline__ float wave_sum(float v) { return xsum_x32(xsum_x16(xsum_row16(v))); }
__host__ __device__ __forceinline__ int pcol5(int j) { return 8 * ((j >> 2) & 3) + 4 * ((j >> 4) & 1) + (j & 3); }
__host__ __device__ __forceinline__ int pcol(int c) { return (c & ~31) | pcol5(c & 31); }
__device__ __forceinline__ int keyrow(int r) { return r < M_LAT ? (r / SEQ) * NKEY + (r % SEQ) : ((r - M_LAT) / CTXL) * NKEY + SEQ + ((r - M_LAT) % CTXL); }
__device__ __forceinline__ int bidx(int r) { return r < M_LAT ? r / SEQ : 4; }

struct P {
    const float* in[34];
    float* out;
    unsigned char* ws;
};
__device__ __forceinline__ const float* modv(const P& p, int l, int bi, int j) { return (const float*)(p.ws + WS_MODV) + ((size_t)(l * 5 + bi) * 6 + j) * D; }
__device__ __forceinline__ float* xs_row(const P& p, int r) { return r < M_LAT ? p.out + (size_t)r * D : (float*)(p.ws + WS_XSC) + (size_t)(r - M_LAT) * D; }
__device__ __forceinline__ f32x4 ld_bf4(const bf16* q) { const u32x2 a = *(const u32x2*)q; return (f32x4){__uint_as_float(a.x << 16), __uint_as_float(a.x & 0xffff0000u), __uint_as_float(a.y << 16), __uint_as_float(a.y & 0xffff0000u)}; }
__device__ __forceinline__ const float* x0_row(const P& p, int r) { return r < M_LAT ? p.in[0] + (size_t)r * D : p.in[2] + (size_t)(r - M_LAT) * D; }

__host__ __device__ __forceinline__ int win_src_col(int np) {
    const int pn = np >> 8, c = np & 255, bj = c >> 7, hh = (c >> 5) & 3, j32 = c & 31, d = 32 * bj + j32;
    if (pn < 2) return (4 * pn + hh) * 64 + d;
    if (pn == 2) return hh < 2 ? 512 + hh * 64 + d : 640 + (hh - 2) * 64 + d;
    if (pn < 7) { const int ch = (pn - 3) * 128 + pcol(c & 127); return 768 + (bj ? 512 : 0) + ch; }
    if (pn < 9) return 1792 + (4 * (pn - 7) + hh) * 64 + d;
    if (pn < 11) return 2304 + (4 * (pn - 9) + hh) * 64 + d;
    if (pn < 13) return 2816 + (pn - 11) * 256 + pcol(c);
    return 3328 + (pn - 13) * 256 + pcol(c);
}
__device__ __forceinline__ void xpose_block(const float* src, int ldn, int k0, int scol, bf16* dst, int ldk, float* scr, int lane) {
    float ld_[32];
#pragma unroll
    for (int i = 0; i < 32; ++i) ld_[i] = src[(size_t)(k0 + 2 * i + (lane >> 5)) * ldn + scol];
#pragma unroll
    for (int i = 0; i < 32; ++i) scr[(2 * i + (lane >> 5)) * 33 + (lane & 31)] = ld_[i];
    asm volatile("s_waitcnt lgkmcnt(0)" ::: "memory");
    const int c = lane & 7;
#pragma unroll
    for (int j = 0; j < 4; ++j) { const int n = (lane >> 3) + 8 * j; const float* s = scr + (8 * c) * 33 + n;
        u32x4 o; o.x = pk2(s[0 * 33], s[1 * 33]); o.y = pk2(s[2 * 33], s[3 * 33]); o.z = pk2(s[4 * 33], s[5 * 33]); o.w = pk2(s[6 * 33], s[7 * 33]);
        *(u32x4*)(dst + (size_t)n * ldk + 8 * c) = o; }
    asm volatile("s_waitcnt lgkmcnt(0)" ::: "memory");
}
__device__ __forceinline__ unsigned pk4_fp8(float a, float b, float c, float d) { unsigned w = __builtin_amdgcn_cvt_pk_fp8_f32(a, b, 0u, false); return __builtin_amdgcn_cvt_pk_fp8_f32(c, d, w, true); }
__device__ __forceinline__ void xpose_block_f8(const float* src, int ldn, int k0, int scol, unsigned char* dst, int ldk, float* scr, int lane, float sc) {
    float ld_[32];
#pragma unroll
    for (int i = 0; i < 32; ++i) ld_[i] = src[(size_t)(k0 + 2 * i + (lane >> 5)) * ldn + scol];
#pragma unroll
    for (int i = 0; i < 32; ++i) scr[(2 * i + (lane >> 5)) * 33 + (lane & 31)] = ld_[i];
    asm volatile("s_waitcnt lgkmcnt(0)" ::: "memory");
    const int c = lane & 7;
#pragma unroll
    for (int j = 0; j < 4; ++j) { const int n = (lane >> 3) + 8 * j; const float* s = scr + (8 * c) * 33 + n;
        u32x2 o; o.x = pk4_fp8(s[0 * 33] * sc, s[1 * 33] * sc, s[2 * 33] * sc, s[3 * 33] * sc); o.y = pk4_fp8(s[4 * 33] * sc, s[5 * 33] * sc, s[6 * 33] * sc, s[7 * 33] * sc);
        *(u32x2*)(dst + (size_t)n * ldk + 8 * c) = o; }
    asm volatile("s_waitcnt lgkmcnt(0)" ::: "memory");
}
constexpr float F8_W13 = 32.f, F8_W2 = 64.f, F8_HM = 4.f;
constexpr int SC_W13 = 0x7a7a7a7a, SC_W2 = 0x79797979, SC_HM = 0x7d7d7d7d, SC_ONE = 0x7f7f7f7f;
constexpr int IT_WIN = 16 * 200, IT_WP = 8 * 32, IT_WOUT = 16 * 32, IT_F13 = 16 * 176, IT_F2 = 44 * 32, IT_M13 = 16 * 224, IT_M2 = 56 * 32;
constexpr int IT_EARLY = 2 * IT_WIN + 6 * IT_WP + 2 * IT_WOUT + IT_F13 + IT_F2;
constexpr int IT_TOTAL = IT_EARLY + 8 * IT_M13 + 8 * IT_M2;
constexpr int IT_PRO = IT_EARLY;
constexpr int L1A0 = IT_WIN, L1A1 = 2 * IT_WIN, L1B0 = 2 * IT_WIN + 3 * IT_WP, L1B1 = 2 * IT_WIN + 6 * IT_WP, L1C0 = L1B1 + IT_WOUT, L1C1 = L1B1 + 2 * IT_WOUT;
constexpr int N_L1 = (L1A1 - L1A0) + (L1B1 - L1B0) + (L1C1 - L1C0), N_PRO = IT_EARLY - N_L1;
__host__ __device__ __forceinline__ int pro_item(int j) {
    if (j < L1A0) return j; j += L1A1 - L1A0;
    if (j < L1B0) return j; j += L1B1 - L1B0;
    if (j < L1C0) return j; return j + (L1C1 - L1C0); }
__host__ __device__ __forceinline__ int l1_item(int j) {
    if (j < L1A1 - L1A0) return L1A0 + j; j -= L1A1 - L1A0;
    if (j < L1B1 - L1B0) return L1B0 + j; j -= L1B1 - L1B0;
    return L1C0 + j; }
constexpr int IT_DEF1 = IT_EARLY + 33000, IT_DEFA = IT_DEF1 + 1500, IT_DEF2 = IT_DEF1 + 4000;
__device__ __forceinline__ void prep_item(const P& p, int it, float* scr, int lane) {
    const int nl = lane & 31;
    if (it < 2 * IT_WIN) { const int l = it / IT_WIN, r = it % IT_WIN, kb = r / 200, nb = r % 200;
        { xpose_block_f8(p.in[8] + (size_t)l * D * IN_W, IN_W, 64 * kb, win_src_col(32 * nb + nl), (unsigned char*)(p.ws + WS_WIN) + (size_t)l * IN_W * D * 2 + (size_t)(32 * nb) * D + 64 * kb, D, scr, lane, F8_W13); return; }
        xpose_block(p.in[8] + (size_t)l * D * IN_W, IN_W, 64 * kb, win_src_col(32 * nb + nl), (bf16*)(p.ws + WS_WIN) + (size_t)l * IN_W * D + (size_t)(32 * nb) * D + 64 * kb, D, scr, lane); return; }
    it -= 2 * IT_WIN;
    if (it < 6 * IT_WP) { const int l = it / (3 * IT_WP), r3 = it % (3 * IT_WP), br = r3 / IT_WP, r = r3 % IT_WP, kb = r / 32, nb = r % 32;
        xpose_block((br == 0 ? p.in[21] : br == 1 ? p.in[22] : p.in[23]) + (size_t)l * 512 * D, D, 64 * kb, pcol(32 * nb + nl), (bf16*)(p.ws + WS_WP) + (size_t)l * D * 1536 + (size_t)(32 * nb) * 1536 + br * 512 + 64 * kb, 1536, scr, lane); return; }
    it -= 6 * IT_WP;
    if (it < 2 * IT_WOUT) { const int l = it / IT_WOUT, r = it % IT_WOUT, kb = r / 32, nb = r % 32;
        xpose_block(p.in[24] + (size_t)l * D * D, D, 64 * kb, 32 * nb + nl, (bf16*)(p.ws + WS_WOUT) + (size_t)l * D * D + (size_t)(32 * nb) * D + 64 * kb, D, scr, lane); return; }
    it -= 2 * IT_WOUT;
    if (it < IT_F13) { const int kb = it / 176, nb = it % 176, np = 32 * nb + nl, c = np & 255, j = np >> 8;
        xpose_block_f8(((c >> 7) ? p.in[26] : p.in[25]), DFF, 64 * kb, j * 128 + pcol(c & 127), (unsigned char*)(p.ws + WS_FFN13) + (size_t)(32 * nb) * D + 64 * kb, D, scr, lane, F8_W13); return; }
    it -= IT_F13;
    if (it < IT_F2) { const int kb = it / 32, nb = it % 32;
        xpose_block(p.in[27], D, 64 * kb, 32 * nb + nl, (bf16*)(p.ws + WS_FFN2) + (size_t)(32 * nb) * DFF + 64 * kb, DFF, scr, lane); return; }
    it -= IT_F2;
    if (it < 8 * IT_M13) { const int e = it / IT_M13, r = it % IT_M13, kb = r / 224, nb = r % 224, np = 32 * nb + nl, c = np & 255, j = np >> 8;
        xpose_block_f8(((c >> 7) ? p.in[31] : p.in[30]) + (size_t)e * D * DFFX, DFFX, 64 * kb, j * 128 + pcol(c & 127), (unsigned char*)(p.ws + WS_MOE13) + (size_t)e * 7168 * D + (size_t)(32 * nb) * D + 64 * kb, D, scr, lane, F8_W13); return; }
    it -= 8 * IT_M13;
    { const int e = it / IT_M2, r = it % IT_M2, kb = r / 32, nb = r % 32;
        xpose_block_f8(p.in[32] + (size_t)e * DFFX * D, D, 64 * kb, pcol(32 * nb + nl), (unsigned char*)(p.ws + WS_MOE2) + (size_t)e * D * DFFX + (size_t)(32 * nb) * DFFX + 64 * kb, DFFX, scr, lane, F8_W2); }
}

__device__ __forceinline__ void ph_mod_item(const P& p, int item, float* lds, int tid) {
    const int l = item / 96, n0 = (item % 96) * 64, w = tid >> 6, lane = tid & 63;
    const float* wm = p.in[4] + (size_t)l * D * 6144 + (size_t)(128 * w) * 6144 + n0 + lane;
    float* sl = lds + 8 * 5 * 64;
    for (int i = tid; i < 5 * D; i += 512) { const float v = i < 4 * D ? p.in[1][i] : p.in[3][i - 4 * D]; sl[i] = siluf_(v); }
    __syncthreads();
    float a0 = 0.f, a1 = 0.f, a2 = 0.f, a3 = 0.f, a4 = 0.f;
#pragma unroll 32
    for (int k = 0; k < 128; ++k) { const float wv = wm[(size_t)k * 6144]; const int kk = 128 * w + k;
        a0 += sl[kk] * wv; a1 += sl[D + kk] * wv; a2 += sl[2 * D + kk] * wv; a3 += sl[3 * D + kk] * wv; a4 += sl[4 * D + kk] * wv; }
    lds[(w * 5 + 0) * 64 + lane] = a0; lds[(w * 5 + 1) * 64 + lane] = a1; lds[(w * 5 + 2) * 64 + lane] = a2; lds[(w * 5 + 3) * 64 + lane] = a3; lds[(w * 5 + 4) * 64 + lane] = a4;
    __syncthreads();
    if (tid < 320) { const int bi = tid >> 6; float s = 0.f;
#pragma unroll
        for (int ww = 0; ww < 8; ++ww) s += lds[(ww * 5 + bi) * 64 + lane];
        ((float*)(p.ws + WS_MODV))[(size_t)(l * 5 + bi) * 6144 + n0 + lane] = s + p.in[5][l * 6144 + n0 + lane]; }
    __syncthreads();
}
__device__ __forceinline__ void ph_misc(const P& p, int tid, int nthreads) {
    if (tid < 16) { const int f = tid;
        const double CS[16][2] = {{0.5403023058681397174, 0.84147098480789650665}, {0.84600911028170792533, 0.5331684399140228157}, {0.95041528025518286254, 0.31098359290718572638},
            {0.98423023447009458711, 0.17689218624615003844}, {0.9950041652780257661, 0.099833416646828152307}, {0.99841927779266443401, 0.056204499214692484859},
            {0.99950004166527780258, 0.031617506402433710095}, {0.99984189028361432743, 0.017781856879666127606}, {0.99995000041666527778, 0.0099998333341666646825},
            {0.99998418865336578085, 0.0056233836139601852304}, {0.99999500000416666528, 0.0031622723897082476155}, {0.99999841886158658243, 0.0017782784728035290072},
            {0.99999950000004166667, 0.00099999983333334166667}, {0.99999984188612115825, 0.0005623412955523593817}, {0.99999995000000041667, 0.0003162277607463751926},
            {0.99999998418861174082, 0.00017782794006665673962}};
        double C = 1.0, S = 0.0, c1 = 0.0, s1 = 0.0;
#pragma unroll
        for (int q = 0; q < 16; ++q) if (q == f) { c1 = CS[q][0]; s1 = CS[q][1]; }
        float* t = (float*)(p.ws + WS_ROPE);
        for (int pos = 0; pos < 64; ++pos) { t[pos * 16 + f] = (float)C; t[1024 + pos * 16 + f] = (float)S; const double nc = C * c1 - S * s1, ns = S * c1 + C * s1; C = nc; S = ns; } }
    if (tid < 2) { const int l = tid; float s1 = 0.f, s2 = 0.f;
        for (int k = 0; k < 64; ++k) { s1 += p.in[16][l * 64 + k] * p.in[17][l * 64 + k]; s2 += p.in[18][l * 64 + k] * p.in[19][l * 64 + k]; }
        const float li = 0.8f - 0.6f * expf(-0.3f * (float)l);
        float* t = (float*)(p.ws + WS_LAM); t[l] = expf(s1) - expf(s2) + li; t[2 + l] = li;
        float mq = 0.f, mk = 0.f;
        for (int k = 0; k < 64; ++k) { mq = fmaxf(mq, fabsf(p.in[10][l * 64 + k])); mk = fmaxf(mk, fabsf(p.in[11][l * 64 + k])); }
        const float cref = 64.f * C2 * mq * mk * 1.02f + 0.25f;
        t[4 + l] = (cref < 60.f) ? cref : -1.f; }
}

__device__ __forceinline__ void norm_row(const float* xrow, const float* g, const float* sc, const float* sh, bf16* orow, int lane, f32x4 (&hv)[4]) {
    f32x4 v[4]; float s = 0.f;
#pragma unroll
    for (int j = 0; j < 4; ++j) { v[j] = *(const f32x4*)(xrow + 4 * lane + 256 * j); s += (v[j].x * v[j].x + v[j].y * v[j].y) + (v[j].z * v[j].z + v[j].w * v[j].w); }
    const float rinv = rsq_(wave_sum(s) * (1.f / D) + EPS);
#pragma unroll
    for (int j = 0; j < 4; ++j) { const int c = 4 * lane + 256 * j; const f32x4 gv = *(const f32x4*)(g + c), scv = *(const f32x4*)(sc + c), shv = *(const f32x4*)(sh + c);
        hv[j] = (v[j] * rinv * gv) * (1.f + scv) + shv;
        u32x2 o; o.x = pk2(hv[j].x, hv[j].y); o.y = pk2(hv[j].z, hv[j].w); *(u32x2*)(orow + c) = o; }
}
__device__ __forceinline__ void ph_norm(const P& p, int l, int which  , int nrows, int gw, int NGW, int lane) {
    const bool first = which == 0 && l == 0; const int lim = first ? nrows : M_LAT;
    const float* g = (which ? p.in[7] : p.in[6]) + l * D;
    f32x4 vc[4], vn[4];
#define NLOAD(R, V) do { if (first) { const float* xr_ = x0_row(p, (R)); _Pragma("unroll") for (int j = 0; j < 4; ++j) V[j] = *(const f32x4*)(xr_ + 4 * lane + 256 * j); } \
        else { const bf16* xb_ = (const bf16*)(p.ws + WS_XB) + (size_t)(R) * D; _Pragma("unroll") for (int j = 0; j < 4; ++j) V[j] = ld_bf4(xb_ + 4 * lane + 256 * j); } } while (0)
    int r = gw; if (r < lim) NLOAD(r, vc);
    for (; r < lim; r += NGW) {
        const int rn = r + NGW; if (rn < lim) NLOAD(rn, vn);
        const int bi = bidx(r); const float* sc = modv(p, l, bi, which ? 4 : 1); const float* sh = modv(p, l, bi, which ? 3 : 0);
        float s = 0.f;
#pragma unroll
        for (int j = 0; j < 4; ++j) s += (vc[j].x * vc[j].x + vc[j].y * vc[j].y) + (vc[j].z * vc[j].z + vc[j].w * vc[j].w);
        const float rinv = rsq_(wave_sum(s) * (1.f / D) + EPS);
#pragma unroll
        for (int j = 0; j < 4; ++j) { const int c = 4 * lane + 256 * j; const f32x4 gv = *(const f32x4*)(g + c), scv = *(const f32x4*)(sc + c), shv = *(const f32x4*)(sh + c);
            const f32x4 h = (vc[j] * rinv * gv) * (1.f + scv) + shv;
            if (which == 0 && !ALL_MEGA) { u32x2 o; o.x = pk2(h.x, h.y); o.y = pk2(h.z, h.w); *(u32x2*)((bf16*)(p.ws + WS_H) + (size_t)r * D + c) = o; }
            *(unsigned*)((unsigned char*)(p.ws + WS_H8) + (size_t)r * D + c) = pk4_fp8(h.x, h.y, h.z, h.w); }
#pragma unroll
        for (int j = 0; j < 4; ++j) vc[j] = vn[j];
    }
#undef NLOAD
    if (first) return;
    for (; r < nrows; r += NGW) {
        const float* xr = xs_row(p, r); const int bi = bidx(r);
        {
            const int rc = r - M_LAT, nks = which == 1 ? 4 : 11; const bf16* P = (const bf16*)(p.ws + (which == 1 ? WS_CPO : WS_CPF)) + (size_t)rc * D;
            const float* base = which == 1 ? p.in[2] + (size_t)rc * D : xr; const float* gt = modv(p, 0, 4, which == 1 ? 2 : 5);
            const float* g = (which ? p.in[7] : p.in[6]) + l * D; const float* sc = modv(p, l, bi, which ? 4 : 1); const float* sh = modv(p, l, bi, which ? 3 : 0);
            f32x4 v[4]; float s = 0.f;
#pragma unroll
            for (int j = 0; j < 4; ++j) { const int c = 4 * lane + 256 * j; f32x4 y = (f32x4){0.f, 0.f, 0.f, 0.f};
                for (int ks = 0; ks < nks; ++ks) { const u32x2 a = *(const u32x2*)(P + (size_t)ks * 1024 * 1024 + c);
                    y.x += __uint_as_float(a.x << 16); y.y += __uint_as_float(a.x & 0xffff0000u); y.z += __uint_as_float(a.y << 16); y.w += __uint_as_float(a.y & 0xffff0000u); }
                v[j] = *(const f32x4*)(base + c) + *(const f32x4*)(gt + c) * y; s += (v[j].x * v[j].x + v[j].y * v[j].y) + (v[j].z * v[j].z + v[j].w * v[j].w);
                if (which == 1) *(f32x4*)((float*)(p.ws + WS_XSC) + (size_t)rc * D + c) = v[j]; }
            const float rinv = rsq_(wave_sum(s) * (1.f / D) + EPS); bf16* orow = (bf16*)(p.ws + WS_H) + (size_t)r * D;
#pragma unroll
            for (int j = 0; j < 4; ++j) { const int c = 4 * lane + 256 * j; const f32x4 gv = *(const f32x4*)(g + c), scv = *(const f32x4*)(sc + c), shv = *(const f32x4*)(sh + c);
                const f32x4 h = (v[j] * rinv * gv) * (1.f + scv) + shv;
                if (which == 0 && !ALL_MEGA) { u32x2 o; o.x = pk2(h.x, h.y); o.y = pk2(h.z, h.w); *(u32x2*)(orow + c) = o; }
                *(unsigned*)((unsigned char*)(p.ws + WS_H8) + (size_t)r * D + c) = pk4_fp8(h.x, h.y, h.z, h.w); }
        }
    }
}
__device__ __forceinline__ void router_row(const P& p, int r, int lane, unsigned* rowbuf  , const f32x4 (&v)[4], const f32x4 (&wr)[32], int& e1, int& e2, float& p1, float& p2) {
    const int bi = bidx(r); f32x4 hv[4];
    {
        const float* g = p.in[7] + 1 * D; const float* sc = modv(p, 1, bi, 4); const float* sh = modv(p, 1, bi, 3);
        float s = 0.f;
#pragma unroll
        for (int j = 0; j < 4; ++j) s += (v[j].x * v[j].x + v[j].y * v[j].y) + (v[j].z * v[j].z + v[j].w * v[j].w);
        const float rinv = rsq_(wave_sum(s) * (1.f / D) + EPS);
#pragma unroll
        for (int j = 0; j < 4; ++j) { const int c = 4 * lane + 256 * j; const f32x4 gv = *(const f32x4*)(g + c), scv = *(const f32x4*)(sc + c), shv = *(const f32x4*)(sh + c);
            hv[j] = (v[j] * rinv * gv) * (1.f + scv) + shv; rowbuf[lane + 64 * j] = pk4_fp8(hv[j].x, hv[j].y, hv[j].z, hv[j].w); } }
    float lg[8];
#pragma unroll
    for (int e = 0; e < 8; ++e) lg[e] = 0.f;
#pragma unroll
    for (int j = 0; j < 4; ++j)
#pragma unroll
        for (int i = 0; i < 4; ++i) { const f32x4 w0 = wr[(4 * j + i) * 2], w1 = wr[(4 * j + i) * 2 + 1]; const float h = hv[j][i];
            lg[0] += h * w0.x; lg[1] += h * w0.y; lg[2] += h * w0.z; lg[3] += h * w0.w; lg[4] += h * w1.x; lg[5] += h * w1.y; lg[6] += h * w1.z; lg[7] += h * w1.w; }
#pragma unroll
    for (int e = 0; e < 8; ++e) lg[e] = wave_sum(lg[e]) + p.in[29][e];
    e1 = 0; float v1 = lg[0];
#pragma unroll
    for (int e = 1; e < 8; ++e) if (lg[e] > v1) { v1 = lg[e]; e1 = e; }
    e2 = -1; float v2 = -INFINITY;
#pragma unroll
    for (int e = 0; e < 8; ++e) if (e != e1 && lg[e] > v2) { v2 = lg[e]; e2 = e; }
    p1 = 1.f / (1.f + expf(v2 - v1)); p2 = 1.f - p1;
}
__device__ __forceinline__ void ph_router(const P& p, int wg, int nwg, int nw, unsigned char* lds, int tid) {
    unsigned* cnt = (unsigned*)(p.ws + WS_CTL) + CW_CNT;
    const int wave = tid >> 6, lane = tid & 63;
    int* sE = (int*)lds; float* sP = (float*)(lds + 1024); unsigned* sC = (unsigned*)(lds + 2048); int* sS = (int*)(lds + 3072);
    unsigned* rows = (unsigned*)(lds + 4096);
    const int per = 64 / nw;
    f32x4 wr[32];
#pragma unroll
    for (int j = 0; j < 4; ++j)
#pragma unroll
        for (int i = 0; i < 4; ++i) { const int k = 4 * lane + 256 * j + i; wr[(4 * j + i) * 2] = *(const f32x4*)(p.in[28] + (size_t)k * 8); wr[(4 * j + i) * 2 + 1] = *(const f32x4*)(p.in[28] + (size_t)k * 8 + 4); }
    for (int j0 = 0; (j0 * nwg + wg) * nw < M_LAT; j0 += per) {
        if (tid < 16) sC[tid] = 0u;
        if (tid < 128) sE[tid] = -1;
        __syncthreads();
        f32x4 xv[4], xn[4];
#define RLOAD(R, V) do { const bf16* xb_ = (const bf16*)(p.ws + WS_XB) + (size_t)(R) * D; _Pragma("unroll") for (int j = 0; j < 4; ++j) V[j] = ld_bf4(xb_ + 4 * lane + 256 * j); } while (0)
        { const int r0 = (j0 * nwg + wg) * nw + wave; if (r0 < M_LAT) RLOAD(r0, xv); }
        for (int jj = 0; jj < per; ++jj) { const int r = ((j0 + jj) * nwg + wg) * nw + wave, li = jj * nw + wave;
            { const int rnx = ((j0 + jj + 1) * nwg + wg) * nw + wave; if (jj + 1 < per && rnx < M_LAT) RLOAD(rnx, xn); }
            if (r < M_LAT) { int e1, e2; float p1, p2; router_row(p, r, lane, rows + li * 256, xv, wr, e1, e2, p1, p2);
                if (lane == 0) { sE[2 * li] = e1; sE[2 * li + 1] = e2; sP[2 * li] = p1; sP[2 * li + 1] = p2; atomicAdd(&sC[e1], 1u); atomicAdd(&sC[e2], 1u); } }
#pragma unroll
            for (int j = 0; j < 4; ++j) xv[j] = xn[j]; }
#undef RLOAD
        __syncthreads();
        if (tid < 8) sC[8 + tid] = sC[tid] ? atomicAdd(cnt + tid, sC[tid]) : 0u;
        __syncthreads();
        if (tid < 128) { const int e = sE[tid]; if (e >= 0) { int pre = 0; for (int q = 0; q < tid; ++q) pre += (sE[q] == e) ? 1 : 0;
                const int li = tid >> 1, jj = li / nw, w = li % nw, r = ((j0 + jj) * nwg + wg) * nw + w;
                const int slot = (int)sC[8 + e] + pre; sS[tid] = slot;
                ((int*)(p.ws + WS_TOKE))[2 * r + (tid & 1)] = e; ((int*)(p.ws + WS_TOKS))[2 * r + (tid & 1)] = slot; ((float*)(p.ws + WS_EXPP))[e * 16384 + slot] = sP[tid]; } }
        __syncthreads();
        for (int i = tid; i < 128 * 64; i += nw * 64) { const int pr = i >> 6, ck = i & 63, e = sE[pr]; if (e >= 0) { const u32x4 v = *(const u32x4*)(rows + (pr >> 1) * 256 + ck * 4);
                *(u32x4*)((unsigned char*)(p.ws + WS_H2PX) + ((size_t)e * 16384 + sS[pr]) * D + ck * 16) = v; } }
        __syncthreads();
    }
}
__device__ __forceinline__ void moe_bases(const P& p, int (&base)[9]) {
    const unsigned* cnt = (const unsigned*)(p.ws + WS_CTL) + CW_CNT; int b = 0;
#pragma unroll
    for (int e = 0; e < 8; ++e) { base[e] = b; b += (int)((cnt[e] + 255u) & ~255u); }
    base[8] = b;
}
__device__ __forceinline__ void ph_final(const P& p, int gw, int NGW, int lane) {
    int base[9]; moe_bases(p, base);
    const int* te = (const int*)(p.ws + WS_TOKE); const int* ts = (const int*)(p.ws + WS_TOKS);
#define FROWS(R, ROWS) do { _Pragma("unroll") for (int k = 0; k < 2; ++k) { const int e = te[2 * (R) + k]; int bs = 0; _Pragma("unroll") for (int q = 0; q < 8; ++q) bs = (q == e) ? base[q] : bs; ROWS[k] = bs + ts[2 * (R) + k]; } } while (0)
#define FLOAD(R, ROWS, XV, YA) do { const bf16* xb_ = (const bf16*)(p.ws + WS_XB) + (size_t)(R) * D; _Pragma("unroll") for (int j = 0; j < 4; ++j) { const int c = 4 * lane + 256 * j; XV[j] = *(const u32x2*)(xb_ + c); \
        _Pragma("unroll") for (int k = 0; k < 2; ++k) YA[k][j] = ROWS[k] < 32768 ? *(const u32x2*)((const bf16*)(p.ws + WS_H2P) + (size_t)ROWS[k] * D + c) : (u32x2){0u, 0u}; } } while (0)
    int r = gw; int rc[2] = {0, 0}, rn[2] = {0, 0}; u32x2 xc[4], ya[2][4], xn[4], yn[2][4];
    if (r < M_LAT) { FROWS(r, rc); FLOAD(r, rc, xc, ya); }
    for (; r < M_LAT; r += NGW) {
        const int rnx = r + NGW; if (rnx < M_LAT) { FROWS(rnx, rn); FLOAD(rnx, rn, xn, yn); }
        float* xr = p.out + (size_t)r * D; const float* g5 = modv(p, 1, bidx(r), 5);
        f32x4 v[4]; float s = 0.f;
#pragma unroll
        for (int j = 0; j < 4; ++j) { const int c = 4 * lane + 256 * j; const f32x4 g = *(const f32x4*)(g5 + c);
            const f32x4 x = (f32x4){__uint_as_float(xc[j].x << 16), __uint_as_float(xc[j].x & 0xffff0000u), __uint_as_float(xc[j].y << 16), __uint_as_float(xc[j].y & 0xffff0000u)};
            f32x4 y = (f32x4){0.f, 0.f, 0.f, 0.f};
#pragma unroll
            for (int k = 0; k < 2; ++k) { const u32x2 a = ya[k][j];
                y.x += __uint_as_float(a.x << 16); y.y += __uint_as_float(a.x & 0xffff0000u); y.z += __uint_as_float(a.y << 16); y.w += __uint_as_float(a.y & 0xffff0000u);
                if (rc[k] >= 32768) { for (int ks = 0; ks < 7; ++ks) { const u32x2 q = *(const u32x2*)((const bf16*)(p.ws + WS_YPT) + ((size_t)ks * 2048 + (rc[k] - 32768)) * D + c);
                    y.x += __uint_as_float(q.x << 16); y.y += __uint_as_float(q.x & 0xffff0000u); y.z += __uint_as_float(q.y << 16); y.w += __uint_as_float(q.y & 0xffff0000u); } } }
            v[j] = x + g * y; s += (v[j].x * v[j].x + v[j].y * v[j].y) + (v[j].z * v[j].z + v[j].w * v[j].w); }
        const float rinv = rsq_(wave_sum(s) * (1.f / D) + EPS);
#pragma unroll
        for (int j = 0; j < 4; ++j) { const int c = 4 * lane + 256 * j; *(f32x4*)(xr + c) = v[j] * rinv * *(const f32x4*)(p.in[33] + c); }
        rc[0] = rn[0]; rc[1] = rn[1];
#pragma unroll
        for (int j = 0; j < 4; ++j) { xc[j] = xn[j]; ya[0][j] = yn[0][j]; ya[1][j] = yn[1][j]; }
    }
#undef FROWS
#undef FLOAD
}
__device__ __forceinline__ void ph_occomb(const P& p, int l, int nrows, int gw, int NGW, int lane) {
    const float lam = ((const float*)(p.ws + WS_LAM))[l], li = ((const float*)(p.ws + WS_LAM))[2 + l];
    const int h = lane >> 4, dv = (lane & 15) * 8, half = dv >> 6, d = dv & 63;
    for (int r = gw; r < nrows; r += NGW) {
        const u32x4 a = *(const u32x4*)((const bf16*)(p.ws + WS_OCR) + (size_t)r * 1024 + ((h * 2 + 0) * 2 + half) * 64 + d);
        const u32x4 b = *(const u32x4*)((const bf16*)(p.ws + WS_OCR) + (size_t)r * 1024 + ((h * 2 + 1) * 2 + half) * 64 + d);
        float df[8]; float s = 0.f;
#pragma unroll
        for (int i = 0; i < 4; ++i) { df[2 * i] = __uint_as_float(a[i] << 16) - lam * __uint_as_float(b[i] << 16); df[2 * i + 1] = __uint_as_float(a[i] & 0xffff0000u) - lam * __uint_as_float(b[i] & 0xffff0000u); }
#pragma unroll
        for (int i = 0; i < 8; ++i) s += df[i] * df[i];
        s += __shfl_xor(s, 1); s += __shfl_xor(s, 2); s += __shfl_xor(s, 4); s += __shfl_xor(s, 8);
        const float rinv = (1.f - li) / sqrtf(s * (1.f / 128.f) + EPS);
        const float* sg = p.in[20] + l * 128 + dv;
        u32x4 o; o.x = pk2(df[0] * rinv * sg[0], df[1] * rinv * sg[1]); o.y = pk2(df[2] * rinv * sg[2], df[3] * rinv * sg[3]);
        o.z = pk2(df[4] * rinv * sg[4], df[5] * rinv * sg[5]); o.w = pk2(df[6] * rinv * sg[6], df[7] * rinv * sg[7]);
        *(u32x4*)((bf16*)(p.ws + WS_OABC) + (size_t)r * 1536 + 1024 + h * 128 + dv) = o;
    }
}
__device__ __forceinline__ void occomb_rows32(const P& p, int l, int row0, int h, int lane) {
    const float lam = ((const float*)(p.ws + WS_LAM))[l], li = ((const float*)(p.ws + WS_LAM))[2 + l];
    const int rsel = lane >> 4, dv = (lane & 15) * 8, half = dv >> 6, d = dv & 63;
    const float* sg = p.in[20] + l * 128 + dv;
    const f32x4 g0 = *(const f32x4*)sg, g1 = *(const f32x4*)(sg + 4);
#pragma unroll 2
    for (int it = 0; it < 8; ++it) { const int r = row0 + it * 4 + rsel;
        const u32x4 a = *(const u32x4*)((const bf16*)(p.ws + WS_OCR) + (size_t)r * 1024 + ((h * 2 + 0) * 2 + half) * 64 + d);
        const u32x4 b = *(const u32x4*)((const bf16*)(p.ws + WS_OCR) + (size_t)r * 1024 + ((h * 2 + 1) * 2 + half) * 64 + d);
        float df[8]; float s = 0.f;
#pragma unroll
        for (int i = 0; i < 4; ++i) { df[2 * i] = __uint_as_float(a[i] << 16) - lam * __uint_as_float(b[i] << 16); df[2 * i + 1] = __uint_as_float(a[i] & 0xffff0000u) - lam * __uint_as_float(b[i] & 0xffff0000u); }
#pragma unroll
        for (int i = 0; i < 8; ++i) s += df[i] * df[i];
        s += __shfl_xor(s, 1); s += __shfl_xor(s, 2); s += __shfl_xor(s, 4); s += __shfl_xor(s, 8);
        const float rinv = (1.f - li) / sqrtf(s * (1.f / 128.f) + EPS);
        u32x4 o; o.x = pk2(df[0] * rinv * g0.x, df[1] * rinv * g0.y); o.y = pk2(df[2] * rinv * g0.z, df[3] * rinv * g0.w);
        o.z = pk2(df[4] * rinv * g1.x, df[5] * rinv * g1.y); o.w = pk2(df[6] * rinv * g1.z, df[7] * rinv * g1.w);
        *(u32x4*)((bf16*)(p.ws + WS_OABC) + (size_t)r * 1536 + 1024 + h * 128 + dv) = o; }
}
constexpr int CONV_TILES_LAT = M_LAT / 64, CONV_TILES_ALL = CONV_TILES_LAT + M_CTX / 16;
constexpr int CONV_LDS_BYTES = 94 * 1024 + 16 * 512 * 4;
__device__ __forceinline__ void conv_tile(const P& p, int l, int tile, unsigned char* lds, int tid) {
    int s0, len, t0, nsub;
    if (tile < CONV_TILES_LAT) { s0 = (tile >> 6) * SEQ; len = SEQ; t0 = (tile & 63) * 64; nsub = 4; } else { const int q = tile - CONV_TILES_LAT; s0 = M_LAT + (q >> 4) * CTXL; len = CTXL; t0 = (q & 15) * 16; nsub = 1; }
    bf16* yin = (bf16*)lds;
    float* outs = (float*)(lds + 94 * 1024);
    const bf16* Y = (const bf16*)(p.ws + WS_Y);
    const int nin = 16 * nsub + 30;
    {
        u32x4 v[12];
#pragma unroll
        for (int q = 0; q < 12; ++q) { const int i = tid + q * 512, rr = i >> 6, ck = i & 63, tt = t0 - 15 + rr;
            v[q] = (u32x4){0u, 0u, 0u, 0u}; if (i < nin * 64 && tt >= 0 && tt < len) v[q] = *(const u32x4*)(Y + (size_t)(s0 + tt) * 512 + ck * 8); }
#pragma unroll
        for (int q = 0; q < 12; ++q) { const int i = tid + q * 512, rr = i >> 6, ck = i & 63; if (i < nin * 64) *(u32x4*)(yin + rr * 512 + ck * 8) = v[q]; } }
    const int ch = tid, wave = tid >> 6, lane = tid & 63;
    float w[31];
    const float* wp = p.in[12] + (size_t)l * 31 * 512 + ch;
#pragma unroll
    for (int j = 0; j < 31; ++j) w[j] = wp[j * 512];
    const float bias = p.in[13][l * 512 + ch];
    const f32x4 lg0 = *(const f32x4*)(p.in[14] + l * 512 + lane * 8), lg1 = *(const f32x4*)(p.in[14] + l * 512 + lane * 8 + 4);
    const f32x4 lb0 = *(const f32x4*)(p.in[15] + l * 512 + lane * 8), lb1 = *(const f32x4*)(p.in[15] + l * 512 + lane * 8 + 4);
    __syncthreads();
#pragma unroll 1
    for (int sb = 0; sb < nsub; ++sb) {
        float a[16];
#pragma unroll
        for (int o = 0; o < 16; ++o) a[o] = bias;
#pragma unroll
        for (int i = 0; i < 46; ++i) { const float x = bf2f(yin[(sb * 16 + i) * 512 + ch]);
#pragma unroll
            for (int o = 0; o < 16; ++o) { const int j = i - o; if (j >= 0 && j < 31) a[o] += x * w[j]; } }
#pragma unroll
        for (int o = 0; o < 16; ++o) outs[o * 512 + ch] = a[o];
        __syncthreads();
#pragma unroll
        for (int rr = 0; rr < 2; ++rr) { const int o = 2 * wave + rr;
            f32x4 v0 = *(const f32x4*)(outs + o * 512 + lane * 8), v1 = *(const f32x4*)(outs + o * 512 + lane * 8 + 4);
            const float mean = wave_sum((v0.x + v0.y) + (v0.z + v0.w) + (v1.x + v1.y) + (v1.z + v1.w)) * (1.f / 512.f);
            v0 = v0 - mean; v1 = v1 - mean;
            const float var = wave_sum((v0.x * v0.x + v0.y * v0.y) + (v0.z * v0.z + v0.w * v0.w) + (v1.x * v1.x + v1.y * v1.y) + (v1.z * v1.z + v1.w * v1.w)) * (1.f / 512.f);
            const float rstd = rsq_(var + EPS);
            v0 = v0 * rstd * lg0 + lb0; v1 = v1 * rstd * lg1 + lb1;
            u32x4 ov; ov.x = pk2(siluf_(v0.x), siluf_(v0.y)); ov.y = pk2(siluf_(v0.z), siluf_(v0.w)); ov.z = pk2(siluf_(v1.x), siluf_(v1.y)); ov.w = pk2(siluf_(v1.z), siluf_(v1.w));
            *(u32x4*)((bf16*)(p.ws + WS_OABC) + (size_t)(s0 + t0 + sb * 16 + o) * 1536 + 512 + lane * 8) = ov; }
        __syncthreads();
    }
}


namespace pg8 {
#define PG8_LAS __attribute__((address_space(3)))
typedef unsigned short bf16_t;
typedef short bf16x8 __attribute__((ext_vector_type(8)));
typedef float f32x4 __attribute__((ext_vector_type(4)));
typedef unsigned u32x4 __attribute__((ext_vector_type(4)));
constexpr int BM = 256, BK = 64, HALF = 128, HTB = HALF * BK * 2  , STAGE_BYTES = 8 * HTB, NXCD = 8, WGM = 8;

__host__ __device__ __forceinline__ int lds_byte(int r, int c) { const int st = (r >> 4) * 2 + (c >> 5), rr = r & 15, cc = c & 31, ob = rr * 64 + cc * 2; return st * 1024 + (ob ^ (((ob >> 9) & 1) << 5)); }
__host__ __device__ __forceinline__ void stage_rc(int b, int& R, int& C) { const int st = b / 1024, sb = b % 1024, swz = sb ^ (((sb >> 9) & 1) << 5); R = (st >> 1) * 16 + swz / 64; C = (st & 1) * 32 + (swz % 64) / 2; }
__host__ __device__ __forceinline__ int perm32(int rho) { const int n = rho >> 4, i = rho & 15; return 8 * (i >> 2) + 4 * n + (i & 3); }

typedef int v4i_t __attribute__((ext_vector_type(4))); typedef int v8i_t __attribute__((ext_vector_type(8)));
__device__ __forceinline__ v8i_t pg8_cat(bf16x8 a, bf16x8 b) { const v4i_t x = __builtin_bit_cast(v4i_t, a), y = __builtin_bit_cast(v4i_t, b); return __builtin_shufflevector(x, y, 0, 1, 2, 3, 4, 5, 6, 7); }
struct Unit { int pm, pn, ko, pa; };
struct Gemm { const bf16_t* A; const bf16_t* Bt; int M, N, K, ld; int sc_w, sc_a; int a_pa; };

struct StaticOrder {
    int nM, nN, nwg, G, c;
    __host__ __device__ void init(int M, int N, int G_, int c_) { nM = M / BM; nN = N / BM; nwg = nM * nN; G = G_; c = c_; }
    __host__ __device__ bool next(int i, Unit& u) const {
        const long L = (long)i * G + c; if (L >= nwg) return false;
        int wgid = (int)L; { const int q = nwg / NXCD, r = nwg % NXCD, xcd = wgid % NXCD, off = wgid / NXCD; wgid = (xcd < r ? xcd * (q + 1) : r * (q + 1) + (xcd - r) * q) + off; }
        const int nig = WGM * nN, gid = wgid / nig, fm = gid * WGM, gsz = (nM - fm) < WGM ? (nM - fm) : WGM;
        u.pm = fm + ((wgid % nig) % gsz); u.pn = (wgid % nig) / gsz; u.ko = 0; u.pa = u.pm; return true;
    }
    __device__ __forceinline__ void a_ready(const Unit&) const {}
    __device__ __forceinline__ void done(const Unit&) const {}
};


typedef float f32x2_cv __attribute__((ext_vector_type(2))); typedef __bf16 bf16x2_cv __attribute__((ext_vector_type(2)));
__device__ __forceinline__ unsigned cvt_pk_bf16(float lo, float hi) { f32x2_cv v = {lo, hi}; bf16x2_cv b = __builtin_convertvector(v, bf16x2_cv); return __builtin_bit_cast(unsigned, b); }
typedef float f32x2 __attribute__((ext_vector_type(2)));

struct InprojL1Order {
    StaticOrder so; int G, c;
    __device__ void init(int G_, int c_) { so.init(16384, 6400, G_, c_); G = G_; c = c_; }
    __device__ bool next(int i, Unit& u) const {
        const int L = i * G + c;
        if (L < 1600) return so.next(i, u);
        const int q = L - 1600; if (q >= 20) return false;
        const int k = q % 5; u.pm = 64 + q / 5; u.pn = k == 0 ? 2 : 8 + k; u.ko = 0; u.pa = u.pm; return true;
    }
    __device__ __forceinline__ void a_ready(const Unit&) const {}
    __device__ __forceinline__ void done(const Unit&) const {}
};
struct MoeOrder {
    StaticOrder so; int nper; int t1, t2, t3, t4, t5, t6, t7;
    __device__ void init(const int (&base)[9], int nper_, int G_, int c_, int max_tiles = 1 << 20) { const int nt_ = (base[8] >> 8) < max_tiles ? (base[8] >> 8) : max_tiles; so.init(nt_ * BM, nper_ * BM, G_, c_); nper = nper_;
        t1 = base[1] >> 8; t2 = base[2] >> 8; t3 = base[3] >> 8; t4 = base[4] >> 8; t5 = base[5] >> 8; t6 = base[6] >> 8; t7 = base[7] >> 8; }
    __device__ bool next(int i, Unit& u) const {
        if (!so.next(i, u)) return false;
        const int e = (u.pm >= t1) + (u.pm >= t2) + (u.pm >= t3) + (u.pm >= t4) + (u.pm >= t5) + (u.pm >= t6) + (u.pm >= t7);
        const int te = e == 0 ? 0 : e == 1 ? t1 : e == 2 ? t2 : e == 3 ? t3 : e == 4 ? t4 : e == 5 ? t5 : e == 6 ? t6 : t7;
        u.pn += e * nper; u.pa = e * 64 + (u.pm - te); return true;
    }
    __device__ __forceinline__ void a_ready(const Unit&) const {}
    __device__ __forceinline__ void done(const Unit&) const {}
};

struct CtxSliceOrder {
    int nks, G, c;
    __device__ void init(int nks_, int G_, int c_) { nks = nks_; G = G_; c = c_; }
    __device__ bool next(int i, Unit& u) const {
        const int s = i * G + c; if (s >= 16 * nks) return false;
        const int q = s / nks, r = s % nks; u.pm = 64 + (q >> 2); u.pn = q & 3; u.ko = r * 256; u.pa = u.pm; return true;
    }
    __device__ __forceinline__ void a_ready(const Unit&) const {}
    __device__ __forceinline__ void done(const Unit&) const {}
};
struct MoeTailOrder {
    int ntail, G, c; int t1, t2, t3, t4, t5, t6, t7;
    __device__ void init(const int (&base)[9], int G_, int c_) { ntail = (base[8] >> 8) - 128; G = G_; c = c_;
        t1 = base[1] >> 8; t2 = base[2] >> 8; t3 = base[3] >> 8; t4 = base[4] >> 8; t5 = base[5] >> 8; t6 = base[6] >> 8; t7 = base[7] >> 8; }
    __device__ bool next(int i, Unit& u) const {
        const int s = i * G + c; if (s >= ntail * 28) return false;
        const int tile = s / 28, r = s % 28; u.pm = 128 + tile;
        const int e = (u.pm >= t1) + (u.pm >= t2) + (u.pm >= t3) + (u.pm >= t4) + (u.pm >= t5) + (u.pm >= t6) + (u.pm >= t7);
        const int te = e == 0 ? 0 : e == 1 ? t1 : e == 2 ? t2 : e == 3 ? t3 : e == 4 ? t4 : e == 5 ? t5 : e == 6 ? t6 : t7;
        u.pn = e * 4 + r / 7; u.ko = (r % 7) * 256; u.pa = e * 64 + (u.pm - te); return true;
    }
    __device__ __forceinline__ void a_ready(const Unit&) const {}
    __device__ __forceinline__ void done(const Unit&) const {}
};

__device__ __forceinline__ u32x4 pack8(f32x4 a, f32x4 b) { u32x4 w; w.x = cvt_pk_bf16(a[0], a[1]); w.y = cvt_pk_bf16(a[2], a[3]); w.z = cvt_pk_bf16(b[0], b[1]); w.w = cvt_pk_bf16(b[2], b[3]); return w; }
__device__ __forceinline__ float sigm(float x) { return __builtin_amdgcn_rcpf(1.f + __expf(-x)); }
__device__ __forceinline__ f32x4 sigm4(f32x4 v) { f32x4 r; r[0] = sigm(v[0]); r[1] = sigm(v[1]); r[2] = sigm(v[2]); r[3] = sigm(v[3]); return r; }
__device__ __forceinline__ f32x4 lo4(u32x4 g) { f32x4 r; r[0] = __uint_as_float(g.x << 16); r[1] = __uint_as_float(g.x & 0xffff0000u); r[2] = __uint_as_float(g.y << 16); r[3] = __uint_as_float(g.y & 0xffff0000u); return r; }
__device__ __forceinline__ f32x4 hi4(u32x4 g) { f32x4 r; r[0] = __uint_as_float(g.z << 16); r[1] = __uint_as_float(g.z & 0xffff0000u); r[2] = __uint_as_float(g.w << 16); r[3] = __uint_as_float(g.w & 0xffff0000u); return r; }
typedef unsigned u32x2 __attribute__((ext_vector_type(2)));

struct EpiInproj {
    static constexpr bool PERM = false, AFTER_DRAIN = false, MIDK = false, DUPABLE = true;
    unsigned char* ws; const float* qn_g; const float* kn_g; const float* b_gate;
    __device__ __forceinline__ void operator()(const f32x4 (&acc)[2][2][4][2], const Unit& u, int wr, int wc, int fr, int fq) const {
        const int pn = u.pn, pm = u.pm, row0 = pm * BM + wr * 64 + fr;
        const int kroff = pm < 64 ? (pm >> 4) * 256 : (pm - 64) * 4096 - 12288;
#ifndef DBG_INPROJ
#define DBG_INPROJ 15
#endif
        if (pn >= 13) { if (!(DBG_INPROJ & 1)) return;
            const int gc0 = (pn - 13) * 256 + wc * 32 + 8 * fq; f32x4 bv[2][2];
#pragma unroll
            for (int bj = 0; bj < 2; ++bj)
#pragma unroll
                for (int n = 0; n < 2; ++n) bv[bj][n] = *(const f32x4*)(b_gate + gc0 + 128 * bj + 4 * n);
            unsigned char* gb = ws + WS_G + (size_t)row0 * 3072 + (pn - 13) * 256 + (4 * wc + fq) * 16;
#pragma unroll
            for (int ai = 0; ai < 2; ++ai)
#pragma unroll
                for (int m = 0; m < 4; ++m) { u32x4 w;
#pragma unroll
                    for (int bj = 0; bj < 2; ++bj)
#pragma unroll
                        for (int n = 0; n < 2; ++n) { const f32x4 x = acc[ai][bj][m][n] + bv[bj][n]; unsigned d = 0u;
#pragma unroll
                            for (int e = 0; e < 4; ++e) { const float g255 = __builtin_amdgcn_rcpf(__builtin_fmaf(__expf(-x[e]), 1.f / 255.f, 1.f / 255.f));
                                d = __builtin_amdgcn_cvt_pk_u8_f32(__builtin_fmaxf(g255, 1.f), e, d); }
                            w[2 * bj + n] = d; }
                    *(u32x4*)(gb + (size_t)(ai * HALF + m * 16) * 3072) = w; }
        } else if (pn >= 11) { if (!(DBG_INPROJ & 2)) return;
            const int c0 = (pn - 11) * 256 + wc * 32 + 8 * fq;
#pragma unroll
            for (int ai = 0; ai < 2; ++ai)
#pragma unroll
                for (int m = 0; m < 4; ++m) { bf16_t* dst = (bf16_t*)(ws + WS_VC) + (size_t)(row0 + ai * HALF + m * 16 + kroff) * 512 + c0;
#pragma unroll
                    for (int bj = 0; bj < 2; ++bj) *(u32x4*)(dst + 128 * bj) = pack8(acc[ai][bj][m][0], acc[ai][bj][m][1]); }
        } else if (pn >= 3 && pn < 7) { if (!(DBG_INPROJ & 4)) return;
            const int c0 = (pn - 3) * 128 + wc * 32 + 8 * fq;
#pragma unroll
            for (int ai = 0; ai < 2; ++ai)
#pragma unroll
                for (int m = 0; m < 4; ++m) { bf16_t* dst = (bf16_t*)(ws + WS_Y) + (size_t)(row0 + ai * HALF + m * 16) * 512 + c0;
                    *(u32x4*)dst = pack8(acc[ai][0][m][0] * sigm4(acc[ai][1][m][0]), acc[ai][0][m][1] * sigm4(acc[ai][1][m][1])); }
        } else { if (!(DBG_INPROJ & 8)) return;
            const bool isv = (pn == 2 && wc >= 2), isq = pn < 2 || pn == 7 || pn == 8, normed = pn < 3 && !isv, roped = !isv && pm < 64;
            bf16_t* dst; int pitch, roff;
            if (pn < 2) { dst = (bf16_t*)(ws + WS_QA) + (4 * pn + wc) * 64; pitch = 512; roff = 0; }
            else if (pn == 2) { dst = (bf16_t*)(ws + (wc < 2 ? WS_KA : WS_VA)) + (wc & 1) * 64; pitch = 128; roff = kroff; }
            else if (pn < 9) { dst = (bf16_t*)(ws + WS_QC) + (4 * (pn - 7) + wc) * 64; pitch = 512; roff = 0; }
            else { dst = (bf16_t*)(ws + WS_KC) + (4 * (pn - 9) + wc) * 64; pitch = 512; roff = kroff; }
            dst += isv ? 4 * fq : 8 * fq;
            f32x4 gv[2][2];
            const float* g = isq ? qn_g : kn_g;
#pragma unroll
            for (int bj = 0; bj < 2; ++bj)
#pragma unroll
                for (int n = 0; n < 2; ++n) gv[bj][n] = normed ? *(const f32x4*)(g + 32 * bj + 16 * n + 4 * fq) : (f32x4){1.f, 1.f, 1.f, 1.f};
            const float qs = isq ? C2 : 1.f;
            const float* cosT = (const float*)(ws + WS_ROPE) + 4 * fq; const float* sinT = cosT + 1024;
#pragma unroll
            for (int ai = 0; ai < 2; ++ai)
#pragma unroll
                for (int m = 0; m < 4; ++m) { const int row = row0 + ai * HALF + m * 16;
                    f32x4 v[2][2];
#pragma unroll
                    for (int bj = 0; bj < 2; ++bj)
#pragma unroll
                        for (int n = 0; n < 2; ++n) v[bj][n] = acc[ai][bj][m][n];
                    if (normed) { float ss = 0.f;
#pragma unroll
                        for (int bj = 0; bj < 2; ++bj)
#pragma unroll
                            for (int n = 0; n < 2; ++n) ss += (v[bj][n][0] * v[bj][n][0] + v[bj][n][1] * v[bj][n][1]) + (v[bj][n][2] * v[bj][n][2] + v[bj][n][3] * v[bj][n][3]);
                        ss = ::xsum_x32(::xsum_x16(ss));
                        const float rinv = ::rsq_(ss * (1.f / 64.f) + EPS);
#pragma unroll
                        for (int bj = 0; bj < 2; ++bj)
#pragma unroll
                            for (int n = 0; n < 2; ++n) v[bj][n] = v[bj][n] * rinv * gv[bj][n]; }
                    if (roped) { const int t = row & 4095;
#pragma unroll
                        for (int bj = 0; bj < 2; ++bj) { const int pos = bj ? (t & 63) : (t >> 6); const f32x4 cs = *(const f32x4*)(cosT + pos * 16), sn = *(const f32x4*)(sinT + pos * 16);
                            const f32x4 x1 = v[bj][0], x2 = v[bj][1]; v[bj][0] = x1 * cs - x2 * sn; v[bj][1] = x2 * cs + x1 * sn; } }
                    bf16_t* rp = dst + (size_t)(row + roff) * pitch;
                    if (isv) {
#pragma unroll
                        for (int bj = 0; bj < 2; ++bj)
#pragma unroll
                            for (int n = 0; n < 2; ++n) { const f32x4 o = v[bj][n]; u32x2 w; w.x = cvt_pk_bf16(o[0], o[1]); w.y = cvt_pk_bf16(o[2], o[3]); *(u32x2*)(rp + 32 * bj + 16 * n) = w; } }
                    else {
#pragma unroll
                        for (int bj = 0; bj < 2; ++bj) *(u32x4*)(rp + 32 * bj) = pack8(v[bj][0] * qs, v[bj][1] * qs); }
                }
        }
    }
};
struct EpiMerge {
    static constexpr bool PERM = false, AFTER_DRAIN = false, MIDK = true, DUPABLE = false;
    const unsigned char* G; bf16_t* MB;
    static __device__ __forceinline__ float ub(unsigned w, int k) { return (float)((w >> (8 * k)) & 0xffu); }
    __device__ __forceinline__ void mid(f32x4 (&acc)[2][2][4][2], const Unit& u, int wr, int wc, int fr, int fq, int seg) const {
        const unsigned rowb = (unsigned)(u.pm * BM + wr * 64 + fr) * 3072u + (unsigned)((seg - 1) * 1024 + u.pn * 256 + (4 * wc + fq) * 16);
        const unsigned char* Gb = G;
#pragma unroll
        for (int ai = 0; ai < 2; ++ai) { u32x4 ga[4], gb[4];
#pragma unroll
            for (int m = 0; m < 4; ++m) { const unsigned o = rowb + (unsigned)(ai * HALF + m * 16) * 3072u; ga[m] = *(const u32x4*)(Gb + o); gb[m] = *(const u32x4*)(Gb + (o + 1024u)); }
#pragma unroll
            for (int m = 0; m < 4; ++m)
#pragma unroll
                for (int bj = 0; bj < 2; ++bj)
#pragma unroll
                    for (int n = 0; n < 2; ++n) { const unsigned a = ga[m][2 * bj + n], b = gb[m][2 * bj + n]; f32x4 r;
#pragma unroll
                        for (int e = 0; e < 4; ++e) r[e] = ub(a, e) * __builtin_amdgcn_rcpf(ub(b, e));
                        acc[ai][bj][m][n] *= r; }
            asm volatile("" ::: "memory"); }
    }
    __device__ __forceinline__ void operator()(const f32x4 (&acc)[2][2][4][2], const Unit& u, int wr, int wc, int fr, int fq) const {
        const int row0 = u.pm * BM + wr * 64 + fr, c0 = u.pn * 256 + wc * 32 + 8 * fq;
#pragma unroll
        for (int ai = 0; ai < 2; ++ai)
#pragma unroll
            for (int m = 0; m < 4; ++m) { const int row = row0 + ai * HALF + m * 16; const u32x4 g = *(const u32x4*)(G + (size_t)row * 3072 + 2048 + u.pn * 256 + (4 * wc + fq) * 16);
#pragma unroll
                for (int bj = 0; bj < 2; ++bj) { f32x4 g0, g1;
#pragma unroll
                    for (int e = 0; e < 4; ++e) { g0[e] = ub(g[2 * bj], e) * (1.f / 255.f); g1[e] = ub(g[2 * bj + 1], e) * (1.f / 255.f); }
                    *(u32x4*)(MB + (size_t)row * 1024 + c0 + 128 * bj) = pack8(acc[ai][bj][m][0] * g0, acc[ai][bj][m][1] * g1); } }
    }
};
struct EpiResid {
    static constexpr bool PERM = false, AFTER_DRAIN = false, MIDK = false, DUPABLE = false;
    __device__ __forceinline__ int nst(const Unit&) const { return 0; }
    const float* base_f32; bf16_t* xb; const float* gate;
    __device__ __forceinline__ void operator()(const f32x4 (&acc)[2][2][4][2], const Unit& u, int wr, int wc, int fr, int fq) const {
        const int pm = u.pm, c0 = u.pn * 256 + wc * 32 + 4 * fq, bi = pm >> 4, row0 = pm * BM + wr * 64 + fr;
        f32x4 gv[2][2];
#pragma unroll
        for (int bj = 0; bj < 2; ++bj)
#pragma unroll
            for (int n = 0; n < 2; ++n) gv[bj][n] = *(const f32x4*)(gate + (size_t)bi * 6 * 1024 + c0 + 128 * bj + 16 * n);
#pragma unroll
        for (int ai = 0; ai < 2; ++ai)
#pragma unroll
            for (int m = 0; m < 4; ++m) { const size_t off = (size_t)(row0 + ai * HALF + m * 16) * 1024 + c0;
#pragma unroll
                for (int bj = 0; bj < 2; ++bj)
#pragma unroll
                    for (int n = 0; n < 2; ++n) { const size_t o = off + 128 * bj + 16 * n; f32x4 b;
                        if (base_f32) b = *(const f32x4*)(base_f32 + o);
                        else { const u32x2 q = *(const u32x2*)(xb + o); b[0] = __uint_as_float(q.x << 16); b[1] = __uint_as_float(q.x & 0xffff0000u); b[2] = __uint_as_float(q.y << 16); b[3] = __uint_as_float(q.y & 0xffff0000u); }
                        const f32x4 r = b + gv[bj][n] * acc[ai][bj][m][n]; u32x2 w; w.x = cvt_pk_bf16(r[0], r[1]); w.y = cvt_pk_bf16(r[2], r[3]); *(u32x2*)(xb + o) = w; } }
    }
};
struct EpiSwiglu {
    static constexpr bool PERM = false, AFTER_DRAIN = false, MIDK = false, DUPABLE = false;
    bf16_t* O; int ld, nper;
    __device__ __forceinline__ void operator()(const f32x4 (&acc)[2][2][4][2], const Unit& u, int wr, int wc, int fr, int fq) const {
        const int row0 = u.pm * BM + wr * 64 + fr, c0 = (u.pn % nper) * 128 + wc * 32 + 8 * fq;
#pragma unroll
        for (int ai = 0; ai < 2; ++ai)
#pragma unroll
            for (int m = 0; m < 4; ++m) { const f32x4 a0 = acc[ai][0][m][0], a1 = acc[ai][0][m][1];
                *(u32x4*)(O + (size_t)(row0 + ai * HALF + m * 16) * ld + c0) = pack8(a0 * sigm4(a0) * acc[ai][1][m][0], a1 * sigm4(a1) * acc[ai][1][m][1]); }
    }
};
struct EpiSwigluF8 {
    static constexpr bool PERM = false, AFTER_DRAIN = false, MIDK = false, DUPABLE = false;
    unsigned char* O; int ld, nper;
    __device__ __forceinline__ void operator()(const f32x4 (&acc)[2][2][4][2], const Unit& u, int wr, int wc, int fr, int fq) const {
        const int row0 = u.pm * BM + wr * 64 + fr, c0 = (u.pn % nper) * 128 + wc * 32 + 8 * fq;
#pragma unroll
        for (int ai = 0; ai < 2; ++ai)
#pragma unroll
            for (int m = 0; m < 4; ++m) { const f32x4 a0 = acc[ai][0][m][0], a1 = acc[ai][0][m][1];
                const f32x4 y0 = a0 * sigm4(a0) * acc[ai][1][m][0] * 4.f, y1 = a1 * sigm4(a1) * acc[ai][1][m][1] * 4.f;
                u32x2 w; w.x = __builtin_amdgcn_cvt_pk_fp8_f32(y0[2], y0[3], __builtin_amdgcn_cvt_pk_fp8_f32(y0[0], y0[1], 0u, false), true);
                w.y = __builtin_amdgcn_cvt_pk_fp8_f32(y1[2], y1[3], __builtin_amdgcn_cvt_pk_fp8_f32(y1[0], y1[1], 0u, false), true);
                *(u32x2*)(O + (size_t)(row0 + ai * HALF + m * 16) * ld + c0) = w; }
    }
};
struct EpiCtxPartial {
    static constexpr bool PERM = false, AFTER_DRAIN = false, MIDK = false, DUPABLE = false;
    bf16_t* P;
    __device__ __forceinline__ void operator()(const f32x4 (&acc)[2][2][4][2], const Unit& u, int wr, int wc, int fr, int fq) const {
        const int row0 = (u.pm - 64) * BM + wr * 64 + fr, c0 = u.pn * 256 + wc * 32 + 4 * fq; bf16_t* Y = P + (size_t)(u.ko >> 8) * 1024 * 1024;
#pragma unroll
        for (int ai = 0; ai < 2; ++ai)
#pragma unroll
            for (int m = 0; m < 4; ++m) { const int row = row0 + ai * HALF + m * 16;
#pragma unroll
                for (int bj = 0; bj < 2; ++bj)
#pragma unroll
                    for (int n = 0; n < 2; ++n) { const f32x4 a = acc[ai][bj][m][n]; u32x2 w; w.x = cvt_pk_bf16(a[0], a[1]); w.y = cvt_pk_bf16(a[2], a[3]); *(u32x2*)(Y + (size_t)row * 1024 + c0 + 128 * bj + 16 * n) = w; } }
    }
};
struct EpiMoeDownTail {
    static constexpr bool PERM = false, AFTER_DRAIN = false, MIDK = false, DUPABLE = false;
    bf16_t* YPT; const float* rowp;
    __device__ __forceinline__ void operator()(const f32x4 (&acc)[2][2][4][2], const Unit& u, int wr, int wc, int fr, int fq) const {
        const int row0 = u.pm * BM + wr * 64 + fr, c0 = (u.pn & 3) * 256 + wc * 32 + 8 * fq; bf16_t* Y = YPT + (size_t)(u.ko >> 8) * 2048 * 1024 - (size_t)32768 * 1024;
#pragma unroll
        for (int ai = 0; ai < 2; ++ai)
#pragma unroll
            for (int m = 0; m < 4; ++m) { const int row = row0 + ai * HALF + m * 16; const float rp = rowp[u.pa * BM + wr * 64 + fr + ai * HALF + m * 16];
#pragma unroll
                for (int bj = 0; bj < 2; ++bj) *(u32x4*)(Y + (size_t)row * 1024 + c0 + 128 * bj) = pack8(acc[ai][bj][m][0] * rp, acc[ai][bj][m][1] * rp); }
    }
};
struct EpiMoeDown {
    static constexpr bool PERM = false, AFTER_DRAIN = false, MIDK = false, DUPABLE = false;
    bf16_t* YP; const float* rowp;
    __device__ __forceinline__ void operator()(const f32x4 (&acc)[2][2][4][2], const Unit& u, int wr, int wc, int fr, int fq) const {
        const int row0 = u.pm * BM + wr * 64 + fr, c0 = (u.pn & 3) * 256 + wc * 32 + 8 * fq;
#pragma unroll
        for (int ai = 0; ai < 2; ++ai)
#pragma unroll
            for (int m = 0; m < 4; ++m) { const int row = row0 + ai * HALF + m * 16; const float rp = rowp[u.pa * BM + wr * 64 + fr + ai * HALF + m * 16];
#pragma unroll
                for (int bj = 0; bj < 2; ++bj) *(u32x4*)(YP + (size_t)row * 1024 + c0 + 128 * bj) = pack8(acc[ai][bj][m][0] * rp, acc[ai][bj][m][1] * rp); }
    }
};

template <class Epi, class Sched, bool ALIGN_EPI = false, bool SP2 = false, bool F8 = false>
__device__ __forceinline__ void gemm_phase(PG8_LAS unsigned char* lds, const Gemm g, const Sched& S, const Epi& E) {
    int tid_o = threadIdx.x; asm volatile("" : "+v"(tid_o));
    const int tid = tid_o, wid = __builtin_amdgcn_readfirstlane(tid >> 6), lane = tid & 63, wr = wid >> 2, wc = wid & 3, fr = lane & 15, fq = lane >> 4;
    const int K = g.K, nt = K / BK;
    unsigned voffA[2], voffB[2];
#pragma unroll
    for (int i = 0; i < 2; ++i) { int R, C; stage_rc(tid * 16 + i * 8192, R, C); const int Rb = Epi::PERM ? ((R & ~31) + perm32(R & 31)) : R;
        voffA[i] = (unsigned)(R * g.ld + C) * 2u; voffB[i] = (unsigned)(Rb * g.ld + C) * 2u; }
    const size_t kstep = (size_t)(BK * 2);
    const size_t hstep = (size_t)HALF * g.ld * 2;
    const size_t tstep = 2 * hstep;
    const unsigned ldsw = (unsigned)wid * 1024u;
    const int aoff = lds_byte(wr * 64 + fr, fq * 8), boff = lds_byte(wc * 32 + fr, fq * 8);
#define PG8_SA(b, h) (((b) * 2 + (h)) * HTB)
#define PG8_SB(b, h) ((4 + (b) * 2 + (h)) * HTB)
#define PG8_STAGE(bufoff, gbase, voff) do { _Pragma("unroll") for (int _i = 0; _i < 2; ++_i) \
        __builtin_amdgcn_global_load_lds((const unsigned*)((const char*)(gbase) + (voff)[_i]), (PG8_LAS unsigned*)(lds + (bufoff) + ldsw + _i * 8192), 16, 0, 0); } while (0)
#define PG8_LDA(dst, b, h) do { if constexpr (F8) { _Pragma("unroll") for (int m = 0; m < 4; ++m) { const v4i_t x_ = *(const PG8_LAS v4i_t*)(lds + PG8_SA(b, h) + aoff + m * 2048), y_ = *(const PG8_LAS v4i_t*)(lds + PG8_SA(b, h) + aoff + m * 2048 + 1024); dst##8[m] = __builtin_shufflevector(x_, y_, 0, 1, 2, 3, 4, 5, 6, 7); } } \
        else { _Pragma("unroll") for (int m = 0; m < 4; ++m) _Pragma("unroll") for (int k = 0; k < 2; ++k) dst[m][k] = *(const PG8_LAS bf16x8*)(lds + PG8_SA(b, h) + aoff + m * 2048 + k * 1024); } } while (0)
#define PG8_LDB(dst, b, h) do { if constexpr (F8) { _Pragma("unroll") for (int n = 0; n < 2; ++n) { const v4i_t x_ = *(const PG8_LAS v4i_t*)(lds + PG8_SB(b, h) + boff + n * 2048), y_ = *(const PG8_LAS v4i_t*)(lds + PG8_SB(b, h) + boff + n * 2048 + 1024); dst##8[n] = __builtin_shufflevector(x_, y_, 0, 1, 2, 3, 4, 5, 6, 7); } } \
        else { _Pragma("unroll") for (int n = 0; n < 2; ++n) _Pragma("unroll") for (int k = 0; k < 2; ++k) dst[n][k] = *(const PG8_LAS bf16x8*)(lds + PG8_SB(b, h) + boff + n * 2048 + k * 1024); } } while (0)
#define PG8_MMA(ai, bj, At, Bt) do { if constexpr (F8) { __builtin_amdgcn_s_setprio(1); _Pragma("unroll") for (int m = 0; m < 4; ++m) _Pragma("unroll") for (int n = 0; n < 2; ++n) \
        asm volatile("v_mfma_scale_f32_16x16x128_f8f6f4 %0, %1, %2, %0, %3, %4 op_sel_hi:[0,0,0]" : "+v"(acc[ai][bj][m][n]) : "v"(Bt##8[n]), "v"(At##8[m]), "v"(scw_), "v"(sca_));     __builtin_amdgcn_s_setprio(0); } else { __builtin_amdgcn_s_setprio(1); _Pragma("unroll") for (int m = 0; m < 4; ++m) _Pragma("unroll") for (int n = 0; n < 2; ++n) _Pragma("unroll") for (int k = 0; k < 2; ++k) \
        acc[ai][bj][m][n] = __builtin_amdgcn_mfma_f32_16x16x32_bf16(Bt[n][k], At[m][k], acc[ai][bj][m][n], 0, 0, 0); __builtin_amdgcn_s_setprio(0); } } while (0)
#define PG8_WAIT_V(n) asm volatile("s_waitcnt vmcnt(" #n ")" ::: "memory")
#define PG8_WAIT_L(n) asm volatile("s_waitcnt lgkmcnt(" #n ")" ::: "memory")
#define PG8_BAR __builtin_amdgcn_s_barrier()
#define PG8_SCHED __builtin_amdgcn_sched_barrier(0)
    Unit cur, nxt; int ui = 0;
    if (!S.next(0, cur)) return;
    f32x4 acc[2][2][4][2];
#pragma unroll
    for (int a = 0; a < 2; ++a)
#pragma unroll
        for (int b = 0; b < 2; ++b)
#pragma unroll
            for (int m = 0; m < 4; ++m)
#pragma unroll
                for (int n = 0; n < 2; ++n) acc[a][b][m][n] = (f32x4){0.f, 0.f, 0.f, 0.f};
    int scw_ = g.sc_w, sca_ = g.sc_a; asm volatile("" : "+v"(scw_), "+v"(sca_));
    bf16x8 At[4][2], B0[2][2], B1[2][2]; v8i_t At8[4], B08[2], B18[2];
    const char* cA = (const char*)g.A + (size_t)(g.a_pa ? cur.pa : cur.pm) * tstep + (size_t)cur.ko * 2; const char* cB = (const char*)g.Bt + (size_t)cur.pn * tstep + (size_t)cur.ko * 2;
    S.a_ready(cur);
    if constexpr (SP2) {
        PG8_STAGE(PG8_SB(0, 0), cB, voffB); PG8_STAGE(PG8_SB(0, 1), cB + hstep, voffB); PG8_STAGE(PG8_SA(0, 0), cA, voffA); PG8_STAGE(PG8_SA(0, 1), cA + hstep, voffA);
        if (wr == 1) PG8_BAR;
        PG8_WAIT_V(2); PG8_BAR;
        PG8_STAGE(PG8_SB(1, 0), cB + kstep, voffB); PG8_STAGE(PG8_SA(1, 0), cA + kstep, voffA); PG8_STAGE(PG8_SB(1, 1), cB + hstep + kstep, voffB);
        PG8_WAIT_V(6); PG8_BAR;
    } else {
        PG8_STAGE(PG8_SB(0, 0), cB, voffB); PG8_STAGE(PG8_SA(0, 0), cA, voffA); PG8_STAGE(PG8_SB(0, 1), cB + hstep, voffB); PG8_STAGE(PG8_SA(0, 1), cA + hstep, voffA);
        if (wr == 1) PG8_BAR;
        PG8_WAIT_V(4); PG8_BAR;
        PG8_STAGE(PG8_SB(1, 0), cB + kstep, voffB); PG8_STAGE(PG8_SA(1, 0), cA + kstep, voffA); PG8_STAGE(PG8_SB(1, 1), cB + hstep + kstep, voffB);
        PG8_WAIT_V(6); PG8_BAR;
    }
    for (;;) {
        const bool has_next = S.next(ui + 1, nxt);
        const char* nA = has_next ? (const char*)g.A + (size_t)(g.a_pa ? nxt.pa : nxt.pm) * tstep + (size_t)nxt.ko * 2 : cA; const char* nB = has_next ? (const char*)g.Bt + (size_t)nxt.pn * tstep + (size_t)nxt.ko * 2 : cB;
#pragma unroll 1
        for (int t = 0; t < nt; t += 2) {
            const bool last = (t == nt - 2);
            const char* a1 = cA + (size_t)(t + 1) * kstep;
            const char* a2 = last ? nA : cA + (size_t)(t + 2) * kstep; const char* b2 = last ? nB : cB + (size_t)(t + 2) * kstep;
            const char* a3 = a2 + kstep; const char* b3 = b2 + kstep;
            if (last && has_next) S.a_ready(nxt);
            if constexpr (Epi::MIDK) { if (t == 8 || t == 16) E.mid(acc, cur, wr, wc, fr, fq, t >> 3); }
            if constexpr (SP2) {
            PG8_LDB(B0, 0, 0); PG8_LDB(B1, 0, 1); PG8_SCHED; PG8_LDA(At, 0, 0); PG8_STAGE(PG8_SA(1, 1), a1 + hstep, voffA);
            PG8_WAIT_V(8); PG8_WAIT_L(0); PG8_BAR; PG8_MMA(0, 0, At, B0); PG8_MMA(0, 1, At, B1); PG8_BAR; PG8_SCHED;
            PG8_LDA(At, 0, 1); PG8_STAGE(PG8_SB(0, 0), b2, voffB); PG8_STAGE(PG8_SB(0, 1), b2 + hstep, voffB); PG8_STAGE(PG8_SA(0, 0), a2, voffA);
            PG8_WAIT_V(8); PG8_WAIT_L(0); PG8_BAR; PG8_MMA(1, 0, At, B0); PG8_MMA(1, 1, At, B1); PG8_BAR; PG8_SCHED;
            PG8_LDB(B0, 1, 0); PG8_LDB(B1, 1, 1); PG8_SCHED; PG8_LDA(At, 1, 0); PG8_STAGE(PG8_SA(0, 1), a2 + hstep, voffA);
            PG8_WAIT_V(8); PG8_WAIT_L(0); PG8_BAR; PG8_MMA(0, 0, At, B0); PG8_MMA(0, 1, At, B1); PG8_BAR; PG8_SCHED;
            PG8_LDA(At, 1, 1); PG8_STAGE(PG8_SB(1, 0), b3, voffB); PG8_STAGE(PG8_SB(1, 1), b3 + hstep, voffB); PG8_STAGE(PG8_SA(1, 0), a3, voffA);
            PG8_WAIT_V(8); PG8_WAIT_L(0); PG8_BAR; PG8_MMA(1, 0, At, B0); PG8_MMA(1, 1, At, B1); PG8_BAR; PG8_SCHED;
            } else {
            PG8_LDB(B0, 0, 0); PG8_SCHED; PG8_LDA(At, 0, 0); PG8_STAGE(PG8_SA(1, 1), a1 + hstep, voffA);
            PG8_WAIT_L(8); PG8_BAR; PG8_WAIT_L(0); PG8_MMA(0, 0, At, B0); PG8_BAR; PG8_SCHED;
            PG8_LDB(B1, 0, 1); PG8_STAGE(PG8_SB(0, 0), b2, voffB);
            PG8_BAR; PG8_WAIT_L(0); PG8_MMA(0, 1, At, B1); PG8_BAR;
            PG8_LDA(At, 0, 1); PG8_STAGE(PG8_SA(0, 0), a2, voffA);
            PG8_BAR; PG8_WAIT_L(0); PG8_MMA(1, 0, At, B0); PG8_BAR; PG8_SCHED;
            PG8_STAGE(PG8_SB(0, 1), b2 + hstep, voffB);
            PG8_WAIT_V(6); PG8_BAR; PG8_MMA(1, 1, At, B1); PG8_BAR;
            PG8_LDB(B0, 1, 0); PG8_SCHED; PG8_LDA(At, 1, 0); PG8_STAGE(PG8_SA(0, 1), a2 + hstep, voffA);
            PG8_WAIT_L(8); PG8_BAR; PG8_WAIT_L(0); PG8_MMA(0, 0, At, B0); PG8_BAR; PG8_SCHED;
            PG8_LDB(B1, 1, 1); PG8_STAGE(PG8_SB(1, 0), b3, voffB);
            PG8_BAR; PG8_WAIT_L(0); PG8_MMA(0, 1, At, B1); PG8_BAR;
            PG8_LDA(At, 1, 1); PG8_STAGE(PG8_SA(1, 0), a3, voffA);
            PG8_BAR; PG8_WAIT_L(0); PG8_MMA(1, 0, At, B0); PG8_BAR; PG8_SCHED;
            PG8_STAGE(PG8_SB(1, 1), b3 + hstep, voffB);
            PG8_WAIT_V(6); PG8_BAR; PG8_MMA(1, 1, At, B1); PG8_BAR;
            }
        }
        if constexpr (F8) asm volatile("s_nop 15\n\ts_nop 7" ::: "memory");
        if constexpr (ALIGN_EPI) { if (wr == 0) PG8_BAR; }
        if constexpr (!Epi::AFTER_DRAIN) { E(acc, cur, wr, wc, fr, fq);
#ifdef DUP_EPI
            if constexpr (Epi::DUPABLE) { asm volatile("" ::: "memory"); E(acc, cur, wr, wc, fr, fq); }
#endif
            S.done(cur); }
        if (!has_next) break;
#pragma unroll
        for (int a = 0; a < 2; ++a)
#pragma unroll
            for (int b = 0; b < 2; ++b)
#pragma unroll
                for (int m = 0; m < 4; ++m)
#pragma unroll
                    for (int n = 0; n < 2; ++n) acc[a][b][m][n] = (f32x4){0.f, 0.f, 0.f, 0.f};
        cur = nxt; cA = nA; cB = nB; ++ui;
        if constexpr (ALIGN_EPI) { if (wr == 1) PG8_BAR; }
    }
    PG8_WAIT_V(0);
    if constexpr (!ALIGN_EPI) { if (wr == 0) PG8_BAR; }
    PG8_BAR;
    if constexpr (Epi::AFTER_DRAIN) { E.fused(acc, cur, wr, wc, fr, fq, lds, wid, lane); S.done(cur); }
#undef PG8_SA
#undef PG8_SB
#undef PG8_STAGE
#undef PG8_LDA
#undef PG8_LDB
#undef PG8_MMA
#undef PG8_WAIT_V
#undef PG8_WAIT_L
#undef PG8_BAR
#undef PG8_SCHED
}
}


#include <hip/hip_bf16.h>
#include <cmath>

namespace attn_body {
using bf16=__hip_bfloat16;
using bf16x8=__attribute__((ext_vector_type(8)))short;
using s16x4=__attribute__((ext_vector_type(4)))short;
using f32x16=__attribute__((ext_vector_type(16)))float;
using u32x4=__attribute__((ext_vector_type(4)))unsigned;
constexpr int D=64;
constexpr int NW=8,QBLK=32,QB=QBLK*NW,KVBLK=64;
constexpr int ATTN_UNIT_ROWS=QB;
__device__ __forceinline__ int crow(int r,int hi){return (r&3)+8*(r>>2)+4*hi;}
#define SBAR() __builtin_amdgcn_sched_barrier(0)
__device__ __forceinline__ void cmask(f32x16&p0,f32x16&p1,int jb,int qrel,int hi){
  const float NEG=-INFINITY; int kb=64*jb+4*hi;
  #pragma unroll
  for(int r=0;r<16;++r){int kv=kb+(r&3)+8*(r>>2); if(kv>qrel)p0[r]=NEG; if(kv+32>qrel)p1[r]=NEG;}
}

constexpr int NSLOT=3, SLOTB=8192;
constexpr int LDS_K=0, LDS_V=NSLOT*SLOTB, LDS_WS=2*NSLOT*SLOTB, LDS_OST=LDS_WS+NW*64*4, LDS_BYTES=LDS_OST+NW*4096;
constexpr float C2=0.125f*1.4426950408889634f;
__device__ __forceinline__ void glds16(const void*gsrc,unsigned lds_dst){unsigned keep;
  asm volatile("s_mov_b32 %0, m0\n\ts_mov_b32 m0, %2\n\ts_nop 0\n\tglobal_load_lds_dwordx4 %1, off\n\ts_mov_b32 m0, %0":"=&s"(keep):"v"(gsrc),"s"(lds_dst):"memory");}
template<int OFF> __device__ __forceinline__ void glds16s(const void*sbase,unsigned voff,unsigned lds_dst){unsigned keep;
  asm volatile("s_mov_b32 %0, m0\n\ts_mov_b32 m0, %2\n\ts_nop 0\n\tglobal_load_lds_dwordx4 %1, %3 offset:%c4\n\ts_mov_b32 m0, %0":"=&s"(keep):"v"(voff),"s"(lds_dst),"s"(sbase),"i"(OFF):"memory");}
__device__ __forceinline__ float max3f(float a,float b,float c){float r;asm("v_max3_f32 %0, %1, %2, %3":"=v"(r):"v"(a),"v"(b),"v"(c));return r;}
__device__ __forceinline__ float max2f(float a,float b){float r;asm("v_max_f32_e32 %0, %1, %2":"=v"(r):"v"(a),"v"(b));return r;}
__device__ __forceinline__ float fadd_s(float a,float b){float r;asm("v_add_f32_e32 %0, %1, %2":"=v"(r):"v"(a),"v"(b));return r;}
__device__ __forceinline__ float fsub_s(float a,float b){float r;asm("v_sub_f32_e32 %0, %1, %2":"=v"(r):"v"(a),"v"(b));return r;}
typedef float f32x2_t __attribute__((ext_vector_type(2))); typedef __bf16 bf16x2_t __attribute__((ext_vector_type(2)));
__device__ __forceinline__ unsigned cvtpk_s(float lo,float hi){f32x2_t v={lo,hi};bf16x2_t b=__builtin_convertvector(v,bf16x2_t);return __builtin_bit_cast(unsigned,b);}
#define WAIT_BAR(N) asm volatile("s_waitcnt vmcnt(" #N ") lgkmcnt(0)\n\ts_barrier":::"memory")

__device__ __forceinline__ void qkt(f32x16&p0,f32x16&p1,const char*Kslot,const bf16x8*qr,const f32x16&negm,int r32,int hi){
  const char*kb=Kslot+hi*1024+r32*16;
  #pragma unroll
  for(int d0=0;d0<4;++d0){
    const bf16x8 b0=*reinterpret_cast<const bf16x8*>(kb+d0*2048);
    const bf16x8 b1=*reinterpret_cast<const bf16x8*>(kb+d0*2048+512);
    if(d0==0){p0=__builtin_amdgcn_mfma_f32_32x32x16_bf16(b0,qr[0],negm,0,0,0);p1=__builtin_amdgcn_mfma_f32_32x32x16_bf16(b1,qr[0],negm,0,0,0);}
    else{p0=__builtin_amdgcn_mfma_f32_32x32x16_bf16(b0,qr[d0],p0,0,0,0);p1=__builtin_amdgcn_mfma_f32_32x32x16_bf16(b1,qr[d0],p1,0,0,0);}}
}
typedef __attribute__((address_space(3))) const char* lds_cptr;
typedef short v4i16_t __attribute__((ext_vector_type(4)));
__device__ __forceinline__ void kload8(bf16x8*kf,lds_cptr kp){
  kf[0]=*(const __attribute__((address_space(3))) bf16x8*)(kp);      kf[1]=*(const __attribute__((address_space(3))) bf16x8*)(kp+512);
  kf[2]=*(const __attribute__((address_space(3))) bf16x8*)(kp+2048); kf[3]=*(const __attribute__((address_space(3))) bf16x8*)(kp+2560);
  kf[4]=*(const __attribute__((address_space(3))) bf16x8*)(kp+4096); kf[5]=*(const __attribute__((address_space(3))) bf16x8*)(kp+4608);
  kf[6]=*(const __attribute__((address_space(3))) bf16x8*)(kp+6144); kf[7]=*(const __attribute__((address_space(3))) bf16x8*)(kp+6656);
}
__device__ __forceinline__ void kload2(bf16x8*kf,lds_cptr kp,int j){ kf[2*j]=*(const __attribute__((address_space(3))) bf16x8*)(kp+j*2048); kf[2*j+1]=*(const __attribute__((address_space(3))) bf16x8*)(kp+j*2048+512); }
__device__ __forceinline__ s16x4 vtr(lds_cptr p){ return __builtin_bit_cast(s16x4,__builtin_amdgcn_ds_read_tr16_b64_v4i16((__attribute__((address_space(3))) v4i16_t*)p)); }
__device__ __forceinline__ float rowmax(const f32x16&p0,const f32x16&p1){
  float a=max3f(p0[0],p0[1],p1[0]),b=max3f(p0[2],p0[3],p1[1]);a=max3f(a,p1[2],p1[3]);
  #pragma unroll
  for(int r=4;r<16;r+=4){a=max3f(a,p0[r],p0[r+1]);b=max3f(b,p0[r+2],p0[r+3]);a=max3f(a,p1[r],p1[r+1]);b=max3f(b,p1[r+2],p1[r+3]);}
  const float m=max2f(a,b);
  auto rr=__builtin_amdgcn_permlane32_swap(__float_as_uint(m),__float_as_uint(m),false,false);
  return max2f(__uint_as_float(rr[0]),__uint_as_float(rr[1]));
}
__device__ __forceinline__ void pv(f32x16*o,int vb,bf16x8 pa0,bf16x8 pa1,bf16x8 pa2,bf16x8 pa3){
  #pragma unroll
  for(int d0=0;d0<2;++d0){s16x4 lo[4],hi[4];
    #pragma unroll
    for(int ks=0;ks<4;++ks){
      asm volatile("ds_read_b64_tr_b16 %0,%1 offset:%c2":"=&v"(lo[ks]):"v"(vb),"i"(d0*4096+ks*1024):"memory");
      asm volatile("ds_read_b64_tr_b16 %0,%1 offset:%c2":"=&v"(hi[ks]):"v"(vb),"i"(d0*4096+ks*1024+512):"memory");}
    asm volatile("s_waitcnt lgkmcnt(0)":::"memory");SBAR();
    #define PK(k) (bf16x8){lo[k][0],lo[k][1],lo[k][2],lo[k][3],hi[k][0],hi[k][1],hi[k][2],hi[k][3]}
    o[d0]=__builtin_amdgcn_mfma_f32_32x32x16_bf16(pa0,PK(0),o[d0],0,0,0);
    o[d0]=__builtin_amdgcn_mfma_f32_32x32x16_bf16(pa1,PK(1),o[d0],0,0,0);
    o[d0]=__builtin_amdgcn_mfma_f32_32x32x16_bf16(pa2,PK(2),o[d0],0,0,0);
    o[d0]=__builtin_amdgcn_mfma_f32_32x32x16_bf16(pa3,PK(3),o[d0],0,0,0);
    #undef PK
  }
}

#ifndef ATTN_STORE16
#define ATTN_STORE16(p,v) (*(u32x4*)(p)=(v))
#endif
template<int THRL,bool FIXREF=false> __device__ __forceinline__ void attn_unit(const bf16*Qu,int qp,const bf16*__restrict__ Kh,const bf16*__restrict__ Vh,int kvp,bf16*Ou,int op,int NT,char*shm,float cref=0.f){
  int tid_o=threadIdx.x; asm volatile("":"+v"(tid_o)); const int tid=tid_o,lane=tid&63,r32=lane&31,hi=lane>>5; const int wid=__builtin_amdgcn_readfirstlane(tid>>6);
  const bf16*Qw=Qu+(long)(wid*QBLK)*qp;
  const unsigned lds0=(unsigned)(uintptr_t)shm;
  float*wsf=(float*)(shm+LDS_WS)+wid*64;
  const unsigned kvo=(unsigned)(lane*kvp+wid*8)*2u, vvo=(unsigned)((16*(wid&3)+(lane>>2))*kvp+(wid>>2)*32+(lane&3)*8)*2u;
  const unsigned kdst=lds0+LDS_K+wid*1024, vdst=lds0+LDS_V+wid*1024;
  #define DMA_K(t,slot) glds16s<0>((const char*)Kh+(size_t)(t)*(KVBLK*2)*kvp,kvo,(unsigned)__builtin_amdgcn_readfirstlane(kdst+(slot)))
  #define DMA_V(t,slot) glds16s<0>((const char*)Vh+(size_t)(t)*(KVBLK*2)*kvp,vvo,(unsigned)__builtin_amdgcn_readfirstlane(vdst+(slot)))
  const int vb0=(int)(lds0+LDS_V)+((lane>>4)&1)*32+(lane&3)*8+(4*hi+((lane&15)>>2))*64;
  const char*Kbase=shm+LDS_K; bf16x8 kf[8];
  const lds_cptr shm3=(lds_cptr)shm; const lds_cptr kp0=shm3+LDS_K+hi*1024+r32*16; const lds_cptr vp0=shm3+LDS_V+((lane>>4)&1)*32+(lane&3)*8+(4*hi+((lane&15)>>2))*64;
  DMA_K(0,0);DMA_V(0,0);DMA_K(1,SLOTB);
  bf16x8 qr[4];
  #pragma unroll
  for(int d0=0;d0<4;++d0)qr[d0]=*reinterpret_cast<const bf16x8*>(&Qw[(long)r32*qp+d0*16+hi*8]);
  float mhat=0.f,l_reg=0.f;f32x16 o[2];o[0]=f32x16{};o[1]=f32x16{};f32x16 negm=f32x16{}; if constexpr(FIXREF){ _Pragma("unroll") for(int r=0;r<16;++r)negm[r]=-cref; } asm volatile("":"+v"(negm));
  #define CMASK(P0,P1,t) do{}while(0)
  bool resc=false;
  #define START(P0,P1) do{ resc=false; if constexpr(!FIXREF){ const float rm=rowmax(P0,P1); \
    { const float dl=rm; mhat=fadd_s(mhat,dl); \
      _Pragma("unroll") for(int r=0;r<16;++r){P0[r]=fsub_s(P0[r],dl);P1[r]=fsub_s(P1[r],dl);} \
      _Pragma("unroll") for(int r=0;r<16;++r)negm[r]=-mhat; asm volatile("":"+v"(negm)); } } \
    _Pragma("unroll") for(int r=0;r<16;++r)P0[r]=__builtin_amdgcn_exp2f(P0[r]); }while(0)
  #define RESC() do{ if constexpr(!FIXREF){ if(resc){ asm volatile("s_waitcnt lgkmcnt(0)":::"memory"); \
      _Pragma("unroll") for(int d_=0;d_<2;++d_) _Pragma("unroll") for(int r=0;r<16;++r)o[d_][r]*=wsf[crow(r,hi)]; } } }while(0)
  f32x16 pA0,pA1,pB0,pB1;
  int sl_prev=0,sl_cur=0,sl_next=SLOTB;
  #define ROT() do{sl_prev=sl_cur;sl_cur=sl_next;sl_next=(sl_next==(NSLOT-1)*SLOTB)?0:sl_next+SLOTB;}while(0)
  DMA_K(2,2*SLOTB);
  WAIT_BAR(3);
  qkt(pA0,pA1,Kbase,qr,negm,r32,hi);asm volatile("s_nop 15\n\ts_nop 7":"+v"(pA0),"+v"(pA1));CMASK(pA0,pA1,0);
  START(pA0,pA1);
  _Pragma("unroll") for(int r=0;r<16;++r)pA1[r]=__builtin_amdgcn_exp2f(pA1[r]);
  WAIT_BAR(0);
  DMA_K(3,0);DMA_V(1,SLOTB);
  ROT();
  kload8(kf,kp0+sl_cur);
  WAIT_BAR(2);
  s16x4 vlo[8],vhi[8]; u32x4 pw0,pw1,pw2,pw3;
  #define PKW(P,B) cvtpk_s(P[B],P[B+1])
  #define PAF(k) __builtin_bit_cast(bf16x8,pw##k)
  #define VFR(i) (bf16x8){vlo[i][0],vlo[i][1],vlo[i][2],vlo[i][3],vhi[i][0],vhi[i][1],vhi[i][2],vhi[i][3]}
  #define PIN(x) asm volatile("":"+v"(x))
  #define MX3(a,b,c) __builtin_fmaxf(__builtin_fmaxf((a),(b)),(c))
  #define GAPA(MF,A0,A1,A2,A3,W0,W1,PW) do{ MF; sacc+=A0; sacc+=A1; sacc+=A2; sacc+=A3; PIN(sacc); W0; W1; PIN(PW); SBAR(); }while(0)
  #define EX(v) __builtin_amdgcn_exp2f(v)
  #define GAPB(MF,X,B) do{ MF; X[B]=EX(X[B]); X[B+1]=EX(X[B+1]); X[B+2]=EX(X[B+2]); X[B+3]=EX(X[B+3]); PIN(X); SBAR(); }while(0)
  #define VRD(i) do{ vlo[i]=vtr(vp_+(((i)>>2)*4096+((i)&3)*1024)); vhi[i]=vtr(vp_+(((i)>>2)*4096+((i)&3)*1024+512)); }while(0)
  #define KRD(G,j) do{ if(G){ kload2(kf,kp0+sl_next,j); SBAR(); } }while(0)
  #define STEP(C0,C1,P0,P1,t,GK,GV,GL) do{ SBAR(); \
    const lds_cptr vp_=vp0+sl_prev; \
    VRD(0); SBAR(); float sacc=(P0[0]+P0[1]); \
    GAPA(C0=__builtin_amdgcn_mfma_f32_32x32x16_bf16(kf[0],qr[0],negm,0,0,0), P0[2],P0[3],P0[4],P0[5],     pw0[0]=PKW(P0,0), pw0[1]=PKW(P0,2), pw0); \
    VRD(4); SBAR(); GAPA(C1=__builtin_amdgcn_mfma_f32_32x32x16_bf16(kf[1],qr[0],negm,0,0,0), P0[6],P0[7],P0[8],P0[9],     pw0[2]=PKW(P0,4), pw0[3]=PKW(P0,6), pw0); \
    VRD(1); SBAR(); GAPA(C0=__builtin_amdgcn_mfma_f32_32x32x16_bf16(kf[2],qr[1],C0,0,0,0),   P0[10],P0[11],P0[12],P0[13], pw1[0]=PKW(P0,8), pw1[1]=PKW(P0,10), pw1); \
    VRD(5); SBAR(); GAPA(C1=__builtin_amdgcn_mfma_f32_32x32x16_bf16(kf[3],qr[1],C1,0,0,0),   P0[14],P0[15],P1[0],P1[1],   pw1[2]=PKW(P0,12),pw1[3]=PKW(P0,14), pw1); \
    VRD(2); SBAR(); GAPA(C0=__builtin_amdgcn_mfma_f32_32x32x16_bf16(kf[4],qr[2],C0,0,0,0),   P1[2],P1[3],P1[4],P1[5],     pw2[0]=PKW(P1,0), pw2[1]=PKW(P1,2), pw2); \
    VRD(6); SBAR(); GAPA(C1=__builtin_amdgcn_mfma_f32_32x32x16_bf16(kf[5],qr[2],C1,0,0,0),   P1[6],P1[7],P1[8],P1[9],     pw2[2]=PKW(P1,4), pw2[3]=PKW(P1,6), pw2); \
    VRD(3); SBAR(); GAPA(C0=__builtin_amdgcn_mfma_f32_32x32x16_bf16(kf[6],qr[3],C0,0,0,0),   P1[10],P1[11],P1[12],P1[13], pw3[0]=PKW(P1,8), pw3[1]=PKW(P1,10), pw3); \
    VRD(7); SBAR(); GAPA(C1=__builtin_amdgcn_mfma_f32_32x32x16_bf16(kf[7],qr[3],C1,0,0,0),   P1[14],P1[15],0.f,0.f,       pw3[2]=PKW(P1,12),pw3[3]=PKW(P1,14), pw3); \
    l_reg+=sacc; \
    if(GK){DMA_K((t)+3,sl_cur);} if(GV){DMA_V((t)+1,sl_next);} \
    CMASK(C0,C1,t); \
    if constexpr(!FIXREF){ float a=MX3(C0[0],C0[1],C1[0]),b=MX3(C0[2],C0[3],C1[1]); a=MX3(a,C1[2],C1[3]); \
      _Pragma("unroll") for(int r=4;r<16;r+=4){a=MX3(a,C0[r],C0[r+1]);b=MX3(b,C0[r+2],C0[r+3]);a=MX3(a,C1[r],C1[r+1]);b=MX3(b,C1[r+2],C1[r+3]);} \
      float rm=__builtin_fmaxf(a,b); { auto rr=__builtin_amdgcn_permlane32_swap(__float_as_uint(rm),__float_as_uint(rm),false,false); rm=__builtin_fmaxf(__uint_as_float(rr[0]),__uint_as_float(rr[1])); } \
      resc=false; \
      if(__builtin_expect(__any(rm>(float)THRL),0)){ const float dl=__builtin_fmaxf(rm,0.f); mhat+=dl; \
        _Pragma("unroll") for(int r=0;r<16;++r){C0[r]-=dl;C1[r]-=dl;} \
        _Pragma("unroll") for(int r=0;r<16;++r)negm[r]=-mhat; asm volatile("":"+v"(negm)); \
        const float f=__builtin_amdgcn_exp2f(-dl); l_reg*=f; if(hi==0)wsf[r32]=f; resc=true; } } \
    SBAR(); \
    GAPB(o[0]=__builtin_amdgcn_mfma_f32_32x32x16_bf16(PAF(0),VFR(0),o[0],0,0,0), C0,0); \
    GAPB(o[1]=__builtin_amdgcn_mfma_f32_32x32x16_bf16(PAF(0),VFR(4),o[1],0,0,0), C0,4); \
    KRD(GL,0); GAPB(o[0]=__builtin_amdgcn_mfma_f32_32x32x16_bf16(PAF(1),VFR(1),o[0],0,0,0), C0,8); \
    KRD(GL,1); GAPB(o[1]=__builtin_amdgcn_mfma_f32_32x32x16_bf16(PAF(1),VFR(5),o[1],0,0,0), C0,12); \
    KRD(GL,2); GAPB(o[0]=__builtin_amdgcn_mfma_f32_32x32x16_bf16(PAF(2),VFR(2),o[0],0,0,0), C1,0); \
    KRD(GL,3); GAPB(o[1]=__builtin_amdgcn_mfma_f32_32x32x16_bf16(PAF(2),VFR(6),o[1],0,0,0), C1,4); \
    GAPB(o[0]=__builtin_amdgcn_mfma_f32_32x32x16_bf16(PAF(3),VFR(3),o[0],0,0,0), C1,8); \
    GAPB(o[1]=__builtin_amdgcn_mfma_f32_32x32x16_bf16(PAF(3),VFR(7),o[1],0,0,0), C1,12); \
    }while(0)
  int t=1;
  #undef CMASK
  #define CMASK(P0,P1,t) do{}while(0)
  for(;t+5<NT;t+=2){
    STEP(pB0,pB1,pA0,pA1,t,true,true,true);     WAIT_BAR(2); RESC(); ROT();
    STEP(pA0,pA1,pB0,pB1,t+1,true,true,true);   WAIT_BAR(2); RESC(); ROT();
  }
  #undef CMASK
  #define CMASK(P0,P1,t) do{}while(0)
  #define ENDW(tt) do{ if((tt)+3<NT){WAIT_BAR(2);} else if((tt)+2<NT){WAIT_BAR(1);} else {WAIT_BAR(0);} }while(0)
  for(;t+1<NT;t+=2){
    STEP(pB0,pB1,pA0,pA1,t,(t+3<NT),(t+1<NT),(t+1<NT));       ENDW(t);   RESC(); ROT();
    STEP(pA0,pA1,pB0,pB1,t+1,(t+4<NT),(t+2<NT),(t+2<NT));     ENDW(t+1); RESC(); ROT();
  }
  STEP(pB0,pB1,pA0,pA1,NT-1,false,false,false); RESC();
  { float sacc=pB0[0]+pB0[1]; _Pragma("unroll") for(int r=2;r<16;++r)sacc+=pB0[r]; _Pragma("unroll") for(int r=0;r<16;++r)sacc+=pB1[r]; l_reg+=sacc;
    pw0=(u32x4){PKW(pB0,0),PKW(pB0,2),PKW(pB0,4),PKW(pB0,6)};pw1=(u32x4){PKW(pB0,8),PKW(pB0,10),PKW(pB0,12),PKW(pB0,14)};pw2=(u32x4){PKW(pB1,0),PKW(pB1,2),PKW(pB1,4),PKW(pB1,6)};pw3=(u32x4){PKW(pB1,8),PKW(pB1,10),PKW(pB1,12),PKW(pB1,14)};
    SBAR(); pv(o,vb0+sl_cur,PAF(0),PAF(1),PAF(2),PAF(3)); }
  #undef PKW
  #undef PAF
  #undef VFR
  #undef PIN
  #undef MX3
  #undef GAPA
  #undef GAPB
  #undef EX
  #undef VRD
  #undef KRD
  #undef STEP
  #undef ENDW
  __builtin_amdgcn_s_setprio(0);
  {auto rr=__builtin_amdgcn_permlane32_swap(__float_as_uint(l_reg),__float_as_uint(l_reg),false,false);l_reg=__uint_as_float(rr[0])+__uint_as_float(rr[1]);}
  if(hi==0)wsf[32+r32]=l_reg;asm volatile("s_waitcnt lgkmcnt(0)":::"memory");
  float rli[16];
  #pragma unroll
  for(int r=0;r<16;++r)rli[r]=__builtin_amdgcn_rcpf(wsf[32+crow(r,hi)]);
  bf16*Ow=Ou+(long)(wid*QBLK)*op;
  { bf16*stg=(bf16*)(shm+LDS_OST)+wid*2048;
    #pragma unroll
    for(int r=0;r<16;++r){const int orow=crow(r,hi);
      #pragma unroll
      for(int d0=0;d0<2;++d0)stg[orow*64+d0*32+r32]=__float2bfloat16(o[d0][r]*rli[r]);}
    asm volatile("s_waitcnt lgkmcnt(0)":::"memory");
    #pragma unroll
    for(int i=0;i<4;++i){const int row=i*8+(lane>>3),ch=lane&7; const u32x4 v=*(const u32x4*)(stg+row*64+ch*8); ATTN_STORE16(Ow+(long)row*op+ch*8,v);} }
  asm volatile("s_waitcnt lgkmcnt(0)\n\ts_barrier":::"memory");
  #undef DMA_K
  #undef DMA_V
  #undef CMASK
  #undef START
  #undef RESC
  #undef ROT
}
constexpr int ATTN_LDS_BYTES=LDS_BYTES;
constexpr int C2_KSL=8192, C2_VSL=16384, C2_LK=0, C2_LV=3*C2_KSL, C2_LWS=C2_LV+2*C2_VSL, C2_END=C2_LWS+NW*64*4, C2_STASH=65536;
static_assert(C2_END<=C2_STASH,"c2 lds");
template<int MODE,int THRL> __device__ __forceinline__ void attn_unit_v128(const bf16*Qu,int qp,const bf16*__restrict__ Kh,const bf16*__restrict__ Vh,int kvp,bf16*Ou,int op,int NT,char*shm,float lam,float oscale,const float*__restrict__ sg){
  int tid_o=threadIdx.x; asm volatile("":"+v"(tid_o)); const int tid=tid_o,lane=tid&63,r32=lane&31,hi=lane>>5; const int wid=__builtin_amdgcn_readfirstlane(tid>>6);
  const bf16*Qw=Qu+(long)(wid*QBLK)*qp;
  const unsigned lds0=(unsigned)(uintptr_t)shm;
  float*wsf=(float*)(shm+C2_LWS)+wid*64;
  const unsigned kvo=(unsigned)(lane*kvp+wid*8)*2u, vvo=(unsigned)((16*(wid&3)+(lane>>2))*kvp+(wid>>2)*32+(lane&3)*8)*2u;
  const unsigned kdst=lds0+C2_LK+wid*1024, vdst=lds0+C2_LV+wid*1024;
  #define XK(t,slot) glds16s<0>((const char*)Kh+(size_t)(t)*(KVBLK*2)*kvp,kvo,(unsigned)__builtin_amdgcn_readfirstlane(kdst+(slot)))
  #define XV(t,slot) do{ glds16s<0>((const char*)Vh+(size_t)(t)*(KVBLK*2)*kvp,vvo,(unsigned)__builtin_amdgcn_readfirstlane(vdst+(slot))); glds16s<0>((const char*)Vh+128+(size_t)(t)*(KVBLK*2)*kvp,vvo,(unsigned)__builtin_amdgcn_readfirstlane(vdst+8192+(slot))); }while(0)
  const char*Kbase=shm+C2_LK; bf16x8 kf[8];
  const lds_cptr shm3=(lds_cptr)shm; const lds_cptr kp0=shm3+C2_LK+hi*1024+r32*16; const lds_cptr vp0=shm3+C2_LV+((lane>>4)&1)*32+(lane&3)*8+(4*hi+((lane&15)>>2))*64;
  const int vb0=(int)(lds0+C2_LV)+((lane>>4)&1)*32+(lane&3)*8+(4*hi+((lane&15)>>2))*64;
  XK(0,0);XV(0,0);XK(1,C2_KSL);
  bf16x8 qr[4];
  #pragma unroll
  for(int d0=0;d0<4;++d0)qr[d0]=*reinterpret_cast<const bf16x8*>(&Qw[(long)r32*qp+d0*16+hi*8]);
  float mhat=0.f,l_reg=0.f;f32x16 o[4];o[0]=f32x16{};o[1]=f32x16{};o[2]=f32x16{};o[3]=f32x16{};f32x16 negm=f32x16{};asm volatile("":"+v"(negm));
  bool resc=false;
  #define XRESC() do{ if(resc){ asm volatile("s_waitcnt lgkmcnt(0)":::"memory"); \
      _Pragma("unroll") for(int d_=0;d_<4;++d_) _Pragma("unroll") for(int r=0;r<16;++r)o[d_][r]*=wsf[crow(r,hi)]; } }while(0)
  f32x16 C0,C1; s16x4 vlo[8],vhi[8]; u32x4 pw0,pw1,pw2,pw3;
  int k_t=C2_KSL,k_t1=2*C2_KSL;
  int v_tm1=0,v_t=C2_VSL;
  #define XROT() do{ k_t=k_t1; k_t1=(k_t1==2*C2_KSL)?0:k_t1+C2_KSL; const int s_=v_tm1; v_tm1=v_t; v_t=s_; }while(0)
  XK(2,2*C2_KSL);
  WAIT_BAR(3);
  qkt(C0,C1,Kbase,qr,negm,r32,hi);asm volatile("s_nop 15\n\ts_nop 7":"+v"(C0),"+v"(C1));
  { const float rm=rowmax(C0,C1); mhat=fadd_s(mhat,rm);
    _Pragma("unroll") for(int r=0;r<16;++r){C0[r]=fsub_s(C0[r],rm);C1[r]=fsub_s(C1[r],rm);}
    _Pragma("unroll") for(int r=0;r<16;++r)negm[r]=-mhat; asm volatile("":"+v"(negm));
    _Pragma("unroll") for(int r=0;r<16;++r){C0[r]=__builtin_amdgcn_exp2f(C0[r]);C1[r]=__builtin_amdgcn_exp2f(C1[r]);}
    float sacc=0.f; _Pragma("unroll") for(int r=0;r<16;++r)sacc+=C0[r]; _Pragma("unroll") for(int r=0;r<16;++r)sacc+=C1[r]; l_reg=sacc;
    pw0=(u32x4){cvtpk_s(C0[0],C0[1]),cvtpk_s(C0[2],C0[3]),cvtpk_s(C0[4],C0[5]),cvtpk_s(C0[6],C0[7])}; pw1=(u32x4){cvtpk_s(C0[8],C0[9]),cvtpk_s(C0[10],C0[11]),cvtpk_s(C0[12],C0[13]),cvtpk_s(C0[14],C0[15])};
    pw2=(u32x4){cvtpk_s(C1[0],C1[1]),cvtpk_s(C1[2],C1[3]),cvtpk_s(C1[4],C1[5]),cvtpk_s(C1[6],C1[7])}; pw3=(u32x4){cvtpk_s(C1[8],C1[9]),cvtpk_s(C1[10],C1[11]),cvtpk_s(C1[12],C1[13]),cvtpk_s(C1[14],C1[15])};
    asm volatile("":"+v"(pw0),"+v"(pw1),"+v"(pw2),"+v"(pw3)); }
  WAIT_BAR(0);
  if(3<NT){XK(3,0);} XV(1,C2_VSL);
  kload8(kf,kp0+k_t);
  if(3<NT){WAIT_BAR(3);}else{WAIT_BAR(2);}
  #define PAF(k) __builtin_bit_cast(bf16x8,pw##k)
  #define VFR(i) (bf16x8){vlo[i][0],vlo[i][1],vlo[i][2],vlo[i][3],vhi[i][0],vhi[i][1],vhi[i][2],vhi[i][3]}
  #define PIN(x) asm volatile("":"+v"(x))
  #define MX3(a,b,c) __builtin_fmaxf(__builtin_fmaxf((a),(b)),(c))
  #define EX(v) __builtin_amdgcn_exp2f(v)
  #define VRD(s,f) do{ vlo[s]=vtr(vp_+((((f)&3))*4096+((f)>>2)*1024)); vhi[s]=vtr(vp_+((((f)&3))*4096+((f)>>2)*1024+512)); }while(0)
  #define KRD(G,j) do{ if(G){ kload2(kf,kp0+k_t1,j); SBAR(); } }while(0)
  #define QKG(MF,i) do{ VRD(i,i); SBAR(); MF; SBAR(); }while(0)
  #define PVG(f,RD,X0,X1,A0,A1,PK) do{ o[(f)&3]=__builtin_amdgcn_mfma_f32_32x32x16_bf16(PAFK(f),VFR((f)&7),o[(f)&3],0,0,0); RD; X0=EX(X0); X1=EX(X1); sacc+=A0; sacc+=A1; PIN(sacc); PK; PIN(C0); PIN(C1); SBAR(); }while(0)
  #define PAFK(f) (((f)>>2)==0?PAF(0):((f)>>2)==1?PAF(1):((f)>>2)==2?PAF(2):PAF(3))
  #define PKW(P,B) cvtpk_s(P[B],P[B+1])
  #define XSTEP(t,GK,GV,GL) do{ SBAR(); \
    if(GV){XV((t),v_t);} \
    const lds_cptr vp_=vp0+v_tm1; \
    QKG(C0=__builtin_amdgcn_mfma_f32_32x32x16_bf16(kf[0],qr[0],negm,0,0,0),0); \
    QKG(C1=__builtin_amdgcn_mfma_f32_32x32x16_bf16(kf[1],qr[0],negm,0,0,0),1); \
    QKG(C0=__builtin_amdgcn_mfma_f32_32x32x16_bf16(kf[2],qr[1],C0,0,0,0),2); \
    QKG(C1=__builtin_amdgcn_mfma_f32_32x32x16_bf16(kf[3],qr[1],C1,0,0,0),3); \
    QKG(C0=__builtin_amdgcn_mfma_f32_32x32x16_bf16(kf[4],qr[2],C0,0,0,0),4); \
    QKG(C1=__builtin_amdgcn_mfma_f32_32x32x16_bf16(kf[5],qr[2],C1,0,0,0),5); \
    QKG(C0=__builtin_amdgcn_mfma_f32_32x32x16_bf16(kf[6],qr[3],C0,0,0,0),6); \
    QKG(C1=__builtin_amdgcn_mfma_f32_32x32x16_bf16(kf[7],qr[3],C1,0,0,0),7); \
    if(GK){XK((t)+3,k_t);} \
    { float a=MX3(C0[0],C0[1],C1[0]),b=MX3(C0[2],C0[3],C1[1]); a=MX3(a,C1[2],C1[3]); \
      _Pragma("unroll") for(int r=4;r<16;r+=4){a=MX3(a,C0[r],C0[r+1]);b=MX3(b,C0[r+2],C0[r+3]);a=MX3(a,C1[r],C1[r+1]);b=MX3(b,C1[r+2],C1[r+3]);} \
      float rm=__builtin_fmaxf(a,b); { auto rr=__builtin_amdgcn_permlane32_swap(__float_as_uint(rm),__float_as_uint(rm),false,false); rm=__builtin_fmaxf(__uint_as_float(rr[0]),__uint_as_float(rr[1])); } \
      resc=false; \
      if(__builtin_expect(__any(rm>(float)THRL),0)){ const float dl=__builtin_fmaxf(rm,0.f); mhat+=dl; \
        _Pragma("unroll") for(int r=0;r<16;++r){C0[r]-=dl;C1[r]-=dl;} \
        _Pragma("unroll") for(int r=0;r<16;++r)negm[r]=-mhat; asm volatile("":"+v"(negm)); \
        const float f=__builtin_amdgcn_exp2f(-dl); l_reg*=f; if(hi==0)wsf[r32]=f; resc=true; } } \
    SBAR(); \
    float sacc=0.f; \
    PVG(0, VRD(0,8),  C0[0],C0[1],  0.f,0.f,      ;); \
    PVG(1, VRD(1,9),  C0[2],C0[3],  C0[0],C0[1],  ;); \
    PVG(2, VRD(2,10), C0[4],C0[5],  C0[2],C0[3],  ;); \
    KRD(GL,0); PVG(3, VRD(3,11), C0[6],C0[7],  C0[4],C0[5],  ;); \
    KRD(GL,1); PVG(4, VRD(4,12), C0[8],C0[9],  C0[6],C0[7],  pw0[0]=PKW(C0,0);pw0[1]=PKW(C0,2);PIN(pw0)); \
    KRD(GL,2); PVG(5, VRD(5,13), C0[10],C0[11],C0[8],C0[9],  pw0[2]=PKW(C0,4);pw0[3]=PKW(C0,6);PIN(pw0)); \
    KRD(GL,3); PVG(6, VRD(6,14), C0[12],C0[13],C0[10],C0[11],;); \
    PVG(7, VRD(7,15), C0[14],C0[15],C0[12],C0[13],;); \
    PVG(8, ;,         C1[0],C1[1],  C0[14],C0[15],pw1[0]=PKW(C0,8);pw1[1]=PKW(C0,10);PIN(pw1)); \
    PVG(9, ;,         C1[2],C1[3],  C1[0],C1[1],  pw1[2]=PKW(C0,12);pw1[3]=PKW(C0,14);PIN(pw1)); \
    PVG(10,;,         C1[4],C1[5],  C1[2],C1[3],  ;); \
    PVG(11,;,         C1[6],C1[7],  C1[4],C1[5],  ;); \
    PVG(12,;,         C1[8],C1[9],  C1[6],C1[7],  pw2[0]=PKW(C1,0);pw2[1]=PKW(C1,2);PIN(pw2)); \
    PVG(13,;,         C1[10],C1[11],C1[8],C1[9],  pw2[2]=PKW(C1,4);pw2[3]=PKW(C1,6);PIN(pw2)); \
    PVG(14,;,         C1[12],C1[13],C1[10],C1[11],;); \
    PVG(15,;,         C1[14],C1[15],C1[12],C1[13],;); \
    sacc+=C1[14]; sacc+=C1[15]; l_reg+=sacc; \
    pw3[0]=PKW(C1,8);pw3[1]=PKW(C1,10);pw3[2]=PKW(C1,12);pw3[3]=PKW(C1,14);PIN(pw3); SBAR(); \
    }while(0)
  int t=1;
  if(wid>=4)__builtin_amdgcn_s_setprio(1);
  XSTEP(1,(4<NT),false,(2<NT)); if(4<NT){WAIT_BAR(1);}else{WAIT_BAR(0);} XRESC(); XROT(); t=2;
  for(;t+3<NT;++t){ XSTEP(t,true,true,true); WAIT_BAR(1); XRESC(); XROT(); }
  for(;t+1<NT;++t){ XSTEP(t,false,true,true); WAIT_BAR(0); XRESC(); XROT(); }
  XSTEP(NT-1,false,true,false); WAIT_BAR(0); XRESC();
  __builtin_amdgcn_s_setprio(0);
  { const int vb=vb0+v_t;
    #pragma unroll
    for(int d0=0;d0<4;++d0){s16x4 lo[4],hh[4];
      #pragma unroll
      for(int ks=0;ks<4;++ks){
        asm volatile("ds_read_b64_tr_b16 %0,%1 offset:%c2":"=&v"(lo[ks]):"v"(vb),"i"(d0*4096+ks*1024):"memory");
        asm volatile("ds_read_b64_tr_b16 %0,%1 offset:%c2":"=&v"(hh[ks]):"v"(vb),"i"(d0*4096+ks*1024+512):"memory");}
      asm volatile("s_waitcnt lgkmcnt(0)":::"memory");SBAR();
      #define PKD(k) (bf16x8){lo[k][0],lo[k][1],lo[k][2],lo[k][3],hh[k][0],hh[k][1],hh[k][2],hh[k][3]}
      o[d0]=__builtin_amdgcn_mfma_f32_32x32x16_bf16(PAF(0),PKD(0),o[d0],0,0,0);
      o[d0]=__builtin_amdgcn_mfma_f32_32x32x16_bf16(PAF(1),PKD(1),o[d0],0,0,0);
      o[d0]=__builtin_amdgcn_mfma_f32_32x32x16_bf16(PAF(2),PKD(2),o[d0],0,0,0);
      o[d0]=__builtin_amdgcn_mfma_f32_32x32x16_bf16(PAF(3),PKD(3),o[d0],0,0,0);
      #undef PKD
    } }
  #undef PKW
  #undef PAFK
  #undef PVG
  #undef QKG
  #undef KRD
  #undef VRD
  #undef EX
  #undef MX3
  #undef PIN
  #undef VFR
  #undef PAF
  #undef XSTEP
  {auto rr=__builtin_amdgcn_permlane32_swap(__float_as_uint(l_reg),__float_as_uint(l_reg),false,false);l_reg=__uint_as_float(rr[0])+__uint_as_float(rr[1]);}
  if(hi==0)wsf[32+r32]=l_reg;asm volatile("s_waitcnt lgkmcnt(0)":::"memory");
  float rli[16];
  #pragma unroll
  for(int r=0;r<16;++r)rli[r]=__builtin_amdgcn_rcpf(wsf[32+crow(r,hi)]);
  unsigned*stash=(unsigned*)(shm+C2_STASH)+wid*2048;
  if constexpr(MODE==0){
    #pragma unroll
    for(int d0=0;d0<4;++d0)
      #pragma unroll
      for(int r=0;r<16;r+=2)stash[(d0*8+(r>>1))*64+lane]=cvtpk_s(o[d0][r]*rli[r],o[d0][r+1]*rli[r+1]);
  }else{
    float ss[16];
    #pragma unroll
    for(int r=0;r<16;++r)ss[r]=0.f;
    #pragma unroll
    for(int d0=0;d0<4;++d0)
      #pragma unroll
      for(int r=0;r<16;r+=2){const unsigned w=stash[(d0*8+(r>>1))*64+lane];
        const float da=__uint_as_float(w<<16)-lam*(o[d0][r]*rli[r]),db=__uint_as_float(w&0xffff0000u)-lam*(o[d0][r+1]*rli[r+1]);
        o[d0][r]=da;o[d0][r+1]=db;ss[r]+=da*da;ss[r+1]+=db*db;}
    #pragma unroll
    for(int r=0;r<16;++r){float v=::xsum_x16(::xsum_row16(ss[r]));
      ss[r]=oscale*::rsq_(v*(1.f/128.f)+1e-6f);}
    bf16*stg=(bf16*)stash;
    #pragma unroll
    for(int d0=0;d0<4;++d0){const float g=sg[d0*32+r32];
      #pragma unroll
      for(int r=0;r<16;++r)stg[crow(r,hi)*128+d0*32+r32]=__float2bfloat16(o[d0][r]*ss[r]*g);}
    asm volatile("s_waitcnt lgkmcnt(0)":::"memory");
    bf16*Ow=Ou+(long)(wid*QBLK)*op;
    #pragma unroll
    for(int i=0;i<8;++i){const int row=i*4+(lane>>4),ch=lane&15;const u32x4 v=*(const u32x4*)(stg+row*128+ch*8);*(u32x4*)(Ow+(long)row*op+ch*8)=v;}
  }
  asm volatile("s_waitcnt lgkmcnt(0)\n\ts_barrier":::"memory");
  #undef XK
  #undef XV
  #undef XRESC
  #undef XROT
}
#undef SBAR
#undef WAIT_BAR
}

namespace attn_c {
using bf16 = __hip_bfloat16;
constexpr int D = 128, DQK = 64, NW = 8, QBLK = 32, KVBLK = 64, SDEPTH = 2;
constexpr size_t SHM_V = KVBLK * D * 2, SHM_K = KVBLK * DQK * 2, SHM_ATTN = 2 * SHM_V + 2 * SHM_K + NW * 64 * 4;
constexpr float THR_L2 = 8.f * 1.4426950408889634f;
using bf16x8 = __attribute__((ext_vector_type(8))) short;
using s16x4  = __attribute__((ext_vector_type(4))) short;
using f32x16 = __attribute__((ext_vector_type(16))) float;
using f32x8  = __attribute__((ext_vector_type(8))) float;
using u32x4  = __attribute__((ext_vector_type(4))) unsigned;
#define KSWZ(row, colB) ((row) * 128 + ((colB) ^ ((((row) >> 1) & 7) << 4)))
#define SBAR_C() __builtin_amdgcn_sched_barrier(0)
__device__ __forceinline__ int crow(int r, int hi) { return (r & 3) + 8 * (r >> 2) + 4 * hi; }
__device__ __forceinline__ unsigned cvtpk(float lo, float hi) {
  typedef float f2_ __attribute__((ext_vector_type(2))); typedef __bf16 b2_ __attribute__((ext_vector_type(2))); f2_ v = {lo, hi}; b2_ b = __builtin_convertvector(v, b2_); return __builtin_bit_cast(unsigned, b);
}
template <typename TIn> struct Stage;
template <> struct Stage<bf16>  { using T = bf16x8;
  __device__ static __forceinline__ T ld8(const bf16* p) { return *reinterpret_cast<const bf16x8*>(p); }
  __device__ static __forceinline__ bf16x8 tobf(T x) { return x; } };
template <> struct Stage<float> { using T = f32x8;
  __device__ static __forceinline__ T ld8(const float* p) { return *reinterpret_cast<const f32x8*>(p); }
  __device__ static __forceinline__ bf16x8 tobf(T x) {
    u32x4 w = {cvtpk(x[0], x[1]), cvtpk(x[2], x[3]), cvtpk(x[4], x[5]), cvtpk(x[6], x[7])}; return *reinterpret_cast<bf16x8*>(&w); } };

__device__ __forceinline__ void partialSM(f32x16& p0, f32x16& p1, float& m_reg, float& mn, float& alpha) {
  constexpr float C = 1.f;
  float pmax = p0[0]; for (int r = 1; r < 16; ++r) pmax = fmaxf(pmax, p0[r]); for (int r = 0; r < 16; ++r) pmax = fmaxf(pmax, p1[r]);
  { auto rr = __builtin_amdgcn_permlane32_swap(__float_as_uint(pmax), __float_as_uint(pmax), false, false);
    pmax = fmaxf(__uint_as_float(rr[0]), __uint_as_float(rr[1])); }
  if (__builtin_expect(__all(pmax - m_reg <= THR_L2), 1)) { mn = m_reg; alpha = 1.f; }
  else { mn = fmaxf(m_reg, pmax); alpha = __builtin_amdgcn_exp2f((m_reg - mn) * C); m_reg = mn; }
  float mnC = -mn * C;
  for (int r = 0; r < 16; ++r) p0[r] = fmaf(p0[r], C, mnC); for (int r = 0; r < 16; ++r) p1[r] = fmaf(p1[r], C, mnC);
  for (int r = 0; r < 16; ++r) p0[r] = __builtin_amdgcn_exp2f(p0[r]);
}
__device__ __forceinline__ void finishSM(f32x16& p0, f32x16& p1, float alpha, float& l_reg, bf16x8& pa0, bf16x8& pa1, bf16x8& pa2, bf16x8& pa3) {
  for (int r = 0; r < 16; ++r) p1[r] = __builtin_amdgcn_exp2f(p1[r]);
  float ps = 0; for (int r = 0; r < 16; ++r) ps += p0[r]; for (int r = 0; r < 16; ++r) ps += p1[r];
  { auto rr = __builtin_amdgcn_permlane32_swap(__float_as_uint(ps), __float_as_uint(ps), false, false);
    ps = __uint_as_float(rr[0]) + __uint_as_float(rr[1]); }
  l_reg = l_reg * alpha + ps;
#define PK4(P, BASE, OUT) do { unsigned a0 = cvtpk(P[BASE + 0], P[BASE + 1]), a1 = cvtpk(P[BASE + 2], P[BASE + 3]);   \
    unsigned b0 = cvtpk(P[BASE + 4], P[BASE + 5]), b1 = cvtpk(P[BASE + 6], P[BASE + 7]);                              \
    auto r0 = __builtin_amdgcn_permlane32_swap(a0, b0, false, false); auto r1 = __builtin_amdgcn_permlane32_swap(a1, b1, false, false); \
    u32x4 w = {r0[0], r1[0], r0[1], r1[1]}; OUT = *reinterpret_cast<bf16x8*>(&w); } while (0)
  PK4(p0, 0, pa0); PK4(p0, 8, pa1); PK4(p1, 0, pa2); PK4(p1, 8, pa3);
#undef PK4
}
__device__ __forceinline__ void qkt(f32x16& p0, f32x16& p1, const bf16* Ks, const bf16x8* qr, int r32, int hi) {
  p0 = f32x16{}; p1 = f32x16{};
  for (int d0 = 0; d0 < 4; ++d0) { int cb = (d0 * 16 + hi * 8) * 2;
    bf16x8 b0 = *reinterpret_cast<const bf16x8*>((const char*)Ks + KSWZ(r32, cb));
    bf16x8 b1 = *reinterpret_cast<const bf16x8*>((const char*)Ks + KSWZ(32 + r32, cb));
    p0 = __builtin_amdgcn_mfma_f32_32x32x16_bf16(b0, qr[d0], p0, 0, 0, 0);
    p1 = __builtin_amdgcn_mfma_f32_32x32x16_bf16(b1, qr[d0], p1, 0, 0, 0); }
}
__device__ __forceinline__ int v_st(int k, int c) { const int kk = (k & ~0xC) | ((k & 4) << 1) | ((k & 8) >> 1); return ((kk >> 3) * 4 + (c >> 5)) * 512 + ((kk & 7) * 32 + (c & 31)) * 2; }
__device__ __forceinline__ int v_rd_base(int lane) { return ((lane & 3) << 3) | (((lane >> 2) & 3) << 6) | (((lane >> 4) & 1) << 5) | (((lane >> 5) & 1) << 8); }
constexpr int v_rd_off(int d0, int ks, int half) { return d0 * 512 + ks * 4096 + half * 2048; }
template <int OFF> __device__ __forceinline__ s16x4 tr_read(int vb) {
  s16x4 r; asm volatile("ds_read_b64_tr_b16 %0, %1 offset:%2" : "=&v"(r) : "v"(vb), "i"(OFF) : "memory"); return r;
}
template <int D0> __device__ __forceinline__ void pv_one(f32x16& od, int vb, bf16x8 pa0, bf16x8 pa1, bf16x8 pa2, bf16x8 pa3) {
  const s16x4 l0 = tr_read<v_rd_off(D0, 0, 0)>(vb), h0 = tr_read<v_rd_off(D0, 0, 1)>(vb), l1 = tr_read<v_rd_off(D0, 1, 0)>(vb), h1 = tr_read<v_rd_off(D0, 1, 1)>(vb);
  const s16x4 l2 = tr_read<v_rd_off(D0, 2, 0)>(vb), h2 = tr_read<v_rd_off(D0, 2, 1)>(vb), l3 = tr_read<v_rd_off(D0, 3, 0)>(vb), h3 = tr_read<v_rd_off(D0, 3, 1)>(vb);
  asm volatile("s_waitcnt lgkmcnt(0)" ::: "memory"); SBAR_C();
#define PK(L, H) (bf16x8){L[0], L[1], L[2], L[3], H[0], H[1], H[2], H[3]}
  od = __builtin_amdgcn_mfma_f32_32x32x16_bf16(pa0, PK(l0, h0), od, 0, 0, 0);
  od = __builtin_amdgcn_mfma_f32_32x32x16_bf16(pa1, PK(l1, h1), od, 0, 0, 0);
  od = __builtin_amdgcn_mfma_f32_32x32x16_bf16(pa2, PK(l2, h2), od, 0, 0, 0);
  od = __builtin_amdgcn_mfma_f32_32x32x16_bf16(pa3, PK(l3, h3), od, 0, 0, 0);
#undef PK
}
__device__ __forceinline__ void pv_d0(f32x16* o, int vb, bf16x8 pa0, bf16x8 pa1, bf16x8 pa2, bf16x8 pa3) {
  pv_one<0>(o[0], vb, pa0, pa1, pa2, pa3); pv_one<1>(o[1], vb, pa0, pa1, pa2, pa3); pv_one<2>(o[2], vb, pa0, pa1, pa2, pa3); pv_one<3>(o[3], vb, pa0, pa1, pa2, pa3);
}

template <int MODE> __device__ __forceinline__ void attn_c_unit(const bf16* __restrict__ Qb, int ldq, const bf16* __restrict__ Kh, const bf16* __restrict__ Vh, int ldk,
                                            bf16* __restrict__ Ob, int ldo, int seq, char* lds, float lam, float oscale, const float* __restrict__ sg) {
  typedef bf16 TQ; const int LDQ = ldq, LDK = ldk, LDO = ldo;
  using St = Stage<bf16>; using SQ = Stage<bf16>;
  int tid_o = threadIdx.x; asm volatile("" : "+v"(tid_o)); const int tid = tid_o, wid = tid >> 6, lane = tid & 63, r32 = lane & 31, hi = lane >> 5;
  bf16* V_lds = (bf16*)lds; bf16* K_lds = (bf16*)(lds + 2 * SHM_V);
  float* ws = (float*)(lds + 2 * SHM_V + 2 * SHM_K) + wid * 64; float* li_l = ws; float* al_l = ws + 32;
  float m_reg = -1e30f, l_reg = 0; f32x16 o[4] = {}; bf16x8 qr[4];
  const TQ* Qw = Qb + (long)(wid * QBLK + r32) * LDQ + hi * 8;
#pragma unroll
  for (int d0 = 0; d0 < 4; ++d0) qr[d0] = SQ::tobf(SQ::ld8(Qw + d0 * 16));
  const int sr = tid >> 4, sc = (tid & 15) * 8, vst0 = v_st(sr, sc), vst1 = v_st(32 + sr, sc), kr = tid >> 3, kcb = (tid & 7) * 16;
  const int vb0 = (int)(uintptr_t)V_lds + v_rd_base(lane);
  struct { typename St::T vs0, vs1, ks0; } sr_[SDEPTH];
#define SLOAD(i, k0) do { sr_[i].vs0 = St::ld8(&Vh[(long)((k0) + sr) * LDK + sc]); sr_[i].vs1 = St::ld8(&Vh[(long)((k0) + 32 + sr) * LDK + sc]); \
    sr_[i].ks0 = St::ld8(&Kh[(long)((k0) + kr) * LDK + (kcb >> 1)]); } while (0)
#define SWRITE(b, i) do { *(bf16x8*)((char*)V_lds + (b) * SHM_V + vst0) = St::tobf(sr_[i].vs0);          \
    *(bf16x8*)((char*)V_lds + (b) * SHM_V + vst1) = St::tobf(sr_[i].vs1);                               \
    *(bf16x8*)((char*)K_lds + (b) * SHM_K + KSWZ(kr, kcb)) = St::tobf(sr_[i].ks0); } while (0)
#define SWAIT() do { if constexpr (SDEPTH == 2) asm volatile("s_waitcnt vmcnt(3)" ::: "memory"); else asm volatile("s_waitcnt vmcnt(0)" ::: "memory"); } while (0)
#define RESC(a) do { if (__any((a) < 1.f)) { if (hi == 0) al_l[r32] = (a); asm volatile("s_waitcnt lgkmcnt(0)" ::: "memory"); \
    for (int d = 0; d < 4; ++d) for (int r = 0; r < 16; ++r) o[d][r] *= al_l[crow(r, hi)]; } } while (0)
  f32x16 pA0, pA1, pB0, pB1; float mnA, mnB, alA, alB; bf16x8 pa0, pa1, pa2, pa3; const int NT = seq / KVBLK;
  constexpr int SE = 0, SO = SDEPTH - 1;
  SLOAD(SE, 0); asm volatile("s_waitcnt vmcnt(0)" ::: "memory"); SWRITE(0, SE); __syncthreads();
  qkt(pA0, pA1, K_lds, qr, r32, hi); partialSM(pA0, pA1, m_reg, mnA, alA);
  SLOAD(SO, KVBLK); if constexpr (SDEPTH == 2) { if (2 < NT) SLOAD(SE, 2 * KVBLK); }
  SWAIT(); SWRITE(1, SO); __syncthreads();
  for (int j = 1; j + 1 < NT; j += 2) {
    SBAR_C(); qkt(pB0, pB1, (bf16*)((char*)K_lds + SHM_K), qr, r32, hi);
    finishSM(pA0, pA1, alA, l_reg, pa0, pa1, pa2, pa3); SBAR_C();
    SLOAD(SO, (j + SDEPTH) * KVBLK); SBAR_C();
    pv_d0(o, vb0, pa0, pa1, pa2, pa3); partialSM(pB0, pB1, m_reg, mnB, alB);
    __syncthreads(); SWAIT(); SWRITE(0, SE);
    RESC(alB); __syncthreads();
    SBAR_C(); qkt(pA0, pA1, K_lds, qr, r32, hi);
    finishSM(pB0, pB1, alB, l_reg, pa0, pa1, pa2, pa3); SBAR_C();
    if (SDEPTH == 1 || j + 3 < NT) SLOAD(SE, (j + 1 + SDEPTH) * KVBLK); SBAR_C();
    pv_d0(o, vb0 + (int)SHM_V, pa0, pa1, pa2, pa3); partialSM(pA0, pA1, m_reg, mnA, alA);
    __syncthreads(); SWAIT(); SWRITE(1, SO);
    RESC(alA); __syncthreads();
  }
  SBAR_C(); qkt(pB0, pB1, (bf16*)((char*)K_lds + SHM_K), qr, r32, hi);
  finishSM(pA0, pA1, alA, l_reg, pa0, pa1, pa2, pa3); SBAR_C();
  pv_d0(o, vb0, pa0, pa1, pa2, pa3); partialSM(pB0, pB1, m_reg, mnB, alB);
  __syncthreads(); RESC(alB);
  finishSM(pB0, pB1, alB, l_reg, pa0, pa1, pa2, pa3); SBAR_C();
  pv_d0(o, vb0 + (int)SHM_V, pa0, pa1, pa2, pa3);
  if (hi == 0) li_l[r32] = l_reg; asm volatile("s_waitcnt lgkmcnt(0)" ::: "memory");
  float rli[16];
#pragma unroll
  for (int r = 0; r < 16; ++r) rli[r] = __builtin_amdgcn_rcpf(li_l[crow(r, hi)]);
  unsigned* stash = (unsigned*)(lds + 65536) + wid * 2048;
  if constexpr (MODE == 0) {
#pragma unroll
    for (int d0 = 0; d0 < 4; ++d0)
#pragma unroll
      for (int r = 0; r < 16; r += 2) stash[(d0 * 8 + (r >> 1)) * 64 + lane] = cvtpk(o[d0][r] * rli[r], o[d0][r + 1] * rli[r + 1]);
  } else {
    float ss[16];
#pragma unroll
    for (int r = 0; r < 16; ++r) ss[r] = 0.f;
#pragma unroll
    for (int d0 = 0; d0 < 4; ++d0)
#pragma unroll
      for (int r = 0; r < 16; r += 2) { const unsigned w = stash[(d0 * 8 + (r >> 1)) * 64 + lane];
        const float da = __uint_as_float(w << 16) - lam * (o[d0][r] * rli[r]), db = __uint_as_float(w & 0xffff0000u) - lam * (o[d0][r + 1] * rli[r + 1]);
        o[d0][r] = da; o[d0][r + 1] = db; ss[r] += da * da; ss[r + 1] += db * db; }
#pragma unroll
    for (int r = 0; r < 16; ++r) { float v = ss[r]; v += __shfl_xor(v, 1); v += __shfl_xor(v, 2); v += __shfl_xor(v, 4); v += __shfl_xor(v, 8); v += __shfl_xor(v, 16);
      ss[r] = oscale / sqrtf(v * (1.f / 128.f) + 1e-6f); }
    bf16* stg = (bf16*)stash;
#pragma unroll
    for (int d0 = 0; d0 < 4; ++d0) { const float g = sg[d0 * 32 + r32];
#pragma unroll
      for (int r = 0; r < 16; ++r) stg[crow(r, hi) * 128 + d0 * 32 + r32] = __float2bfloat16(o[d0][r] * ss[r] * g); }
    asm volatile("s_waitcnt lgkmcnt(0)" ::: "memory");
    bf16* Ow = Ob + (long)(wid * QBLK) * LDO;
#pragma unroll
    for (int i = 0; i < 8; ++i) { const int row = i * 4 + (lane >> 4), ch = lane & 15; const u32x4 v = *(const u32x4*)(stg + row * 128 + ch * 8); *(u32x4*)(Ow + (long)row * LDO + ch * 8) = v; }
  }
  __syncthreads();
#undef SLOAD
#undef SWRITE
#undef SWAIT
#undef RESC
}


#undef KSWZ
}


#define LAS __attribute__((address_space(3)))

#define XB_TMO      128
#define XB_XCNT(j)  (256  + 64 * (j))
#define XB_XSUB(j)  (1280 + 64 * (j))
#define XB_XGEN(j)  (2304 + 64 * (j))
#define XB_TOP      3328
#define XB_TOPGEN   3392
#define XCD_BAR_WORDS 3456
#define XB_SPIN_CAP (1u << 18)

__device__ __forceinline__ unsigned xb_ld(unsigned* p)              { return __hip_atomic_load(p, __ATOMIC_RELAXED, __HIP_MEMORY_SCOPE_AGENT); }
__device__ __forceinline__ unsigned xb_add(unsigned* p, unsigned v) { return __hip_atomic_fetch_add(p, v, __ATOMIC_RELAXED, __HIP_MEMORY_SCOPE_AGENT); }
__device__ __forceinline__ unsigned xb_xcc_id() { return (unsigned)__builtin_amdgcn_s_getreg((3 << 11) | 20) & 0xFu; }
#define XB_SPIN(cond, bar) do { unsigned _sp = 0; while (cond) { __builtin_amdgcn_s_sleep(1); \
    if ((++_sp & 255u) == 0u) { if (xb_ld(&(bar)[XB_TMO])) break; if (_sp > XB_SPIN_CAP) { atomicAdd(&(bar)[XB_TMO], 1u); break; } } } } while (0)

struct XcdBarrier {
    unsigned* bar; unsigned x;
    volatile LAS unsigned* st;
};

__device__ __forceinline__ XcdBarrier xcd_barrier_post(unsigned* bar, volatile LAS unsigned* st) {
    XcdBarrier b; b.bar = bar; b.x = xb_xcc_id(); b.st = st;
    if (threadIdx.x == 0) (void)xb_add(&bar[XB_XCNT(b.x)], 1u);
    return b;
}
__device__ __forceinline__ void xcd_barrier_complete(unsigned* bar, unsigned x, unsigned& nloc, unsigned& nx) {
    const unsigned G = gridDim.x * gridDim.y * gridDim.z;
    unsigned sum, cnt, mine, sp = 0u;
    for (;;) {
        sum = 0u; cnt = 0u; mine = 0u;
#pragma unroll
        for (unsigned j = 0; j < 16; ++j) { const unsigned c = xb_ld(&bar[XB_XCNT(j)]); sum += c; cnt += (c > 0u) ? 1u : 0u; mine = (j == x) ? c : mine; }
        if (sum == G) break;
        __builtin_amdgcn_s_sleep(1);
        if ((++sp & 255u) == 0u) { if (xb_ld(&bar[XB_TMO])) break; if (sp > XB_SPIN_CAP) { atomicAdd(&bar[XB_TMO], 1u); break; } }
    }
    nloc = mine > 0u ? mine : 1u; nx = cnt > 0u ? cnt : 1u;
}

__device__ __forceinline__ void xcd_barrier(const XcdBarrier& b) {
    asm volatile("s_waitcnt vmcnt(0)" ::: "memory");
    __syncthreads();
    if (threadIdx.x == 0) {
        unsigned* bar = b.bar;
        __builtin_amdgcn_s_waitcnt(0);
        unsigned nloc = b.st[0], nx = b.st[1];
        if (nloc == 0u) { xcd_barrier_complete(bar, b.x, nloc, nx); b.st[0] = nloc; b.st[1] = nx; }
        const unsigned old = xb_add(&bar[XB_XSUB(b.x)], 1u);
        const unsigned gen = old / nloc;
        if (old + 1u == (gen + 1u) * nloc) {
            __builtin_amdgcn_fence(__ATOMIC_RELEASE, "agent");
            asm volatile("s_waitcnt vmcnt(0)" ::: "memory");
            const unsigned og = xb_add(&bar[XB_TOP], 1u);
            const unsigned tg = og / nx;
            if (og + 1u == (tg + 1u) * nx) xb_add(&bar[XB_TOPGEN], 1u);
            else XB_SPIN(xb_ld(&bar[XB_TOPGEN]) == tg, bar);
            __builtin_amdgcn_fence(__ATOMIC_ACQUIRE, "agent");
            xb_add(&bar[XB_XGEN(b.x)], 1u);
            asm volatile("s_waitcnt vmcnt(0)" ::: "memory");
        } else {
            XB_SPIN(xb_ld(&bar[XB_XGEN(b.x)]) == gen, bar);
            __builtin_amdgcn_fence(__ATOMIC_ACQUIRE, "agent");
            asm volatile("s_waitcnt vmcnt(0)" ::: "memory");
        }
    }
    __syncthreads();
}

constexpr int NWAVES = 8, RING_BYTES = 131072, LDSCTL_OFF = RING_BYTES, MISC_OFF = LDSCTL_OFF + 320, LDS_BYTES = 147456;
constexpr int CW_BAR = 4096;
#ifndef KMASK
#define KMASK 0xFFFF
#endif
#define KEN(k) (((KMASK) >> (k)) & 1)
#ifndef DUPMASK
#define DUPMASK 0
#endif
#define NREP(k) ((((DUPMASK) >> (k)) & 1) ? 2 : 1)
struct Args { P p; int ph_lo, ph_hi, li, pad; };

struct InprojOrderA {
    pg8::StaticOrder so; int G, c, nmain, nextra;
    __device__ void init(int l, int G_, int c_) { so.init(l == 0 ? MT : M_LAT, 13 * 256, G_, c_); G = G_; c = c_; nmain = so.nwg; nextra = l == 0 ? 0 : 20; }
    __device__ bool next(int i, pg8::Unit& u) const {
        const int L = i * G + c;
        if (L < nmain) return so.next(i, u);
        const int q = L - nmain; if (q >= nextra) return false;
        const int k = q % 5; u.pm = 64 + q / 5; u.pn = k == 0 ? 2 : 8 + k; u.ko = 0; u.pa = u.pm; return true;
    }
    __device__ __forceinline__ void a_ready(const pg8::Unit&) const {}
    __device__ __forceinline__ void done(const pg8::Unit&) const {}
};
struct InprojOrderB {
    pg8::StaticOrder so;
    __device__ void init(int l, int G_, int c_) { so.init(l == 0 ? MT : M_LAT, 12 * 256, G_, G_ - 1 - c_); }
    __device__ bool next(int i, pg8::Unit& u) const { if (!so.next(i, u)) return false; u.pn += 13; return true; }
    __device__ __forceinline__ void a_ready(const pg8::Unit&) const {}
    __device__ __forceinline__ void done(const pg8::Unit&) const {}
};
struct InprojOrder {
    pg8::StaticOrder so; int G, c, nmain, nextra;
    __device__ void init(int l, int G_, int c_) { so.init(l == 0 ? MT : M_LAT, IN_W, G_, c_); G = G_; c = c_; nmain = so.nwg; nextra = l == 0 ? 0 : 20; }
    __device__ bool next(int i, pg8::Unit& u) const {
        const int L = i * G + c;
        if (L < nmain) return so.next(i, u);
        const int q = L - nmain; if (q >= nextra) return false;
        const int k = q % 5; u.pm = 64 + q / 5; u.pn = k == 0 ? 2 : 8 + k; u.ko = 0; u.pa = u.pm; return true;
    }
    __device__ __forceinline__ void a_ready(const pg8::Unit&) const {}
    __device__ __forceinline__ void done(const pg8::Unit&) const {}
};

__device__ __forceinline__ P load_p() {
    const __attribute__((address_space(4))) P* k = (const __attribute__((address_space(4))) P*)__builtin_amdgcn_kernarg_segment_ptr();
    asm volatile("" : "+s"(k));
    P r;
#pragma unroll
    for (int i = 0; i < 34; ++i) r.in[i] = k->in[i];
    r.out = k->out; r.ws = k->ws; return r;
}
__global__ void __launch_bounds__(NWAVES * 64, 2) mega(Args args) {
    extern __shared__ __attribute__((aligned(16))) unsigned char lds[];
    LAS unsigned char* ldsl = (LAS unsigned char*)lds;
    const int tid = threadIdx.x, lane = tid & 63, wave = __builtin_amdgcn_readfirstlane(tid >> 6);
    const int G = gridDim.x, bx = blockIdx.x, vcu = (G % 8 == 0) ? (bx % 8) * (G / 8) + bx / 8 : bx;
    const int gw = vcu * NWAVES + wave, NGW = G * NWAVES;
    for (int u = tid; u < (LDS_BYTES - LDSCTL_OFF) / 4; u += NWAVES * 64) ((LAS unsigned*)(ldsl + LDSCTL_OFF))[u] = 0u;
    __syncthreads();
    XcdBarrier bar = xcd_barrier_post((unsigned*)(args.p.ws + WS_CTL) + CW_BAR + args.li * XCD_BAR_WORDS, (volatile LAS unsigned*)(ldsl + MISC_OFF) + 8);
    const int lo = args.ph_lo, hi = args.ph_hi;
#define IN(k) (lo <= (k) && (k) < hi)
#define OPQ(x) ({ int t_ = (x); asm volatile("" : "+v"(t_)); t_; })
#define SEAM(k) do { if (IN(k) && IN((k) + 1)) { xcd_barrier(bar); if (NREP(16) == 2) xcd_barrier(bar); } } while (0)

    if (KEN(0) && IN(0)) { const P& p = args.p;
        for (int rep_ = 0; rep_ < NREP(0); ++rep_) {
        for (int it = vcu; it < 192; it += G) ph_mod_item(p, it, (float*)lds, OPQ(tid));
        if (vcu == G - 1) ph_misc(p, tid, NWAVES * 64);
        float* scr = (float*)(lds + wave * 16384);
        if (ALL_MEGA) { for (int j = gw; j < N_PRO - IT_F13 - IT_F2; j += NGW) prep_item(p, pro_item(j), scr, OPQ(lane)); }
        else for (int it = gw; it < IT_TOTAL; it += NGW) prep_item(p, it, scr, OPQ(lane));
        __syncthreads(); }
    }
    SEAM(0);

    for (int l = 0; l < 2; ++l) {
        const int pb = l == 0 ? 1 : 10;
        const int nrows = l == 0 ? MT : M_LAT;
        if (KEN(1) && IN(pb)) { const P p = load_p(); for (int rep_ = 0; rep_ < NREP(1); ++rep_) ph_norm(p, l, 0, MT, OPQ(gw), NGW, OPQ(lane)); }
        SEAM(pb);
        if (KEN(2) && IN(pb + 1)) { const P p = load_p(); unsigned char* ws = p.ws;
            pg8::EpiInproj E{ws, p.in[10] + l * 64, p.in[11] + l * 64, p.in[9] + l * 3072};
            for (int rep_ = 0; rep_ < NREP(2); ++rep_) {
                { pg8::Gemm g{(const bf16*)(ws + WS_H8), (const bf16*)(ws + WS_WIN + (size_t)l * IN_W * D * 2), MT, IN_W, D / 2, D / 2, SC_W13, SC_ONE};
                  InprojOrder S; S.init(l, G, bx);
                  pg8::gemm_phase<pg8::EpiInproj, InprojOrder, true, true, true>(ldsl, g, S, E); } }
            if (ALL_MEGA && l == 0) {
                const int lo_ = (MT / 256 * 25) % G, hi_ = G; const P& pa = args.p; float* scr = (float*)(lds + wave * 16384);
                const bool mid_ = lo_ < hi_; const int rank = mid_ ? (int)bx - lo_ : (int)bx, nid = mid_ ? hi_ - lo_ : G;
                if (rank >= 0 && rank < nid) for (int j = rank * NWAVES + wave; j < N_L1; j += nid * NWAVES) prep_item(pa, l1_item(j), scr, OPQ(lane)); }
            if (ALL_MEGA && l == 1) {
                const int nfull = (M_LAT / 256 * 25 + 20) % G;
                if (nfull != 0 && (int)bx >= nfull) { const P& pa = args.p; const int rank = (int)bx - nfull, nid = G - nfull; float* scr = (float*)(lds + wave * 16384);
                    for (int it = IT_DEFA + rank * NWAVES + wave; it < IT_TOTAL; it += nid * NWAVES) prep_item(pa, it, scr, OPQ(lane)); }
                else if (nfull == 0) { const P& pa = args.p; float* scr = (float*)(lds + wave * 16384);
                    for (int it = IT_DEFA + (int)bx * NWAVES + wave; it < IT_TOTAL; it += G * NWAVES) prep_item(pa, it, scr, OPQ(lane)); } }
        }
        SEAM(pb + 1);
        if (IN(pb + 2)) { const P p = load_p(); unsigned char* ws = p.ws;
            if (KEN(3)) for (int rep_ = 0; rep_ < NREP(3); ++rep_) for (int t = vcu; t < (l == 0 ? CONV_TILES_ALL : CONV_TILES_LAT); t += G) conv_tile(p, l, t, lds, OPQ(tid));
            __syncthreads();
            if (KEN(4)) for (int rep_ = 0; rep_ < NREP(4); ++rep_) for (int k = 0;; ++k) {
                const int nl = vcu < 512 ? (512 - vcu + G - 1) / G : 0; int u;
                if (k < nl) u = vcu + k * G; else { const int q = (vcu + G - 32 % G) % G + (k - nl) * G; if (l != 0 || q >= 32) break; u = 512 + q; }
                int b, vh, qrow0, krow0, NT;
                if (u < 512) { b = u >> 7; vh = (u >> 4) & 7; qrow0 = b * SEQ + (u & 15) * 256; krow0 = b * NKEY; NT = NKEY / 64; }
                else { const int q = u - 512; b = q >> 3; vh = q & 7; qrow0 = M_LAT + b * CTXL; krow0 = b * NKEY + SEQ; NT = CTXL / 64; }
                const attn_body::bf16* qa_ = (const attn_body::bf16*)(ws + WS_QA) + (size_t)qrow0 * 512 + vh * 64; const attn_body::bf16* ka_ = (const attn_body::bf16*)(ws + WS_KA) + (size_t)krow0 * 128 + (vh >> 2) * 64;
                const attn_body::bf16* va_ = (const attn_body::bf16*)(ws + WS_VA) + (size_t)krow0 * 128 + (vh >> 2) * 64; attn_body::bf16* oa_ = (attn_body::bf16*)(ws + WS_OABC) + (size_t)qrow0 * 1536 + vh * 64;
                const float cref = ((const float*)(ws + WS_LAM))[4 + l];
                if (cref > 0.f) attn_body::attn_unit<8, true>(qa_, 512, ka_, va_, 128, oa_, 1536, NT, (char*)lds, cref);
                else attn_body::attn_unit<8, false>(qa_, 512, ka_, va_, 128, oa_, 1536, NT, (char*)lds);
            }
            if (KEN(4)) for (int rep_ = 0; rep_ < NREP(4); ++rep_) for (int k = 0;; ++k) {
                const int nl = vcu < 256 ? (256 - vcu + G - 1) / G : 0; int su;
                if (k < nl) su = vcu + k * G; else { const int q = (vcu + G - 64 % G) % G + (k - nl) * G; if (l != 0 || q >= 16) break; su = 256 + q; }
                int b, h, qrow0, krow0, NT;
                if (su < 256) { b = su >> 6; h = (su >> 4) & 3; qrow0 = b * SEQ + (su & 15) * 256; krow0 = b * NKEY; NT = NKEY / 64; }
                else { const int q = su - 256; b = q >> 2; h = q & 3; qrow0 = M_LAT + b * CTXL; krow0 = b * NKEY + SEQ; NT = CTXL / 64; }
                {
                    const float lam = ((const float*)(ws + WS_LAM))[l], li = ((const float*)(ws + WS_LAM))[2 + l];
                    const attn_c::bf16* q_ = (const attn_c::bf16*)(ws + WS_QC) + (size_t)qrow0 * 512 + (2 * h) * 64; const attn_c::bf16* k_ = (const attn_c::bf16*)(ws + WS_KC) + (size_t)krow0 * 512 + (2 * h) * 64;
                    const attn_c::bf16* v_ = (const attn_c::bf16*)(ws + WS_VC) + (size_t)krow0 * 512 + h * 128;
                    attn_body::attn_unit_v128<0, 8>(q_, 512, k_, v_, 512, (attn_c::bf16*)nullptr, 0, NT, (char*)lds, 0.f, 0.f, (const float*)nullptr);
                    attn_body::attn_unit_v128<1, 8>(q_ + 64, 512, k_ + 64, v_, 512, (attn_c::bf16*)(ws + WS_OABC) + (size_t)qrow0 * 1536 + 1024 + h * 128, 1536, NT, (char*)lds, lam, 1.f - li, p.in[20] + l * 128); }
            }
        }
        if (IN(pb + 2) && IN(pb + 4)) xcd_barrier(bar);
        if (KEN(6) && IN(pb + 4)) { const P p = load_p(); unsigned char* ws = p.ws;
            pg8::Gemm g{(const bf16*)(ws + WS_OABC), (const bf16*)(ws + WS_WP) + (size_t)l * D * 1536, nrows, D, 1536, 1536};
            pg8::StaticOrder S; S.init(nrows, D, G, bx);
            pg8::EpiMerge E{(const unsigned char*)(ws + WS_G), (bf16*)(ws + WS_MB)};
            for (int rep_ = 0; rep_ < NREP(6); ++rep_) pg8::gemm_phase<pg8::EpiMerge, pg8::StaticOrder, true, true>(ldsl, g, S, E);
            if (ALL_MEGA && l == 0 && (int)bx >= MT / 256 * 4 - G) {
                const P& pa = args.p; const int n2 = MT / 256 * 4 - G, rank = (int)bx - n2, nid = G - n2; float* scr = (float*)(lds + wave * 16384);
                for (int it = IT_EARLY + rank * NWAVES + wave; it < IT_DEF1; it += nid * NWAVES) prep_item(pa, it, scr, OPQ(lane)); }
        }
        SEAM(pb + 4);
        if (KEN(7) && IN(pb + 5)) { const P p = load_p(); unsigned char* ws = p.ws;
            pg8::Gemm g{(const bf16*)(ws + WS_MB), (const bf16*)(ws + WS_WOUT) + (size_t)l * D * D, M_LAT, D, D, D};
            pg8::StaticOrder S; S.init(M_LAT, D, G, bx);
            pg8::EpiResid E{l == 0 ? p.in[0] : (const float*)nullptr, (bf16*)(ws + WS_XB), modv(p, l, 0, 2)};
            pg8::gemm_phase<pg8::EpiResid, pg8::StaticOrder, true, true>(ldsl, g, S, E);
            if (l == 0) {
                pg8::Gemm gt{(const bf16*)(ws + WS_MB), (const bf16*)(ws + WS_WOUT), MT, D, 256, D};
                pg8::CtxSliceOrder St; St.init(4, G, bx);
                pg8::EpiCtxPartial Et{(bf16*)(ws + WS_CPO)};
                pg8::gemm_phase<pg8::EpiCtxPartial, pg8::CtxSliceOrder, true, true>(ldsl, gt, St, Et);
                if (ALL_MEGA && (int)bx >= (G > 64 ? 64 : 0)) {
                    const P& pa = args.p; const int n2 = G > 64 ? 64 : 0, rank = (int)bx - n2, nid = G - n2; float* scr = (float*)(lds + wave * 16384);
                    for (int it = IT_EARLY - IT_F13 - IT_F2 + rank * NWAVES + wave; it < IT_EARLY - IT_F2; it += nid * NWAVES) prep_item(pa, it, scr, OPQ(lane));
                    for (int it = IT_DEF1 + rank * NWAVES + wave; it < IT_DEFA; it += nid * NWAVES) prep_item(pa, it, scr, OPQ(lane)); }
                }
        }
        SEAM(pb + 5);
        if (l == 0) {
            if (KEN(8) && IN(pb + 6)) { const P p = load_p(); for (int rep_ = 0; rep_ < NREP(8); ++rep_) ph_norm(p, l, 1, MT, OPQ(gw), NGW, OPQ(lane)); }
            SEAM(pb + 6);
            if (KEN(9) && IN(pb + 7)) { const P p = load_p(); unsigned char* ws = p.ws;
                pg8::Gemm g{(const bf16*)(ws + WS_H8), (const bf16*)(ws + WS_FFN13), MT, 2 * DFF, D / 2, D / 2, SC_W13, SC_ONE};
                pg8::StaticOrder S; S.init(MT, 2 * DFF, G, bx);
                pg8::EpiSwiglu E{(bf16*)(ws + WS_HMID), DFF, 1 << 20};
                for (int rep_ = 0; rep_ < NREP(9); ++rep_) pg8::gemm_phase<pg8::EpiSwiglu, pg8::StaticOrder, true, true, true>(ldsl, g, S, E);
                if (ALL_MEGA && (MT / 256 * 22) % G != 0 && (int)bx >= (MT / 256 * 22) % G) {
                    const P& pa = args.p; const int n2 = (MT / 256 * 22) % G, rank = (int)bx - n2, nid = G - n2; float* scr = (float*)(lds + wave * 16384);
                    for (int it = IT_EARLY - IT_F2 + rank * NWAVES + wave; it < IT_EARLY; it += nid * NWAVES) prep_item(pa, it, scr, OPQ(lane)); }
                else if (ALL_MEGA && (MT / 256 * 22) % G == 0) { const P& pa = args.p; float* scr = (float*)(lds + wave * 16384);
                    for (int it = IT_EARLY - IT_F2 + (int)bx * NWAVES + wave; it < IT_EARLY; it += G * NWAVES) prep_item(pa, it, scr, OPQ(lane)); }
            }
            SEAM(pb + 7);
            if (KEN(10) && IN(pb + 8)) { const P p = load_p(); unsigned char* ws = p.ws;
                pg8::Gemm g{(const bf16*)(ws + WS_HMID), (const bf16*)(ws + WS_FFN2), M_LAT, D, DFF, DFF};
                pg8::StaticOrder S; S.init(M_LAT, D, G, bx);
                pg8::EpiResid E{(const float*)nullptr, (bf16*)(ws + WS_XB), modv(p, 0, 0, 5)};
                pg8::gemm_phase<pg8::EpiResid, pg8::StaticOrder, true, true>(ldsl, g, S, E);
                {
                    pg8::Gemm gt{(const bf16*)(ws + WS_HMID), (const bf16*)(ws + WS_FFN2), MT, D, 256, DFF};
                    pg8::CtxSliceOrder St; St.init(11, G, bx);
                    pg8::EpiCtxPartial Et{(bf16*)(ws + WS_CPF)};
                    pg8::gemm_phase<pg8::EpiCtxPartial, pg8::CtxSliceOrder, true, true>(ldsl, gt, St, Et);
                    }
            }
            SEAM(pb + 8);
        } else {
            if (KEN(11) && IN(pb + 6)) { const P p = load_p(); ph_router(p, vcu, G, NWAVES, lds, OPQ(tid)); }
            if (IN(pb + 6) && IN(pb + 8)) xcd_barrier(bar);
            if (KEN(13) && IN(pb + 8)) { const P p = load_p(); unsigned char* ws = p.ws;
                int base[9]; moe_bases(p, base);
                pg8::Gemm g{(const bf16*)(ws + WS_H2PX), (const bf16*)(ws + WS_MOE13), base[8], 8 * 2 * DFFX, D / 2, D / 2, SC_W13, SC_ONE, 1};
                pg8::MoeOrder S; S.init(base, 28, G, bx);
                pg8::EpiSwigluF8 E{(unsigned char*)(ws + WS_HMX), DFFX, 28};
                for (int rep_ = 0; rep_ < NREP(13); ++rep_) pg8::gemm_phase<pg8::EpiSwigluF8, pg8::MoeOrder, true, true, true>(ldsl, g, S, E);
            }
            SEAM(pb + 8);
            if (KEN(14) && IN(pb + 9)) { const P p = load_p(); unsigned char* ws = p.ws;
                int base[9]; moe_bases(p, base);
                pg8::Gemm g{(const bf16*)(ws + WS_HMX), (const bf16*)(ws + WS_MOE2), base[8], 8 * D, DFFX / 2, DFFX / 2, SC_W2, SC_HM};
                pg8::MoeOrder S; S.init(base, 4, G, bx, 128);
                pg8::EpiMoeDown E{(bf16*)(ws + WS_H2P), (const float*)(ws + WS_EXPP)};
                for (int rep_ = 0; rep_ < NREP(14); ++rep_) pg8::gemm_phase<pg8::EpiMoeDown, pg8::MoeOrder, true, true, true>(ldsl, g, S, E);
                {
                    pg8::Gemm gt{(const bf16*)(ws + WS_HMX), (const bf16*)(ws + WS_MOE2), base[8], 8 * D, 256, DFFX / 2, SC_W2, SC_HM};
                    pg8::MoeTailOrder St; St.init(base, G, bx);
                    pg8::EpiMoeDownTail Et{(bf16*)(ws + WS_YPT), (const float*)(ws + WS_EXPP)};
                    pg8::gemm_phase<pg8::EpiMoeDownTail, pg8::MoeTailOrder, true, true, true>(ldsl, gt, St, Et); }
            }
            SEAM(pb + 9);
            if (KEN(15) && IN(pb + 10)) { const P p = load_p(); ph_final(p, OPQ(gw), NGW, OPQ(lane)); }
        }
    }
#undef IN
#undef SEAM
}
constexpr int N_PHASES = 21;

#if !ALL_MEGA
__global__ void __launch_bounds__(256) k_prep(P p) {
    __shared__ float scr[4][64 * 33];
    const int wave = threadIdx.x >> 6, lane = threadIdx.x & 63;
    for (int it = blockIdx.x * 4 + wave; it < IT_TOTAL; it += gridDim.x * 4) prep_item(p, it, scr[wave], lane);
}
__global__ void __launch_bounds__(512) k_mod(P p) { __shared__ float sm[8 * 5 * 64 + 5 * 1024]; for (int it = blockIdx.x; it < 192; it += gridDim.x) ph_mod_item(p, it, sm, threadIdx.x); if (blockIdx.x == 0) ph_misc(p, threadIdx.x, 512); }
__global__ void __launch_bounds__(256) k_norm(P p, int l, int which, int nrows) { ph_norm(p, l, which, nrows, blockIdx.x * 4 + (threadIdx.x >> 6), gridDim.x * 4, threadIdx.x & 63); }
__global__ void __launch_bounds__(256) k_router(P p) { __shared__ __attribute__((aligned(16))) unsigned char sm[4096 + 65536 - 4096]; ph_router(p, blockIdx.x, gridDim.x, 4, sm, threadIdx.x); }
__global__ void __launch_bounds__(256) k_final(P p) { ph_final(p, blockIdx.x * 4 + (threadIdx.x >> 6), gridDim.x * 4, threadIdx.x & 63); }
__global__ void __launch_bounds__(256) k_occomb(P p, int l, int nrows) { ph_occomb(p, l, nrows, blockIdx.x * 4 + (threadIdx.x >> 6), gridDim.x * 4, threadIdx.x & 63); }
__global__ void __launch_bounds__(512, 2) k_conv(P p, int l, int ntiles) { extern __shared__ __attribute__((aligned(16))) unsigned char sm[]; for (int t = blockIdx.x; t < ntiles; t += gridDim.x) { int tid = threadIdx.x; asm volatile("" : "+v"(tid)); conv_tile(p, l, t, sm, tid); } }
__global__ void __launch_bounds__(256) k_attn(P p, int typeC) {
    __shared__ float Ks[32][64], Vs[32][64];
    const int qb = blockIdx.x, vh = blockIdx.y, tid = threadIdx.x;
    const bf16 *Q, *K, *V; bf16* O; int qp, kp, op;
    if (!typeC) { Q = (const bf16*)(p.ws + WS_QA) + vh * 64; qp = 512; K = (const bf16*)(p.ws + WS_KA) + (vh / 4) * 64; V = (const bf16*)(p.ws + WS_VA) + (vh / 4) * 64; kp = 128; O = (bf16*)(p.ws + WS_OABC) + vh * 64; op = 1536; }
    else { Q = (const bf16*)(p.ws + WS_QC) + (vh >> 1) * 64; qp = 512; K = (const bf16*)(p.ws + WS_KC) + (vh >> 1) * 64; V = (const bf16*)(p.ws + WS_VC) + (vh >> 2) * 128 + (vh & 1) * 64; kp = 512; O = (bf16*)(p.ws + WS_OCR) + vh * 64; op = 1024; }
    int k0, nk; if (qb < 64) { k0 = (qb / 16) * NKEY; nk = NKEY; } else { k0 = (qb - 64) * NKEY + SEQ; nk = CTXL; }
    const int row = qb * 256 + tid;
    float q[64], o[64];
#pragma unroll
    for (int d = 0; d < 64; ++d) { q[d] = bf2f(Q[(size_t)row * qp + d]); o[d] = 0.f; }
    float m = -INFINITY, lsum = 0.f;
    for (int kt = 0; kt < nk; kt += 32) {
        __syncthreads();
        for (int i = tid; i < 32 * 64; i += 256) { const int kk = i >> 6, d = i & 63; Ks[kk][d] = bf2f(K[(size_t)(k0 + kt + kk) * kp + d]); Vs[kk][d] = bf2f(V[(size_t)(k0 + kt + kk) * kp + d]); }
        __syncthreads();
        float s[32]; float mx = m;
#pragma unroll
        for (int j = 0; j < 32; ++j) { float a = 0.f;
#pragma unroll
            for (int d = 0; d < 64; ++d) a += q[d] * Ks[j][d];
            s[j] = a; mx = fmaxf(mx, a); }
        const float alpha = exp2f(m - mx); m = mx; lsum *= alpha;
#pragma unroll
        for (int d = 0; d < 64; ++d) o[d] *= alpha;
#pragma unroll
        for (int j = 0; j < 32; ++j) { const float pj = exp2f(s[j] - m); lsum += pj;
#pragma unroll
            for (int d = 0; d < 64; ++d) o[d] += pj * Vs[j][d]; }
    }
    const float rl = 1.f / lsum;
#pragma unroll
    for (int d = 0; d < 64; d += 2) *(unsigned*)(O + (size_t)row * op + d) = pk2(o[d] * rl, o[d + 1] * rl);
}

struct TileCtx { float (*C)[257]; int rt64, pn, tid; };
template <class Epi> __global__ void __launch_bounds__(256) k_gemm(P p, Epi E, const bf16* A, int lda, const bf16* Bt, int ldb, int K) {
    extern __shared__ __attribute__((aligned(16))) float smem_g[];
    float (*As)[64] = (float (*)[64])smem_g;
    float (*Bs)[256] = (float (*)[256])(smem_g + 32 * 64);
    float (*Ct)[257] = (float (*)[257])(smem_g + 32 * 64 + 32 * 256);
    const int tid = threadIdx.x, tx = tid & 31, ty = tid >> 5, rt64 = blockIdx.x, pn = blockIdx.y;
    int bt; if (!E.map(p, rt64, pn, bt)) return;
    const bf16* Ab = A + (size_t)rt64 * 64 * lda; const bf16* Bb = Bt + (size_t)bt * 256 * ldb;
    float acc[8][8];
#pragma unroll
    for (int i = 0; i < 8; ++i)
#pragma unroll
        for (int j = 0; j < 8; ++j) acc[i][j] = 0.f;
    for (int k0 = 0; k0 < K; k0 += 32) {
        if (Epi::MIDK && (k0 == 512 || k0 == 1024)) E.mid(p, acc, rt64 * 64 + ty * 8, pn, tx, k0 / 512);
        __syncthreads();
        { const int r = tid >> 2, kq = (tid & 3) * 8; const u32x4 v = *(const u32x4*)(Ab + (size_t)r * lda + k0 + kq);
            As[kq + 0][r] = __uint_as_float(v.x << 16); As[kq + 1][r] = __uint_as_float(v.x & 0xffff0000u); As[kq + 2][r] = __uint_as_float(v.y << 16); As[kq + 3][r] = __uint_as_float(v.y & 0xffff0000u);
            As[kq + 4][r] = __uint_as_float(v.z << 16); As[kq + 5][r] = __uint_as_float(v.z & 0xffff0000u); As[kq + 6][r] = __uint_as_float(v.w << 16); As[kq + 7][r] = __uint_as_float(v.w & 0xffff0000u); }
#pragma unroll
        for (int q4 = 0; q4 < 4; ++q4) { const u32x4 v = *(const u32x4*)(Bb + (size_t)tid * ldb + k0 + q4 * 8); const int kq = q4 * 8;
            Bs[kq + 0][tid] = __uint_as_float(v.x << 16); Bs[kq + 1][tid] = __uint_as_float(v.x & 0xffff0000u); Bs[kq + 2][tid] = __uint_as_float(v.y << 16); Bs[kq + 3][tid] = __uint_as_float(v.y & 0xffff0000u);
            Bs[kq + 4][tid] = __uint_as_float(v.z << 16); Bs[kq + 5][tid] = __uint_as_float(v.z & 0xffff0000u); Bs[kq + 6][tid] = __uint_as_float(v.w << 16); Bs[kq + 7][tid] = __uint_as_float(v.w & 0xffff0000u); }
        __syncthreads();
#pragma unroll 4
        for (int k = 0; k < 32; ++k) { float a[8], b[8];
#pragma unroll
            for (int i = 0; i < 8; ++i) a[i] = As[k][ty * 8 + i];
#pragma unroll
            for (int j = 0; j < 8; ++j) b[j] = Bs[k][tx + 32 * j];
#pragma unroll
            for (int i = 0; i < 8; ++i)
#pragma unroll
                for (int j = 0; j < 8; ++j) acc[i][j] += a[i] * b[j]; }
    }
    if (Epi::MIDK) E.mid(p, acc, rt64 * 64 + ty * 8, pn, tx, 3);
#pragma unroll
    for (int i = 0; i < 8; ++i)
#pragma unroll
        for (int j = 0; j < 8; ++j) Ct[ty * 8 + i][tx + 32 * j] = acc[i][j];
    __syncthreads();
    TileCtx c{Ct, rt64, pn, tid};
    E.tile(p, c);
}
struct NInproj {
    static constexpr bool MIDK = false; int l;
    __device__ bool map(const P&, int, int pn, int& bt) const { bt = pn; return true; }
    __device__ void mid(const P&, float (&)[8][8], int, int, int, int) const {}
    __device__ void tile(const P& p, const TileCtx& t) const {
        const int c = t.tid, pn = t.pn, bj = c >> 7, hh = (c >> 5) & 3, j32 = c & 31, d = 32 * bj + j32, f = j32 & 15, nh = (j32 >> 4) & 1;
        const float* cosT = (const float*)(p.ws + WS_ROPE); const float* sinT = cosT + 1024;
        for (int r = 0; r < 64; ++r) {
            const int row = t.rt64 * 64 + r; const float v = t.C[r][c];
            if (pn < 3 || (pn >= 7 && pn < 11)) {
                const bool isq = pn < 2 || (pn >= 7 && pn < 9), isA = pn < 3, isv = (pn == 2 && hh >= 2);
                float x = v, xp = t.C[r][c ^ 16];
                if (isA && !isv) { float ss = 0.f;
                    for (int dd = 0; dd < 64; ++dd) { const float u = t.C[r][128 * (dd >> 5) + 32 * hh + (dd & 31)]; ss += u * u; }
                    const float rinv = 1.f / sqrtf(ss * (1.f / 64.f) + EPS); const float* g = p.in[isq ? 10 : 11] + l * 64;
                    x = x * rinv * g[d]; xp = xp * rinv * g[d ^ 16]; }
                float o = x;
                if (!isv && row < M_LAT) { const int tpos = row % SEQ, pos = bj ? (tpos % 64) : (tpos / 64); const float cs = cosT[pos * 16 + f], sn = sinT[pos * 16 + f];
                    o = nh ? (x * cs + xp * sn) : (x * cs - xp * sn); }
                if (isq) o *= C2;
                bf16* dst;
                if (pn < 2) dst = (bf16*)(p.ws + WS_QA) + (size_t)row * 512 + (4 * pn + hh) * 64 + d;
                else if (pn == 2) dst = (bf16*)(p.ws + (hh < 2 ? WS_KA : WS_VA)) + (size_t)keyrow(row) * 128 + (hh & 1) * 64 + d;
                else if (pn < 9) dst = (bf16*)(p.ws + WS_QC) + (size_t)row * 512 + (4 * (pn - 7) + hh) * 64 + d;
                else dst = (bf16*)(p.ws + WS_KC) + (size_t)keyrow(row) * 512 + (4 * (pn - 9) + hh) * 64 + d;
                *dst = (bf16)f2bf(o);
            } else if (pn < 7) {
                if (c < 128) { const float gt = t.C[r][c + 128]; ((bf16*)(p.ws + WS_Y))[(size_t)row * 512 + (pn - 3) * 128 + pcol(c)] = (bf16)f2bf(v * sigmoidf_(gt)); }
            } else if (pn < 13) {
                ((bf16*)(p.ws + WS_VC))[(size_t)keyrow(row) * 512 + (pn - 11) * 256 + pcol(c)] = (bf16)f2bf(v);
            } else {
                const int gc = (pn - 13) * 256 + pcol(c);
                ((bf16*)(p.ws + WS_G))[(size_t)row * 3072 + gc] = (bf16)f2bf(sigmoidf_(v + p.in[9][l * 3072 + gc]));
            }
        }
    }
};
struct NMerge {
    static constexpr bool MIDK = true; int pad_;
    __device__ bool map(const P&, int, int pn, int& bt) const { bt = pn; return true; }
    __device__ void mid(const P& p, float (&acc)[8][8], int row0, int pn, int tx, int seg  ) const {
        const bf16* G = (const bf16*)(p.ws + WS_G);
#pragma unroll
        for (int i = 0; i < 8; ++i)
#pragma unroll
            for (int j = 0; j < 8; ++j) { const int col = pn * 256 + pcol(tx + 32 * j); const size_t o = (size_t)(row0 + i) * 3072 + col;
                const float f = seg == 3 ? bf2f(G[o + 2048]) : bf2f(G[o + (seg - 1) * 1024]) / bf2f(G[o + seg * 1024]); acc[i][j] *= f; }
    }
    __device__ void tile(const P& p, const TileCtx& t) const {
        for (int r = 0; r < 64; ++r) ((bf16*)(p.ws + WS_MB))[(size_t)(t.rt64 * 64 + r) * D + t.pn * 256 + pcol(t.tid)] = (bf16)f2bf(t.C[r][t.tid]);
    }
};
struct NResid {
    static constexpr bool MIDK = false; int l, gj  , first  ;
    __device__ bool map(const P&, int, int pn, int& bt) const { bt = pn; return true; }
    __device__ void mid(const P&, float (&)[8][8], int, int, int, int) const {}
    __device__ void tile(const P& p, const TileCtx& t) const {
        for (int r = 0; r < 64; ++r) { const int row = t.rt64 * 64 + r, col = t.pn * 256 + t.tid;
            const float b = first ? x0_row(p, row)[col] : xs_row(p, row)[col];
            xs_row(p, row)[col] = b + modv(p, l, bidx(row), gj)[col] * t.C[r][t.tid]; }
    }
};
struct NSwiglu {
    static constexpr bool MIDK = false; int moe;
    __device__ bool map(const P& p, int rt64, int pn, int& bt) const {
        if (!moe) { bt = pn; return true; }
        int base[9]; moe_bases(p, base); if (rt64 * 64 >= base[8]) return false;
        int e = 0;
#pragma unroll
        for (int q = 1; q < 8; ++q) if (rt64 * 64 >= base[q]) e = q;
        bt = e * 28 + pn; return true;
    }
    __device__ void mid(const P&, float (&)[8][8], int, int, int, int) const {}
    __device__ void tile(const P& p, const TileCtx& t) const {
        if (t.tid >= 128) return;
        bf16* O = (bf16*)(p.ws + (moe ? WS_HMX : WS_HMID)); const int ld = moe ? DFFX : DFF;
        for (int r = 0; r < 64; ++r) O[(size_t)(t.rt64 * 64 + r) * ld + t.pn * 128 + pcol(t.tid)] = (bf16)f2bf(siluf_(t.C[r][t.tid]) * t.C[r][t.tid + 128]);
    }
};
struct NMoeDown {
    static constexpr bool MIDK = false; int pad_;
    __device__ bool map(const P& p, int rt64, int pn, int& bt) const {
        int base[9]; moe_bases(p, base); if (rt64 * 64 >= base[8]) return false;
        int e = 0;
#pragma unroll
        for (int q = 1; q < 8; ++q) if (rt64 * 64 >= base[q]) e = q;
        bt = e * 4 + pn; return true;
    }
    __device__ void mid(const P&, float (&)[8][8], int, int, int, int) const {}
    __device__ void tile(const P& p, const TileCtx& t) const {
        for (int r = 0; r < 64; ++r) { const int row = t.rt64 * 64 + r;
            ((bf16*)(p.ws + WS_H2P))[(size_t)row * D + t.pn * 256 + pcol(t.tid)] = (bf16)f2bf(((const float*)(p.ws + WS_ROWP))[row] * t.C[r][t.tid]); }
    }
};


#endif

constexpr int GEMM_LDS = (32 * 64 + 32 * 256 + 64 * 257) * 4;
constexpr int CONV_LDS = CONV_LDS_BYTES;
#if !ALL_MEGA
static void launch_naive_phase(const P& p, int ph, hipStream_t stream) {
    unsigned char* ws = p.ws;
    if (ph == 0) { k_prep<<<1024, 256, 0, stream>>>(p); k_mod<<<192, 512, 0, stream>>>(p); return; }
    const int l = ph >= 10 ? 1 : 0, k = ph - (l ? 10 : 1), nrows = l == 0 ? MT : M_LAT;
    switch (k) {
    case 0: k_norm<<<1024, 256, 0, stream>>>(p, l, 0, MT); break;
    case 1: k_gemm<NInproj><<<dim3(MT / 64, 25), 256, GEMM_LDS, stream>>>(p, NInproj{l}, (const bf16*)(ws + WS_H), D, (const bf16*)(ws + WS_WIN) + (size_t)l * IN_W * D, D, D); break;
    case 2: k_conv<<<320, 512, CONV_LDS, stream>>>(p, l, l == 0 ? CONV_TILES_ALL : CONV_TILES_LAT);
            k_attn<<<dim3(nrows / 256, 8), 256, 0, stream>>>(p, 0); k_attn<<<dim3(nrows / 256, 16), 256, 0, stream>>>(p, 1); break;
    case 3: k_occomb<<<1024, 256, 0, stream>>>(p, l, nrows); break;
    case 4: k_gemm<NMerge><<<dim3(nrows / 64, 4), 256, GEMM_LDS, stream>>>(p, NMerge{0}, (const bf16*)(ws + WS_OABC), 1536, (const bf16*)(ws + WS_WP) + (size_t)l * D * 1536, 1536, 1536); break;
    case 5: k_gemm<NResid><<<dim3(nrows / 64, 4), 256, GEMM_LDS, stream>>>(p, NResid{l, 2, l == 0}, (const bf16*)(ws + WS_MB), D, (const bf16*)(ws + WS_WOUT) + (size_t)l * D * D, D, D); break;
    case 6: if (l == 0) k_norm<<<1024, 256, 0, stream>>>(p, l, 1, MT); else k_router<<<1024, 256, 0, stream>>>(p); break;
    case 7: if (l == 0) k_gemm<NSwiglu><<<dim3(MT / 64, 22), 256, GEMM_LDS, stream>>>(p, NSwiglu{0}, (const bf16*)(ws + WS_H), D, (const bf16*)(ws + WS_FFN13), D, D);
            break;
    case 8: if (l == 0) k_gemm<NResid><<<dim3(MT / 64, 4), 256, GEMM_LDS, stream>>>(p, NResid{l, 5, 0}, (const bf16*)(ws + WS_HMID), DFF, (const bf16*)(ws + WS_FFN2), DFF, DFF);
            else k_gemm<NSwiglu><<<dim3(RMAX / 64, 28), 256, GEMM_LDS, stream>>>(p, NSwiglu{1}, (const bf16*)(ws + WS_H2P), D, (const bf16*)(ws + WS_MOE13), D, D); break;
    case 9: k_gemm<NMoeDown><<<dim3(RMAX / 64, 4), 256, GEMM_LDS, stream>>>(p, NMoeDown{0}, (const bf16*)(ws + WS_HMX), DFFX, (const bf16*)(ws + WS_MOE2), DFFX, DFFX); break;
    case 10: k_final<<<1024, 256, 0, stream>>>(p); break;
    }
}
#endif
extern "C" void kernel_launch(void* const* d_in, const int* in_sizes, int n_in, void* d_out, int out_size, void* d_ws, size_t ws_size, hipStream_t stream) {
    static int grid = 0;
    if (grid == 0) {
        if (n_in != 34 || out_size != M_LAT * D || ws_size < WS_END2) { fprintf(stderr, "kernel_launch: unexpected shapes (n_in %d out %d ws %zu need %zu)\n", n_in, out_size, ws_size, (size_t)WS_END2); grid = -1; return; }
        int dev = 0, cus = 0, per_cu = 0;
        if (hipGetDevice(&dev) != hipSuccess || hipDeviceGetAttribute(&cus, hipDeviceAttributeMultiprocessorCount, dev) != hipSuccess) { grid = -1; return; }
        if (hipFuncSetAttribute((const void*)mega, hipFuncAttributeMaxDynamicSharedMemorySize, LDS_BYTES) != hipSuccess) { fprintf(stderr, "kernel_launch: hipFuncSetAttribute failed\n"); grid = -1; return; }
#if !ALL_MEGA
        (void)hipFuncSetAttribute((const void*)k_gemm<NInproj>, hipFuncAttributeMaxDynamicSharedMemorySize, GEMM_LDS);
        (void)hipFuncSetAttribute((const void*)k_gemm<NMerge>, hipFuncAttributeMaxDynamicSharedMemorySize, GEMM_LDS);
        (void)hipFuncSetAttribute((const void*)k_gemm<NResid>, hipFuncAttributeMaxDynamicSharedMemorySize, GEMM_LDS);
        (void)hipFuncSetAttribute((const void*)k_gemm<NSwiglu>, hipFuncAttributeMaxDynamicSharedMemorySize, GEMM_LDS);
        (void)hipFuncSetAttribute((const void*)k_gemm<NMoeDown>, hipFuncAttributeMaxDynamicSharedMemorySize, GEMM_LDS);
        (void)hipFuncSetAttribute((const void*)k_conv, hipFuncAttributeMaxDynamicSharedMemorySize, CONV_LDS);
#endif
        if (hipOccupancyMaxActiveBlocksPerMultiprocessor(&per_cu, (const void*)mega, NWAVES * 64, LDS_BYTES) != hipSuccess || per_cu < 1) fprintf(stderr, "kernel_launch: occupancy query says %d\n", per_cu);
        (void)hipGetLastError();
        grid = cus;
    }
    if (grid < 0) return;
    P p{};
    for (int i = 0; i < 34; ++i) p.in[i] = (const float*)d_in[i];
    p.out = (float*)d_out; p.ws = (unsigned char*)d_ws;
    (void)hipMemsetAsync((char*)d_ws + WS_CTL, 0, CTL_ZERO_BYTES, stream);
    const unsigned mask = MEGA_MASK;
    int li = 0;
    for (int ph = 0; ph < N_PHASES;) {
        if ((mask >> ph) & 1u) { int hi = ph; while (hi < N_PHASES && ((mask >> hi) & 1u)) ++hi;
#if !ALL_MEGA && defined(DBG_INPROJ)
            if (ph == 2) launch_naive_phase(p, 2, stream);
#endif
            Args a{}; a.p = p; a.ph_lo = ph; a.ph_hi = hi; a.li = li++; a.pad = 0;
            hipLaunchKernelGGL(mega, dim3(grid), dim3(NWAVES * 64), LDS_BYTES, stream, a);
            ph = hi; }
#if !ALL_MEGA
        else { launch_naive_phase(p, ph, stream); ++ph; }
#else
        else ++ph;
#endif
    }
}
```
